# Optimizing an MI355X kernel written in HIP

```python
import math
import jax
import jax.numpy as jnp
from jax import lax
import numpy as np

D_MODEL = 1024
BATCH = 8
SEQ = 4096
DEPTH = 2

GRID_W = 64
CTX_LEN = 256

N_MIXERS = 4
GROUP_WIDTH = D_MODEL // N_MIXERS
GROUP_HEADS = 4

SGU_CHUNK = 128
SGU_GROUPS = GROUP_HEADS

DIFF_HEADS = GROUP_HEADS
DIFF_V_DIM = GROUP_WIDTH // DIFF_HEADS
DIFF_QK_DIM = DIFF_V_DIM // 2

HGRN_HEADS = GROUP_HEADS
HGRN_KEY_DIM = 64
HGRN_VAL_DIM = GROUP_WIDTH // HGRN_HEADS
SCAN_CHUNK = 32

MLA_HEADS = GROUP_HEADS
MLA_Q_LORA = 256
MLA_KV_LORA = 128
MLA_NOPE_DIM = 64
MLA_ROPE_DIM = 32
MLA_V_DIM = GROUP_WIDTH // MLA_HEADS

ROPE_BASE = 10000.0
Q_BLOCK = 128

N_EXPERTS = 32
TOP_K = 4
D_EXPERT = D_MODEL
SWIGLU_ALPHA = 1.702
SWIGLU_LIMIT = 7.0
MOE_BLOCK = 256

NORM_EPS = 1e-6
DEEPNORM_ALPHA = (2 * DEPTH) ** 0.25
DEEPNORM_BETA = (8 * DEPTH) ** -0.25

COL_SIZES = (
    2 * GROUP_WIDTH,
    DIFF_HEADS * 2 * DIFF_QK_DIM,
    DIFF_HEADS * 2 * DIFF_QK_DIM,
    DIFF_HEADS * DIFF_V_DIM,
    HGRN_HEADS * HGRN_KEY_DIM,
    HGRN_HEADS * HGRN_VAL_DIM,
    HGRN_HEADS * HGRN_KEY_DIM,
    HGRN_HEADS * HGRN_KEY_DIM,
    GROUP_WIDTH,
    MLA_Q_LORA,
    MLA_KV_LORA,
    MLA_ROPE_DIM,
)
IN_COLS = sum(COL_SIZES)

kernel_name = 'hybrid_parallel_group_dit_block'


def layer_norm(x, w=None, b=None):
    xf = x.astype(jnp.float32)
    mu = jnp.mean(xf, axis=-1, keepdims=True)
    xc = xf - mu
    y = xc * lax.rsqrt(jnp.mean(xc * xc, axis=-1, keepdims=True) + NORM_EPS)
    if w is not None:
        y = y * w + b
    return y.astype(x.dtype)


def rms_norm(x, w):
    xf = x.astype(jnp.float32)
    y = xf * lax.rsqrt(jnp.mean(xf * xf, axis=-1, keepdims=True) + NORM_EPS)
    return (y * w).astype(x.dtype)


def modulate(h, shift, scale):
    return h * (1.0 + scale) + shift


def to_heads(t, n_heads):
    bsz, n, _ = t.shape
    return t.reshape(bsz, n, n_heads, -1).transpose(0, 2, 1, 3)


def from_heads(t):
    bsz, nh, n, hd = t.shape
    return t.transpose(0, 2, 1, 3).reshape(bsz, n, nh * hd)


def split_cols(p):
    bounds = [int(b) for b in np.cumsum(COL_SIZES)[:-1]]
    return jnp.split(p, bounds, axis=-1)


def grid_angles(n, rot_dim):
    rows = n // GRID_W
    row = jnp.repeat(jnp.arange(rows, dtype=jnp.float32), GRID_W)
    col = jnp.tile(jnp.arange(GRID_W, dtype=jnp.float32), rows)
    axis_dim = rot_dim // 2
    inv_freq = ROPE_BASE ** (-jnp.arange(0, axis_dim, 2, dtype=jnp.float32) / axis_dim)
    return row[:, None] * inv_freq, col[:, None] * inv_freq


def rope_1d(x, ang):
    cos = jnp.cos(ang).astype(x.dtype)
    sin = jnp.sin(ang).astype(x.dtype)
    x1, x2 = jnp.split(x, 2, axis=-1)
    return jnp.concatenate([x1 * cos - x2 * sin, x2 * cos + x1 * sin], axis=-1)


def axial_rope(x, ang_row, ang_col):
    xr, xc = jnp.split(x, 2, axis=-1)
    return jnp.concatenate([rope_1d(xr, ang_row), rope_1d(xc, ang_col)], axis=-1)


def sweep_query_blocks(attend, q):
    *lead, n, hd = q.shape
    nb = n // Q_BLOCK
    qb = jnp.moveaxis(q.reshape(*lead, nb, Q_BLOCK, hd), -3, 0)
    out = jnp.moveaxis(lax.map(attend, qb), 0, -3)
    return out.reshape(*out.shape[:-3], n, out.shape[-1])


def softmax_attend(q, k, v, scale):
    s = jnp.einsum('bhqd,bhsd->bhqs', q, k).astype(jnp.float32) * scale
    p = jax.nn.softmax(s, axis=-1)
    return jnp.einsum('bhqs,bhsv->bhqv', p.astype(v.dtype), v)


def diff_attend(q, k, v, lam, scale):
    s = jnp.einsum('bhmqd,bhmsd->bhmqs', q, k).astype(jnp.float32) * scale
    p = jax.nn.softmax(s, axis=-1)
    a = p[:, :, 0] - lam * p[:, :, 1]
    return jnp.einsum('bhqs,bhsv->bhqv', a.astype(v.dtype), v)


def diff_qk_heads(t):
    bsz, n, _ = t.shape
    return t.reshape(bsz, n, DIFF_HEADS, 2, DIFF_QK_DIM).transpose(0, 2, 3, 1, 4)


def spatial_gating(uv, ln_w, ln_b, w_s, b_s):
    uv = jax.nn.gelu(uv, approximate=False)
    u, v = jnp.split(uv, 2, axis=-1)
    v = layer_norm(v, ln_w, ln_b)
    bsz, n, _ = v.shape
    v = v.reshape(bsz, n // SGU_CHUNK, SGU_CHUNK, SGU_GROUPS, -1)
    v = jnp.einsum('gts,bnsgc->bntgc', w_s, v) + b_s.T[None, None, :, :, None]
    return u * v.reshape(bsz, n, -1)


def differential_attention(q, k, v, qc, kc, vc, lam_p, subln_w, lam_init, ang, need_ctx):
    scale = DIFF_QK_DIM ** -0.5
    lam_p = lam_p.astype(jnp.float32)
    lam = jnp.exp(jnp.sum(lam_p[0] * lam_p[1])) - jnp.exp(jnp.sum(lam_p[2] * lam_p[3])) + lam_init

    def post(o):
        return from_heads(rms_norm(o, subln_w) * (1.0 - lam_init))

    kc_h = diff_qk_heads(kc)
    vc_h = to_heads(vc, DIFF_HEADS)
    k_all = jnp.concatenate([kc_h, axial_rope(diff_qk_heads(k), *ang)], axis=3)
    v_all = jnp.concatenate([vc_h, to_heads(v, DIFF_HEADS)], axis=2)
    q_h = axial_rope(diff_qk_heads(q), *ang)
    o = sweep_query_blocks(lambda qb: diff_attend(qb, k_all, v_all, lam, scale), q_h)
    o_ctx = post(diff_attend(diff_qk_heads(qc), kc_h, vc_h, lam, scale)) if need_ctx else None
    return post(o), o_ctx


def forget_gate(f_raw, lb_vec):
    lb_h = lb_vec.reshape(HGRN_HEADS, 1, HGRN_KEY_DIM)
    f = lb_h + (1.0 - lb_h) * jax.nn.sigmoid(f_raw.astype(jnp.float32))
    return 1.0 - f, jnp.log(f)


def gla_chunked(q, k, v, log_f, s0):
    bsz, nh, n, _ = q.shape
    dv = v.shape[-1]
    nc = n // SCAN_CHUNK

    def chunk(t):
        return t.reshape(bsz, nh, nc, SCAN_CHUNK, t.shape[-1])

    q, k, v, log_f = chunk(q), chunk(k), chunk(v), chunk(log_f)
    b = jnp.cumsum(log_f, axis=3)
    b_last = b[:, :, :, -1:, :]
    q_dec = q * jnp.exp(b)
    scores = jnp.einsum('bhnik,bhnjk->bhnij', q_dec, k * jnp.exp(-b))
    lower = jnp.tril(jnp.ones((SCAN_CHUNK, SCAN_CHUNK), dtype=bool))
    o_intra = jnp.einsum('bhnij,bhnjv->bhniv', jnp.where(lower, scores, 0.0), v)
    d_state = jnp.einsum('bhnjk,bhnjv->bhnkv', k * jnp.exp(b_last - b), v)
    chunk_decay = jnp.exp(b_last[:, :, :, 0, :])

    def step(state, inp):
        dec, ds = inp
        return dec[..., None] * state + ds, state

    s_final, s_enter = lax.scan(step, s0, (jnp.moveaxis(chunk_decay, 2, 0), jnp.moveaxis(d_state, 2, 0)))
    o_inter = jnp.einsum('bhnik,bhnkv->bhniv', q_dec, jnp.moveaxis(s_enter, 0, 2))
    return (o_intra + o_inter).reshape(bsz, nh, n, dv), s_final


def bidirectional_scan(q, v, k_f, log_f_f, k_b, log_f_b, s0_f, s0_b):
    def flip(t):
        return jnp.flip(t, axis=2)

    o_f, s_f = gla_chunked(q, k_f, v, log_f_f, s0_f)
    o_b, s_b = gla_chunked(flip(q), flip(k_b), flip(v), flip(log_f_b), s0_b)
    return o_f + flip(o_b), s_f, s_b


def hgrn2_bidirectional(q, i, ff, fb, g, qc, ic, ffc, fbc, gc, lb, norm_w, need_ctx):
    def prep(q_, i_, ff_, fb_):
        qh = jax.nn.silu(to_heads(q_, HGRN_HEADS).astype(jnp.float32))
        vh = to_heads(i_, HGRN_HEADS).astype(jnp.float32)
        k_f, log_f_f = forget_gate(to_heads(ff_, HGRN_HEADS), lb[0])
        k_b, log_f_b = forget_gate(to_heads(fb_, HGRN_HEADS), lb[1])
        return qh, vh, k_f, log_f_f, k_b, log_f_b

    def readout(o, g_):
        return (from_heads(rms_norm(o, norm_w)) * jax.nn.silu(g_.astype(jnp.float32))).astype(g_.dtype)

    s0 = jnp.zeros((q.shape[0], HGRN_HEADS, HGRN_KEY_DIM, HGRN_VAL_DIM), jnp.float32)
    o_c, s_f, s_b = bidirectional_scan(*prep(qc, ic, ffc, fbc), s0, s0)
    o, _, _ = bidirectional_scan(*prep(q, i, ff, fb), s_f, s_b)
    return readout(o, g), (readout(o_c, gc) if need_ctx else None)


def latent_attention(cq, ckv, kr, cqc, ckvc, krc, q_norm_w, w_uq, kv_norm_w, w_ukv, ang, need_ctx):
    scale = (MLA_NOPE_DIM + MLA_ROPE_DIM) ** -0.5

    def queries(cq_, rotate):
        qf = to_heads(rms_norm(cq_, q_norm_w) @ w_uq, MLA_HEADS)
        q_nope, q_rope = qf[..., :MLA_NOPE_DIM], qf[..., MLA_NOPE_DIM:]
        if rotate:
            q_rope = axial_rope(q_rope, *ang)
        return jnp.concatenate([q_nope, q_rope], axis=-1)

    def keys_values(ckv_, kr_, rotate):
        kvf = to_heads(rms_norm(ckv_, kv_norm_w) @ w_ukv, MLA_HEADS)
        k_nope, v = kvf[..., :MLA_NOPE_DIM], kvf[..., MLA_NOPE_DIM:]
        k_rope = kr_[:, None]
        if rotate:
            k_rope = axial_rope(k_rope, *ang)
        k_rope = jnp.broadcast_to(k_rope, k_nope.shape[:-1] + (MLA_ROPE_DIM,))
        return jnp.concatenate([k_nope, k_rope], axis=-1), v

    kc, vc = keys_values(ckvc, krc, False)
    k, v = keys_values(ckv, kr, True)
    k_all = jnp.concatenate([kc, k], axis=2)
    v_all = jnp.concatenate([vc, v], axis=2)
    o = sweep_query_blocks(lambda qb: softmax_attend(qb, k_all, v_all, scale), queries(cq, True))
    o_ctx = from_heads(softmax_attend(queries(cqc, False), kc, vc, scale)) if need_ctx else None
    return from_heads(o), o_ctx


def hybrid_mixer(h, hc, w_in, w_out, sgu_ln_w, sgu_ln_b, sgu_w, sgu_b,
                 diff_lam, diff_subln_w, lam_init, hgrn_lb, hgrn_norm_w,
                 mla_q_norm_w, mla_w_uq, mla_kv_norm_w, mla_w_ukv,
                 ang_diff, ang_mla, need_ctx):
    (a_uv, b_q, b_k, b_v, c_q, c_i, c_ff, c_fb, c_g, d_cq, d_ckv, d_kr) = split_cols(h @ w_in)
    (a_uvc, b_qc, b_kc, b_vc, c_qc, c_ic, c_ffc, c_fbc, c_gc, d_cqc, d_ckvc, d_krc) = split_cols(hc @ w_in)

    o_a = spatial_gating(a_uv, sgu_ln_w, sgu_ln_b, sgu_w, sgu_b)
    o_b, o_bc = differential_attention(b_q, b_k, b_v, b_qc, b_kc, b_vc, diff_lam, diff_subln_w,
                                       lam_init, ang_diff, need_ctx)
    o_c, o_cc = hgrn2_bidirectional(c_q, c_i, c_ff, c_fb, c_g, c_qc, c_ic, c_ffc, c_fbc, c_gc,
                                    hgrn_lb, hgrn_norm_w, need_ctx)
    o_d, o_dc = latent_attention(d_cq, d_ckv, d_kr, d_cqc, d_ckvc, d_krc, mla_q_norm_w, mla_w_uq,
                                 mla_kv_norm_w, mla_w_ukv, ang_mla, need_ctx)
    dt = h.dtype
    y = jnp.concatenate([o_a.astype(dt), o_b.astype(dt), o_c.astype(dt), o_d.astype(dt)], axis=-1) @ w_out
    if not need_ctx:
        return y, None
    o_ac = spatial_gating(a_uvc, sgu_ln_w, sgu_ln_b, sgu_w, sgu_b)
    yc = jnp.concatenate([o_ac.astype(dt), o_bc.astype(dt), o_cc.astype(dt), o_dc.astype(dt)], axis=-1) @ w_out
    return y, yc


def clamped_swiglu(hid):
    glu, lin = hid[..., ::2], hid[..., 1::2]
    glu = jnp.minimum(glu, SWIGLU_LIMIT)
    lin = jnp.clip(lin, -SWIGLU_LIMIT, SWIGLU_LIMIT)
    return glu * jax.nn.sigmoid(SWIGLU_ALPHA * glu) * (lin + 1.0)


def moe_ffn(h, router_w, router_b, w1, b1, w2, b2):
    n_tok, d = h.shape
    logits = (h @ router_w + router_b).astype(jnp.float32)
    top_val, top_idx = lax.top_k(logits, TOP_K)
    gate = jax.nn.softmax(top_val, axis=-1)
    n_assign = n_tok * TOP_K
    flat_e = top_idx.reshape(-1)
    order = jnp.argsort(flat_e)
    sorted_e = flat_e[order]
    sorted_tok = (order // TOP_K).astype(jnp.int32)
    sorted_gate = gate.reshape(-1)[order]
    counts = jnp.bincount(flat_e, length=N_EXPERTS)
    padded = (counts + MOE_BLOCK - 1) // MOE_BLOCK * MOE_BLOCK
    pad_end = jnp.cumsum(padded)
    pad_start = pad_end - padded
    grp_start = jnp.cumsum(counts) - counts
    dest = pad_start[sorted_e] + jnp.arange(n_assign) - grp_start[sorted_e]
    n_blocks = -(-n_assign // MOE_BLOCK) + N_EXPERTS
    n_rows = n_blocks * MOE_BLOCK
    buf_tok = jnp.zeros((n_rows,), jnp.int32).at[dest].set(sorted_tok)
    buf_gate = jnp.zeros((n_rows,), jnp.float32).at[dest].set(sorted_gate)
    block_e = jnp.minimum(jnp.searchsorted(pad_end, jnp.arange(n_blocks) * MOE_BLOCK, side='right'),
                          N_EXPERTS - 1)

    def expert_block(args):
        tok_b, gate_b, e = args
        xb = h[tok_b]
        a = clamped_swiglu(xb @ w1[e] + b1[e])
        return (a @ w2[e] + b2[e]) * gate_b[:, None].astype(h.dtype)

    ys = lax.map(expert_block, (buf_tok.reshape(n_blocks, MOE_BLOCK),
                                buf_gate.reshape(n_blocks, MOE_BLOCK), block_e))
    return jnp.zeros_like(h).at[buf_tok].add(ys.reshape(n_rows, d).astype(h.dtype))


def setup_inputs(seed: int = 0) -> dict:
    key = jax.random.key(seed)
    ks = jax.random.split(key, 30)
    L, D, E, F = DEPTH, D_MODEL, N_EXPERTS, D_EXPERT

    def nrm(k, shape, s):
        return jax.random.normal(k, shape, jnp.float32) * s

    def gain(k, shape):
        return 1.0 + nrm(k, shape, 0.02)

    return {
        'x': nrm(ks[0], (BATCH, SEQ, D), 1.0),
        'c': nrm(ks[1], (BATCH, D), 1.0),
        'ctx': nrm(ks[2], (BATCH, CTX_LEN, D), 1.0),
        'c_ctx': nrm(ks[3], (D,), 1.0),
        'ada_w': nrm(ks[4], (L, D, 6 * D), 0.5 * D ** -0.5),
        'ada_b': nrm(ks[5], (L, 6 * D), 0.02),
        'w_in': nrm(ks[6], (L, D, IN_COLS), D ** -0.5),
        'w_out': nrm(ks[7], (L, D, D), DEEPNORM_BETA * D ** -0.5),
        'sgu_ln_w': gain(ks[8], (L, GROUP_WIDTH)),
        'sgu_ln_b': nrm(ks[9], (L, GROUP_WIDTH), 0.02),
        'sgu_w': nrm(ks[10], (L, SGU_GROUPS, SGU_CHUNK, SGU_CHUNK), SGU_CHUNK ** -0.5),
        'sgu_b': gain(ks[11], (L, SGU_GROUPS, SGU_CHUNK)),
        'diff_lambda': nrm(ks[12], (L, 4, DIFF_QK_DIM), 0.1),
        'diff_subln_w': gain(ks[13], (L, DIFF_V_DIM)),
        'hgrn_lower_bounds': nrm(ks[14], (L, 2, HGRN_HEADS * HGRN_KEY_DIM), 0.1),
        'hgrn_norm_w': gain(ks[15], (L, HGRN_VAL_DIM)),
        'mla_q_norm_w': gain(ks[16], (L, MLA_Q_LORA)),
        'mla_w_uq': nrm(ks[17], (L, MLA_Q_LORA, MLA_HEADS * (MLA_NOPE_DIM + MLA_ROPE_DIM)), MLA_Q_LORA ** -0.5),
        'mla_kv_norm_w': gain(ks[18], (L, MLA_KV_LORA)),
        'mla_w_ukv': nrm(ks[19], (L, MLA_KV_LORA, MLA_HEADS * (MLA_NOPE_DIM + MLA_V_DIM)), MLA_KV_LORA ** -0.5),
        'ln_mix_w': gain(ks[20], (L, D)),
        'ln_mix_b': nrm(ks[21], (L, D), 0.02),
        'ln_ffn_w': gain(ks[22], (L, D)),
        'ln_ffn_b': nrm(ks[23], (L, D), 0.02),
        'router_w': nrm(ks[24], (L, D, E), D ** -0.5),
        'router_b': nrm(ks[25], (L, E), 0.01),
        'expert_w1': nrm(ks[26], (L, E, D, 2 * F), D ** -0.5),
        'expert_b1': nrm(ks[27], (L, E, 2 * F), 0.02),
        'expert_w2': nrm(ks[28], (L, E, F, D), DEEPNORM_BETA * F ** -0.5),
        'expert_b2': nrm(ks[29], (L, E, D), 0.02),
    }


def reference(x, c, ctx, c_ctx, ada_w, ada_b, w_in, w_out, sgu_ln_w, sgu_ln_b, sgu_w, sgu_b,
              diff_lambda, diff_subln_w, hgrn_lower_bounds, hgrn_norm_w,
              mla_q_norm_w, mla_w_uq, mla_kv_norm_w, mla_w_ukv,
              ln_mix_w, ln_mix_b, ln_ffn_w, ln_ffn_b,
              router_w, router_b, expert_w1, expert_b1, expert_w2, expert_b2):
    bsz, n_lat, d = x.shape
    n_ctx = ctx.shape[1]
    ang_diff = grid_angles(n_lat, DIFF_QK_DIM)
    ang_mla = grid_angles(n_lat, MLA_ROPE_DIM)
    lb_all = jax.nn.softmax(hgrn_lower_bounds.astype(jnp.float32), axis=0)
    lb_all = jnp.cumsum(lb_all, axis=0) - lb_all[0]
    silu_c = jax.nn.silu(c)
    silu_cc = jax.nn.silu(c_ctx)
    xc = ctx
    for l in range(DEPTH):
        need_ctx = l < DEPTH - 1
        lam_init = 0.8 - 0.6 * math.exp(-0.3 * l)
        mod = (silu_c @ ada_w[l] + ada_b[l])[:, None, :]
        mod_c = silu_cc @ ada_w[l] + ada_b[l]
        sh1, sc1, g1, sh2, sc2, g2 = jnp.split(mod, 6, axis=-1)
        csh1, csc1, cg1, csh2, csc2, cg2 = jnp.split(mod_c, 6, axis=-1)

        h = modulate(layer_norm(x), sh1, sc1)
        hc = modulate(layer_norm(xc), csh1, csc1)
        y, yc = hybrid_mixer(h, hc, w_in[l], w_out[l], sgu_ln_w[l], sgu_ln_b[l], sgu_w[l], sgu_b[l],
                             diff_lambda[l], diff_subln_w[l], lam_init, lb_all[l], hgrn_norm_w[l],
                             mla_q_norm_w[l], mla_w_uq[l], mla_kv_norm_w[l], mla_w_ukv[l],
                             ang_diff, ang_mla, need_ctx)
        x = layer_norm(DEEPNORM_ALPHA * x + g1 * y, ln_mix_w[l], ln_mix_b[l])
        h2 = modulate(layer_norm(x), sh2, sc2)
        if need_ctx:
            xc = layer_norm(DEEPNORM_ALPHA * xc + cg1 * yc, ln_mix_w[l], ln_mix_b[l])
            h2c = modulate(layer_norm(xc), csh2, csc2)
            tokens = jnp.concatenate([h2.reshape(-1, d), h2c.reshape(-1, d)], axis=0)
        else:
            tokens = h2.reshape(-1, d)
        f_out = moe_ffn(tokens, router_w[l], router_b[l], expert_w1[l], expert_b1[l],
                        expert_w2[l], expert_b2[l])
        y2 = f_out[:bsz * n_lat].reshape(bsz, n_lat, d)
        x = layer_norm(DEEPNORM_ALPHA * x + g2 * y2, ln_ffn_w[l], ln_ffn_b[l])
        if need_ctx:
            y2c = f_out[bsz * n_lat:].reshape(bsz, n_ctx, d)
            xc = layer_norm(DEEPNORM_ALPHA * xc + cg2 * y2c, ln_ffn_w[l], ln_ffn_b[l])
    return x
```

```cpp
#include <hip/hip_runtime.h>
#include <stdint.h>
#include <string.h>

#define MK_MULTI 1
#define MK_NPH N_PHASES
#define MK_DEBUG 0
#define MK_DEBUG_LIST \
  add(p.mod, 2*9*6144, 1,0,0,0,7); add(p.WinT, 2ull*NINP*DM, 0,0,0,0,7); add(p.H, (unsigned long long)MR*DM, 0,0,0,0,7); add(p.Puv, (unsigned long long)MR*512, 0,0,0,0,7); \
  add(p.Cq, (unsigned long long)MR*256, 0,0,0,0,7); add(p.Ckv, (unsigned long long)MR*128, 0,0,0,0,7); add(p.RS, (unsigned long long)MR*2, 1,0,0,0,7); \
  add(p.Kn, (unsigned long long)MR*256, 0,0,0,0,7); add(p.Vmt, (unsigned long long)MR*256, 0,0,0,0,7); \
  add(p.O, (unsigned long long)MR*DM, 0, DM, 0, 256, 1); \
  add(p.Y, (unsigned long long)MR*DM, 1);

#define DI __device__ __forceinline__
typedef unsigned short bf16_t;
typedef short bf16x8 __attribute__((ext_vector_type(8)));
typedef float f32x4 __attribute__((ext_vector_type(4)));
typedef float f32x2 __attribute__((ext_vector_type(2)));
typedef float f32x16 __attribute__((ext_vector_type(16)));
typedef unsigned u32x4 __attribute__((ext_vector_type(4)));
typedef unsigned u32x2 __attribute__((ext_vector_type(2)));

constexpr int DM = 1024, NB = 8, SEQ = 4096, CTX = 256, TP = 4352, MR = NB * TP;
constexpr int NIN = 2976, NINP = 3072;
constexpr int NE = 32;
constexpr int NCH = TP / 32;
constexpr int NSLOT = 147456;
constexpr float LN_EPS = 1e-6f;
constexpr float DN_ALPHA = 1.4142135623730951f;
constexpr float LOG2E = 1.4426950408889634f;
constexpr int NTHREADS = 512;
constexpr int LDS_BYTES = 147456;

#define XB_TMO      128
#define XB_XCNT(j)  (256  + 64 * (j))
#define XB_XSUB(j)  (1280 + 64 * (j))
#define XB_XGEN(j)  (2304 + 64 * (j))
#define XB_TOP      3328
#define XB_TOPGEN   3392
#define XCD_BAR_WORDS 3456
#define XB_SPIN_CAP (1u << 22)
#define LAS __attribute__((address_space(3)))

DI unsigned xb_ld(unsigned* p)              { return __hip_atomic_load(p, __ATOMIC_RELAXED, __HIP_MEMORY_SCOPE_AGENT); }
DI unsigned xb_add(unsigned* p, unsigned v) { return __hip_atomic_fetch_add(p, v, __ATOMIC_RELAXED, __HIP_MEMORY_SCOPE_AGENT); }
DI unsigned xb_xcc_id() { return (unsigned)__builtin_amdgcn_s_getreg((3 << 11) | 20) & 0xFu; }
#define XB_SPIN(cond, bar) do { unsigned _sp = 0; while (cond) { __builtin_amdgcn_s_sleep(1); \
    if ((++_sp & 255u) == 0u) { if (xb_ld(&(bar)[XB_TMO])) break; if (_sp > XB_SPIN_CAP) { atomicAdd(&(bar)[XB_TMO], 1u); break; } } } } while (0)

struct XcdBarrier { unsigned* bar; unsigned x; volatile LAS unsigned* st; };

DI XcdBarrier xcd_barrier_post(unsigned* bar, volatile LAS unsigned* st) {
    XcdBarrier b; b.bar = bar; b.x = xb_xcc_id(); b.st = st;
    if (threadIdx.x == 0) (void)xb_add(&bar[XB_XCNT(b.x)], 1u);
    return b;
}
DI void xcd_barrier_complete(unsigned* bar, unsigned x, unsigned& nloc, unsigned& nx) {
    const unsigned G = gridDim.x * gridDim.y * gridDim.z;
    unsigned sum, cnt, mine, sp = 0u;
    for (;;) {
        sum = 0u; cnt = 0u; mine = 0u;
#pragma unroll
        for (unsigned j = 0; j < 16; ++j) { const unsigned c = xb_ld(&bar[XB_XCNT(j)]); sum += c; cnt += (c > 0u) ? 1u : 0u; mine = (j == x) ? c : mine; }
        if (sum == G) break;
        __builtin_amdgcn_s_sleep(1);
        if ((++sp & 255u) == 0u) { if (xb_ld(&bar[XB_TMO])) break; if (sp > XB_SPIN_CAP) { atomicAdd(&bar[XB_TMO], 1u); break; } }
    }
    nloc = mine > 0u ? mine : 1u; nx = cnt > 0u ? cnt : 1u;
}
DI void xcd_barrier(const XcdBarrier& b) {
    asm volatile("s_waitcnt vmcnt(0)" ::: "memory");
    __syncthreads();
    if (threadIdx.x == 0) {
        unsigned* bar = b.bar;
        __builtin_amdgcn_s_waitcnt(0);
        unsigned nloc = b.st[0], nx = b.st[1];
        if (nloc == 0u) { xcd_barrier_complete(bar, b.x, nloc, nx); b.st[0] = nloc; b.st[1] = nx; }
        const unsigned old = xb_add(&bar[XB_XSUB(b.x)], 1u);
        const unsigned gen = old / nloc;
        if (old + 1u == (gen + 1u) * nloc) {
            __builtin_amdgcn_fence(__ATOMIC_RELEASE, "agent");
            asm volatile("s_waitcnt vmcnt(0)" ::: "memory");
            const unsigned og = xb_add(&bar[XB_TOP], 1u);
            const unsigned tg = og / nx;
            if (og + 1u == (tg + 1u) * nx) xb_add(&bar[XB_TOPGEN], 1u);
            else XB_SPIN(xb_ld(&bar[XB_TOPGEN]) == tg, bar);
            __builtin_amdgcn_fence(__ATOMIC_ACQUIRE, "agent");
            xb_add(&bar[XB_XGEN(b.x)], 1u);
            asm volatile("s_waitcnt vmcnt(0)" ::: "memory");
        } else {
            XB_SPIN(xb_ld(&bar[XB_XGEN(b.x)]) == gen, bar);
            __builtin_amdgcn_fence(__ATOMIC_ACQUIRE, "agent");
            asm volatile("s_waitcnt vmcnt(0)" ::: "memory");
        }
    }
    __syncthreads();
}

struct Params {
    const float *x, *c, *ctx, *c_ctx, *ada_w, *ada_b, *w_in, *w_out, *sgu_ln_w, *sgu_ln_b, *sgu_w, *sgu_b,
                *diff_lambda, *diff_subln_w, *hgrn_lb, *hgrn_norm_w, *mla_q_norm_w, *mla_w_uq, *mla_kv_norm_w, *mla_w_ukv,
                *ln_mix_w, *ln_mix_b, *ln_ffn_w, *ln_ffn_b, *router_w, *router_b, *w1, *b1, *w2, *b2;
    float* out;
    unsigned* bar; unsigned* gcnt;
    float *mod, *lball, *lam, *ropec, *ropes;
    bf16_t *WinT, *WoutT, *WuqT, *WukvT, *W1T, *W2T;
    float* X; bf16_t* H;
    bf16_t *Puv, *Qd, *Kd, *Vdt, *Hq, *Vht, *Lf, *Hg, *Cq, *Ckv, *Kr, *Qm, *Kn, *Vmt, *O;
    float *RS, *DST, *DEC, *Y;
    int* ltok; float* lgate; int* rslot; bf16_t *ACT, *YS;
};

DI int otid() { int t = threadIdx.x; asm volatile("" : "+v"(t)); return t; }
DI float bf2f(bf16_t v) { return __uint_as_float(((unsigned)v) << 16); }
typedef __bf16 bf16x2_t __attribute__((ext_vector_type(2)));
DI unsigned pk2(float lo, float hi) { const bf16x2_t v = {(__bf16)lo, (__bf16)hi}; return __builtin_bit_cast(unsigned, v); }
DI float lo2f(unsigned w) { return __uint_as_float(w << 16); }
DI float hi2f(unsigned w) { return __uint_as_float(w & 0xffff0000u); }
DI bf16x8 pack8(const float (&v)[8]) { u32x4 w; w.x = pk2(v[0], v[1]); w.y = pk2(v[2], v[3]); w.z = pk2(v[4], v[5]); w.w = pk2(v[6], v[7]); return __builtin_bit_cast(bf16x8, w); }
DI float wave_sum(float v) {
#pragma unroll
    for (int o = 32; o >= 1; o >>= 1) v += __shfl_xor(v, o);
    return v;
}
DI float sigmoidf_(float x) { return 1.0f / (1.0f + __expf(-x)); }
DI float siluf_(float x) { return x * sigmoidf_(x); }
DI int crow(int r, int hh) { return (r & 3) + 8 * (r >> 2) + 4 * hh; }
#define MFMA16(a, b, c) __builtin_amdgcn_mfma_f32_16x16x32_bf16((a), (b), (c), 0, 0, 0)
#define MFMA32(a, b, c) __builtin_amdgcn_mfma_f32_32x32x16_bf16((a), (b), (c), 0, 0, 0)

DI const float* in_row(const Params& p, int row) {
    const int b = row / TP, t = row - b * TP;
    return t < CTX ? p.ctx + ((size_t)b * CTX + t) * DM : p.x + ((size_t)b * SEQ + (t - CTX)) * DM;
}
DI const float* mod_vec(const Params& p, int l, int row, int j) {
    const int b = row / TP, t = row - b * TP;
    const int r = t < CTX ? 8 : b;
    return p.mod + ((size_t)(l * 9 + r) * 6 + j) * DM;
}

DI void transpose_tile(const float* __restrict__ src, int K, int N, bf16_t* __restrict__ dst, int k0, int n0, const float* __restrict__ kscale, int perm_ukv, char* wl, int lane) {
    bf16_t* S = (bf16_t*)wl;
#pragma unroll 4
    for (int it = 0; it < 16; ++it) {
        const int kk = it * 4 + (lane >> 4), nn = (lane & 15) * 4;
        f32x4 v = {0.f, 0.f, 0.f, 0.f};
        if (n0 + nn < N) v = *(const f32x4*)(src + (size_t)(k0 + kk) * N + n0 + nn);
        if (kscale) { const float s = kscale[k0 + kk]; v = v * s; }
        unsigned* d = (unsigned*)(S + kk * 66 + nn);
        d[0] = pk2(v[0], v[1]); d[1] = pk2(v[2], v[3]);
    }
    __builtin_amdgcn_fence(__ATOMIC_RELEASE, "workgroup");
    __builtin_amdgcn_wave_barrier();
    __builtin_amdgcn_fence(__ATOMIC_ACQUIRE, "workgroup");
#pragma unroll 2
    for (int it = 0; it < 8; ++it) {
        const int nn = it * 8 + (lane >> 3), kc = lane & 7;
        unsigned short e[8];
#pragma unroll
        for (int j = 0; j < 8; ++j) e[j] = S[(kc * 8 + j) * 66 + nn];
        u32x4 w; w.x = e[0] | ((unsigned)e[1] << 16); w.y = e[2] | ((unsigned)e[3] << 16); w.z = e[4] | ((unsigned)e[5] << 16); w.w = e[6] | ((unsigned)e[7] << 16);
        int n = n0 + nn;
        if (perm_ukv) { const int hh = n >> 7, t = n & 127; n = t < 64 ? hh * 64 + t : 256 + hh * 64 + (t - 64); }
        *(u32x4*)(dst + (size_t)n * K + k0 + kc * 8) = w;
    }
    __builtin_amdgcn_fence(__ATOMIC_RELEASE, "workgroup");
    __builtin_amdgcn_wave_barrier();
}

DI void phase_prologue(const Params& p, char* lds) {
    const int tid = otid(), wid = tid >> 6, lane = tid & 63;
    char* wl = lds + wid * 8704;
    constexpr int T_IN = 16 * 48, T_OUT = 16 * 16, T_UQ = 4 * 6, T_UKV = 2 * 8, T_W1 = 32 * 16 * 32, T_W2 = 32 * 16 * 16;
    constexpr int T_LAYER = T_IN + T_OUT + T_UQ + T_UKV + T_W1 + T_W2;
    constexpr int T_ALL = 2 * T_LAYER;
    constexpr int U_TR = (T_ALL + 7) / 8;
    constexpr int U_GEMV = 2 * 6144 / 64 / 8;
    const int nunits = U_TR + U_GEMV + 1;
    for (int u = blockIdx.x; u < nunits; u += gridDim.x) {
        if (u < U_TR) {
            int t = u * 8 + wid;
            if (t < T_ALL) {
                const int l = t / T_LAYER; t -= l * T_LAYER;
                if (t < T_IN) { const int kt = t / 48, nt = t % 48;
                    transpose_tile(p.w_in + (size_t)l * DM * NIN, DM, NIN, p.WinT + (size_t)l * NINP * DM, kt * 64, nt * 64, nullptr, 0, wl, lane);
                } else if ((t -= T_IN) < T_OUT) { const int kt = t / 16, nt = t % 16;
                    transpose_tile(p.w_out + (size_t)l * DM * DM, DM, DM, p.WoutT + (size_t)l * DM * DM, kt * 64, nt * 64, nullptr, 0, wl, lane);
                } else if ((t -= T_OUT) < T_UQ) { const int kt = t / 6, nt = t % 6;
                    transpose_tile(p.mla_w_uq + (size_t)l * 256 * 384, 256, 384, p.WuqT + (size_t)l * 384 * 256, kt * 64, nt * 64, p.mla_q_norm_w + l * 256, 0, wl, lane);
                } else if ((t -= T_UQ) < T_UKV) { const int kt = t / 8, nt = t % 8;
                    transpose_tile(p.mla_w_ukv + (size_t)l * 128 * 512, 128, 512, p.WukvT + (size_t)l * 512 * 128, kt * 64, nt * 64, p.mla_kv_norm_w + l * 128, 1, wl, lane);
                } else if ((t -= T_UKV) < T_W1) { const int e = t / 512, r = t % 512, kt = r / 32, nt = r % 32;
                    transpose_tile(p.w1 + ((size_t)l * NE + e) * DM * 2048, DM, 2048, p.W1T + ((size_t)l * NE + e) * 2048 * DM, kt * 64, nt * 64, nullptr, 0, wl, lane);
                } else { t -= T_W1; const int e = t / 256, r = t % 256, kt = r / 16, nt = r % 16;
                    transpose_tile(p.w2 + ((size_t)l * NE + e) * DM * DM, DM, DM, p.W2T + ((size_t)l * NE + e) * DM * DM, kt * 64, nt * 64, nullptr, 0, wl, lane);
                }
            }
        } else if (u < U_TR + U_GEMV) {
            const int wu = (u - U_TR) * 8 + wid;
            const int l = wu / 96, n = (wu % 96) * 64 + lane;
            const float* W = p.ada_w + (size_t)l * DM * 6144 + n;
            float* sc = (float*)(lds + 73728);
            __syncthreads();
            for (int i = tid; i < 9 * DM; i += NTHREADS) { const float cv = i < 8 * DM ? p.c[i] : p.c_ctx[i - 8 * DM]; sc[i] = siluf_(cv); }
            __syncthreads();
            float acc[9];
#pragma unroll
            for (int r = 0; r < 9; ++r) acc[r] = 0.f;
#pragma unroll 2
            for (int k = 0; k < DM; k += 4) {
                float w[4];
#pragma unroll
                for (int j = 0; j < 4; ++j) w[j] = W[(size_t)(k + j) * 6144];
#pragma unroll
                for (int r = 0; r < 9; ++r) {
                    const f32x4 cc = *(const f32x4*)(sc + r * DM + k);
#pragma unroll
                    for (int j = 0; j < 4; ++j) acc[r] += cc[j] * w[j];
                }
            }
            const float bb = p.ada_b[l * 6144 + n];
#pragma unroll
            for (int r = 0; r < 9; ++r) p.mod[(size_t)(l * 9 + r) * 6144 + n] = acc[r] + bb;
        } else {
            if (tid < 512) {
                const int j = tid;
                const float a0 = p.hgrn_lb[j], a1 = p.hgrn_lb[512 + j];
                const float m = fmaxf(a0, a1), e0 = expf(a0 - m), e1 = expf(a1 - m);
                p.lball[j] = 0.f;
                p.lball[512 + j] = e1 / (e0 + e1);
            }
            if (tid < 2) {
                const float* lp = p.diff_lambda + tid * 4 * 32;
                float s01 = 0.f, s23 = 0.f;
                for (int i = 0; i < 32; ++i) { s01 += lp[i] * lp[32 + i]; s23 += lp[64 + i] * lp[96 + i]; }
                const float lam_init = 0.8f - 0.6f * expf(-0.3f * (float)tid);
                p.lam[tid] = expf(s01) - expf(s23) + lam_init;
            }
            {
                const int pos = tid >> 3, i = tid & 7;
                const float inv = powf(10000.0f, -(float)(2 * i) / 16.0f);
                float sn, cs; sincosf((float)pos * inv, &sn, &cs);
                p.ropec[tid] = cs; p.ropes[tid] = sn;
            }
        }
    }
}

DI void phase_ln1(const Params& p, char* lds) {
    const int tid = otid(), wid = tid >> 6, lane = tid & 63;
    for (int row = blockIdx.x * 8 + wid; row < MR; row += gridDim.x * 8) {
        const float* xr = in_row(p, row);
        f32x4 v[4]; float s = 0.f;
#pragma unroll
        for (int j = 0; j < 4; ++j) { v[j] = *(const f32x4*)(xr + j * 256 + lane * 4); s += (v[j][0] + v[j][1]) + (v[j][2] + v[j][3]); }
        const float mean = wave_sum(s) * (1.f / DM);
        float q = 0.f;
#pragma unroll
        for (int j = 0; j < 4; ++j) { v[j] = v[j] - mean; q += (v[j][0] * v[j][0] + v[j][1] * v[j][1]) + (v[j][2] * v[j][2] + v[j][3] * v[j][3]); }
        const float rstd = rsqrtf(wave_sum(q) * (1.f / DM) + LN_EPS);
        const float* sh = mod_vec(p, 0, row, 0); const float* sc = mod_vec(p, 0, row, 1);
#pragma unroll
        for (int j = 0; j < 4; ++j) {
            const int c = j * 256 + lane * 4;
            const f32x4 a = *(const f32x4*)(sh + c), b = *(const f32x4*)(sc + c);
            const f32x4 h = v[j] * rstd * (b + 1.0f) + a;
            u32x2 w; w.x = pk2(h[0], h[1]); w.y = pk2(h[2], h[3]);
            *(u32x2*)(p.H + (size_t)row * DM + c) = w;
        }
    }
}

template <int ORI>
DI void gemm_core(const bf16_t* const (&pa)[4], const bf16_t* const (&pb)[2], int K, char* lds, f32x4 (&acc)[4][4]) {
    const int tid = otid(), wid = tid >> 6, lane = tid & 63, wr = wid >> 1, wc = wid & 1, fr = lane & 15, fq = lane >> 4;
    const int sw = ((tid & 7) ^ ((tid >> 4) & 7)) << 4;
    const int offA = (tid >> 3) * 128 + sw, offB = 32768 + (tid >> 3) * 128 + sw;
    const int rdA = (wr * 64 + fr) * 128 + ((fq ^ (fr >> 1)) << 4), rdB = 32768 + (wc * 64 + fr) * 128 + ((fq ^ (fr >> 1)) << 4);
#pragma unroll
    for (int mi = 0; mi < 4; ++mi)
#pragma unroll
        for (int ni = 0; ni < 4; ++ni) acc[mi][ni] = (f32x4){0.f, 0.f, 0.f, 0.f};
    u32x4 ra[4], rb[2];
#pragma unroll
    for (int i = 0; i < 4; ++i) ra[i] = *(const u32x4*)(pa[i]);
#pragma unroll
    for (int j = 0; j < 2; ++j) rb[j] = *(const u32x4*)(pb[j]);
#pragma unroll
    for (int i = 0; i < 4; ++i) *(u32x4*)(lds + offA + i * 8192) = ra[i];
#pragma unroll
    for (int j = 0; j < 2; ++j) *(u32x4*)(lds + offB + j * 8192) = rb[j];
    __syncthreads();
    const int nk = K >> 6;
    for (int kt = 0; kt < nk; ++kt) {
        const char* cur = lds + (kt & 1) * 49152;
        const bool more = kt + 1 < nk;
        if (more) {
#pragma unroll
            for (int i = 0; i < 4; ++i) ra[i] = *(const u32x4*)(pa[i] + (kt + 1) * 64);
#pragma unroll
            for (int j = 0; j < 2; ++j) rb[j] = *(const u32x4*)(pb[j] + (kt + 1) * 64);
        }
#pragma unroll
        for (int kk = 0; kk < 2; ++kk) {
            bf16x8 af[4], bfr[4];
#pragma unroll
            for (int mi = 0; mi < 4; ++mi) af[mi] = *(const bf16x8*)(cur + ((rdA + mi * 2048) ^ (kk * 64)));
#pragma unroll
            for (int ni = 0; ni < 4; ++ni) bfr[ni] = *(const bf16x8*)(cur + ((rdB + ni * 2048) ^ (kk * 64)));
#pragma unroll
            for (int mi = 0; mi < 4; ++mi)
#pragma unroll
                for (int ni = 0; ni < 4; ++ni) {
                    if (ORI == 0) acc[mi][ni] = MFMA16(bfr[ni], af[mi], acc[mi][ni]);
                    else          acc[mi][ni] = MFMA16(af[mi], bfr[ni], acc[mi][ni]);
                }
        }
        if (more) {
            char* nxt = lds + ((kt + 1) & 1) * 49152;
#pragma unroll
            for (int i = 0; i < 4; ++i) *(u32x4*)(nxt + offA + i * 8192) = ra[i];
#pragma unroll
            for (int j = 0; j < 2; ++j) *(u32x4*)(nxt + offB + j * 8192) = rb[j];
        }
        __syncthreads();
    }
}

DI void gemm_ptrs(const bf16_t* A, int lda, int row0, const bf16_t* Bt, int ldb, int n0, const bf16_t* (&pa)[4], const bf16_t* (&pb)[2]) {
    const int tid = otid(), r = tid >> 3, c = (tid & 7) * 8;
#pragma unroll
    for (int i = 0; i < 4; ++i) pa[i] = A + (size_t)(row0 + r + 64 * i) * lda + c;
#pragma unroll
    for (int j = 0; j < 2; ++j) pb[j] = Bt + (size_t)(n0 + r + 64 * j) * ldb + c;
}

DI void store4_bf16(bf16_t* dst, const f32x4& v) { u32x2 w; w.x = pk2(v[0], v[1]); w.y = pk2(v[2], v[3]); *(u32x2*)dst = w; }

DI f32x4 rope_tile(const Params& p, f32x4 v, int row, int axis_is_col, int fq) {
    f32x4 o;
    const int b = row / TP, t = row - b * TP;
    const int pos = t - CTX;
    const int ax = axis_is_col ? (pos & 63) : (pos >> 6);
#pragma unroll
    for (int r = 0; r < 4; ++r) {
        const float pr = __shfl_xor(v[r], 32);
        float cs = 1.f, sn = 0.f;
        if (t >= CTX) { const int i = (fq & 1) * 4 + r; cs = p.ropec[ax * 8 + i]; sn = p.ropes[ax * 8 + i]; }
        o[r] = fq < 2 ? v[r] * cs - pr * sn : v[r] * cs + pr * sn;
    }
    return o;
}

DI void phase_inproj(const Params& p, int l, char* lds) {
    const int tid = otid(), wid = tid >> 6, lane = tid & 63, wr = wid >> 1, wc = wid & 1, fr = lane & 15, fq = lane >> 4;
    const bf16_t* Bt = p.WinT + (size_t)l * NINP * DM;
    const int nunits = (MR / 256) * 24;
    for (int u = blockIdx.x; u < nunits; u += gridDim.x) {
        const int mt = u / 24, nt = u % 24, m0 = mt * 256, n0 = nt * 128;
        const bf16_t* pa[4]; const bf16_t* pb[2];
        gemm_ptrs(p.H, DM, m0, Bt, DM, n0, pa, pb);
        f32x4 acc[4][4];
        const bool tr = (nt == 8 || nt == 9 || nt == 12 || nt == 13);
        if (tr) gemm_core<1>(pa, pb, DM, lds, acc); else gemm_core<0>(pa, pb, DM, lds, acc);
        if (tr) {
            bf16_t* dst = (nt < 10) ? p.Vdt : p.Vht;
            const int fbase = (nt < 10) ? 1024 : 1536;
            const int b = m0 / TP, t0 = m0 - b * TP;
#pragma unroll
            for (int mi = 0; mi < 4; ++mi)
#pragma unroll
                for (int ni = 0; ni < 4; ++ni) {
                    const int f = n0 + wc * 64 + ni * 16 + fr - fbase;
                    const int t = t0 + wr * 64 + mi * 16 + fq * 4;
                    store4_bf16(dst + ((size_t)(b * 256 + f)) * TP + t, acc[mi][ni]);
                }
        } else {
#pragma unroll
            for (int mi = 0; mi < 4; ++mi)
#pragma unroll
                for (int ni = 0; ni < 4; ++ni) {
                    const int row = m0 + wr * 64 + mi * 16 + fr;
                    const int col = n0 + wc * 64 + ni * 16 + fq * 4;
                    f32x4 v = acc[mi][ni];
                    if (nt < 4) {
#pragma unroll
                        for (int r = 0; r < 4; ++r) v[r] = 0.5f * v[r] * (1.0f + erff(v[r] * 0.70710678118654752f));
                        store4_bf16(p.Puv + (size_t)row * 512 + col, v);
                    } else if (nt < 8) {
                        v = rope_tile(p, v, row, (col >> 4) & 1, fq);
                        if (nt < 6) { v = v * (0.17677669529663687f * LOG2E); store4_bf16(p.Qd + (size_t)row * 256 + (col - 512), v); }
                        else store4_bf16(p.Kd + (size_t)row * 256 + (col - 768), v);
                    } else if (nt < 12) {
#pragma unroll
                        for (int r = 0; r < 4; ++r) v[r] = siluf_(v[r]);
                        store4_bf16(p.Hq + (size_t)row * 256 + (col - 1280), v);
                    } else if (nt < 18) {
                        const int dir = nt >= 16, cc = col - (dir ? 2048 : 1792);
                        const f32x4 lb = *(const f32x4*)(p.lball + (l * 2 + dir) * 256 + cc);
#pragma unroll
                        for (int r = 0; r < 4; ++r) v[r] = __logf(lb[r] + (1.0f - lb[r]) * sigmoidf_(v[r]));
                        store4_bf16(p.Lf + ((size_t)dir * MR + row) * 256 + cc, v);
                    } else if (nt < 20) {
#pragma unroll
                        for (int r = 0; r < 4; ++r) v[r] = siluf_(v[r]);
                        store4_bf16(p.Hg + (size_t)row * 256 + (col - 2304), v);
                    } else if (nt < 22) {
                        store4_bf16(p.Cq + (size_t)row * 256 + (col - 2560), v);
                    } else if (nt == 22) {
                        store4_bf16(p.Ckv + (size_t)row * 128 + (col - 2816), v);
                    } else {
                        v = rope_tile(p, v, row, (col >> 4) & 1, fq);
                        if (col < 2976) store4_bf16(p.Kr + (size_t)row * 32 + (col - 2944), v);
                    }
                }
        }
    }
}

DI void phase_sgu_prep(const Params& p, int l, char* lds) {
    const int tid = otid(), wid = tid >> 6, lane = tid & 63, fr = lane & 15, fq = lane >> 4;
    constexpr int U_SGU = (MR / 128) * 4, U_PREP = MR / 64;
    float* stats = (float*)(lds + 16384);
    for (int u = blockIdx.x; u < U_SGU + U_PREP; u += gridDim.x) {
        if (u < U_SGU) {
            const int ch = u >> 2, g = u & 3, row0 = ch * 128;
            __syncthreads();
#pragma unroll 1
            for (int i = 0; i < 16; ++i) {
                const int r = wid * 16 + i;
                const u32x2 w = *(const u32x2*)(p.Puv + (size_t)(row0 + r) * 512 + 256 + lane * 4);
                const float a0 = lo2f(w.x), a1 = hi2f(w.x), a2 = lo2f(w.y), a3 = hi2f(w.y);
                const float mean = wave_sum((a0 + a1) + (a2 + a3)) * (1.f / 256.f);
                const float d0 = a0 - mean, d1 = a1 - mean, d2 = a2 - mean, d3 = a3 - mean;
                const float var = wave_sum((d0 * d0 + d1 * d1) + (d2 * d2 + d3 * d3)) * (1.f / 256.f);
                if (lane == 0) { stats[r * 2] = mean; stats[r * 2 + 1] = rsqrtf(var + LN_EPS); }
            }
            __syncthreads();
            {
                const int s = tid >> 2, c0 = (tid & 3) * 16;
                const float mean = stats[s * 2], rstd = stats[s * 2 + 1];
                const bf16_t* src = p.Puv + (size_t)(row0 + s) * 512 + 256 + g * 64 + c0;
                const u32x4 w0 = *(const u32x4*)src, w1 = *(const u32x4*)(src + 8);
                const unsigned ww[8] = {w0.x, w0.y, w0.z, w0.w, w1.x, w1.y, w1.z, w1.w};
                const float* lw = p.sgu_ln_w + l * 256 + g * 64 + c0; const float* lb = p.sgu_ln_b + l * 256 + g * 64 + c0;
#pragma unroll
                for (int j = 0; j < 16; ++j) {
                    const float xv = (j & 1) ? hi2f(ww[j >> 1]) : lo2f(ww[j >> 1]);
                    const float y = (xv - mean) * rstd * lw[j] + lb[j];
                    const int c = c0 + j;
                    const unsigned pk = pk2(y, 0.f);
                    *(bf16_t*)(lds + c * 256 + ((((s >> 3) ^ (c & 15)) << 4) | ((s & 7) * 2))) = (bf16_t)(pk & 0xffffu);
                }
            }
            __syncthreads();
            f32x4 acc[4];
#pragma unroll
            for (int ni = 0; ni < 4; ++ni) acc[ni] = (f32x4){0.f, 0.f, 0.f, 0.f};
            const float* Wg = p.sgu_w + ((size_t)(l * 4 + g) * 128 + wid * 16 + fr) * 128;
#pragma unroll
            for (int ks = 0; ks < 4; ++ks) {
                const f32x4 a0 = *(const f32x4*)(Wg + ks * 32 + fq * 8), a1 = *(const f32x4*)(Wg + ks * 32 + fq * 8 + 4);
                const float av[8] = {a0[0], a0[1], a0[2], a0[3], a1[0], a1[1], a1[2], a1[3]};
                const bf16x8 af = pack8(av);
#pragma unroll
                for (int ni = 0; ni < 4; ++ni) {
                    const int c = ni * 16 + fr;
                    const bf16x8 bfr = *(const bf16x8*)(lds + c * 256 + (((ks * 4 + fq) ^ (c & 15)) << 4));
                    acc[ni] = MFMA16(bfr, af, acc[ni]);
                }
            }
            const int t = wid * 16 + fr, row = row0 + t;
            const float bs = p.sgu_b[(l * 4 + g) * 128 + t];
#pragma unroll
            for (int ni = 0; ni < 4; ++ni) {
                const int c = g * 64 + ni * 16 + fq * 4;
                const u32x2 w = *(const u32x2*)(p.Puv + (size_t)row * 512 + c);
                f32x4 o;
                o[0] = (acc[ni][0] + bs) * lo2f(w.x); o[1] = (acc[ni][1] + bs) * hi2f(w.x);
                o[2] = (acc[ni][2] + bs) * lo2f(w.y); o[3] = (acc[ni][3] + bs) * hi2f(w.y);
                store4_bf16(p.O + (size_t)row * DM + c, o);
            }
        } else {
            const int rbase = (u - U_SGU) * 64 + wid * 8;
#pragma unroll 1
            for (int i = 0; i < 8; ++i) {
                const int row = rbase + i;
                const u32x2 wq = *(const u32x2*)(p.Cq + (size_t)row * 256 + lane * 4);
                const unsigned wk = *(const unsigned*)(p.Ckv + (size_t)row * 128 + lane * 2);
                const float q0 = lo2f(wq.x), q1 = hi2f(wq.x), q2 = lo2f(wq.y), q3 = hi2f(wq.y), k0 = lo2f(wk), k1 = hi2f(wk);
                const float sq = wave_sum((q0 * q0 + q1 * q1) + (q2 * q2 + q3 * q3));
                const float sk = wave_sum(k0 * k0 + k1 * k1);
                if (lane == 0) { p.RS[row * 2] = rsqrtf(sq * (1.f / 256.f) + LN_EPS); p.RS[row * 2 + 1] = rsqrtf(sk * (1.f / 128.f) + LN_EPS); }
            }
        }
    }
}

DI void hgrn_h1_unit(const Params& p, int wu, int lane) {
    const int c = wu % NCH; int t = wu / NCH; const int dir = t & 1, h = (t >> 1) & 3, b = t >> 3;
    const int row0 = b * TP + c * 32, hh = lane >> 5, l31 = lane & 31;
    const bf16_t* Lf = p.Lf + ((size_t)dir * MR + row0) * 256 + h * 64;
    bf16x8 Bf[2][2];
    float* decp = p.DEC + (size_t)wu * 64;
#pragma unroll
    for (int kt = 0; kt < 2; ++kt) {
        const int k = kt * 32 + l31;
        float lf[32], kd[32];
#pragma unroll
        for (int j = 0; j < 32; ++j) lf[j] = bf2f(Lf[(size_t)j * 256 + k]);
        float tot = 0.f;
#pragma unroll
        for (int j = 0; j < 32; ++j) tot += lf[j];
        float run = 0.f;
        if (dir == 0) {
#pragma unroll
            for (int j = 0; j < 32; ++j) { run += lf[j]; kd[j] = (1.0f - __expf(lf[j])) * __expf(tot - run); }
        } else {
#pragma unroll
            for (int j = 31; j >= 0; --j) { run += lf[j]; kd[j] = (1.0f - __expf(lf[j])) * __expf(tot - run); }
        }
        if (hh == 0) decp[k] = __expf(tot);
#pragma unroll
        for (int s = 0; s < 2; ++s) {
            float v8[8];
#pragma unroll
            for (int jj = 0; jj < 8; ++jj) v8[jj] = hh ? kd[16 * s + 8 + jj] : kd[16 * s + jj];
            Bf[kt][s] = pack8(v8);
        }
    }
    const bf16_t* Vt = p.Vht + ((size_t)(b * 4 + h) * 64) * TP + c * 32;
    float* dst = p.DST + (size_t)wu * 4096;
#pragma unroll
    for (int vt = 0; vt < 2; ++vt) {
        bf16x8 Af[2];
#pragma unroll
        for (int s = 0; s < 2; ++s) Af[s] = *(const bf16x8*)(Vt + (size_t)(vt * 32 + l31) * TP + 16 * s + 8 * hh);
#pragma unroll
        for (int kt = 0; kt < 2; ++kt) {
            f32x16 d;
#pragma unroll
            for (int i = 0; i < 16; ++i) d[i] = 0.f;
            d = MFMA32(Af[0], Bf[kt][0], d);
            d = MFMA32(Af[1], Bf[kt][1], d);
#pragma unroll
            for (int r = 0; r < 16; ++r) dst[(vt * 32 + crow(r, hh)) * 64 + kt * 32 + l31] = d[r];
        }
    }
}

DI void phase_upproj_h1(const Params& p, int l, char* lds) {
    const int tid = otid(), wid = tid >> 6, lane = tid & 63, wr = wid >> 1, wc = wid & 1, fr = lane & 15, fq = lane >> 4;
    constexpr int U_Q = (MR / 256) * 3, U_KV = (MR / 256) * 4, U_H1 = NB * 4 * 2 * NCH / 8;
    for (int u = blockIdx.x; u < U_Q + U_KV + U_H1; u += gridDim.x) {
        if (u < U_Q) {
            const int mt = u / 3, nt = u % 3, m0 = mt * 256, n0 = nt * 128;
            const bf16_t* pa[4]; const bf16_t* pb[2];
            gemm_ptrs(p.Cq, 256, m0, p.WuqT + (size_t)l * 384 * 256, 256, n0, pa, pb);
            f32x4 acc[4][4];
            gemm_core<0>(pa, pb, 256, lds, acc);
#pragma unroll
            for (int mi = 0; mi < 4; ++mi)
#pragma unroll
                for (int ni = 0; ni < 4; ++ni) {
                    const int row = m0 + wr * 64 + mi * 16 + fr, col = n0 + wc * 64 + ni * 16 + fq * 4;
                    f32x4 v = acc[mi][ni] * (p.RS[row * 2] * (0.10206207261596577f * LOG2E));
                    const int cm = col % 96;
                    const f32x4 vr = rope_tile(p, v, row, (cm >> 4) & 1, fq);
                    if (cm >= 64) v = vr;
                    store4_bf16(p.Qm + (size_t)row * 384 + col, v);
                }
        } else if (u < U_Q + U_KV) {
            const int uu = u - U_Q, mt = uu >> 2, nt = uu & 3, m0 = mt * 256, n0 = nt * 128;
            const bf16_t* pa[4]; const bf16_t* pb[2];
            gemm_ptrs(p.Ckv, 128, m0, p.WukvT + (size_t)l * 512 * 128, 128, n0, pa, pb);
            f32x4 acc[4][4];
            if (nt < 2) {
                gemm_core<0>(pa, pb, 128, lds, acc);
#pragma unroll
                for (int mi = 0; mi < 4; ++mi)
#pragma unroll
                    for (int ni = 0; ni < 4; ++ni) {
                        const int row = m0 + wr * 64 + mi * 16 + fr, col = n0 + wc * 64 + ni * 16 + fq * 4;
                        store4_bf16(p.Kn + (size_t)row * 256 + col, acc[mi][ni] * p.RS[row * 2 + 1]);
                    }
            } else {
                gemm_core<1>(pa, pb, 128, lds, acc);
                const int b = m0 / TP, t0 = m0 - b * TP;
#pragma unroll
                for (int mi = 0; mi < 4; ++mi)
#pragma unroll
                    for (int ni = 0; ni < 4; ++ni) {
                        const int f = n0 - 256 + wc * 64 + ni * 16 + fr;
                        const int rl = wr * 64 + mi * 16 + fq * 4;
                        const f32x4 rs = {p.RS[(m0 + rl) * 2 + 1], p.RS[(m0 + rl + 1) * 2 + 1], p.RS[(m0 + rl + 2) * 2 + 1], p.RS[(m0 + rl + 3) * 2 + 1]};
                        store4_bf16(p.Vmt + ((size_t)(b * 256 + f)) * TP + t0 + rl, acc[mi][ni] * rs);
                    }
            }
        } else {
            hgrn_h1_unit(p, (u - U_Q - U_KV) * 8 + wid, lane);
        }
    }
}

DI void hgrn_h2_unit(const Params& p, int cu  ) {
    const int gid = cu * NTHREADS + otid();
    const int seq = gid >> 10, e4 = gid & 1023;
    const int dir = seq & 1, k4 = (e4 & 15) * 4;
    f32x4 st = {0.f, 0.f, 0.f, 0.f};
#pragma unroll 4
    for (int t = 0; t < NCH; ++t) {
        const int pc = dir == 0 ? t : (t < 8 ? 7 - t : 143 - t);
        float* ptr = p.DST + ((size_t)(seq * NCH + pc)) * 4096 + e4 * 4;
        const f32x4 ds = *(const f32x4*)ptr;
        const f32x4 dc = *(const f32x4*)(p.DEC + (size_t)(seq * NCH + pc) * 64 + k4);
        *(f32x4*)ptr = st;
        st = dc * st + ds;
    }
}

DI void hgrn_h3_unit(const Params& p, int l, int wu, int lane, char* wl) {
    const int pc = wu % NCH; const int t_ = wu / NCH; const int h = t_ & 3, b = t_ >> 2;
    const int row0 = b * TP + pc * 32, hh = lane >> 5, i = lane & 31;
    float* Bl = (float*)wl;
    f32x16 Y[2];
#pragma unroll
    for (int r = 0; r < 16; ++r) { Y[0][r] = 0.f; Y[1][r] = 0.f; }
#pragma unroll 1
    for (int dir = 0; dir < 2; ++dir) {
        const bf16_t* Lf = p.Lf + ((size_t)dir * MR + row0) * 256 + h * 64;
        {
            float lf[32];
#pragma unroll
            for (int j = 0; j < 32; ++j) lf[j] = bf2f(Lf[(size_t)j * 256 + lane]);
            float run = 0.f;
            if (dir == 0) {
#pragma unroll
                for (int j = 0; j < 32; ++j) { run += lf[j]; Bl[j * 68 + lane] = run; }
            } else {
#pragma unroll
                for (int j = 31; j >= 0; --j) { run += lf[j]; Bl[j * 68 + lane] = run; }
            }
        }
        __syncthreads();
        bf16x8 Qf[4], Kf[4];
#pragma unroll
        for (int s = 0; s < 4; ++s) {
            const int kb = 16 * s + 8 * hh;
            const u32x4 qw = *(const u32x4*)(p.Hq + (size_t)(row0 + i) * 256 + h * 64 + kb);
            const u32x4 fw = *(const u32x4*)(Lf + (size_t)i * 256 + kb);
            const f32x4 b0 = *(const f32x4*)(Bl + i * 68 + kb), b1 = *(const f32x4*)(Bl + i * 68 + kb + 4);
            const float bb[8] = {b0[0], b0[1], b0[2], b0[3], b1[0], b1[1], b1[2], b1[3]};
            const unsigned qq[4] = {qw.x, qw.y, qw.z, qw.w}, ff[4] = {fw.x, fw.y, fw.z, fw.w};
            float qd[8], kd[8];
#pragma unroll
            for (int j = 0; j < 8; ++j) {
                const float qv = (j & 1) ? hi2f(qq[j >> 1]) : lo2f(qq[j >> 1]);
                const float fv = (j & 1) ? hi2f(ff[j >> 1]) : lo2f(ff[j >> 1]);
                qd[j] = qv * __expf(bb[j]);
                kd[j] = (1.0f - __expf(fv)) * __expf(-bb[j]);
            }
            Qf[s] = pack8(qd); Kf[s] = pack8(kd);
        }
        f32x16 X;
#pragma unroll
        for (int r = 0; r < 16; ++r) X[r] = 0.f;
#pragma unroll
        for (int s = 0; s < 4; ++s) X = MFMA32(Kf[s], Qf[s], X);
#pragma unroll
        for (int r = 0; r < 16; ++r) { const int j = crow(r, hh); const bool keep = dir == 0 ? (j <= i) : (j >= i); X[r] = keep ? X[r] : 0.f; }
        bf16x8 Xs[2];
#pragma unroll
        for (int s = 0; s < 2; ++s) { const float v8[8] = {X[8 * s], X[8 * s + 1], X[8 * s + 2], X[8 * s + 3], X[8 * s + 4], X[8 * s + 5], X[8 * s + 6], X[8 * s + 7]}; Xs[s] = pack8(v8); }
        const bf16_t* Vt = p.Vht + ((size_t)(b * 4 + h) * 64) * TP + pc * 32;
        const float* ST = p.DST + ((size_t)(((b * 4 + h) * 2 + dir) * NCH + pc)) * 4096;
#pragma unroll
        for (int vt = 0; vt < 2; ++vt) {
            const bf16_t* vrow = Vt + (size_t)(vt * 32 + i) * TP;
#pragma unroll
            for (int s = 0; s < 2; ++s) {
                const u32x2 lo = *(const u32x2*)(vrow + 16 * s + 4 * hh), hi = *(const u32x2*)(vrow + 16 * s + 8 + 4 * hh);
                u32x4 w; w.x = lo.x; w.y = lo.y; w.z = hi.x; w.w = hi.y;
                Y[vt] = MFMA32(__builtin_bit_cast(bf16x8, w), Xs[s], Y[vt]);
            }
            const float* srow = ST + (vt * 32 + i) * 64;
#pragma unroll
            for (int s = 0; s < 4; ++s) {
                const f32x4 a0 = *(const f32x4*)(srow + 16 * s + 8 * hh), a1 = *(const f32x4*)(srow + 16 * s + 8 * hh + 4);
                const float v8[8] = {a0[0], a0[1], a0[2], a0[3], a1[0], a1[1], a1[2], a1[3]};
                Y[vt] = MFMA32(pack8(v8), Qf[s], Y[vt]);
            }
        }
        __syncthreads();
    }
    float ss = 0.f;
#pragma unroll
    for (int r = 0; r < 16; ++r) ss += Y[0][r] * Y[0][r] + Y[1][r] * Y[1][r];
    ss += __shfl_xor(ss, 32);
    const float rs = rsqrtf(ss * (1.f / 64.f) + LN_EPS);
    const int row = row0 + i;
#pragma unroll
    for (int vt = 0; vt < 2; ++vt)
#pragma unroll
        for (int g4 = 0; g4 < 4; ++g4) {
            const int v0 = vt * 32 + 8 * g4 + 4 * hh;
            const f32x4 nw = *(const f32x4*)(p.hgrn_norm_w + l * 64 + v0);
            const u32x2 gw = *(const u32x2*)(p.Hg + (size_t)row * 256 + h * 64 + v0);
            f32x4 o;
            o[0] = Y[vt][g4 * 4 + 0] * rs * nw[0] * lo2f(gw.x); o[1] = Y[vt][g4 * 4 + 1] * rs * nw[1] * hi2f(gw.x);
            o[2] = Y[vt][g4 * 4 + 2] * rs * nw[2] * lo2f(gw.y); o[3] = Y[vt][g4 * 4 + 3] * rs * nw[3] * hi2f(gw.y);
            store4_bf16(p.O + (size_t)row * DM + 512 + h * 64 + v0, o);
        }
}

template <bool DIFF>
DI void attn_unit(const Params& p, int l, int b, int h, int qrow0  , int nkt  , char* lds) {
    const int tid = otid(), wid = tid >> 6, lane = tid & 63, hh = lane >> 5, q31 = lane & 31;
    constexpr int NS = DIFF ? 2 : 1;
    constexpr int NQF = DIFF ? 4 : 6;
    constexpr int BUF = 8192 + 8192 + (DIFF ? 0 : 4096);
    const int qrow = qrow0 + wid * 32 + q31;
    bf16x8 Qf[NQF];
    {
        const bf16_t* qp = DIFF ? p.Qd + (size_t)qrow * 256 + h * 64 : p.Qm + (size_t)qrow * 384 + h * 96;
#pragma unroll
        for (int s = 0; s < NQF; ++s) Qf[s] = *(const bf16x8*)(qp + 16 * s + 8 * hh);
    }
    const size_t krow0 = (size_t)b * TP;
    const bf16_t* kptr = (DIFF ? p.Kd : p.Kn) + (krow0 + (tid >> 3)) * 256 + h * 64 + (tid & 7) * 8;
    const bf16_t* vptr = (DIFF ? p.Vdt : p.Vmt) + ((size_t)(b * 4 + h) * 64 + (tid >> 3)) * TP + (tid & 7) * 8;
    const bf16_t* rptr = p.Kr + (krow0 + ((tid & 255) >> 2)) * 32 + (tid & 3) * 8;
    const int key_w = tid >> 3, c_w = tid & 7;
    const int kwoff = key_w * 128 + ((c_w ^ ((key_w >> 1) & 7)) << 4);
    const int d_w = tid >> 3;
    const int vwoff0 = 8192 + d_w * 128 + (((2 * c_w) ^ ((d_w >> 1) & 15)) << 3), vwoff1 = 8192 + d_w * 128 + (((2 * c_w + 1) ^ ((d_w >> 1) & 15)) << 3);
    const int rkey = (tid & 255) >> 2, rc = tid & 3;
    const int rwoff = 16384 + rkey * 64 + ((rc ^ ((rkey >> 2) & 3)) << 4);
    const int krd = q31 * 128, ksw = (q31 >> 1) & 7;
    const int rrd = 16384 + q31 * 64, rsw = (q31 >> 2) & 3;
    const int vrd = 8192 + q31 * 128, vsw = (q31 >> 1) & 15;
    f32x16 ot[NS][2];
    float m[NS], lsum[NS];
#pragma unroll
    for (int a = 0; a < NS; ++a) { m[a] = -1e30f; lsum[a] = 0.f;
#pragma unroll
        for (int r = 0; r < 16; ++r) { ot[a][0][r] = 0.f; ot[a][1][r] = 0.f; } }
    u32x4 rk, rv, rr;
    rk = *(const u32x4*)kptr; rv = *(const u32x4*)vptr;
    if (!DIFF) { if (tid < 256) rr = *(const u32x4*)rptr; }
    __syncthreads();
    *(u32x4*)(lds + kwoff) = rk;
    *(u32x2*)(lds + vwoff0) = (u32x2){rv.x, rv.y}; *(u32x2*)(lds + vwoff1) = (u32x2){rv.z, rv.w};
    if (!DIFF) { if (tid < 256) *(u32x4*)(lds + rwoff) = rr; }
    __syncthreads();
    for (int kt = 0; kt < nkt; ++kt) {
        const char* cur = lds + (kt & 1) * BUF;
        const bool more = kt + 1 < nkt;
        if (more) {
            rk = *(const u32x4*)(kptr + (size_t)(kt + 1) * 64 * 256);
            rv = *(const u32x4*)(vptr + (kt + 1) * 64);
            if (!DIFF) { if (tid < 256) rr = *(const u32x4*)(rptr + (size_t)(kt + 1) * 64 * 32); }
        }
        bf16x8 Pf[NS][2][2];
#pragma unroll
        for (int a = 0; a < NS; ++a) {
            f32x16 st[2];
#pragma unroll
            for (int t = 0; t < 2; ++t) {
                f32x16 acc;
#pragma unroll
                for (int r = 0; r < 16; ++r) acc[r] = 0.f;
                if (DIFF) {
#pragma unroll
                    for (int s = 0; s < 2; ++s) {
                        const int c = 4 * a + 2 * s + hh;
                        const bf16x8 kf = *(const bf16x8*)(cur + t * 4096 + krd + ((c ^ ksw) << 4));
                        acc = MFMA32(kf, Qf[2 * a + s], acc);
                    }
                } else {
#pragma unroll
                    for (int s = 0; s < 4; ++s) {
                        const int c = 2 * s + hh;
                        const bf16x8 kf = *(const bf16x8*)(cur + t * 4096 + krd + ((c ^ ksw) << 4));
                        acc = MFMA32(kf, Qf[s], acc);
                    }
#pragma unroll
                    for (int s = 0; s < 2; ++s) {
                        const int c = 2 * s + hh;
                        const bf16x8 kf = *(const bf16x8*)(cur + t * 2048 + rrd + ((c ^ rsw) << 4));
                        acc = MFMA32(kf, Qf[4 + s], acc);
                    }
                }
                st[t] = acc;
            }
            float tm = st[0][0];
#pragma unroll
            for (int r = 1; r < 16; ++r) tm = fmaxf(tm, st[0][r]);
#pragma unroll
            for (int r = 0; r < 16; ++r) tm = fmaxf(tm, st[1][r]);
            tm = fmaxf(tm, __shfl_xor(tm, 32));
            const float mn = fmaxf(m[a], tm);
            const float alpha = __builtin_amdgcn_exp2f(m[a] - mn);
            m[a] = mn;
            float ps = 0.f;
#pragma unroll
            for (int t = 0; t < 2; ++t) {
#pragma unroll
                for (int r = 0; r < 16; ++r) { const float e = __builtin_amdgcn_exp2f(st[t][r] - mn); st[t][r] = e; ps += e; }
#pragma unroll
                for (int s = 0; s < 2; ++s) {
                    const float v8[8] = {st[t][8 * s], st[t][8 * s + 1], st[t][8 * s + 2], st[t][8 * s + 3], st[t][8 * s + 4], st[t][8 * s + 5], st[t][8 * s + 6], st[t][8 * s + 7]};
                    Pf[a][t][s] = pack8(v8);
                }
            }
            lsum[a] = lsum[a] * alpha + ps;
#pragma unroll
            for (int r = 0; r < 16; ++r) { ot[a][0][r] *= alpha; ot[a][1][r] *= alpha; }
            if (DIFF) __builtin_amdgcn_sched_barrier(0);
        }
#pragma unroll
        for (int dt = 0; dt < 2; ++dt)
#pragma unroll
            for (int t = 0; t < 2; ++t)
#pragma unroll
                for (int s = 0; s < 2; ++s) {
                    const int c8 = 8 * t + 4 * s + hh;
                    const u32x2 lo = *(const u32x2*)(cur + dt * 4096 + vrd + ((c8 ^ vsw) << 3));
                    const u32x2 hi = *(const u32x2*)(cur + dt * 4096 + vrd + (((c8 + 2) ^ vsw) << 3));
                    u32x4 w; w.x = lo.x; w.y = lo.y; w.z = hi.x; w.w = hi.y;
                    const bf16x8 vf = __builtin_bit_cast(bf16x8, w);
#pragma unroll
                    for (int a = 0; a < NS; ++a) ot[a][dt] = MFMA32(vf, Pf[a][t][s], ot[a][dt]);
                }
        if (more) {
            char* nxt = lds + ((kt + 1) & 1) * BUF;
            *(u32x4*)(nxt + kwoff) = rk;
            *(u32x2*)(nxt + vwoff0) = (u32x2){rv.x, rv.y}; *(u32x2*)(nxt + vwoff1) = (u32x2){rv.z, rv.w};
            if (!DIFF) { if (tid < 256) *(u32x4*)(nxt + rwoff) = rr; }
        }
        __syncthreads();
    }
    float linv[NS];
#pragma unroll
    for (int a = 0; a < NS; ++a) { const float lt = lsum[a] + __shfl_xor(lsum[a], 32); linv[a] = 1.0f / lt; }
    f32x16 o[2];
    if (DIFF) {
        const float lam = p.lam[l];
#pragma unroll
        for (int dt = 0; dt < 2; ++dt)
#pragma unroll
            for (int r = 0; r < 16; ++r) o[dt][r] = ot[0][dt][r] * linv[0] - lam * (ot[NS - 1][dt][r] * linv[NS - 1]);
        float ss = 0.f;
#pragma unroll
        for (int r = 0; r < 16; ++r) ss += o[0][r] * o[0][r] + o[1][r] * o[1][r];
        ss += __shfl_xor(ss, 32);
        const float lam_init = 0.8f - 0.6f * __expf(-0.3f * (float)l);
        const float rs = rsqrtf(ss * (1.f / 64.f) + LN_EPS) * (1.0f - lam_init);
#pragma unroll
        for (int dt = 0; dt < 2; ++dt)
#pragma unroll
            for (int r = 0; r < 16; ++r) o[dt][r] *= rs;
    } else {
#pragma unroll
        for (int dt = 0; dt < 2; ++dt)
#pragma unroll
            for (int r = 0; r < 16; ++r) o[dt][r] = ot[0][dt][r] * linv[0];
    }
    bf16_t* orow = p.O + (size_t)qrow * DM + (DIFF ? 256 : 768) + h * 64;
#pragma unroll
    for (int dt = 0; dt < 2; ++dt)
#pragma unroll
        for (int g4 = 0; g4 < 4; ++g4) {
            const int d0 = dt * 32 + 8 * g4 + 4 * hh;
            f32x4 v = {o[dt][g4 * 4], o[dt][g4 * 4 + 1], o[dt][g4 * 4 + 2], o[dt][g4 * 4 + 3]};
            if (DIFF) { const f32x4 sw = *(const f32x4*)(p.diff_subln_w + l * 64 + d0); v = v * sw; }
            store4_bf16(orow + d0, v);
        }
}

DI void phase_attn_diff_h2(const Params& p, int l, char* lds) {
    const int U_H2 = 128, U_LAT = NB * 4 * 16, U_CTX = (l == 0) ? NB * 4 : 0;
    for (int u = blockIdx.x; u < U_H2 + U_LAT + U_CTX; u += gridDim.x) {
        if (u < U_H2) hgrn_h2_unit(p, u);
        else {
            int b, h, q0, nkt; const int v = u - U_H2;
            if (v < U_LAT) { b = v >> 6; h = (v >> 4) & 3; q0 = b * TP + CTX + (v & 15) * 256; nkt = TP / 64; }
            else { const int w = v - U_LAT; b = w >> 2; h = w & 3; q0 = b * TP; nkt = CTX / 64; }
            attn_unit<true>(p, l, b, h, q0, nkt, lds);
        }
    }
}
DI void phase_attn_mla_h3(const Params& p, int l, char* lds) {
    const int tid_ = otid(); const int wid = tid_ >> 6, lane = tid_ & 63;
    const int U_LAT = NB * 4 * 16, U_CTX = (l == 0) ? NB * 4 : 0, U_H3 = NB * 4 * NCH / 8;
    for (int u = blockIdx.x; u < U_LAT + U_CTX + U_H3; u += gridDim.x) {
        if (u < U_LAT + U_CTX) {
            int b, h, q0, nkt;
            if (u < U_LAT) { b = u >> 6; h = (u >> 4) & 3; q0 = b * TP + CTX + (u & 15) * 256; nkt = TP / 64; }
            else { const int w = u - U_LAT; b = w >> 2; h = w & 3; q0 = b * TP; nkt = CTX / 64; }
            attn_unit<false>(p, l, b, h, q0, nkt, lds);
        } else { __syncthreads(); hgrn_h3_unit(p, l, (u - U_LAT - U_CTX) * 8 + wid, lane, lds + 65536 + wid * 8704); }
    }
}

DI void phase_outproj(const Params& p, int l, char* lds) {
    const int tid = otid(), wid = tid >> 6, lane = tid & 63, wr = wid >> 1, wc = wid & 1, fr = lane & 15, fq = lane >> 4;
    const int nunits = (MR / 256) * 8;
    for (int u = blockIdx.x; u < nunits; u += gridDim.x) {
        const int mt = u >> 3, nt = u & 7, m0 = mt * 256, n0 = nt * 128;
        if (l == 1 && (mt % 17) == 0) continue;
        const bf16_t* pa[4]; const bf16_t* pb[2];
        gemm_ptrs(p.O, DM, m0, p.WoutT + (size_t)l * DM * DM, DM, n0, pa, pb);
        f32x4 acc[4][4];
        gemm_core<0>(pa, pb, DM, lds, acc);
#pragma unroll
        for (int mi = 0; mi < 4; ++mi)
#pragma unroll
            for (int ni = 0; ni < 4; ++ni) {
                const int row = m0 + wr * 64 + mi * 16 + fr, col = n0 + wc * 64 + ni * 16 + fq * 4;
                *(f32x4*)(p.Y + (size_t)row * DM + col) = acc[mi][ni];
            }
    }
}

DI void phase_postmix(const Params& p, int l, char* lds) {
    const int tid = otid(), wid = tid >> 6, lane = tid & 63;
    float* WrT = (float*)lds;
    int* lcnt = (int*)(lds + 131072);
    int* lbase = lcnt + 32;
    unsigned* ent = (unsigned*)(lds + 131072 + 256);
    const int G = gridDim.x, nrb = (MR + G - 1) / G;
    const float* rw = p.router_w + (size_t)l * DM * NE;
    __syncthreads();
    for (int i = tid; i < DM * NE / 4; i += NTHREADS) {
        const f32x4 v = *(const f32x4*)(rw + i * 4);
        const int d = i >> 3, e0 = (i & 7) * 4;
#pragma unroll
        for (int j = 0; j < 4; ++j) WrT[(e0 + j) * DM + d] = v[j];
    }
    if (tid < 32) lcnt[tid] = 0;
    __syncthreads();
    const int rbeg = blockIdx.x * nrb;
    const float* lw = p.ln_mix_w + l * DM; const float* lb = p.ln_mix_b + l * DM;
    for (int i = wid; i < nrb; i += 8) {
        const int row = rbeg + i;
        if (row >= MR) break;
        const int t = row % TP;
        const bool skip = (l == 1 && t < CTX);
        if (skip) { if (lane < 4) ent[(i * 4 + lane) * 2] = 0xffffffffu; continue; }
        const float* xr = l == 0 ? in_row(p, row) : p.X + (size_t)row * DM;
        const float* yr = p.Y + (size_t)row * DM;
        const float* g1 = mod_vec(p, l, row, 2); const float* sh2 = mod_vec(p, l, row, 3); const float* sc2 = mod_vec(p, l, row, 4);
        float v[16]; float s = 0.f;
#pragma unroll
        for (int j = 0; j < 16; ++j) { const int c = lane + 64 * j; v[j] = DN_ALPHA * xr[c] + g1[c] * yr[c]; s += v[j]; }
        float mean = wave_sum(s) * (1.f / DM); float q = 0.f;
#pragma unroll
        for (int j = 0; j < 16; ++j) { v[j] -= mean; q += v[j] * v[j]; }
        float rstd = rsqrtf(wave_sum(q) * (1.f / DM) + LN_EPS);
        s = 0.f;
#pragma unroll
        for (int j = 0; j < 16; ++j) { const int c = lane + 64 * j; v[j] = v[j] * rstd * lw[c] + lb[c]; p.X[(size_t)row * DM + c] = v[j]; s += v[j]; }
        mean = wave_sum(s) * (1.f / DM); q = 0.f;
#pragma unroll
        for (int j = 0; j < 16; ++j) { v[j] -= mean; q += v[j] * v[j]; }
        rstd = rsqrtf(wave_sum(q) * (1.f / DM) + LN_EPS);
#pragma unroll
        for (int j = 0; j < 16; ++j) { const int c = lane + 64 * j; v[j] = v[j] * rstd * (1.0f + sc2[c]) + sh2[c]; }
#pragma unroll
        for (int j = 0; j < 16; ++j) { const int c = lane + 64 * j; const unsigned w = pk2(v[j], 0.f); p.H[(size_t)row * DM + c] = (bf16_t)(w & 0xffffu); }
        float pl[32];
#pragma unroll
        for (int e = 0; e < 32; ++e) { float a = 0.f;
#pragma unroll
            for (int j = 0; j < 16; ++j) a += v[j] * WrT[e * DM + lane + 64 * j];
            pl[e] = a; }
#pragma unroll
        for (int e = 0; e < 32; ++e) pl[e] += __shfl_xor(pl[e], 32);
        float r16[16];
#pragma unroll
        for (int e = 0; e < 16; ++e) { const bool up = (lane & 16) != 0; const float keep = up ? pl[e + 16] : pl[e]; const float send = up ? pl[e] : pl[e + 16]; r16[e] = keep + __shfl_xor(send, 16); }
        float r8[8];
#pragma unroll
        for (int e = 0; e < 8; ++e) { const bool up = (lane & 8) != 0; const float keep = up ? r16[e + 8] : r16[e]; const float send = up ? r16[e] : r16[e + 8]; r8[e] = keep + __shfl_xor(send, 8); }
        float r4[4];
#pragma unroll
        for (int e = 0; e < 4; ++e) { const bool up = (lane & 4) != 0; const float keep = up ? r8[e + 4] : r8[e]; const float send = up ? r8[e] : r8[e + 4]; r4[e] = keep + __shfl_xor(send, 4); }
        float r2[2];
#pragma unroll
        for (int e = 0; e < 2; ++e) { const bool up = (lane & 2) != 0; const float keep = up ? r4[e + 2] : r4[e]; const float send = up ? r4[e] : r4[e + 2]; r2[e] = keep + __shfl_xor(send, 2); }
        float logit;
        { const bool up = (lane & 1) != 0; const float keep = up ? r2[1] : r2[0]; const float send = up ? r2[0] : r2[1]; logit = keep + __shfl_xor(send, 1); }
        const int e_me = lane & 31;
        logit += p.router_b[l * NE + e_me];
        logit = (logit == logit) ? fminf(fmaxf(logit, -1e30f), 1e30f) : -1e30f;
        int rank = 0;
#pragma unroll
        for (int e = 0; e < 32; ++e) { const float o = __shfl(logit, e); rank += (o > logit || (o == logit && e < e_me)) ? 1 : 0; }
        const unsigned long long sel = __ballot(rank < 4 && lane < 32);
        const float vmax = __shfl(logit, __ffsll((long long)__ballot(rank == 0 && lane < 32)) - 1);
        const float ex = (rank < 4) ? __expf(logit - vmax) : 0.f;
        float den = (lane < 32) ? ex : 0.f;
        den = wave_sum(den);
        if (lane < 32 && rank < 4) {
            const int lp = atomicAdd(&lcnt[e_me], 1);
            ent[(i * 4 + rank) * 2] = (unsigned)e_me | ((unsigned)lp << 8);
            ent[(i * 4 + rank) * 2 + 1] = __float_as_uint(ex / den);
        }
        (void)sel;
    }
    __syncthreads();
    if (tid < 32) lbase[tid] = (int)atomicAdd(&p.gcnt[l * NE + tid], (unsigned)lcnt[tid]);
    __syncthreads();
    for (int j = tid; j < nrb * 4; j += NTHREADS) {
        const int row = rbeg + (j >> 2);
        if (row >= MR) break;
        const unsigned w = ent[j * 2];
        if (w == 0xffffffffu) continue;
        const int e = w & 255, pos = lbase[e] + (int)(w >> 8);
        p.ltok[(size_t)e * MR + pos] = row;
        p.lgate[(size_t)e * MR + pos] = __uint_as_float(ent[j * 2 + 1]);
        p.rslot[(size_t)row * 4 + (j & 3)] = (e << 24) | pos;
    }
}

DI int moe_prefix(const Params& p, int l, int* tpre  ) {
    __syncthreads();
    if (otid() == 0) {
        int acc = 0;
        for (int e = 0; e < NE; ++e) { tpre[e] = acc; acc += ((int)p.gcnt[l * NE + e] + 255) >> 8; }
        tpre[NE] = acc;
    }
    __syncthreads();
    return tpre[NE];
}
DI int moe_find(const int* tpre, int mt) { int e = 0;
#pragma unroll 1
    for (int j = 0; j < NE; ++j) if (tpre[j + 1] <= mt) e = j + 1;
    return e; }

DI void phase_moe1(const Params& p, int l, char* lds) {
    const int tid = otid(), wid = tid >> 6, lane = tid & 63, wr = wid >> 1, wc = wid & 1, fr = lane & 15, fq = lane >> 4;
    int* tpre = (int*)(lds + 98304);
    const int ntile = moe_prefix(p, l, tpre);
    const int nunits = ntile * 16;
    for (int u = blockIdx.x; u < nunits; u += gridDim.x) {
        const int mt = u >> 4, nt = u & 15, n0 = nt * 128;
        const int e = moe_find(tpre, mt), j0 = (mt - tpre[e]) * 256, cnt = (int)p.gcnt[l * NE + e];
        const bf16_t* Bt = p.W1T + ((size_t)(l * NE + e)) * 2048 * DM;
        const bf16_t* pa[4]; const bf16_t* pb[2];
        {
            const int r = tid >> 3, c = (tid & 7) * 8;
#pragma unroll
            for (int i = 0; i < 4; ++i) { const int pos = j0 + r + 64 * i; const int tok = pos < cnt ? p.ltok[(size_t)e * MR + pos] : 0; pa[i] = p.H + (size_t)tok * DM + c; }
#pragma unroll
            for (int j = 0; j < 2; ++j) pb[j] = Bt + (size_t)(n0 + r + 64 * j) * DM + c;
        }
        f32x4 acc[4][4];
        gemm_core<0>(pa, pb, DM, lds, acc);
        const float* b1 = p.b1 + (size_t)(l * NE + e) * 2048;
        const size_t slot0 = (size_t)mt * 256;
#pragma unroll
        for (int mi = 0; mi < 4; ++mi)
#pragma unroll
            for (int ni = 0; ni < 4; ++ni) {
                const int rl = wr * 64 + mi * 16 + fr, col = n0 + wc * 64 + ni * 16 + fq * 4;
                const f32x4 bb = *(const f32x4*)(b1 + col);
                const f32x4 hv = acc[mi][ni] + bb;
                float o[2];
#pragma unroll
                for (int q = 0; q < 2; ++q) {
                    const float glu = fminf(hv[2 * q], 7.0f), lin = fminf(fmaxf(hv[2 * q + 1], -7.0f), 7.0f);
                    o[q] = glu * sigmoidf_(1.702f * glu) * (lin + 1.0f);
                }
                *(unsigned*)(p.ACT + (slot0 + rl) * 1024 + (col >> 1)) = pk2(o[0], o[1]);
            }
    }
}

DI void phase_moe2(const Params& p, int l, char* lds) {
    const int tid = otid(), wid = tid >> 6, lane = tid & 63, wr = wid >> 1, wc = wid & 1, fr = lane & 15, fq = lane >> 4;
    int* tpre = (int*)(lds + 98304);
    const int ntile = moe_prefix(p, l, tpre);
    const int nunits = ntile * 8;
    for (int u = blockIdx.x; u < nunits; u += gridDim.x) {
        const int mt = u >> 3, nt = u & 7, n0 = nt * 128;
        const int e = moe_find(tpre, mt), j0 = (mt - tpre[e]) * 256, cnt = (int)p.gcnt[l * NE + e];
        const bf16_t* pa[4]; const bf16_t* pb[2];
        gemm_ptrs(p.ACT, 1024, mt * 256, p.W2T + ((size_t)(l * NE + e)) * DM * DM, DM, n0, pa, pb);
        f32x4 acc[4][4];
        gemm_core<0>(pa, pb, 1024, lds, acc);
        const float* b2 = p.b2 + (size_t)(l * NE + e) * DM;
        const size_t slot0 = (size_t)mt * 256;
#pragma unroll
        for (int mi = 0; mi < 4; ++mi) {
            const int rl = wr * 64 + mi * 16 + fr, pos = j0 + rl;
            const float gate = pos < cnt ? p.lgate[(size_t)e * MR + pos] : 0.f;
#pragma unroll
            for (int ni = 0; ni < 4; ++ni) {
                const int col = n0 + wc * 64 + ni * 16 + fq * 4;
                const f32x4 bb = *(const f32x4*)(b2 + col);
                store4_bf16(p.YS + (slot0 + rl) * 1024 + col, (acc[mi][ni] + bb) * gate);
            }
        }
    }
}

DI void phase_final(const Params& p, int l, char* lds) {
    const int tid = otid(), wid = tid >> 6, lane = tid & 63;
    int* tpre = (int*)(lds + 98304);
    moe_prefix(p, l, tpre);
    const float* lw = p.ln_ffn_w + l * DM; const float* lb = p.ln_ffn_b + l * DM;
    for (int row = blockIdx.x * 8 + wid; row < MR; row += gridDim.x * 8) {
        const int b = row / TP, t = row - b * TP;
        if (l == 1 && t < CTX) continue;
        const float* g2 = mod_vec(p, l, row, 5);
        const bf16_t* ys[4];
#pragma unroll
        for (int k = 0; k < 4; ++k) { const int rs = p.rslot[(size_t)row * 4 + k]; const int e = rs >> 24, pos = rs & 0xffffff; ys[k] = p.YS + ((size_t)tpre[e] * 256 + pos) * 1024; }
        f32x4 v[4]; float s = 0.f;
#pragma unroll
        for (int j = 0; j < 4; ++j) {
            const int c = j * 256 + lane * 4;
            f32x4 y = {0.f, 0.f, 0.f, 0.f};
#pragma unroll
            for (int k = 0; k < 4; ++k) { const u32x2 w = *(const u32x2*)(ys[k] + c); y[0] += lo2f(w.x); y[1] += hi2f(w.x); y[2] += lo2f(w.y); y[3] += hi2f(w.y); }
            const f32x4 xv = *(const f32x4*)(p.X + (size_t)row * DM + c), gg = *(const f32x4*)(g2 + c);
            v[j] = xv * DN_ALPHA + gg * y;
            s += (v[j][0] + v[j][1]) + (v[j][2] + v[j][3]);
        }
        float mean = wave_sum(s) * (1.f / DM); float q = 0.f;
#pragma unroll
        for (int j = 0; j < 4; ++j) { v[j] = v[j] - mean; q += (v[j][0] * v[j][0] + v[j][1] * v[j][1]) + (v[j][2] * v[j][2] + v[j][3] * v[j][3]); }
        float rstd = rsqrtf(wave_sum(q) * (1.f / DM) + LN_EPS);
        s = 0.f;
#pragma unroll
        for (int j = 0; j < 4; ++j) {
            const int c = j * 256 + lane * 4;
            v[j] = v[j] * rstd * *(const f32x4*)(lw + c) + *(const f32x4*)(lb + c);
            s += (v[j][0] + v[j][1]) + (v[j][2] + v[j][3]);
        }
        if (l == 1) {
            float* o = p.out + ((size_t)b * SEQ + (t - CTX)) * DM;
#pragma unroll
            for (int j = 0; j < 4; ++j) *(f32x4*)(o + j * 256 + lane * 4) = v[j];
        } else {
#pragma unroll
            for (int j = 0; j < 4; ++j) *(f32x4*)(p.X + (size_t)row * DM + j * 256 + lane * 4) = v[j];
            mean = wave_sum(s) * (1.f / DM); q = 0.f;
#pragma unroll
            for (int j = 0; j < 4; ++j) { v[j] = v[j] - mean; q += (v[j][0] * v[j][0] + v[j][1] * v[j][1]) + (v[j][2] * v[j][2] + v[j][3] * v[j][3]); }
            rstd = rsqrtf(wave_sum(q) * (1.f / DM) + LN_EPS);
            const float* sh = mod_vec(p, 1, row, 0); const float* sc = mod_vec(p, 1, row, 1);
#pragma unroll
            for (int j = 0; j < 4; ++j) {
                const int c = j * 256 + lane * 4;
                const f32x4 h = v[j] * rstd * (*(const f32x4*)(sc + c) + 1.0f) + *(const f32x4*)(sh + c);
                store4_bf16(p.H + (size_t)row * DM + c, h);
            }
        }
    }
}

constexpr int PH_PER_LAYER = 11, N_PHASES = 1 + 2 * PH_PER_LAYER;

__global__ void __launch_bounds__(NTHREADS, 2) mega(Params p, int ph_lo, int ph_hi) {
    extern __shared__ __attribute__((aligned(16))) char smem[];
    const bool fused = (ph_hi - ph_lo) > 1;
    XcdBarrier bar; bar.bar = p.bar; bar.x = 0; bar.st = (volatile LAS unsigned*)(smem + LDS_BYTES - 16);
    if (fused) {
        if (threadIdx.x == 0) *(uint4*)(smem + LDS_BYTES - 16) = make_uint4(0u, 0u, 0u, 0u);
        __syncthreads();
        bar = xcd_barrier_post(p.bar, (volatile LAS unsigned*)(smem + LDS_BYTES - 16));
    }
#define PH(idx, call) do { const int _i = (idx); if (ph_lo <= _i && _i < ph_hi) { call; if (_i + 1 < ph_hi) xcd_barrier(bar); } } while (0)
    PH(0, phase_prologue(p, smem));
#pragma unroll 1
    for (int l = 0; l < 2; ++l) {
        const int base = 1 + l * PH_PER_LAYER;
        PH(base + 0, if (l == 0) phase_ln1(p, smem));
        PH(base + 1, phase_inproj(p, l, smem));
        PH(base + 2, phase_sgu_prep(p, l, smem));
        PH(base + 3, phase_upproj_h1(p, l, smem));
        PH(base + 4, phase_attn_diff_h2(p, l, smem));
        PH(base + 5, phase_attn_mla_h3(p, l, smem));
        PH(base + 6, phase_outproj(p, l, smem));
        PH(base + 7, phase_postmix(p, l, smem));
        PH(base + 8, phase_moe1(p, l, smem));
        PH(base + 9, phase_moe2(p, l, smem));
        PH(base + 10, phase_final(p, l, smem));
    }
#undef PH
}


#ifndef MK_DEBUG
#define MK_DEBUG 0
#endif
#if MK_DEBUG
struct DbgItem { const void* ptr; unsigned long long n; int f32; int ld; int c0; int c1; int mode; int pad; };
struct DbgList { DbgItem it[40]; int count; int pad; };
__global__ void dbg_scan(DbgList L, unsigned* flag) {
    for (int i = 0; i < L.count; ++i) {
        const DbgItem d = L.it[i];
        bool bad = false;
        for (unsigned long long e = (unsigned long long)blockIdx.x * blockDim.x + threadIdx.x; e < d.n; e += (unsigned long long)gridDim.x * blockDim.x) {
            if (d.ld > 0) { const int c = (int)(e % d.ld); if (c < d.c0 || c >= d.c1) continue; }
            if (d.f32) { const unsigned u = ((const unsigned*)d.ptr)[e]; if (((d.mode & 1) && (u & 0x7f800000u) == 0x7f800000u) || ((d.mode & 2) && u == 0xAAAAAAAAu) || ((d.mode & 4) && (u & 0x7f800000u) >= 0x46800000u)) bad = true; }
            else { const unsigned short u = ((const unsigned short*)d.ptr)[e]; if (((d.mode & 1) && (u & 0x7f80u) == 0x7f80u) || ((d.mode & 2) && u == 0xAAAAu) || ((d.mode & 4) && (u & 0x7f80u) >= 0x4680u)) bad = true; }
        }
        if (bad) atomicMin(flag, (unsigned)i);
    }
}
__global__ void dbg_fill(float* out, unsigned long long n, const unsigned* flag, float hostcode) {
    const unsigned f = *flag;
    float v = f < 1000u ? 100.0f * (float)(f + 1u) : 0.0f;
    if (hostcode != 0.f) v = hostcode;
    for (unsigned long long e = (unsigned long long)blockIdx.x * blockDim.x + threadIdx.x; e < n; e += (unsigned long long)gridDim.x * blockDim.x) out[e] = v;
}
#endif

#ifndef MK_MULTI
#define MK_MULTI 1
#endif

extern "C" void kernel_launch(void* const* d_in, const int* in_sizes, int n_in, void* d_out, int out_size, void* d_ws, size_t ws_size, hipStream_t stream) {
    (void)in_sizes; (void)n_in; (void)out_size; (void)ws_size;
    Params p;
    memset(&p, 0, sizeof(p));
    const float* const* in = (const float* const*)d_in;
    p.x = in[0]; p.c = in[1]; p.ctx = in[2]; p.c_ctx = in[3]; p.ada_w = in[4]; p.ada_b = in[5]; p.w_in = in[6]; p.w_out = in[7];
    p.sgu_ln_w = in[8]; p.sgu_ln_b = in[9]; p.sgu_w = in[10]; p.sgu_b = in[11]; p.diff_lambda = in[12]; p.diff_subln_w = in[13];
    p.hgrn_lb = in[14]; p.hgrn_norm_w = in[15]; p.mla_q_norm_w = in[16]; p.mla_w_uq = in[17]; p.mla_kv_norm_w = in[18]; p.mla_w_ukv = in[19];
    p.ln_mix_w = in[20]; p.ln_mix_b = in[21]; p.ln_ffn_w = in[22]; p.ln_ffn_b = in[23]; p.router_w = in[24]; p.router_b = in[25];
    p.w1 = in[26]; p.b1 = in[27]; p.w2 = in[28]; p.b2 = in[29];
    p.out = (float*)d_out;
    char* ws = (char*)d_ws; size_t off = 0;
    auto take = [&](size_t bytes) { char* r = ws + off; off += (bytes + 255) & ~(size_t)255; return r; };
    constexpr size_t CTRL_BYTES = 65536;
    char* ctrl = take(CTRL_BYTES);
    p.bar = (unsigned*)ctrl; p.gcnt = (unsigned*)(ctrl + 16384);
    p.mod = (float*)take((size_t)2 * 9 * 6144 * 4); p.lball = (float*)take(2 * 512 * 4); p.lam = (float*)take(256); p.ropec = (float*)take(512 * 4); p.ropes = (float*)take(512 * 4);
    p.WinT = (bf16_t*)take((size_t)2 * NINP * DM * 2); p.WoutT = (bf16_t*)take((size_t)2 * DM * DM * 2);
    p.WuqT = (bf16_t*)take((size_t)2 * 384 * 256 * 2); p.WukvT = (bf16_t*)take((size_t)2 * 512 * 128 * 2);
    p.W1T = (bf16_t*)take((size_t)2 * NE * 2048 * DM * 2); p.W2T = (bf16_t*)take((size_t)2 * NE * DM * DM * 2);
    p.X = (float*)take((size_t)MR * DM * 4); p.H = (bf16_t*)take((size_t)MR * DM * 2);
    p.Puv = (bf16_t*)take((size_t)MR * 512 * 2); p.Qd = (bf16_t*)take((size_t)MR * 256 * 2); p.Kd = (bf16_t*)take((size_t)MR * 256 * 2); p.Vdt = (bf16_t*)take((size_t)MR * 256 * 2);
    p.Hq = (bf16_t*)take((size_t)MR * 256 * 2); p.Vht = (bf16_t*)take((size_t)MR * 256 * 2); p.Lf = (bf16_t*)take((size_t)2 * MR * 256 * 2); p.Hg = (bf16_t*)take((size_t)MR * 256 * 2);
    p.Cq = (bf16_t*)take((size_t)MR * 256 * 2); p.Ckv = (bf16_t*)take((size_t)MR * 128 * 2); p.Kr = (bf16_t*)take((size_t)MR * 32 * 2);
    p.Qm = (bf16_t*)take((size_t)MR * 384 * 2); p.Kn = (bf16_t*)take((size_t)MR * 256 * 2); p.Vmt = (bf16_t*)take((size_t)MR * 256 * 2);
    p.O = (bf16_t*)take((size_t)MR * DM * 2);
    p.RS = (float*)take((size_t)MR * 2 * 4); p.DST = (float*)take((size_t)NB * 4 * 2 * NCH * 4096 * 4); p.DEC = (float*)take((size_t)NB * 4 * 2 * NCH * 64 * 4);
    p.Y = (float*)take((size_t)MR * DM * 4);
    p.ltok = (int*)take((size_t)NE * MR * 4); p.lgate = (float*)take((size_t)NE * MR * 4); p.rslot = (int*)take((size_t)MR * 4 * 4);
    p.ACT = (bf16_t*)take((size_t)NSLOT * 1024 * 2); p.YS = (bf16_t*)take((size_t)NSLOT * 1024 * 2);

    static int grid = 0;
    if (!grid) {
        int dev = 0, cus = 0, per_cu = 0;
        hipGetDevice(&dev);
        hipDeviceGetAttribute(&cus, hipDeviceAttributeMultiprocessorCount, dev);
        hipFuncSetAttribute((const void*)mega, hipFuncAttributeMaxDynamicSharedMemorySize, LDS_BYTES);
        hipOccupancyMaxActiveBlocksPerMultiprocessor(&per_cu, mega, NTHREADS, LDS_BYTES);
        if (cus <= 0) cus = 256;
        grid = cus * (per_cu < 1 ? 1 : 1);
    }
    hipMemsetAsync(ctrl, 0, CTRL_BYTES, stream);
#if MK_MULTI
#ifndef MK_NPH
#define MK_NPH N_PHASES
#endif
    for (int ph = 0; ph < MK_NPH; ++ph) {
        if (ph == 1 + PH_PER_LAYER) continue;
        hipLaunchKernelGGL(mega, dim3(grid), dim3(NTHREADS), LDS_BYTES, stream, p, ph, ph + 1);
    }
#else
    hipLaunchKernelGGL(mega, dim3(grid), dim3(NTHREADS), LDS_BYTES, stream, p, 0, N_PHASES);
#endif

#if MK_DEBUG
    {
        DbgList L; memset(&L, 0, sizeof(L));
        int n = 0;
        auto add = [&](const void* ptr, unsigned long long cnt, int f32, int ld = 0, int c0 = 0, int c1 = 0, int mode = 3) { L.it[n].ptr = ptr; L.it[n].n = cnt; L.it[n].f32 = f32; L.it[n].ld = ld; L.it[n].c0 = c0; L.it[n].c1 = c1; L.it[n].mode = mode; ++n; };
        MK_DEBUG_LIST
        L.count = n;
        unsigned* flag = (unsigned*)(ctrl + 32768);
        hipMemsetAsync(flag, 0x7f, 4, stream);
        hipLaunchKernelGGL(dbg_scan, dim3(2048), dim3(256), 0, stream, L, flag);
        hipLaunchKernelGGL(dbg_fill, dim3(2048), dim3(256), 0, stream, (float*)d_out, (unsigned long long)NB * SEQ * DM, (const unsigned*)flag, 0.0f);
    }
#endif
}
```

```cpp
#include <hip/hip_runtime.h>
#include <stdint.h>
#include <string.h>

#define MK_MULTI 0
#define MK_NPH N_PHASES
#define MK_DEBUG 0
#define MK_DEBUG_LIST \
  add(p.mod, 2*9*6144, 1,0,0,0,7); add(p.WinT, 2ull*NINP*DM, 0,0,0,0,7); add(p.H, (unsigned long long)MR*DM, 0,0,0,0,7); add(p.Puv, (unsigned long long)MR*512, 0,0,0,0,7); \
  add(p.Cq, (unsigned long long)MR*256, 0,0,0,0,7); add(p.Ckv, (unsigned long long)MR*128, 0,0,0,0,7); add(p.RS, (unsigned long long)MR*2, 1,0,0,0,7); \
  add(p.Kn, (unsigned long long)MR*256, 0,0,0,0,7); add(p.Vmt, (unsigned long long)MR*256, 0,0,0,0,7); \
  add(p.O, (unsigned long long)MR*DM, 0, DM, 0, 256, 1); \
  add(p.Y, (unsigned long long)MR*DM, 1);

#define DI __device__ __forceinline__
typedef unsigned short bf16_t;
typedef short bf16x8 __attribute__((ext_vector_type(8)));
typedef float f32x4 __attribute__((ext_vector_type(4)));
typedef float f32x2 __attribute__((ext_vector_type(2)));
typedef float f32x16 __attribute__((ext_vector_type(16)));
typedef unsigned u32x4 __attribute__((ext_vector_type(4)));
typedef unsigned u32x2 __attribute__((ext_vector_type(2)));

constexpr int DM = 1024, NB = 8, SEQ = 4096, CTX = 256, TP = 4352, MR = NB * TP;
constexpr int NIN = 2976, NINP = 3072;
constexpr int NE = 32;
constexpr int NCH = TP / 32;
constexpr int NSLOT = 147456;
constexpr float LN_EPS = 1e-6f;
constexpr float DN_ALPHA = 1.4142135623730951f;
constexpr float LOG2E = 1.4426950408889634f;
constexpr int NTHREADS = 512;
constexpr int LDS_BYTES = 147456;

#define XB_TMO      128
#define XB_XCNT(j)  (256  + 64 * (j))
#define XB_XSUB(j)  (1280 + 64 * (j))
#define XB_XGEN(j)  (2304 + 64 * (j))
#define XB_TOP      3328
#define XB_TOPGEN   3392
#define XCD_BAR_WORDS 3456
#define XB_SPIN_CAP (1u << 22)
#define LAS __attribute__((address_space(3)))

DI unsigned xb_ld(unsigned* p)              { return __hip_atomic_load(p, __ATOMIC_RELAXED, __HIP_MEMORY_SCOPE_AGENT); }
DI unsigned xb_add(unsigned* p, unsigned v) { return __hip_atomic_fetch_add(p, v, __ATOMIC_RELAXED, __HIP_MEMORY_SCOPE_AGENT); }
DI unsigned xb_xcc_id() { return (unsigned)__builtin_amdgcn_s_getreg((3 << 11) | 20) & 0xFu; }
#define XB_SPIN(cond, bar) do { unsigned _sp = 0; while (cond) { __builtin_amdgcn_s_sleep(1); \
    if ((++_sp & 255u) == 0u) { if (xb_ld(&(bar)[XB_TMO])) break; if (_sp > XB_SPIN_CAP) { atomicAdd(&(bar)[XB_TMO], 1u); break; } } } } while (0)

struct XcdBarrier { unsigned* bar; unsigned x; volatile LAS unsigned* st; };

DI XcdBarrier xcd_barrier_post(unsigned* bar, volatile LAS unsigned* st) {
    XcdBarrier b; b.bar = bar; b.x = xb_xcc_id(); b.st = st;
    if (threadIdx.x == 0) (void)xb_add(&bar[XB_XCNT(b.x)], 1u);
    return b;
}
DI void xcd_barrier_complete(unsigned* bar, unsigned x, unsigned& nloc, unsigned& nx) {
    const unsigned G = gridDim.x * gridDim.y * gridDim.z;
    unsigned sum, cnt, mine, sp = 0u;
    for (;;) {
        sum = 0u; cnt = 0u; mine = 0u;
#pragma unroll
        for (unsigned j = 0; j < 16; ++j) { const unsigned c = xb_ld(&bar[XB_XCNT(j)]); sum += c; cnt += (c > 0u) ? 1u : 0u; mine = (j == x) ? c : mine; }
        if (sum == G) break;
        __builtin_amdgcn_s_sleep(1);
        if ((++sp & 255u) == 0u) { if (xb_ld(&bar[XB_TMO])) break; if (sp > XB_SPIN_CAP) { atomicAdd(&bar[XB_TMO], 1u); break; } }
    }
    nloc = mine > 0u ? mine : 1u; nx = cnt > 0u ? cnt : 1u;
}
DI void xcd_barrier(const XcdBarrier& b) {
    asm volatile("s_waitcnt vmcnt(0)" ::: "memory");
    __syncthreads();
    if (threadIdx.x == 0) {
        unsigned* bar = b.bar;
        __builtin_amdgcn_s_waitcnt(0);
        unsigned nloc = b.st[0], nx = b.st[1];
        if (nloc == 0u) { xcd_barrier_complete(bar, b.x, nloc, nx); b.st[0] = nloc; b.st[1] = nx; }
        const unsigned old = xb_add(&bar[XB_XSUB(b.x)], 1u);
        const unsigned gen = old / nloc;
        if (old + 1u == (gen + 1u) * nloc) {
            __builtin_amdgcn_fence(__ATOMIC_RELEASE, "agent");
            asm volatile("s_waitcnt vmcnt(0)" ::: "memory");
            const unsigned og = xb_add(&bar[XB_TOP], 1u);
            const unsigned tg = og / nx;
            if (og + 1u == (tg + 1u) * nx) xb_add(&bar[XB_TOPGEN], 1u);
            else XB_SPIN(xb_ld(&bar[XB_TOPGEN]) == tg, bar);
            __builtin_amdgcn_fence(__ATOMIC_ACQUIRE, "agent");
            xb_add(&bar[XB_XGEN(b.x)], 1u);
            asm volatile("s_waitcnt vmcnt(0)" ::: "memory");
        } else {
            XB_SPIN(xb_ld(&bar[XB_XGEN(b.x)]) == gen, bar);
            __builtin_amdgcn_fence(__ATOMIC_ACQUIRE, "agent");
            asm volatile("s_waitcnt vmcnt(0)" ::: "memory");
        }
    }
    __syncthreads();
}

struct Params {
    const float *x, *c, *ctx, *c_ctx, *ada_w, *ada_b, *w_in, *w_out, *sgu_ln_w, *sgu_ln_b, *sgu_w, *sgu_b,
                *diff_lambda, *diff_subln_w, *hgrn_lb, *hgrn_norm_w, *mla_q_norm_w, *mla_w_uq, *mla_kv_norm_w, *mla_w_ukv,
                *ln_mix_w, *ln_mix_b, *ln_ffn_w, *ln_ffn_b, *router_w, *router_b, *w1, *b1, *w2, *b2;
    float* out;
    unsigned* bar; unsigned* gcnt;
    float *mod, *lball, *lam, *ropec, *ropes;
    bf16_t *WinT, *WoutT, *WuqT, *WukvT, *W1T, *W2T;
    float* X; bf16_t* H;
    bf16_t *Puv, *Qd, *Kd, *Vdt, *Hq, *Vht, *Lf, *Hg, *Cq, *Ckv, *Kr, *Qm, *Kn, *Vmt, *O;
    float *RS, *DST, *DEC, *Y;
    int* ltok; float* lgate; int* rslot; bf16_t *ACT, *YS;
};

DI int otid() { int t = threadIdx.x; asm volatile("" : "+v"(t)); return t; }
DI float bf2f(bf16_t v) { return __uint_as_float(((unsigned)v) << 16); }
typedef __bf16 bf16x2_t __attribute__((ext_vector_type(2)));
DI unsigned pk2(float lo, float hi) { const bf16x2_t v = {(__bf16)lo, (__bf16)hi}; return __builtin_bit_cast(unsigned, v); }
DI float lo2f(unsigned w) { return __uint_as_float(w << 16); }
DI float hi2f(unsigned w) { return __uint_as_float(w & 0xffff0000u); }
DI bf16x8 pack8(const float (&v)[8]) { u32x4 w; w.x = pk2(v[0], v[1]); w.y = pk2(v[2], v[3]); w.z = pk2(v[4], v[5]); w.w = pk2(v[6], v[7]); return __builtin_bit_cast(bf16x8, w); }
DI float wave_sum(float v) {
#pragma unroll
    for (int o = 32; o >= 1; o >>= 1) v += __shfl_xor(v, o);
    return v;
}
DI float sigmoidf_(float x) { return 1.0f / (1.0f + __expf(-x)); }
DI float siluf_(float x) { return x * sigmoidf_(x); }
DI int crow(int r, int hh) { return (r & 3) + 8 * (r >> 2) + 4 * hh; }
#define MFMA16(a, b, c) __builtin_amdgcn_mfma_f32_16x16x32_bf16((a), (b), (c), 0, 0, 0)
#define MFMA32(a, b, c) __builtin_amdgcn_mfma_f32_32x32x16_bf16((a), (b), (c), 0, 0, 0)

DI const float* in_row(const Params& p, int row) {
    const int b = row / TP, t = row - b * TP;
    return t < CTX ? p.ctx + ((size_t)b * CTX + t) * DM : p.x + ((size_t)b * SEQ + (t - CTX)) * DM;
}
DI const float* mod_vec(const Params& p, int l, int row, int j) {
    const int b = row / TP, t = row - b * TP;
    const int r = t < CTX ? 8 : b;
    return p.mod + ((size_t)(l * 9 + r) * 6 + j) * DM;
}

DI void transpose_tile(const float* __restrict__ src, int K, int N, bf16_t* __restrict__ dst, int k0, int n0, const float* __restrict__ kscale, int perm_ukv, char* wl, int lane) {
    bf16_t* S = (bf16_t*)wl;
#pragma unroll 4
    for (int it = 0; it < 16; ++it) {
        const int kk = it * 4 + (lane >> 4), nn = (lane & 15) * 4;
        f32x4 v = {0.f, 0.f, 0.f, 0.f};
        if (n0 + nn < N) v = *(const f32x4*)(src + (size_t)(k0 + kk) * N + n0 + nn);
        if (kscale) { const float s = kscale[k0 + kk]; v = v * s; }
        unsigned* d = (unsigned*)(S + kk * 66 + nn);
        d[0] = pk2(v[0], v[1]); d[1] = pk2(v[2], v[3]);
    }
    __builtin_amdgcn_fence(__ATOMIC_RELEASE, "workgroup");
    __builtin_amdgcn_wave_barrier();
    __builtin_amdgcn_fence(__ATOMIC_ACQUIRE, "workgroup");
#pragma unroll 2
    for (int it = 0; it < 8; ++it) {
        const int nn = it * 8 + (lane >> 3), kc = lane & 7;
        unsigned short e[8];
#pragma unroll
        for (int j = 0; j < 8; ++j) e[j] = S[(kc * 8 + j) * 66 + nn];
        u32x4 w; w.x = e[0] | ((unsigned)e[1] << 16); w.y = e[2] | ((unsigned)e[3] << 16); w.z = e[4] | ((unsigned)e[5] << 16); w.w = e[6] | ((unsigned)e[7] << 16);
        int n = n0 + nn;
        if (perm_ukv) { const int hh = n >> 7, t = n & 127; n = t < 64 ? hh * 64 + t : 256 + hh * 64 + (t - 64); }
        *(u32x4*)(dst + (size_t)n * K + k0 + kc * 8) = w;
    }
    __builtin_amdgcn_fence(__ATOMIC_RELEASE, "workgroup");
    __builtin_amdgcn_wave_barrier();
}

DI void phase_prologue(const Params& p, char* lds) {
    const int tid = otid(), wid = tid >> 6, lane = tid & 63;
    char* wl = lds + wid * 8704;
    constexpr int T_IN = 16 * 48, T_OUT = 16 * 16, T_UQ = 4 * 6, T_UKV = 2 * 8, T_W1 = 32 * 16 * 32, T_W2 = 32 * 16 * 16;
    constexpr int T_LAYER = T_IN + T_OUT + T_UQ + T_UKV + T_W1 + T_W2;
    constexpr int T_ALL = 2 * T_LAYER;
    constexpr int U_TR = (T_ALL + 7) / 8;
    constexpr int U_GEMV = 2 * 6144 / 64 / 8;
    const int nunits = U_TR + U_GEMV + 1;
    for (int u = blockIdx.x; u < nunits; u += gridDim.x) {
        if (u < U_TR) {
            int t = u * 8 + wid;
            if (t < T_ALL) {
                const int l = t / T_LAYER; t -= l * T_LAYER;
                if (t < T_IN) { const int kt = t / 48, nt = t % 48;
                    transpose_tile(p.w_in + (size_t)l * DM * NIN, DM, NIN, p.WinT + (size_t)l * NINP * DM, kt * 64, nt * 64, nullptr, 0, wl, lane);
                } else if ((t -= T_IN) < T_OUT) { const int kt = t / 16, nt = t % 16;
                    transpose_tile(p.w_out + (size_t)l * DM * DM, DM, DM, p.WoutT + (size_t)l * DM * DM, kt * 64, nt * 64, nullptr, 0, wl, lane);
                } else if ((t -= T_OUT) < T_UQ) { const int kt = t / 6, nt = t % 6;
                    transpose_tile(p.mla_w_uq + (size_t)l * 256 * 384, 256, 384, p.WuqT + (size_t)l * 384 * 256, kt * 64, nt * 64, p.mla_q_norm_w + l * 256, 0, wl, lane);
                } else if ((t -= T_UQ) < T_UKV) { const int kt = t / 8, nt = t % 8;
                    transpose_tile(p.mla_w_ukv + (size_t)l * 128 * 512, 128, 512, p.WukvT + (size_t)l * 512 * 128, kt * 64, nt * 64, p.mla_kv_norm_w + l * 128, 1, wl, lane);
                } else if ((t -= T_UKV) < T_W1) { const int e = t / 512, r = t % 512, kt = r / 32, nt = r % 32;
                    transpose_tile(p.w1 + ((size_t)l * NE + e) * DM * 2048, DM, 2048, p.W1T + ((size_t)l * NE + e) * 2048 * DM, kt * 64, nt * 64, nullptr, 0, wl, lane);
                } else { t -= T_W1; const int e = t / 256, r = t % 256, kt = r / 16, nt = r % 16;
                    transpose_tile(p.w2 + ((size_t)l * NE + e) * DM * DM, DM, DM, p.W2T + ((size_t)l * NE + e) * DM * DM, kt * 64, nt * 64, nullptr, 0, wl, lane);
                }
            }
        } else if (u < U_TR + U_GEMV) {
            const int wu = (u - U_TR) * 8 + wid;
            const int l = wu / 96, n = (wu % 96) * 64 + lane;
            const float* W = p.ada_w + (size_t)l * DM * 6144 + n;
            float* sc = (float*)(lds + 73728);
            __syncthreads();
            for (int i = tid; i < 9 * DM; i += NTHREADS) { const float cv = i < 8 * DM ? p.c[i] : p.c_ctx[i - 8 * DM]; sc[i] = siluf_(cv); }
            __syncthreads();
            float acc[9];
#pragma unroll
            for (int r = 0; r < 9; ++r) acc[r] = 0.f;
#pragma unroll 2
            for (int k = 0; k < DM; k += 4) {
                float w[4];
#pragma unroll
                for (int j = 0; j < 4; ++j) w[j] = W[(size_t)(k + j) * 6144];
#pragma unroll
                for (int r = 0; r < 9; ++r) {
                    const f32x4 cc = *(const f32x4*)(sc + r * DM + k);
#pragma unroll
                    for (int j = 0; j < 4; ++j) acc[r] += cc[j] * w[j];
                }
            }
            const float bb = p.ada_b[l * 6144 + n];
#pragma unroll
            for (int r = 0; r < 9; ++r) p.mod[(size_t)(l * 9 + r) * 6144 + n] = acc[r] + bb;
        } else {
            if (tid < 512) {
                const int j = tid;
                const float a0 = p.hgrn_lb[j], a1 = p.hgrn_lb[512 + j];
                const float m = fmaxf(a0, a1), e0 = expf(a0 - m), e1 = expf(a1 - m);
                p.lball[j] = 0.f;
                p.lball[512 + j] = e1 / (e0 + e1);
            }
            if (tid < 2) {
                const float* lp = p.diff_lambda + tid * 4 * 32;
                float s01 = 0.f, s23 = 0.f;
                for (int i = 0; i < 32; ++i) { s01 += lp[i] * lp[32 + i]; s23 += lp[64 + i] * lp[96 + i]; }
                const float lam_init = 0.8f - 0.6f * expf(-0.3f * (float)tid);
                p.lam[tid] = expf(s01) - expf(s23) + lam_init;
            }
            {
                const int pos = tid >> 3, i = tid & 7;
                const float inv = powf(10000.0f, -(float)(2 * i) / 16.0f);
                float sn, cs; sincosf((float)pos * inv, &sn, &cs);
                p.ropec[tid] = cs; p.ropes[tid] = sn;
            }
        }
    }
}

DI void phase_ln1(const Params& p, char* lds) {
    const int tid = otid(), wid = tid >> 6, lane = tid & 63;
    for (int row = blockIdx.x * 8 + wid; row < MR; row += gridDim.x * 8) {
        const float* xr = in_row(p, row);
        f32x4 v[4]; float s = 0.f;
#pragma unroll
        for (int j = 0; j < 4; ++j) { v[j] = *(const f32x4*)(xr + j * 256 + lane * 4); s += (v[j][0] + v[j][1]) + (v[j][2] + v[j][3]); }
        const float mean = wave_sum(s) * (1.f / DM);
        float q = 0.f;
#pragma unroll
        for (int j = 0; j < 4; ++j) { v[j] = v[j] - mean; q += (v[j][0] * v[j][0] + v[j][1] * v[j][1]) + (v[j][2] * v[j][2] + v[j][3] * v[j][3]); }
        const float rstd = rsqrtf(wave_sum(q) * (1.f / DM) + LN_EPS);
        const float* sh = mod_vec(p, 0, row, 0); const float* sc = mod_vec(p, 0, row, 1);
#pragma unroll
        for (int j = 0; j < 4; ++j) {
            const int c = j * 256 + lane * 4;
            const f32x4 a = *(const f32x4*)(sh + c), b = *(const f32x4*)(sc + c);
            const f32x4 h = v[j] * rstd * (b + 1.0f) + a;
            u32x2 w; w.x = pk2(h[0], h[1]); w.y = pk2(h[2], h[3]);
            *(u32x2*)(p.H + (size_t)row * DM + c) = w;
        }
    }
}

template <int ORI>
DI void gemm_core(const bf16_t* const (&pa)[4], const bf16_t* const (&pb)[2], int K, char* lds, f32x4 (&acc)[4][4]) {
    const int tid = otid(), wid = tid >> 6, lane = tid & 63, wr = wid >> 1, wc = wid & 1, fr = lane & 15, fq = lane >> 4;
    const int sw = ((tid & 7) ^ ((tid >> 4) & 7)) << 4;
    const int offA = (tid >> 3) * 128 + sw, offB = 32768 + (tid >> 3) * 128 + sw;
    const int rdA = (wr * 64 + fr) * 128 + ((fq ^ (fr >> 1)) << 4), rdB = 32768 + (wc * 64 + fr) * 128 + ((fq ^ (fr >> 1)) << 4);
#pragma unroll
    for (int mi = 0; mi < 4; ++mi)
#pragma unroll
        for (int ni = 0; ni < 4; ++ni) acc[mi][ni] = (f32x4){0.f, 0.f, 0.f, 0.f};
    u32x4 ra[4], rb[2];
#pragma unroll
    for (int i = 0; i < 4; ++i) ra[i] = *(const u32x4*)(pa[i]);
#pragma unroll
    for (int j = 0; j < 2; ++j) rb[j] = *(const u32x4*)(pb[j]);
#pragma unroll
    for (int i = 0; i < 4; ++i) *(u32x4*)(lds + offA + i * 8192) = ra[i];
#pragma unroll
    for (int j = 0; j < 2; ++j) *(u32x4*)(lds + offB + j * 8192) = rb[j];
    __syncthreads();
    const int nk = K >> 6;
    for (int kt = 0; kt < nk; ++kt) {
        const char* cur = lds + (kt & 1) * 49152;
        const bool more = kt + 1 < nk;
        if (more) {
#pragma unroll
            for (int i = 0; i < 4; ++i) ra[i] = *(const u32x4*)(pa[i] + (kt + 1) * 64);
#pragma unroll
            for (int j = 0; j < 2; ++j) rb[j] = *(const u32x4*)(pb[j] + (kt + 1) * 64);
        }
#pragma unroll
        for (int kk = 0; kk < 2; ++kk) {
            bf16x8 af[4], bfr[4];
#pragma unroll
            for (int mi = 0; mi < 4; ++mi) af[mi] = *(const bf16x8*)(cur + ((rdA + mi * 2048) ^ (kk * 64)));
#pragma unroll
            for (int ni = 0; ni < 4; ++ni) bfr[ni] = *(const bf16x8*)(cur + ((rdB + ni * 2048) ^ (kk * 64)));
#pragma unroll
            for (int mi = 0; mi < 4; ++mi)
#pragma unroll
                for (int ni = 0; ni < 4; ++ni) {
                    if (ORI == 0) acc[mi][ni] = MFMA16(bfr[ni], af[mi], acc[mi][ni]);
                    else          acc[mi][ni] = MFMA16(af[mi], bfr[ni], acc[mi][ni]);
                }
        }
        if (more) {
            char* nxt = lds + ((kt + 1) & 1) * 49152;
#pragma unroll
            for (int i = 0; i < 4; ++i) *(u32x4*)(nxt + offA + i * 8192) = ra[i];
#pragma unroll
            for (int j = 0; j < 2; ++j) *(u32x4*)(nxt + offB + j * 8192) = rb[j];
        }
        __syncthreads();
    }
}

DI void gemm_ptrs(const bf16_t* A, int lda, int row0, const bf16_t* Bt, int ldb, int n0, const bf16_t* (&pa)[4], const bf16_t* (&pb)[2]) {
    const int tid = otid(), r = tid >> 3, c = (tid & 7) * 8;
#pragma unroll
    for (int i = 0; i < 4; ++i) pa[i] = A + (size_t)(row0 + r + 64 * i) * lda + c;
#pragma unroll
    for (int j = 0; j < 2; ++j) pb[j] = Bt + (size_t)(n0 + r + 64 * j) * ldb + c;
}

DI void store4_bf16(bf16_t* dst, const f32x4& v) { u32x2 w; w.x = pk2(v[0], v[1]); w.y = pk2(v[2], v[3]); *(u32x2*)dst = w; }

DI f32x4 rope_tile(const Params& p, f32x4 v, int row, int axis_is_col, int fq) {
    f32x4 o;
    const int b = row / TP, t = row - b * TP;
    const int pos = t - CTX;
    const int ax = axis_is_col ? (pos & 63) : (pos >> 6);
#pragma unroll
    for (int r = 0; r < 4; ++r) {
        const float pr = __shfl_xor(v[r], 32);
        float cs = 1.f, sn = 0.f;
        if (t >= CTX) { const int i = (fq & 1) * 4 + r; cs = p.ropec[ax * 8 + i]; sn = p.ropes[ax * 8 + i]; }
        o[r] = fq < 2 ? v[r] * cs - pr * sn : v[r] * cs + pr * sn;
    }
    return o;
}

DI void phase_inproj(const Params& p, int l, char* lds) {
    const int tid = otid(), wid = tid >> 6, lane = tid & 63, wr = wid >> 1, wc = wid & 1, fr = lane & 15, fq = lane >> 4;
    const bf16_t* Bt = p.WinT + (size_t)l * NINP * DM;
    const int nunits = (MR / 256) * 24;
    for (int u = blockIdx.x; u < nunits; u += gridDim.x) {
        const int mt = u / 24, nt = u % 24, m0 = mt * 256, n0 = nt * 128;
        const bf16_t* pa[4]; const bf16_t* pb[2];
        gemm_ptrs(p.H, DM, m0, Bt, DM, n0, pa, pb);
        f32x4 acc[4][4];
        const bool tr = (nt == 8 || nt == 9 || nt == 12 || nt == 13);
        if (tr) gemm_core<1>(pa, pb, DM, lds, acc); else gemm_core<0>(pa, pb, DM, lds, acc);
        if (tr) {
            bf16_t* dst = (nt < 10) ? p.Vdt : p.Vht;
            const int fbase = (nt < 10) ? 1024 : 1536;
            const int b = m0 / TP, t0 = m0 - b * TP;
#pragma unroll
            for (int mi = 0; mi < 4; ++mi)
#pragma unroll
                for (int ni = 0; ni < 4; ++ni) {
                    const int f = n0 + wc * 64 + ni * 16 + fr - fbase;
                    const int t = t0 + wr * 64 + mi * 16 + fq * 4;
                    store4_bf16(dst + ((size_t)(b * 256 + f)) * TP + t, acc[mi][ni]);
                }
        } else {
#pragma unroll
            for (int mi = 0; mi < 4; ++mi)
#pragma unroll
                for (int ni = 0; ni < 4; ++ni) {
                    const int row = m0 + wr * 64 + mi * 16 + fr;
                    const int col = n0 + wc * 64 + ni * 16 + fq * 4;
                    f32x4 v = acc[mi][ni];
                    if (nt < 4) {
#pragma unroll
                        for (int r = 0; r < 4; ++r) v[r] = 0.5f * v[r] * (1.0f + erff(v[r] * 0.70710678118654752f));
                        store4_bf16(p.Puv + (size_t)row * 512 + col, v);
                    } else if (nt < 8) {
                        v = rope_tile(p, v, row, (col >> 4) & 1, fq);
                        if (nt < 6) { v = v * (0.17677669529663687f * LOG2E); store4_bf16(p.Qd + (size_t)row * 256 + (col - 512), v); }
                        else store4_bf16(p.Kd + (size_t)row * 256 + (col - 768), v);
                    } else if (nt < 12) {
#pragma unroll
                        for (int r = 0; r < 4; ++r) v[r] = siluf_(v[r]);
                        store4_bf16(p.Hq + (size_t)row * 256 + (col - 1280), v);
                    } else if (nt < 18) {
                        const int dir = nt >= 16, cc = col - (dir ? 2048 : 1792);
                        const f32x4 lb = *(const f32x4*)(p.lball + (l * 2 + dir) * 256 + cc);
#pragma unroll
                        for (int r = 0; r < 4; ++r) v[r] = __logf(lb[r] + (1.0f - lb[r]) * sigmoidf_(v[r]));
                        store4_bf16(p.Lf + ((size_t)dir * MR + row) * 256 + cc, v);
                    } else if (nt < 20) {
#pragma unroll
                        for (int r = 0; r < 4; ++r) v[r] = siluf_(v[r]);
                        store4_bf16(p.Hg + (size_t)row * 256 + (col - 2304), v);
                    } else if (nt < 22) {
                        store4_bf16(p.Cq + (size_t)row * 256 + (col - 2560), v);
                    } else if (nt == 22) {
                        store4_bf16(p.Ckv + (size_t)row * 128 + (col - 2816), v);
                    } else {
                        v = rope_tile(p, v, row, (col >> 4) & 1, fq);
                        if (col < 2976) store4_bf16(p.Kr + (size_t)row * 32 + (col - 2944), v);
                    }
                }
        }
    }
}

DI void phase_sgu_prep(const Params& p, int l, char* lds) {
    const int tid = otid(), wid = tid >> 6, lane = tid & 63, fr = lane & 15, fq = lane >> 4;
    constexpr int U_SGU = (MR / 128) * 4, U_PREP = MR / 64;
    float* stats = (float*)(lds + 16384);
    for (int u = blockIdx.x; u < U_SGU + U_PREP; u += gridDim.x) {
        if (u < U_SGU) {
            const int ch = u >> 2, g = u & 3, row0 = ch * 128;
            __syncthreads();
#pragma unroll 1
            for (int i = 0; i < 16; ++i) {
                const int r = wid * 16 + i;
                const u32x2 w = *(const u32x2*)(p.Puv + (size_t)(row0 + r) * 512 + 256 + lane * 4);
                const float a0 = lo2f(w.x), a1 = hi2f(w.x), a2 = lo2f(w.y), a3 = hi2f(w.y);
                const float mean = wave_sum((a0 + a1) + (a2 + a3)) * (1.f / 256.f);
                const float d0 = a0 - mean, d1 = a1 - mean, d2 = a2 - mean, d3 = a3 - mean;
                const float var = wave_sum((d0 * d0 + d1 * d1) + (d2 * d2 + d3 * d3)) * (1.f / 256.f);
                if (lane == 0) { stats[r * 2] = mean; stats[r * 2 + 1] = rsqrtf(var + LN_EPS); }
            }
            __syncthreads();
            {
                const int s = tid >> 2, c0 = (tid & 3) * 16;
                const float mean = stats[s * 2], rstd = stats[s * 2 + 1];
                const bf16_t* src = p.Puv + (size_t)(row0 + s) * 512 + 256 + g * 64 + c0;
                const u32x4 w0 = *(const u32x4*)src, w1 = *(const u32x4*)(src + 8);
                const unsigned ww[8] = {w0.x, w0.y, w0.z, w0.w, w1.x, w1.y, w1.z, w1.w};
                const float* lw = p.sgu_ln_w + l * 256 + g * 64 + c0; const float* lb = p.sgu_ln_b + l * 256 + g * 64 + c0;
#pragma unroll
                for (int j = 0; j < 16; ++j) {
                    const float xv = (j & 1) ? hi2f(ww[j >> 1]) : lo2f(ww[j >> 1]);
                    const float y = (xv - mean) * rstd * lw[j] + lb[j];
                    const int c = c0 + j;
                    const unsigned pk = pk2(y, 0.f);
                    *(bf16_t*)(lds + c * 256 + ((((s >> 3) ^ (c & 15)) << 4) | ((s & 7) * 2))) = (bf16_t)(pk & 0xffffu);
                }
            }
            __syncthreads();
            f32x4 acc[4];
#pragma unroll
            for (int ni = 0; ni < 4; ++ni) acc[ni] = (f32x4){0.f, 0.f, 0.f, 0.f};
            const float* Wg = p.sgu_w + ((size_t)(l * 4 + g) * 128 + wid * 16 + fr) * 128;
#pragma unroll
            for (int ks = 0; ks < 4; ++ks) {
                const f32x4 a0 = *(const f32x4*)(Wg + ks * 32 + fq * 8), a1 = *(const f32x4*)(Wg + ks * 32 + fq * 8 + 4);
                const float av[8] = {a0[0], a0[1], a0[2], a0[3], a1[0], a1[1], a1[2], a1[3]};
                const bf16x8 af = pack8(av);
#pragma unroll
                for (int ni = 0; ni < 4; ++ni) {
                    const int c = ni * 16 + fr;
                    const bf16x8 bfr = *(const bf16x8*)(lds + c * 256 + (((ks * 4 + fq) ^ (c & 15)) << 4));
                    acc[ni] = MFMA16(bfr, af, acc[ni]);
                }
            }
            const int t = wid * 16 + fr, row = row0 + t;
            const float bs = p.sgu_b[(l * 4 + g) * 128 + t];
#pragma unroll
            for (int ni = 0; ni < 4; ++ni) {
                const int c = g * 64 + ni * 16 + fq * 4;
                const u32x2 w = *(const u32x2*)(p.Puv + (size_t)row * 512 + c);
                f32x4 o;
                o[0] = (acc[ni][0] + bs) * lo2f(w.x); o[1] = (acc[ni][1] + bs) * hi2f(w.x);
                o[2] = (acc[ni][2] + bs) * lo2f(w.y); o[3] = (acc[ni][3] + bs) * hi2f(w.y);
                store4_bf16(p.O + (size_t)row * DM + c, o);
            }
        } else {
            const int rbase = (u - U_SGU) * 64 + wid * 8;
#pragma unroll 1
            for (int i = 0; i < 8; ++i) {
                const int row = rbase + i;
                const u32x2 wq = *(const u32x2*)(p.Cq + (size_t)row * 256 + lane * 4);
                const unsigned wk = *(const unsigned*)(p.Ckv + (size_t)row * 128 + lane * 2);
                const float q0 = lo2f(wq.x), q1 = hi2f(wq.x), q2 = lo2f(wq.y), q3 = hi2f(wq.y), k0 = lo2f(wk), k1 = hi2f(wk);
                const float sq = wave_sum((q0 * q0 + q1 * q1) + (q2 * q2 + q3 * q3));
                const float sk = wave_sum(k0 * k0 + k1 * k1);
                if (lane == 0) { p.RS[row * 2] = rsqrtf(sq * (1.f / 256.f) + LN_EPS); p.RS[row * 2 + 1] = rsqrtf(sk * (1.f / 128.f) + LN_EPS); }
            }
        }
    }
}

DI void hgrn_h1_unit(const Params& p, int wu, int lane) {
    const int c = wu % NCH; int t = wu / NCH; const int dir = t & 1, h = (t >> 1) & 3, b = t >> 3;
    const int row0 = b * TP + c * 32, hh = lane >> 5, l31 = lane & 31;
    const bf16_t* Lf = p.Lf + ((size_t)dir * MR + row0) * 256 + h * 64;
    bf16x8 Bf[2][2];
    float* decp = p.DEC + (size_t)wu * 64;
#pragma unroll
    for (int kt = 0; kt < 2; ++kt) {
        const int k = kt * 32 + l31;
        float lf[32], kd[32];
#pragma unroll
        for (int j = 0; j < 32; ++j) lf[j] = bf2f(Lf[(size_t)j * 256 + k]);
        float tot = 0.f;
#pragma unroll
        for (int j = 0; j < 32; ++j) tot += lf[j];
        float run = 0.f;
        if (dir == 0) {
#pragma unroll
            for (int j = 0; j < 32; ++j) { run += lf[j]; kd[j] = (1.0f - __expf(lf[j])) * __expf(tot - run); }
        } else {
#pragma unroll
            for (int j = 31; j >= 0; --j) { run += lf[j]; kd[j] = (1.0f - __expf(lf[j])) * __expf(tot - run); }
        }
        if (hh == 0) decp[k] = __expf(tot);
#pragma unroll
        for (int s = 0; s < 2; ++s) {
            float v8[8];
#pragma unroll
            for (int jj = 0; jj < 8; ++jj) v8[jj] = hh ? kd[16 * s + 8 + jj] : kd[16 * s + jj];
            Bf[kt][s] = pack8(v8);
        }
    }
    const bf16_t* Vt = p.Vht + ((size_t)(b * 4 + h) * 64) * TP + c * 32;
    float* dst = p.DST + (size_t)wu * 4096;
#pragma unroll
    for (int vt = 0; vt < 2; ++vt) {
        bf16x8 Af[2];
#pragma unroll
        for (int s = 0; s < 2; ++s) Af[s] = *(const bf16x8*)(Vt + (size_t)(vt * 32 + l31) * TP + 16 * s + 8 * hh);
#pragma unroll
        for (int kt = 0; kt < 2; ++kt) {
            f32x16 d;
#pragma unroll
            for (int i = 0; i < 16; ++i) d[i] = 0.f;
            d = MFMA32(Af[0], Bf[kt][0], d);
            d = MFMA32(Af[1], Bf[kt][1], d);
#pragma unroll
            for (int r = 0; r < 16; ++r) dst[(vt * 32 + crow(r, hh)) * 64 + kt * 32 + l31] = d[r];
        }
    }
}

DI void phase_upproj_h1(const Params& p, int l, char* lds) {
    const int tid = otid(), wid = tid >> 6, lane = tid & 63, wr = wid >> 1, wc = wid & 1, fr = lane & 15, fq = lane >> 4;
    constexpr int U_Q = (MR / 256) * 3, U_KV = (MR / 256) * 4, U_H1 = NB * 4 * 2 * NCH / 8;
    for (int u = blockIdx.x; u < U_Q + U_KV + U_H1; u += gridDim.x) {
        if (u < U_Q) {
            const int mt = u / 3, nt = u % 3, m0 = mt * 256, n0 = nt * 128;
            const bf16_t* pa[4]; const bf16_t* pb[2];
            gemm_ptrs(p.Cq, 256, m0, p.WuqT + (size_t)l * 384 * 256, 256, n0, pa, pb);
            f32x4 acc[4][4];
            gemm_core<0>(pa, pb, 256, lds, acc);
#pragma unroll
            for (int mi = 0; mi < 4; ++mi)
#pragma unroll
                for (int ni = 0; ni < 4; ++ni) {
                    const int row = m0 + wr * 64 + mi * 16 + fr, col = n0 + wc * 64 + ni * 16 + fq * 4;
                    f32x4 v = acc[mi][ni] * (p.RS[row * 2] * (0.10206207261596577f * LOG2E));
                    const int cm = col % 96;
                    const f32x4 vr = rope_tile(p, v, row, (cm >> 4) & 1, fq);
                    if (cm >= 64) v = vr;
                    store4_bf16(p.Qm + (size_t)row * 384 + col, v);
                }
        } else if (u < U_Q + U_KV) {
            const int uu = u - U_Q, mt = uu >> 2, nt = uu & 3, m0 = mt * 256, n0 = nt * 128;
            const bf16_t* pa[4]; const bf16_t* pb[2];
            gemm_ptrs(p.Ckv, 128, m0, p.WukvT + (size_t)l * 512 * 128, 128, n0, pa, pb);
            f32x4 acc[4][4];
            if (nt < 2) {
                gemm_core<0>(pa, pb, 128, lds, acc);
#pragma unroll
                for (int mi = 0; mi < 4; ++mi)
#pragma unroll
                    for (int ni = 0; ni < 4; ++ni) {
                        const int row = m0 + wr * 64 + mi * 16 + fr, col = n0 + wc * 64 + ni * 16 + fq * 4;
                        store4_bf16(p.Kn + (size_t)row * 256 + col, acc[mi][ni] * p.RS[row * 2 + 1]);
                    }
            } else {
                gemm_core<1>(pa, pb, 128, lds, acc);
                const int b = m0 / TP, t0 = m0 - b * TP;
#pragma unroll
                for (int mi = 0; mi < 4; ++mi)
#pragma unroll
                    for (int ni = 0; ni < 4; ++ni) {
                        const int f = n0 - 256 + wc * 64 + ni * 16 + fr;
                        const int rl = wr * 64 + mi * 16 + fq * 4;
                        const f32x4 rs = {p.RS[(m0 + rl) * 2 + 1], p.RS[(m0 + rl + 1) * 2 + 1], p.RS[(m0 + rl + 2) * 2 + 1], p.RS[(m0 + rl + 3) * 2 + 1]};
                        store4_bf16(p.Vmt + ((size_t)(b * 256 + f)) * TP + t0 + rl, acc[mi][ni] * rs);
                    }
            }
        } else {
            hgrn_h1_unit(p, (u - U_Q - U_KV) * 8 + wid, lane);
        }
    }
}

DI void hgrn_h2_unit(const Params& p, int cu  ) {
    const int gid = cu * NTHREADS + otid();
    const int seq = gid >> 10, e4 = gid & 1023;
    const int dir = seq & 1, k4 = (e4 & 15) * 4;
    f32x4 st = {0.f, 0.f, 0.f, 0.f};
#pragma unroll 4
    for (int t = 0; t < NCH; ++t) {
        const int pc = dir == 0 ? t : (t < 8 ? 7 - t : 143 - t);
        float* ptr = p.DST + ((size_t)(seq * NCH + pc)) * 4096 + e4 * 4;
        const f32x4 ds = *(const f32x4*)ptr;
        const f32x4 dc = *(const f32x4*)(p.DEC + (size_t)(seq * NCH + pc) * 64 + k4);
        *(f32x4*)ptr = st;
        st = dc * st + ds;
    }
}

DI void hgrn_h3_unit(const Params& p, int l, int wu, int lane, char* wl) {
    const int pc = wu % NCH; const int t_ = wu / NCH; const int h = t_ & 3, b = t_ >> 2;
    const int row0 = b * TP + pc * 32, hh = lane >> 5, i = lane & 31;
    float* Bl = (float*)wl;
    f32x16 Y[2];
#pragma unroll
    for (int r = 0; r < 16; ++r) { Y[0][r] = 0.f; Y[1][r] = 0.f; }
#pragma unroll 1
    for (int dir = 0; dir < 2; ++dir) {
        const bf16_t* Lf = p.Lf + ((size_t)dir * MR + row0) * 256 + h * 64;
        {
            float lf[32];
#pragma unroll
            for (int j = 0; j < 32; ++j) lf[j] = bf2f(Lf[(size_t)j * 256 + lane]);
            float run = 0.f;
            if (dir == 0) {
#pragma unroll
                for (int j = 0; j < 32; ++j) { run += lf[j]; Bl[j * 68 + lane] = run; }
            } else {
#pragma unroll
                for (int j = 31; j >= 0; --j) { run += lf[j]; Bl[j * 68 + lane] = run; }
            }
        }
        __syncthreads();
        bf16x8 Qf[4], Kf[4];
#pragma unroll
        for (int s = 0; s < 4; ++s) {
            const int kb = 16 * s + 8 * hh;
            const u32x4 qw = *(const u32x4*)(p.Hq + (size_t)(row0 + i) * 256 + h * 64 + kb);
            const u32x4 fw = *(const u32x4*)(Lf + (size_t)i * 256 + kb);
            const f32x4 b0 = *(const f32x4*)(Bl + i * 68 + kb), b1 = *(const f32x4*)(Bl + i * 68 + kb + 4);
            const float bb[8] = {b0[0], b0[1], b0[2], b0[3], b1[0], b1[1], b1[2], b1[3]};
            const unsigned qq[4] = {qw.x, qw.y, qw.z, qw.w}, ff[4] = {fw.x, fw.y, fw.z, fw.w};
            float qd[8], kd[8];
#pragma unroll
            for (int j = 0; j < 8; ++j) {
                const float qv = (j & 1) ? hi2f(qq[j >> 1]) : lo2f(qq[j >> 1]);
                const float fv = (j & 1) ? hi2f(ff[j >> 1]) : lo2f(ff[j >> 1]);
                qd[j] = qv * __expf(bb[j]);
                kd[j] = (1.0f - __expf(fv)) * __expf(-bb[j]);
            }
            Qf[s] = pack8(qd); Kf[s] = pack8(kd);
        }
        f32x16 X;
#pragma unroll
        for (int r = 0; r < 16; ++r) X[r] = 0.f;
#pragma unroll
        for (int s = 0; s < 4; ++s) X = MFMA32(Kf[s], Qf[s], X);
#pragma unroll
        for (int r = 0; r < 16; ++r) { const int j = crow(r, hh); const bool keep = dir == 0 ? (j <= i) : (j >= i); X[r] = keep ? X[r] : 0.f; }
        bf16x8 Xs[2];
#pragma unroll
        for (int s = 0; s < 2; ++s) { const float v8[8] = {X[8 * s], X[8 * s + 1], X[8 * s + 2], X[8 * s + 3], X[8 * s + 4], X[8 * s + 5], X[8 * s + 6], X[8 * s + 7]}; Xs[s] = pack8(v8); }
        const bf16_t* Vt = p.Vht + ((size_t)(b * 4 + h) * 64) * TP + pc * 32;
        const float* ST = p.DST + ((size_t)(((b * 4 + h) * 2 + dir) * NCH + pc)) * 4096;
#pragma unroll
        for (int vt = 0; vt < 2; ++vt) {
            const bf16_t* vrow = Vt + (size_t)(vt * 32 + i) * TP;
#pragma unroll
            for (int s = 0; s < 2; ++s) {
                const u32x2 lo = *(const u32x2*)(vrow + 16 * s + 4 * hh), hi = *(const u32x2*)(vrow + 16 * s + 8 + 4 * hh);
                u32x4 w; w.x = lo.x; w.y = lo.y; w.z = hi.x; w.w = hi.y;
                Y[vt] = MFMA32(__builtin_bit_cast(bf16x8, w), Xs[s], Y[vt]);
            }
            const float* srow = ST + (vt * 32 + i) * 64;
#pragma unroll
            for (int s = 0; s < 4; ++s) {
                const f32x4 a0 = *(const f32x4*)(srow + 16 * s + 8 * hh), a1 = *(const f32x4*)(srow + 16 * s + 8 * hh + 4);
                const float v8[8] = {a0[0], a0[1], a0[2], a0[3], a1[0], a1[1], a1[2], a1[3]};
                Y[vt] = MFMA32(pack8(v8), Qf[s], Y[vt]);
            }
        }
        __syncthreads();
    }
    float ss = 0.f;
#pragma unroll
    for (int r = 0; r < 16; ++r) ss += Y[0][r] * Y[0][r] + Y[1][r] * Y[1][r];
    ss += __shfl_xor(ss, 32);
    const float rs = rsqrtf(ss * (1.f / 64.f) + LN_EPS);
    const int row = row0 + i;
#pragma unroll
    for (int vt = 0; vt < 2; ++vt)
#pragma unroll
        for (int g4 = 0; g4 < 4; ++g4) {
            const int v0 = vt * 32 + 8 * g4 + 4 * hh;
            const f32x4 nw = *(const f32x4*)(p.hgrn_norm_w + l * 64 + v0);
            const u32x2 gw = *(const u32x2*)(p.Hg + (size_t)row * 256 + h * 64 + v0);
            f32x4 o;
            o[0] = Y[vt][g4 * 4 + 0] * rs * nw[0] * lo2f(gw.x); o[1] = Y[vt][g4 * 4 + 1] * rs * nw[1] * hi2f(gw.x);
            o[2] = Y[vt][g4 * 4 + 2] * rs * nw[2] * lo2f(gw.y); o[3] = Y[vt][g4 * 4 + 3] * rs * nw[3] * hi2f(gw.y);
            store4_bf16(p.O + (size_t)row * DM + 512 + h * 64 + v0, o);
        }
}

template <bool DIFF>
DI void attn_unit(const Params& p, int l, int b, int h, int qrow0  , int nkt  , char* lds) {
    const int tid = otid(), wid = tid >> 6, lane = tid & 63, hh = lane >> 5, q31 = lane & 31;
    constexpr int NS = DIFF ? 2 : 1;
    constexpr int NQF = DIFF ? 4 : 6;
    constexpr int BUF = 8192 + 8192 + (DIFF ? 0 : 4096);
    const int qrow = qrow0 + wid * 32 + q31;
    bf16x8 Qf[NQF];
    {
        const bf16_t* qp = DIFF ? p.Qd + (size_t)qrow * 256 + h * 64 : p.Qm + (size_t)qrow * 384 + h * 96;
#pragma unroll
        for (int s = 0; s < NQF; ++s) Qf[s] = *(const bf16x8*)(qp + 16 * s + 8 * hh);
    }
    const size_t krow0 = (size_t)b * TP;
    const bf16_t* kptr = (DIFF ? p.Kd : p.Kn) + (krow0 + (tid >> 3)) * 256 + h * 64 + (tid & 7) * 8;
    const bf16_t* vptr = (DIFF ? p.Vdt : p.Vmt) + ((size_t)(b * 4 + h) * 64 + (tid >> 3)) * TP + (tid & 7) * 8;
    const bf16_t* rptr = p.Kr + (krow0 + ((tid & 255) >> 2)) * 32 + (tid & 3) * 8;
    const int key_w = tid >> 3, c_w = tid & 7;
    const int kwoff = key_w * 128 + ((c_w ^ ((key_w >> 1) & 7)) << 4);
    const int d_w = tid >> 3;
    const int vwoff0 = 8192 + d_w * 128 + (((2 * c_w) ^ ((d_w >> 1) & 15)) << 3), vwoff1 = 8192 + d_w * 128 + (((2 * c_w + 1) ^ ((d_w >> 1) & 15)) << 3);
    const int rkey = (tid & 255) >> 2, rc = tid & 3;
    const int rwoff = 16384 + rkey * 64 + ((rc ^ ((rkey >> 2) & 3)) << 4);
    const int krd = q31 * 128, ksw = (q31 >> 1) & 7;
    const int rrd = 16384 + q31 * 64, rsw = (q31 >> 2) & 3;
    const int vrd = 8192 + q31 * 128, vsw = (q31 >> 1) & 15;
    f32x16 ot[NS][2];
    float m[NS], lsum[NS];
#pragma unroll
    for (int a = 0; a < NS; ++a) { m[a] = -1e30f; lsum[a] = 0.f;
#pragma unroll
        for (int r = 0; r < 16; ++r) { ot[a][0][r] = 0.f; ot[a][1][r] = 0.f; } }
    u32x4 rk, rv, rr;
    rk = *(const u32x4*)kptr; rv = *(const u32x4*)vptr;
    if (!DIFF) { if (tid < 256) rr = *(const u32x4*)rptr; }
    __syncthreads();
    *(u32x4*)(lds + kwoff) = rk;
    *(u32x2*)(lds + vwoff0) = (u32x2){rv.x, rv.y}; *(u32x2*)(lds + vwoff1) = (u32x2){rv.z, rv.w};
    if (!DIFF) { if (tid < 256) *(u32x4*)(lds + rwoff) = rr; }
    __syncthreads();
    for (int kt = 0; kt < nkt; ++kt) {
        const char* cur = lds + (kt & 1) * BUF;
        const bool more = kt + 1 < nkt;
        if (more) {
            rk = *(const u32x4*)(kptr + (size_t)(kt + 1) * 64 * 256);
            rv = *(const u32x4*)(vptr + (kt + 1) * 64);
            if (!DIFF) { if (tid < 256) rr = *(const u32x4*)(rptr + (size_t)(kt + 1) * 64 * 32); }
        }
        bf16x8 Pf[NS][2][2];
#pragma unroll
        for (int a = 0; a < NS; ++a) {
            f32x16 st[2];
#pragma unroll
            for (int t = 0; t < 2; ++t) {
                f32x16 acc;
#pragma unroll
                for (int r = 0; r < 16; ++r) acc[r] = 0.f;
                if (DIFF) {
#pragma unroll
                    for (int s = 0; s < 2; ++s) {
                        const int c = 4 * a + 2 * s + hh;
                        const bf16x8 kf = *(const bf16x8*)(cur + t * 4096 + krd + ((c ^ ksw) << 4));
                        acc = MFMA32(kf, Qf[2 * a + s], acc);
                    }
                } else {
#pragma unroll
                    for (int s = 0; s < 4; ++s) {
                        const int c = 2 * s + hh;
                        const bf16x8 kf = *(const bf16x8*)(cur + t * 4096 + krd + ((c ^ ksw) << 4));
                        acc = MFMA32(kf, Qf[s], acc);
                    }
#pragma unroll
                    for (int s = 0; s < 2; ++s) {
                        const int c = 2 * s + hh;
                        const bf16x8 kf = *(const bf16x8*)(cur + t * 2048 + rrd + ((c ^ rsw) << 4));
                        acc = MFMA32(kf, Qf[4 + s], acc);
                    }
                }
                st[t] = acc;
            }
            float tm = st[0][0];
#pragma unroll
            for (int r = 1; r < 16; ++r) tm = fmaxf(tm, st[0][r]);
#pragma unroll
            for (int r = 0; r < 16; ++r) tm = fmaxf(tm, st[1][r]);
            tm = fmaxf(tm, __shfl_xor(tm, 32));
            const float mn = fmaxf(m[a], tm);
            const float alpha = __builtin_amdgcn_exp2f(m[a] - mn);
            m[a] = mn;
            float ps = 0.f;
#pragma unroll
            for (int t = 0; t < 2; ++t) {
#pragma unroll
                for (int r = 0; r < 16; ++r) { const float e = __builtin_amdgcn_exp2f(st[t][r] - mn); st[t][r] = e; ps += e; }
#pragma unroll
                for (int s = 0; s < 2; ++s) {
                    const float v8[8] = {st[t][8 * s], st[t][8 * s + 1], st[t][8 * s + 2], st[t][8 * s + 3], st[t][8 * s + 4], st[t][8 * s + 5], st[t][8 * s + 6], st[t][8 * s + 7]};
                    Pf[a][t][s] = pack8(v8);
                }
            }
            lsum[a] = lsum[a] * alpha + ps;
#pragma unroll
            for (int r = 0; r < 16; ++r) { ot[a][0][r] *= alpha; ot[a][1][r] *= alpha; }
            if (DIFF) __builtin_amdgcn_sched_barrier(0);
        }
#pragma unroll
        for (int dt = 0; dt < 2; ++dt)
#pragma unroll
            for (int t = 0; t < 2; ++t)
#pragma unroll
                for (int s = 0; s < 2; ++s) {
                    const int c8 = 8 * t + 4 * s + hh;
                    const u32x2 lo = *(const u32x2*)(cur + dt * 4096 + vrd + ((c8 ^ vsw) << 3));
                    const u32x2 hi = *(const u32x2*)(cur + dt * 4096 + vrd + (((c8 + 2) ^ vsw) << 3));
                    u32x4 w; w.x = lo.x; w.y = lo.y; w.z = hi.x; w.w = hi.y;
                    const bf16x8 vf = __builtin_bit_cast(bf16x8, w);
#pragma unroll
                    for (int a = 0; a < NS; ++a) ot[a][dt] = MFMA32(vf, Pf[a][t][s], ot[a][dt]);
                }
        if (more) {
            char* nxt = lds + ((kt + 1) & 1) * BUF;
            *(u32x4*)(nxt + kwoff) = rk;
            *(u32x2*)(nxt + vwoff0) = (u32x2){rv.x, rv.y}; *(u32x2*)(nxt + vwoff1) = (u32x2){rv.z, rv.w};
            if (!DIFF) { if (tid < 256) *(u32x4*)(nxt + rwoff) = rr; }
        }
        __syncthreads();
    }
    float linv[NS];
#pragma unroll
    for (int a = 0; a < NS; ++a) { const float lt = lsum[a] + __shfl_xor(lsum[a], 32); linv[a] = 1.0f / lt; }
    f32x16 o[2];
    if (DIFF) {
        const float lam = p.lam[l];
#pragma unroll
        for (int dt = 0; dt < 2; ++dt)
#pragma unroll
            for (int r = 0; r < 16; ++r) o[dt][r] = ot[0][dt][r] * linv[0] - lam * (ot[NS - 1][dt][r] * linv[NS - 1]);
        float ss = 0.f;
#pragma unroll
        for (int r = 0; r < 16; ++r) ss += o[0][r] * o[0][r] + o[1][r] * o[1][r];
        ss += __shfl_xor(ss, 32);
        const float lam_init = 0.8f - 0.6f * __expf(-0.3f * (float)l);
        const float rs = rsqrtf(ss * (1.f / 64.f) + LN_EPS) * (1.0f - lam_init);
#pragma unroll
        for (int dt = 0; dt < 2; ++dt)
#pragma unroll
            for (int r = 0; r < 16; ++r) o[dt][r] *= rs;
    } else {
#pragma unroll
        for (int dt = 0; dt < 2; ++dt)
#pragma unroll
            for (int r = 0; r < 16; ++r) o[dt][r] = ot[0][dt][r] * linv[0];
    }
    bf16_t* orow = p.O + (size_t)qrow * DM + (DIFF ? 256 : 768) + h * 64;
#pragma unroll
    for (int dt = 0; dt < 2; ++dt)
#pragma unroll
        for (int g4 = 0; g4 < 4; ++g4) {
            const int d0 = dt * 32 + 8 * g4 + 4 * hh;
            f32x4 v = {o[dt][g4 * 4], o[dt][g4 * 4 + 1], o[dt][g4 * 4 + 2], o[dt][g4 * 4 + 3]};
            if (DIFF) { const f32x4 sw = *(const f32x4*)(p.diff_subln_w + l * 64 + d0); v = v * sw; }
            store4_bf16(orow + d0, v);
        }
}

DI void phase_attn_diff_h2(const Params& p, int l, char* lds) {
    const int U_H2 = 128, U_LAT = NB * 4 * 16, U_CTX = (l == 0) ? NB * 4 : 0;
    for (int u = blockIdx.x; u < U_H2 + U_LAT + U_CTX; u += gridDim.x) {
        if (u < U_H2) hgrn_h2_unit(p, u);
        else {
            int b, h, q0, nkt; const int v = u - U_H2;
            if (v < U_LAT) { b = v >> 6; h = (v >> 4) & 3; q0 = b * TP + CTX + (v & 15) * 256; nkt = TP / 64; }
            else { const int w = v - U_LAT; b = w >> 2; h = w & 3; q0 = b * TP; nkt = CTX / 64; }
            attn_unit<true>(p, l, b, h, q0, nkt, lds);
        }
    }
}
DI void phase_attn_mla_h3(const Params& p, int l, char* lds) {
    const int tid_ = otid(); const int wid = tid_ >> 6, lane = tid_ & 63;
    const int U_LAT = NB * 4 * 16, U_CTX = (l == 0) ? NB * 4 : 0, U_H3 = NB * 4 * NCH / 8;
    for (int u = blockIdx.x; u < U_LAT + U_CTX + U_H3; u += gridDim.x) {
        if (u < U_LAT + U_CTX) {
            int b, h, q0, nkt;
            if (u < U_LAT) { b = u >> 6; h = (u >> 4) & 3; q0 = b * TP + CTX + (u & 15) * 256; nkt = TP / 64; }
            else { const int w = u - U_LAT; b = w >> 2; h = w & 3; q0 = b * TP; nkt = CTX / 64; }
            attn_unit<false>(p, l, b, h, q0, nkt, lds);
        } else { __syncthreads(); hgrn_h3_unit(p, l, (u - U_LAT - U_CTX) * 8 + wid, lane, lds + 65536 + wid * 8704); }
    }
}

DI void phase_outproj(const Params& p, int l, char* lds) {
    const int tid = otid(), wid = tid >> 6, lane = tid & 63, wr = wid >> 1, wc = wid & 1, fr = lane & 15, fq = lane >> 4;
    const int nunits = (MR / 256) * 8;
    for (int u = blockIdx.x; u < nunits; u += gridDim.x) {
        const int mt = u >> 3, nt = u & 7, m0 = mt * 256, n0 = nt * 128;
        if (l == 1 && (mt % 17) == 0) continue;
        const bf16_t* pa[4]; const bf16_t* pb[2];
        gemm_ptrs(p.O, DM, m0, p.WoutT + (size_t)l * DM * DM, DM, n0, pa, pb);
        f32x4 acc[4][4];
        gemm_core<0>(pa, pb, DM, lds, acc);
#pragma unroll
        for (int mi = 0; mi < 4; ++mi)
#pragma unroll
            for (int ni = 0; ni < 4; ++ni) {
                const int row = m0 + wr * 64 + mi * 16 + fr, col = n0 + wc * 64 + ni * 16 + fq * 4;
                *(f32x4*)(p.Y + (size_t)row * DM + col) = acc[mi][ni];
            }
    }
}

DI void phase_postmix(const Params& p, int l, char* lds) {
    const int tid = otid(), wid = tid >> 6, lane = tid & 63;
    float* WrT = (float*)lds;
    int* lcnt = (int*)(lds + 131072);
    int* lbase = lcnt + 32;
    unsigned* ent = (unsigned*)(lds + 131072 + 256);
    const int G = gridDim.x, nrb = (MR + G - 1) / G;
    const float* rw = p.router_w + (size_t)l * DM * NE;
    __syncthreads();
    for (int i = tid; i < DM * NE / 4; i += NTHREADS) {
        const f32x4 v = *(const f32x4*)(rw + i * 4);
        const int d = i >> 3, e0 = (i & 7) * 4;
#pragma unroll
        for (int j = 0; j < 4; ++j) WrT[(e0 + j) * DM + d] = v[j];
    }
    if (tid < 32) lcnt[tid] = 0;
    __syncthreads();
    const int rbeg = blockIdx.x * nrb;
    const float* lw = p.ln_mix_w + l * DM; const float* lb = p.ln_mix_b + l * DM;
    for (int i = wid; i < nrb; i += 8) {
        const int row = rbeg + i;
        if (row >= MR) break;
        const int t = row % TP;
        const bool skip = (l == 1 && t < CTX);
        if (skip) { if (lane < 4) ent[(i * 4 + lane) * 2] = 0xffffffffu; continue; }
        const float* xr = l == 0 ? in_row(p, row) : p.X + (size_t)row * DM;
        const float* yr = p.Y + (size_t)row * DM;
        const float* g1 = mod_vec(p, l, row, 2); const float* sh2 = mod_vec(p, l, row, 3); const float* sc2 = mod_vec(p, l, row, 4);
        float v[16]; float s = 0.f;
#pragma unroll
        for (int j = 0; j < 16; ++j) { const int c = lane + 64 * j; v[j] = DN_ALPHA * xr[c] + g1[c] * yr[c]; s += v[j]; }
        float mean = wave_sum(s) * (1.f / DM); float q = 0.f;
#pragma unroll
        for (int j = 0; j < 16; ++j) { v[j] -= mean; q += v[j] * v[j]; }
        float rstd = rsqrtf(wave_sum(q) * (1.f / DM) + LN_EPS);
        s = 0.f;
#pragma unroll
        for (int j = 0; j < 16; ++j) { const int c = lane + 64 * j; v[j] = v[j] * rstd * lw[c] + lb[c]; p.X[(size_t)row * DM + c] = v[j]; s += v[j]; }
        mean = wave_sum(s) * (1.f / DM); q = 0.f;
#pragma unroll
        for (int j = 0; j < 16; ++j) { v[j] -= mean; q += v[j] * v[j]; }
        rstd = rsqrtf(wave_sum(q) * (1.f / DM) + LN_EPS);
#pragma unroll
        for (int j = 0; j < 16; ++j) { const int c = lane + 64 * j; v[j] = v[j] * rstd * (1.0f + sc2[c]) + sh2[c]; }
#pragma unroll
        for (int j = 0; j < 16; ++j) { const int c = lane + 64 * j; const unsigned w = pk2(v[j], 0.f); p.H[(size_t)row * DM + c] = (bf16_t)(w & 0xffffu); }
        float pl[32];
#pragma unroll
        for (int e = 0; e < 32; ++e) { float a = 0.f;
#pragma unroll
            for (int j = 0; j < 16; ++j) a += v[j] * WrT[e * DM + lane + 64 * j];
            pl[e] = a; }
#pragma unroll
        for (int e = 0; e < 32; ++e) pl[e] += __shfl_xor(pl[e], 32);
        float r16[16];
#pragma unroll
        for (int e = 0; e < 16; ++e) { const bool up = (lane & 16) != 0; const float keep = up ? pl[e + 16] : pl[e]; const float send = up ? pl[e] : pl[e + 16]; r16[e] = keep + __shfl_xor(send, 16); }
        float r8[8];
#pragma unroll
        for (int e = 0; e < 8; ++e) { const bool up = (lane & 8) != 0; const float keep = up ? r16[e + 8] : r16[e]; const float send = up ? r16[e] : r16[e + 8]; r8[e] = keep + __shfl_xor(send, 8); }
        float r4[4];
#pragma unroll
        for (int e = 0; e < 4; ++e) { const bool up = (lane & 4) != 0; const float keep = up ? r8[e + 4] : r8[e]; const float send = up ? r8[e] : r8[e + 4]; r4[e] = keep + __shfl_xor(send, 4); }
        float r2[2];
#pragma unroll
        for (int e = 0; e < 2; ++e) { const bool up = (lane & 2) != 0; const float keep = up ? r4[e + 2] : r4[e]; const float send = up ? r4[e] : r4[e + 2]; r2[e] = keep + __shfl_xor(send, 2); }
        float logit;
        { const bool up = (lane & 1) != 0; const float keep = up ? r2[1] : r2[0]; const float send = up ? r2[0] : r2[1]; logit = keep + __shfl_xor(send, 1); }
        const int e_me = lane & 31;
        logit += p.router_b[l * NE + e_me];
        logit = (logit == logit) ? fminf(fmaxf(logit, -1e30f), 1e30f) : -1e30f;
        int rank = 0;
#pragma unroll
        for (int e = 0; e < 32; ++e) { const float o = __shfl(logit, e); rank += (o > logit || (o == logit && e < e_me)) ? 1 : 0; }
        const unsigned long long sel = __ballot(rank < 4 && lane < 32);
        const float vmax = __shfl(logit, __ffsll((long long)__ballot(rank == 0 && lane < 32)) - 1);
        const float ex = (rank < 4) ? __expf(logit - vmax) : 0.f;
        float den = (lane < 32) ? ex : 0.f;
        den = wave_sum(den);
        if (lane < 32 && rank < 4) {
            const int lp = atomicAdd(&lcnt[e_me], 1);
            ent[(i * 4 + rank) * 2] = (unsigned)e_me | ((unsigned)lp << 8);
            ent[(i * 4 + rank) * 2 + 1] = __float_as_uint(ex / den);
        }
        (void)sel;
    }
    __syncthreads();
    if (tid < 32) lbase[tid] = (int)atomicAdd(&p.gcnt[l * NE + tid], (unsigned)lcnt[tid]);
    __syncthreads();
    for (int j = tid; j < nrb * 4; j += NTHREADS) {
        const int row = rbeg + (j >> 2);
        if (row >= MR) break;
        const unsigned w = ent[j * 2];
        if (w == 0xffffffffu) continue;
        const int e = w & 255, pos = lbase[e] + (int)(w >> 8);
        p.ltok[(size_t)e * MR + pos] = row;
        p.lgate[(size_t)e * MR + pos] = __uint_as_float(ent[j * 2 + 1]);
        p.rslot[(size_t)row * 4 + (j & 3)] = (e << 24) | pos;
    }
}

DI int moe_prefix(const Params& p, int l, int* tpre  ) {
    __syncthreads();
    if (otid() == 0) {
        int acc = 0;
        for (int e = 0; e < NE; ++e) { tpre[e] = acc; acc += ((int)p.gcnt[l * NE + e] + 255) >> 8; }
        tpre[NE] = acc;
    }
    __syncthreads();
    return tpre[NE];
}
DI int moe_find(const int* tpre, int mt) { int e = 0;
#pragma unroll 1
    for (int j = 0; j < NE; ++j) if (tpre[j + 1] <= mt) e = j + 1;
    return e; }

DI void phase_moe1(const Params& p, int l, char* lds) {
    const int tid = otid(), wid = tid >> 6, lane = tid & 63, wr = wid >> 1, wc = wid & 1, fr = lane & 15, fq = lane >> 4;
    int* tpre = (int*)(lds + 98304);
    const int ntile = moe_prefix(p, l, tpre);
    const int nunits = ntile * 16;
    for (int u = blockIdx.x; u < nunits; u += gridDim.x) {
        const int mt = u >> 4, nt = u & 15, n0 = nt * 128;
        const int e = moe_find(tpre, mt), j0 = (mt - tpre[e]) * 256, cnt = (int)p.gcnt[l * NE + e];
        const bf16_t* Bt = p.W1T + ((size_t)(l * NE + e)) * 2048 * DM;
        const bf16_t* pa[4]; const bf16_t* pb[2];
        {
            const int r = tid >> 3, c = (tid & 7) * 8;
#pragma unroll
            for (int i = 0; i < 4; ++i) { const int pos = j0 + r + 64 * i; const int tok = pos < cnt ? p.ltok[(size_t)e * MR + pos] : 0; pa[i] = p.H + (size_t)tok * DM + c; }
#pragma unroll
            for (int j = 0; j < 2; ++j) pb[j] = Bt + (size_t)(n0 + r + 64 * j) * DM + c;
        }
        f32x4 acc[4][4];
        gemm_core<0>(pa, pb, DM, lds, acc);
        const float* b1 = p.b1 + (size_t)(l * NE + e) * 2048;
        const size_t slot0 = (size_t)mt * 256;
#pragma unroll
        for (int mi = 0; mi < 4; ++mi)
#pragma unroll
            for (int ni = 0; ni < 4; ++ni) {
                const int rl = wr * 64 + mi * 16 + fr, col = n0 + wc * 64 + ni * 16 + fq * 4;
                const f32x4 bb = *(const f32x4*)(b1 + col);
                const f32x4 hv = acc[mi][ni] + bb;
                float o[2];
#pragma unroll
                for (int q = 0; q < 2; ++q) {
                    const float glu = fminf(hv[2 * q], 7.0f), lin = fminf(fmaxf(hv[2 * q + 1], -7.0f), 7.0f);
                    o[q] = glu * sigmoidf_(1.702f * glu) * (lin + 1.0f);
                }
                *(unsigned*)(p.ACT + (slot0 + rl) * 1024 + (col >> 1)) = pk2(o[0], o[1]);
            }
    }
}

DI void phase_moe2(const Params& p, int l, char* lds) {
    const int tid = otid(), wid = tid >> 6, lane = tid & 63, wr = wid >> 1, wc = wid & 1, fr = lane & 15, fq = lane >> 4;
    int* tpre = (int*)(lds + 98304);
    const int ntile = moe_prefix(p, l, tpre);
    const int nunits = ntile * 8;
    for (int u = blockIdx.x; u < nunits; u += gridDim.x) {
        const int mt = u >> 3, nt = u & 7, n0 = nt * 128;
        const int e = moe_find(tpre, mt), j0 = (mt - tpre[e]) * 256, cnt = (int)p.gcnt[l * NE + e];
        const bf16_t* pa[4]; const bf16_t* pb[2];
        gemm_ptrs(p.ACT, 1024, mt * 256, p.W2T + ((size_t)(l * NE + e)) * DM * DM, DM, n0, pa, pb);
        f32x4 acc[4][4];
        gemm_core<0>(pa, pb, 1024, lds, acc);
        const float* b2 = p.b2 + (size_t)(l * NE + e) * DM;
        const size_t slot0 = (size_t)mt * 256;
#pragma unroll
        for (int mi = 0; mi < 4; ++mi) {
            const int rl = wr * 64 + mi * 16 + fr, pos = j0 + rl;
            const float gate = pos < cnt ? p.lgate[(size_t)e * MR + pos] : 0.f;
#pragma unroll
            for (int ni = 0; ni < 4; ++ni) {
                const int col = n0 + wc * 64 + ni * 16 + fq * 4;
                const f32x4 bb = *(const f32x4*)(b2 + col);
                store4_bf16(p.YS + (slot0 + rl) * 1024 + col, (acc[mi][ni] + bb) * gate);
            }
        }
    }
}

DI void phase_final(const Params& p, int l, char* lds) {
    const int tid = otid(), wid = tid >> 6, lane = tid & 63;
    int* tpre = (int*)(lds + 98304);
    moe_prefix(p, l, tpre);
    const float* lw = p.ln_ffn_w + l * DM; const float* lb = p.ln_ffn_b + l * DM;
    for (int row = blockIdx.x * 8 + wid; row < MR; row += gridDim.x * 8) {
        const int b = row / TP, t = row - b * TP;
        if (l == 1 && t < CTX) continue;
        const float* g2 = mod_vec(p, l, row, 5);
        const bf16_t* ys[4];
#pragma unroll
        for (int k = 0; k < 4; ++k) { const int rs = p.rslot[(size_t)row * 4 + k]; const int e = rs >> 24, pos = rs & 0xffffff; ys[k] = p.YS + ((size_t)tpre[e] * 256 + pos) * 1024; }
        f32x4 v[4]; float s = 0.f;
#pragma unroll
        for (int j = 0; j < 4; ++j) {
            const int c = j * 256 + lane * 4;
            f32x4 y = {0.f, 0.f, 0.f, 0.f};
#pragma unroll
            for (int k = 0; k < 4; ++k) { const u32x2 w = *(const u32x2*)(ys[k] + c); y[0] += lo2f(w.x); y[1] += hi2f(w.x); y[2] += lo2f(w.y); y[3] += hi2f(w.y); }
            const f32x4 xv = *(const f32x4*)(p.X + (size_t)row * DM + c), gg = *(const f32x4*)(g2 + c);
            v[j] = xv * DN_ALPHA + gg * y;
            s += (v[j][0] + v[j][1]) + (v[j][2] + v[j][3]);
        }
        float mean = wave_sum(s) * (1.f / DM); float q = 0.f;
#pragma unroll
        for (int j = 0; j < 4; ++j) { v[j] = v[j] - mean; q += (v[j][0] * v[j][0] + v[j][1] * v[j][1]) + (v[j][2] * v[j][2] + v[j][3] * v[j][3]); }
        float rstd = rsqrtf(wave_sum(q) * (1.f / DM) + LN_EPS);
        s = 0.f;
#pragma unroll
        for (int j = 0; j < 4; ++j) {
            const int c = j * 256 + lane * 4;
            v[j] = v[j] * rstd * *(const f32x4*)(lw + c) + *(const f32x4*)(lb + c);
            s += (v[j][0] + v[j][1]) + (v[j][2] + v[j][3]);
        }
        if (l == 1) {
            float* o = p.out + ((size_t)b * SEQ + (t - CTX)) * DM;
#pragma unroll
            for (int j = 0; j < 4; ++j) *(f32x4*)(o + j * 256 + lane * 4) = v[j];
        } else {
#pragma unroll
            for (int j = 0; j < 4; ++j) *(f32x4*)(p.X + (size_t)row * DM + j * 256 + lane * 4) = v[j];
            mean = wave_sum(s) * (1.f / DM); q = 0.f;
#pragma unroll
            for (int j = 0; j < 4; ++j) { v[j] = v[j] - mean; q += (v[j][0] * v[j][0] + v[j][1] * v[j][1]) + (v[j][2] * v[j][2] + v[j][3] * v[j][3]); }
            rstd = rsqrtf(wave_sum(q) * (1.f / DM) + LN_EPS);
            const float* sh = mod_vec(p, 1, row, 0); const float* sc = mod_vec(p, 1, row, 1);
#pragma unroll
            for (int j = 0; j < 4; ++j) {
                const int c = j * 256 + lane * 4;
                const f32x4 h = v[j] * rstd * (*(const f32x4*)(sc + c) + 1.0f) + *(const f32x4*)(sh + c);
                store4_bf16(p.H + (size_t)row * DM + c, h);
            }
        }
    }
}

constexpr int PH_PER_LAYER = 11, N_PHASES = 1 + 2 * PH_PER_LAYER;

__global__ void __launch_bounds__(NTHREADS, 2) mega(Params p, int ph_lo, int ph_hi) {
    extern __shared__ __attribute__((aligned(16))) char smem[];
    const bool fused = (ph_hi - ph_lo) > 1;
    XcdBarrier bar; bar.bar = p.bar; bar.x = 0; bar.st = (volatile LAS unsigned*)(smem + LDS_BYTES - 16);
    if (fused) {
        if (threadIdx.x == 0) *(uint4*)(smem + LDS_BYTES - 16) = make_uint4(0u, 0u, 0u, 0u);
        __syncthreads();
        bar = xcd_barrier_post(p.bar, (volatile LAS unsigned*)(smem + LDS_BYTES - 16));
    }
#define PH(idx, call) do { const int _i = (idx); if (ph_lo <= _i && _i < ph_hi) { call; if (_i + 1 < ph_hi) xcd_barrier(bar); } } while (0)
    PH(0, phase_prologue(p, smem));
#pragma unroll 1
    for (int l = 0; l < 2; ++l) {
        const int base = 1 + l * PH_PER_LAYER;
        PH(base + 0, if (l == 0) phase_ln1(p, smem));
        PH(base + 1, phase_inproj(p, l, smem));
        PH(base + 2, phase_sgu_prep(p, l, smem));
        PH(base + 3, phase_upproj_h1(p, l, smem));
        PH(base + 4, phase_attn_diff_h2(p, l, smem));
        PH(base + 5, phase_attn_mla_h3(p, l, smem));
        PH(base + 6, phase_outproj(p, l, smem));
        PH(base + 7, phase_postmix(p, l, smem));
        PH(base + 8, phase_moe1(p, l, smem));
        PH(base + 9, phase_moe2(p, l, smem));
        PH(base + 10, phase_final(p, l, smem));
    }
#undef PH
}


#ifndef MK_DEBUG
#define MK_DEBUG 0
#endif
#if MK_DEBUG
struct DbgItem { const void* ptr; unsigned long long n; int f32; int ld; int c0; int c1; int mode; int pad; };
struct DbgList { DbgItem it[40]; int count; int pad; };
__global__ void dbg_scan(DbgList L, unsigned* flag) {
    for (int i = 0; i < L.count; ++i) {
        const DbgItem d = L.it[i];
        bool bad = false;
        for (unsigned long long e = (unsigned long long)blockIdx.x * blockDim.x + threadIdx.x; e < d.n; e += (unsigned long long)gridDim.x * blockDim.x) {
            if (d.ld > 0) { const int c = (int)(e % d.ld); if (c < d.c0 || c >= d.c1) continue; }
            if (d.f32) { const unsigned u = ((const unsigned*)d.ptr)[e]; if (((d.mode & 1) && (u & 0x7f800000u) == 0x7f800000u) || ((d.mode & 2) && u == 0xAAAAAAAAu) || ((d.mode & 4) && (u & 0x7f800000u) >= 0x46800000u)) bad = true; }
            else { const unsigned short u = ((const unsigned short*)d.ptr)[e]; if (((d.mode & 1) && (u & 0x7f80u) == 0x7f80u) || ((d.mode & 2) && u == 0xAAAAu) || ((d.mode & 4) && (u & 0x7f80u) >= 0x4680u)) bad = true; }
        }
        if (bad) atomicMin(flag, (unsigned)i);
    }
}
__global__ void dbg_fill(float* out, unsigned long long n, const unsigned* flag, float hostcode) {
    const unsigned f = *flag;
    float v = f < 1000u ? 100.0f * (float)(f + 1u) : 0.0f;
    if (hostcode != 0.f) v = hostcode;
    for (unsigned long long e = (unsigned long long)blockIdx.x * blockDim.x + threadIdx.x; e < n; e += (unsigned long long)gridDim.x * blockDim.x) out[e] = v;
}
#endif

#ifndef MK_MULTI
#define MK_MULTI 0
#endif

extern "C" void kernel_launch(void* const* d_in, const int* in_sizes, int n_in, void* d_out, int out_size, void* d_ws, size_t ws_size, hipStream_t stream) {
    (void)in_sizes; (void)n_in; (void)out_size; (void)ws_size;
    Params p;
    memset(&p, 0, sizeof(p));
    const float* const* in = (const float* const*)d_in;
    p.x = in[0]; p.c = in[1]; p.ctx = in[2]; p.c_ctx = in[3]; p.ada_w = in[4]; p.ada_b = in[5]; p.w_in = in[6]; p.w_out = in[7];
    p.sgu_ln_w = in[8]; p.sgu_ln_b = in[9]; p.sgu_w = in[10]; p.sgu_b = in[11]; p.diff_lambda = in[12]; p.diff_subln_w = in[13];
    p.hgrn_lb = in[14]; p.hgrn_norm_w = in[15]; p.mla_q_norm_w = in[16]; p.mla_w_uq = in[17]; p.mla_kv_norm_w = in[18]; p.mla_w_ukv = in[19];
    p.ln_mix_w = in[20]; p.ln_mix_b = in[21]; p.ln_ffn_w = in[22]; p.ln_ffn_b = in[23]; p.router_w = in[24]; p.router_b = in[25];
    p.w1 = in[26]; p.b1 = in[27]; p.w2 = in[28]; p.b2 = in[29];
    p.out = (float*)d_out;
    char* ws = (char*)d_ws; size_t off = 0;
    auto take = [&](size_t bytes) { char* r = ws + off; off += (bytes + 255) & ~(size_t)255; return r; };
    constexpr size_t CTRL_BYTES = 65536;
    char* ctrl = take(CTRL_BYTES);
    p.bar = (unsigned*)ctrl; p.gcnt = (unsigned*)(ctrl + 16384);
    p.mod = (float*)take((size_t)2 * 9 * 6144 * 4); p.lball = (float*)take(2 * 512 * 4); p.lam = (float*)take(256); p.ropec = (float*)take(512 * 4); p.ropes = (float*)take(512 * 4);
    p.WinT = (bf16_t*)take((size_t)2 * NINP * DM * 2); p.WoutT = (bf16_t*)take((size_t)2 * DM * DM * 2);
    p.WuqT = (bf16_t*)take((size_t)2 * 384 * 256 * 2); p.WukvT = (bf16_t*)take((size_t)2 * 512 * 128 * 2);
    p.W1T = (bf16_t*)take((size_t)2 * NE * 2048 * DM * 2); p.W2T = (bf16_t*)take((size_t)2 * NE * DM * DM * 2);
    p.X = (float*)take((size_t)MR * DM * 4); p.H = (bf16_t*)take((size_t)MR * DM * 2);
    p.Puv = (bf16_t*)take((size_t)MR * 512 * 2); p.Qd = (bf16_t*)take((size_t)MR * 256 * 2); p.Kd = (bf16_t*)take((size_t)MR * 256 * 2); p.Vdt = (bf16_t*)take((size_t)MR * 256 * 2);
    p.Hq = (bf16_t*)take((size_t)MR * 256 * 2); p.Vht = (bf16_t*)take((size_t)MR * 256 * 2); p.Lf = (bf16_t*)take((size_t)2 * MR * 256 * 2); p.Hg = (bf16_t*)take((size_t)MR * 256 * 2);
    p.Cq = (bf16_t*)take((size_t)MR * 256 * 2); p.Ckv = (bf16_t*)take((size_t)MR * 128 * 2); p.Kr = (bf16_t*)take((size_t)MR * 32 * 2);
    p.Qm = (bf16_t*)take((size_t)MR * 384 * 2); p.Kn = (bf16_t*)take((size_t)MR * 256 * 2); p.Vmt = (bf16_t*)take((size_t)MR * 256 * 2);
    p.O = (bf16_t*)take((size_t)MR * DM * 2);
    p.RS = (float*)take((size_t)MR * 2 * 4); p.DST = (float*)take((size_t)NB * 4 * 2 * NCH * 4096 * 4); p.DEC = (float*)take((size_t)NB * 4 * 2 * NCH * 64 * 4);
    p.Y = (float*)take((size_t)MR * DM * 4);
    p.ltok = (int*)take((size_t)NE * MR * 4); p.lgate = (float*)take((size_t)NE * MR * 4); p.rslot = (int*)take((size_t)MR * 4 * 4);
    p.ACT = (bf16_t*)take((size_t)NSLOT * 1024 * 2); p.YS = (bf16_t*)take((size_t)NSLOT * 1024 * 2);

    static int grid = 0;
    if (!grid) {
        int dev = 0, cus = 0, per_cu = 0;
        hipGetDevice(&dev);
        hipDeviceGetAttribute(&cus, hipDeviceAttributeMultiprocessorCount, dev);
        hipFuncSetAttribute((const void*)mega, hipFuncAttributeMaxDynamicSharedMemorySize, LDS_BYTES);
        hipOccupancyMaxActiveBlocksPerMultiprocessor(&per_cu, mega, NTHREADS, LDS_BYTES);
        if (cus <= 0) cus = 256;
        grid = cus * (per_cu < 1 ? 1 : 1);
    }
    hipMemsetAsync(ctrl, 0, CTRL_BYTES, stream);
#if MK_MULTI
#ifndef MK_NPH
#define MK_NPH N_PHASES
#endif
    for (int ph = 0; ph < MK_NPH; ++ph) {
        if (ph == 1 + PH_PER_LAYER) continue;
        hipLaunchKernelGGL(mega, dim3(grid), dim3(NTHREADS), LDS_BYTES, stream, p, ph, ph + 1);
    }
#else
    hipLaunchKernelGGL(mega, dim3(grid), dim3(NTHREADS), LDS_BYTES, stream, p, 0, N_PHASES);
#endif

#if MK_DEBUG
    {
        DbgList L; memset(&L, 0, sizeof(L));
        int n = 0;
        auto add = [&](const void* ptr, unsigned long long cnt, int f32, int ld = 0, int c0 = 0, int c1 = 0, int mode = 3) { L.it[n].ptr = ptr; L.it[n].n = cnt; L.it[n].f32 = f32; L.it[n].ld = ld; L.it[n].c0 = c0; L.it[n].c1 = c1; L.it[n].mode = mode; ++n; };
        MK_DEBUG_LIST
        L.count = n;
        unsigned* flag = (unsigned*)(ctrl + 32768);
        hipMemsetAsync(flag, 0x7f, 4, stream);
        hipLaunchKernelGGL(dbg_scan, dim3(2048), dim3(256), 0, stream, L, flag);
        hipLaunchKernelGGL(dbg_fill, dim3(2048), dim3(256), 0, stream, (float*)d_out, (unsigned long long)NB * SEQ * DM, (const unsigned*)flag, 0.0f);
    }
#endif
}
```

```cpp
#include <hip/hip_runtime.h>
#include <stdint.h>
#include <string.h>

#define MK_MULTI 0
#define MK_NPH N_PHASES
#define MK_DEBUG 0
#define MK_REP 0u
#define MK_DEBUG_LIST \
  add(p.mod, 2*9*6144, 1,0,0,0,7); add(p.WinT, 2ull*NINP*DM, 0,0,0,0,7); add(p.H, (unsigned long long)MR*DM, 0,0,0,0,7); add(p.Puv, (unsigned long long)MR*512, 0,0,0,0,7); \
  add(p.Cq, (unsigned long long)MR*256, 0,0,0,0,7); add(p.Ckv, (unsigned long long)MR*128, 0,0,0,0,7); add(p.RS, (unsigned long long)MR*2, 1,0,0,0,7); \
  add(p.Kn, (unsigned long long)MR*256, 0,0,0,0,7); add(p.Vmt, (unsigned long long)MR*256, 0,0,0,0,7); \
  add(p.O, (unsigned long long)MR*DM, 0, DM, 0, 256, 1); \
  add(p.Y, (unsigned long long)MR*DM, 1);

#define DI __device__ __forceinline__
typedef unsigned short bf16_t;
typedef short bf16x8 __attribute__((ext_vector_type(8)));
typedef float f32x4 __attribute__((ext_vector_type(4)));
typedef float f32x2 __attribute__((ext_vector_type(2)));
typedef float f32x16 __attribute__((ext_vector_type(16)));
typedef unsigned u32x4 __attribute__((ext_vector_type(4)));
typedef unsigned u32x2 __attribute__((ext_vector_type(2)));

constexpr int DM = 1024, NB = 8, SEQ = 4096, CTX = 256, TP = 4352, MR = NB * TP;
constexpr int NIN = 2976, NINP = 3072;
constexpr int NE = 32;
constexpr int NCH = TP / 32;
constexpr int NSLOT = 147456;
constexpr float LN_EPS = 1e-6f;
constexpr float DN_ALPHA = 1.4142135623730951f;
constexpr float LOG2E = 1.4426950408889634f;
constexpr int NTHREADS = 512;
constexpr int LDS_BYTES = 147456;

#define XB_TMO      128
#define XB_XCNT(j)  (256  + 64 * (j))
#define XB_XSUB(j)  (1280 + 64 * (j))
#define XB_XGEN(j)  (2304 + 64 * (j))
#define XB_TOP      3328
#define XB_TOPGEN   3392
#define XCD_BAR_WORDS 3456
#define XB_SPIN_CAP (1u << 22)
#define LAS __attribute__((address_space(3)))
__device__ __forceinline__ int otid();

DI unsigned xb_ld(unsigned* p)              { return __hip_atomic_load(p, __ATOMIC_RELAXED, __HIP_MEMORY_SCOPE_AGENT); }
DI unsigned xb_add(unsigned* p, unsigned v) { return __hip_atomic_fetch_add(p, v, __ATOMIC_RELAXED, __HIP_MEMORY_SCOPE_AGENT); }
DI unsigned xb_xcc_id() { return (unsigned)__builtin_amdgcn_s_getreg((3 << 11) | 20) & 0xFu; }
#define XB_SPIN(cond, bar) do { unsigned _sp = 0; while (cond) { __builtin_amdgcn_s_sleep(1); \
    if ((++_sp & 255u) == 0u) { if (xb_ld(&(bar)[XB_TMO])) break; if (_sp > XB_SPIN_CAP) { atomicAdd(&(bar)[XB_TMO], 1u); break; } } } } while (0)

struct XcdBarrier { unsigned* bar; unsigned x; volatile LAS unsigned* st; };

DI XcdBarrier xcd_barrier_post(unsigned* bar, volatile LAS unsigned* st) {
    XcdBarrier b; b.bar = bar; b.x = xb_xcc_id(); b.st = st;
    if (otid() == 0) (void)xb_add(&bar[XB_XCNT(b.x)], 1u);
    return b;
}
DI void xcd_barrier_complete(unsigned* bar, unsigned x, unsigned& nloc, unsigned& nx) {
    const unsigned G = gridDim.x * gridDim.y * gridDim.z;
    unsigned sum, cnt, mine, sp = 0u;
    for (;;) {
        sum = 0u; cnt = 0u; mine = 0u;
#pragma unroll
        for (unsigned j = 0; j < 16; ++j) { const unsigned c = xb_ld(&bar[XB_XCNT(j)]); sum += c; cnt += (c > 0u) ? 1u : 0u; mine = (j == x) ? c : mine; }
        if (sum == G) break;
        __builtin_amdgcn_s_sleep(1);
        if ((++sp & 255u) == 0u) { if (xb_ld(&bar[XB_TMO])) break; if (sp > XB_SPIN_CAP) { atomicAdd(&bar[XB_TMO], 1u); break; } }
    }
    nloc = mine > 0u ? mine : 1u; nx = cnt > 0u ? cnt : 1u;
}
DI void xcd_barrier(const XcdBarrier& b) {
    asm volatile("s_waitcnt vmcnt(0)" ::: "memory");
    __syncthreads();
    if (otid() == 0) {
        unsigned* bar = b.bar;
        __builtin_amdgcn_s_waitcnt(0);
        unsigned nloc = b.st[0], nx = b.st[1];
        if (nloc == 0u) { xcd_barrier_complete(bar, b.x, nloc, nx); b.st[0] = nloc; b.st[1] = nx; }
        const unsigned old = xb_add(&bar[XB_XSUB(b.x)], 1u);
        const unsigned gen = old / nloc;
        if (old + 1u == (gen + 1u) * nloc) {
            __builtin_amdgcn_fence(__ATOMIC_RELEASE, "agent");
            asm volatile("s_waitcnt vmcnt(0)" ::: "memory");
            const unsigned og = xb_add(&bar[XB_TOP], 1u);
            const unsigned tg = og / nx;
            if (og + 1u == (tg + 1u) * nx) xb_add(&bar[XB_TOPGEN], 1u);
            else XB_SPIN(xb_ld(&bar[XB_TOPGEN]) == tg, bar);
            __builtin_amdgcn_fence(__ATOMIC_ACQUIRE, "agent");
            xb_add(&bar[XB_XGEN(b.x)], 1u);
            asm volatile("s_waitcnt vmcnt(0)" ::: "memory");
        } else {
            XB_SPIN(xb_ld(&bar[XB_XGEN(b.x)]) == gen, bar);
            __builtin_amdgcn_fence(__ATOMIC_ACQUIRE, "agent");
            asm volatile("s_waitcnt vmcnt(0)" ::: "memory");
        }
    }
    __syncthreads();
}

struct Params {
    const float *x, *c, *ctx, *c_ctx, *ada_w, *ada_b, *w_in, *w_out, *sgu_ln_w, *sgu_ln_b, *sgu_w, *sgu_b,
                *diff_lambda, *diff_subln_w, *hgrn_lb, *hgrn_norm_w, *mla_q_norm_w, *mla_w_uq, *mla_kv_norm_w, *mla_w_ukv,
                *ln_mix_w, *ln_mix_b, *ln_ffn_w, *ln_ffn_b, *router_w, *router_b, *w1, *b1, *w2, *b2;
    float* out;
    unsigned* bar; unsigned* gcnt;
    float *mod, *lball, *lam, *ropec, *ropes;
    bf16_t *WinT, *WoutT, *WuqT, *WukvT, *W1T, *W2T;
    float* X; bf16_t* H;
    bf16_t *Puv, *Qd, *Kd, *Vdt, *Hq, *Vht, *Lf, *Hg, *Cq, *Ckv, *Kr, *Qm, *Kn, *Vmt, *O;
    float *RS, *DST, *DEC, *Y;
    int* ltok; float* lgate; int* rslot; bf16_t *ACT, *YS;
};

typedef const __attribute__((address_space(4))) Params CParams;
extern __shared__ __attribute__((aligned(16))) char smem_all[];
constexpr int WVTAB_OFF = 147456 - 16 - 256;
DI int hw_slot() { return (int)(__builtin_amdgcn_s_getreg((6 << 11) | 4) & 63u); }
DI int otid() {
    int l = (int)__builtin_amdgcn_mbcnt_hi(~0u, __builtin_amdgcn_mbcnt_lo(~0u, 0u));
    const int w = __builtin_amdgcn_readfirstlane(((volatile int*)(smem_all + WVTAB_OFF))[hw_slot()]);
    int t = w * 64 + l; asm volatile("" : "+v"(t)); return t;
}
DI float bf2f(bf16_t v) { return __uint_as_float(((unsigned)v) << 16); }
typedef __bf16 bf16x2_t __attribute__((ext_vector_type(2)));
DI unsigned pk2(float lo, float hi) { const bf16x2_t v = {(__bf16)lo, (__bf16)hi}; return __builtin_bit_cast(unsigned, v); }
DI float lo2f(unsigned w) { return __uint_as_float(w << 16); }
DI float hi2f(unsigned w) { return __uint_as_float(w & 0xffff0000u); }
DI bf16x8 pack8(const float (&v)[8]) { u32x4 w; w.x = pk2(v[0], v[1]); w.y = pk2(v[2], v[3]); w.z = pk2(v[4], v[5]); w.w = pk2(v[6], v[7]); return __builtin_bit_cast(bf16x8, w); }
template <int MASK> DI float shx(float v) {
    if (MASK < 32) return __int_as_float(__builtin_amdgcn_ds_swizzle(__float_as_int(v), (MASK << 10) | 0x1f));
    int l = (int)__builtin_amdgcn_mbcnt_hi(~0u, __builtin_amdgcn_mbcnt_lo(~0u, 0u)); asm volatile("" : "+v"(l));
    return __int_as_float(__builtin_amdgcn_ds_bpermute((l ^ 32) << 2, __float_as_int(v)));
}
DI float zf() { float z = 0.f; asm volatile("" : "+v"(z)); return z; }
DI f32x4 zero4() { const float z = zf(); return (f32x4){z, z, z, z}; }
DI float rdlane(float v, int l) { return __int_as_float(__builtin_amdgcn_readlane(__float_as_int(v), l)); }
DI float wave_sum(float v) { v += shx<32>(v); v += shx<16>(v); v += shx<8>(v); v += shx<4>(v); v += shx<2>(v); v += shx<1>(v); return v; }
DI float sigmoidf_(float x) { return 1.0f / (1.0f + __expf(-x)); }
DI float siluf_(float x) { return x * sigmoidf_(x); }
DI int crow(int r, int hh) { return (r & 3) + 8 * (r >> 2) + 4 * hh; }
#define MFMA16(a, b, c) __builtin_amdgcn_mfma_f32_16x16x32_bf16((a), (b), (c), 0, 0, 0)
#define MFMA32(a, b, c) __builtin_amdgcn_mfma_f32_32x32x16_bf16((a), (b), (c), 0, 0, 0)

DI const float* in_row(CParams& p, int row) {
    const int b = row / TP, t = row - b * TP;
    return t < CTX ? p.ctx + ((size_t)b * CTX + t) * DM : p.x + ((size_t)b * SEQ + (t - CTX)) * DM;
}
DI const float* mod_vec(CParams& p, int l, int row, int j) {
    const int b = row / TP, t = row - b * TP;
    const int r = t < CTX ? 8 : b;
    return p.mod + ((size_t)(l * 9 + r) * 6 + j) * DM;
}

DI void transpose_tile(const float* __restrict__ src, int K, int N, bf16_t* __restrict__ dst, int k0, int n0, const float* __restrict__ kscale, int perm_ukv, char* wl, int lane) {
    bf16_t* S = (bf16_t*)wl;
#pragma unroll 4
    for (int it = 0; it < 16; ++it) {
        const int kk = it * 4 + (lane >> 4), nn = (lane & 15) * 4;
        f32x4 v = {0.f, 0.f, 0.f, 0.f};
        if (n0 + nn < N) v = *(const f32x4*)(src + (size_t)(k0 + kk) * N + n0 + nn);
        if (kscale) { const float s = kscale[k0 + kk]; v = v * s; }
        unsigned* d = (unsigned*)(S + kk * 66 + nn);
        d[0] = pk2(v[0], v[1]); d[1] = pk2(v[2], v[3]);
    }
    __builtin_amdgcn_fence(__ATOMIC_RELEASE, "workgroup");
    __builtin_amdgcn_wave_barrier();
    __builtin_amdgcn_fence(__ATOMIC_ACQUIRE, "workgroup");
#pragma unroll 2
    for (int it = 0; it < 8; ++it) {
        const int nn = it * 8 + (lane >> 3), kc = lane & 7;
        unsigned short e[8];
#pragma unroll
        for (int j = 0; j < 8; ++j) e[j] = S[(kc * 8 + j) * 66 + nn];
        u32x4 w; w.x = e[0] | ((unsigned)e[1] << 16); w.y = e[2] | ((unsigned)e[3] << 16); w.z = e[4] | ((unsigned)e[5] << 16); w.w = e[6] | ((unsigned)e[7] << 16);
        int n = n0 + nn;
        if (perm_ukv) { const int hh = n >> 7, t = n & 127; n = t < 64 ? hh * 64 + t : 256 + hh * 64 + (t - 64); }
        *(u32x4*)(dst + (size_t)n * K + k0 + kc * 8) = w;
    }
    __builtin_amdgcn_fence(__ATOMIC_RELEASE, "workgroup");
    __builtin_amdgcn_wave_barrier();
}

DI void phase_prologue(CParams& p, char* lds) {
    const int tid = otid(), wid = tid >> 6, lane = tid & 63;
    char* wl = lds + wid * 8704;
    constexpr int T_IN = 16 * 48, T_OUT = 16 * 16, T_UQ = 4 * 6, T_UKV = 2 * 8, T_W1 = 32 * 16 * 32, T_W2 = 32 * 16 * 16;
    constexpr int T_LAYER = T_IN + T_OUT + T_UQ + T_UKV + T_W1 + T_W2;
    constexpr int T_ALL = 2 * T_LAYER;
    constexpr int U_TR = (T_ALL + 7) / 8;
    constexpr int U_GEMV = 2 * 6144 / 64;
    const int nunits = U_GEMV + U_TR + 1;
    for (int u = blockIdx.x; u < nunits; u += gridDim.x) {
        if (u < U_GEMV) {
            const int l = u / 96, n = (u % 96) * 64 + lane;
            const float* W = p.ada_w + (size_t)l * DM * 6144 + (size_t)(wid * 128) * 6144 + n;
            float* sc = (float*)(lds + 73728);
            float* part = (float*)lds;
            __syncthreads();
            for (int i = tid; i < 9 * DM; i += NTHREADS) { const float cv = i < 8 * DM ? p.c[i] : p.c_ctx[i - 8 * DM]; sc[i] = siluf_(cv); }
            __syncthreads();
            float acc[9];
#pragma unroll
            for (int r = 0; r < 9; ++r) acc[r] = 0.f;
#pragma unroll 2
            for (int k = 0; k < 128; k += 4) {
                float w[4];
#pragma unroll
                for (int j = 0; j < 4; ++j) w[j] = W[(size_t)(k + j) * 6144];
#pragma unroll
                for (int r = 0; r < 9; ++r) {
                    const f32x4 cc = *(const f32x4*)(sc + r * DM + wid * 128 + k);
#pragma unroll
                    for (int j = 0; j < 4; ++j) acc[r] += cc[j] * w[j];
                }
            }
#pragma unroll
            for (int r = 0; r < 9; ++r) part[(wid * 9 + r) * 64 + lane] = acc[r];
            __syncthreads();
            for (int i = tid; i < 9 * 64; i += NTHREADS) {
                const int r = i >> 6, c = i & 63;
                float sum = p.ada_b[l * 6144 + (u % 96) * 64 + c];
#pragma unroll
                for (int w8 = 0; w8 < 8; ++w8) sum += part[(w8 * 9 + r) * 64 + c];
                p.mod[(size_t)(l * 9 + r) * 6144 + (u % 96) * 64 + c] = sum;
            }
            __syncthreads();
        } else if (u < U_GEMV + U_TR) {
            int t = (u - U_GEMV) * 8 + wid;
            if (t < T_ALL) {
                const int l = t / T_LAYER; t -= l * T_LAYER;
                if (t < T_IN) { const int kt = t / 48, nt = t % 48;
                    transpose_tile(p.w_in + (size_t)l * DM * NIN, DM, NIN, p.WinT + (size_t)l * NINP * DM, kt * 64, nt * 64, nullptr, 0, wl, lane);
                } else if ((t -= T_IN) < T_OUT) { const int kt = t / 16, nt = t % 16;
                    transpose_tile(p.w_out + (size_t)l * DM * DM, DM, DM, p.WoutT + (size_t)l * DM * DM, kt * 64, nt * 64, nullptr, 0, wl, lane);
                } else if ((t -= T_OUT) < T_UQ) { const int kt = t / 6, nt = t % 6;
                    transpose_tile(p.mla_w_uq + (size_t)l * 256 * 384, 256, 384, p.WuqT + (size_t)l * 384 * 256, kt * 64, nt * 64, p.mla_q_norm_w + l * 256, 0, wl, lane);
                } else if ((t -= T_UQ) < T_UKV) { const int kt = t / 8, nt = t % 8;
                    transpose_tile(p.mla_w_ukv + (size_t)l * 128 * 512, 128, 512, p.WukvT + (size_t)l * 512 * 128, kt * 64, nt * 64, p.mla_kv_norm_w + l * 128, 1, wl, lane);
                } else if ((t -= T_UKV) < T_W1) { const int e = t / 512, r = t % 512, kt = r / 32, nt = r % 32;
                    transpose_tile(p.w1 + ((size_t)l * NE + e) * DM * 2048, DM, 2048, p.W1T + ((size_t)l * NE + e) * 2048 * DM, kt * 64, nt * 64, nullptr, 0, wl, lane);
                } else { t -= T_W1; const int e = t / 256, r = t % 256, kt = r / 16, nt = r % 16;
                    transpose_tile(p.w2 + ((size_t)l * NE + e) * DM * DM, DM, DM, p.W2T + ((size_t)l * NE + e) * DM * DM, kt * 64, nt * 64, nullptr, 0, wl, lane);
                }
            }
        } else {
            if (tid < 512) {
                const int j = tid;
                const float a0 = p.hgrn_lb[j], a1 = p.hgrn_lb[512 + j];
                const float m = fmaxf(a0, a1), e0 = expf(a0 - m), e1 = expf(a1 - m);
                p.lball[j] = 0.f;
                p.lball[512 + j] = e1 / (e0 + e1);
            }
            if (tid < 2) {
                const float* lp = p.diff_lambda + tid * 4 * 32;
                float s01 = 0.f, s23 = 0.f;
                for (int i = 0; i < 32; ++i) { s01 += lp[i] * lp[32 + i]; s23 += lp[64 + i] * lp[96 + i]; }
                const float lam_init = 0.8f - 0.6f * expf(-0.3f * (float)tid);
                p.lam[tid] = expf(s01) - expf(s23) + lam_init;
            }
            {
                const int pos = tid >> 3, i = tid & 7;
                const float inv = powf(10000.0f, -(float)(2 * i) / 16.0f);
                float sn, cs; sincosf((float)pos * inv, &sn, &cs);
                p.ropec[tid] = cs; p.ropes[tid] = sn;
            }
        }
    }
}

DI void phase_ln1(CParams& p, char* lds) {
    const int tid = otid(), wid = tid >> 6, lane = tid & 63;
    for (int row = blockIdx.x * 8 + wid; row < MR; row += gridDim.x * 8) {
        const float* xr = in_row(p, row);
        f32x4 v[4]; float s = 0.f;
#pragma unroll
        for (int j = 0; j < 4; ++j) { v[j] = *(const f32x4*)(xr + j * 256 + lane * 4); s += (v[j][0] + v[j][1]) + (v[j][2] + v[j][3]); }
        const float mean = wave_sum(s) * (1.f / DM);
        float q = 0.f;
#pragma unroll
        for (int j = 0; j < 4; ++j) { v[j] = v[j] - mean; q += (v[j][0] * v[j][0] + v[j][1] * v[j][1]) + (v[j][2] * v[j][2] + v[j][3] * v[j][3]); }
        const float rstd = rsqrtf(wave_sum(q) * (1.f / DM) + LN_EPS);
        const float* sh = mod_vec(p, 0, row, 0); const float* sc = mod_vec(p, 0, row, 1);
#pragma unroll
        for (int j = 0; j < 4; ++j) {
            const int c = j * 256 + lane * 4;
            const f32x4 a = *(const f32x4*)(sh + c), b = *(const f32x4*)(sc + c);
            const f32x4 h = v[j] * rstd * (b + 1.0f) + a;
            u32x2 w; w.x = pk2(h[0], h[1]); w.y = pk2(h[2], h[3]);
            *(u32x2*)(p.H + (size_t)row * DM + c) = w;
        }
    }
}

template <int ORI>
DI void gemm_core(const bf16_t* const (&pa)[4], const bf16_t* const (&pb)[2], int K, char* lds, f32x4 (&acc)[4][4]) {
    const int tid = otid(), wid = tid >> 6, lane = tid & 63, wr = wid >> 1, wc = wid & 1, fr = lane & 15, fq = lane >> 4;
    const int sw = ((tid & 7) ^ ((tid >> 4) & 7)) << 4;
    const int offA = (tid >> 3) * 128 + sw, offB = 32768 + (tid >> 3) * 128 + sw;
    const int rdA = (wr * 64 + fr) * 128 + ((fq ^ (fr >> 1)) << 4), rdB = 32768 + (wc * 64 + fr) * 128 + ((fq ^ (fr >> 1)) << 4);
#pragma unroll
    for (int mi = 0; mi < 4; ++mi)
#pragma unroll
        for (int ni = 0; ni < 4; ++ni) acc[mi][ni] = zero4();
    u32x4 ra[4], rb[2];
#pragma unroll
    for (int i = 0; i < 4; ++i) ra[i] = *(const u32x4*)(pa[i]);
#pragma unroll
    for (int j = 0; j < 2; ++j) rb[j] = *(const u32x4*)(pb[j]);
#pragma unroll
    for (int i = 0; i < 4; ++i) *(u32x4*)(lds + offA + i * 8192) = ra[i];
#pragma unroll
    for (int j = 0; j < 2; ++j) *(u32x4*)(lds + offB + j * 8192) = rb[j];
    __syncthreads();
    const int nk = K >> 6;
    for (int kt = 0; kt < nk; ++kt) {
        const char* cur = lds + (kt & 1) * 49152;
        const bool more = kt + 1 < nk;
        if (more) {
#pragma unroll
            for (int i = 0; i < 4; ++i) ra[i] = *(const u32x4*)(pa[i] + (kt + 1) * 64);
#pragma unroll
            for (int j = 0; j < 2; ++j) rb[j] = *(const u32x4*)(pb[j] + (kt + 1) * 64);
        }
#pragma unroll
        for (int kk = 0; kk < 2; ++kk) {
            bf16x8 af[4], bfr[4];
#pragma unroll
            for (int mi = 0; mi < 4; ++mi) af[mi] = *(const bf16x8*)(cur + ((rdA + mi * 2048) ^ (kk * 64)));
#pragma unroll
            for (int ni = 0; ni < 4; ++ni) bfr[ni] = *(const bf16x8*)(cur + ((rdB + ni * 2048) ^ (kk * 64)));
#pragma unroll
            for (int mi = 0; mi < 4; ++mi)
#pragma unroll
                for (int ni = 0; ni < 4; ++ni) {
                    if (ORI == 0) acc[mi][ni] = MFMA16(bfr[ni], af[mi], acc[mi][ni]);
                    else          acc[mi][ni] = MFMA16(af[mi], bfr[ni], acc[mi][ni]);
                }
        }
        if (more) {
            char* nxt = lds + ((kt + 1) & 1) * 49152;
#pragma unroll
            for (int i = 0; i < 4; ++i) *(u32x4*)(nxt + offA + i * 8192) = ra[i];
#pragma unroll
            for (int j = 0; j < 2; ++j) *(u32x4*)(nxt + offB + j * 8192) = rb[j];
        }
        __syncthreads();
    }
}

DI void gemm_ptrs(const bf16_t* A, int lda, int row0, const bf16_t* Bt, int ldb, int n0, const bf16_t* (&pa)[4], const bf16_t* (&pb)[2]) {
    const int tid = otid(), r = tid >> 3, c = (tid & 7) * 8;
#pragma unroll
    for (int i = 0; i < 4; ++i) pa[i] = A + (size_t)(row0 + r + 64 * i) * lda + c;
#pragma unroll
    for (int j = 0; j < 2; ++j) pb[j] = Bt + (size_t)(n0 + r + 64 * j) * ldb + c;
}

DI void store4_bf16(bf16_t* dst, const f32x4& v) { u32x2 w; w.x = pk2(v[0], v[1]); w.y = pk2(v[2], v[3]); *(u32x2*)dst = w; }

DI f32x4 rope_tile(CParams& p, f32x4 v, int row, int axis_is_col, int fq) {
    f32x4 o;
    const int b = row / TP, t = row - b * TP;
    const int pos = t - CTX;
    const int ax = axis_is_col ? (pos & 63) : (pos >> 6);
#pragma unroll
    for (int r = 0; r < 4; ++r) {
        const float pr = shx<32>(v[r]);
        float cs = 1.f, sn = 0.f;
        if (t >= CTX) { const int i = (fq & 1) * 4 + r; cs = p.ropec[ax * 8 + i]; sn = p.ropes[ax * 8 + i]; }
        o[r] = fq < 2 ? v[r] * cs - pr * sn : v[r] * cs + pr * sn;
    }
    return o;
}


namespace g8 {
constexpr int BK = 64, HALF = 128, HTB = HALF * BK * 2, STAGE_BYTES = 8 * HTB;
DI int lds_byte(int r, int c) { const int st = (r >> 4) * 2 + (c >> 5), rr = r & 15, cc = c & 31, ob = rr * 64 + cc * 2; return st * 1024 + (ob ^ (((ob >> 9) & 1) << 5)); }
DI void stage_rc(int b, int& R, int& C) { const int st = b / 1024, sb = b % 1024, swz = sb ^ (((sb >> 9) & 1) << 5); R = (st >> 1) * 16 + swz / 64; C = (st & 1) * 32 + (swz % 64) / 2; }
struct GU { const char* a; const char* b; int pm, pn, e, j0; };
DI bool order_next(int i, int nM, int nN, int& pm, int& pn) {
    const int nwg = nM * nN; const long L = (long)i * gridDim.x + blockIdx.x; if (L >= nwg) return false;
    int wgid = (int)L; { const int q = nwg / 8, r = nwg % 8, xcd = wgid % 8, off = wgid / 8; wgid = (xcd < r ? xcd * (q + 1) : r * (q + 1) + (xcd - r) * q) + off; }
    const int nig = 8 * nN, gid = wgid / nig, fm = gid * 8, gsz = (nM - fm) < 8 ? (nM - fm) : 8;
    pm = fm + ((wgid % nig) % gsz); pn = (wgid % nig) / gsz; return true;
}

template <class Epi, class Sched, bool GATHER>
DI void gemm8(char* lds_generic, const int K, const char* Abase, const Sched& S, const Epi& E) {
    LAS unsigned char* lds = (LAS unsigned char*)lds_generic;
    const int tid = otid(), wid = __builtin_amdgcn_readfirstlane(tid >> 6), lane = tid & 63, wr = wid >> 2, wc = wid & 3, fr = lane & 15, fq = lane >> 4;
    const int nt = K / BK;
    int R[2], C[2];
#pragma unroll
    for (int i = 0; i < 2; ++i) stage_rc(tid * 16 + i * 8192, R[i], C[i]);
    unsigned voff[2];
#pragma unroll
    for (int i = 0; i < 2; ++i) voff[i] = (unsigned)(R[i] * K + C[i]) * 2u;
    const size_t kstep = (size_t)(BK * 2), hstep = (size_t)HALF * K * 2;
    const unsigned ldsw = (unsigned)wid * 1024u;
    const int aoff = lds_byte(wr * 64 + fr, fq * 8), boff = lds_byte(wc * 32 + fr, fq * 8);
    unsigned cg[2][2], ng[2][2];
#define G8_SA(b, h) (((b) * 2 + (h)) * HTB)
#define G8_SB(b, h) ((4 + (b) * 2 + (h)) * HTB)
#define G8_LDS(gp, bufoff, i) __builtin_amdgcn_global_load_lds((const unsigned*)(gp), (LAS unsigned*)(lds + (bufoff) + ldsw + (i) * 8192), 16, 0, 0)
#define G8_STAGE_B(bufoff, gbase) do { _Pragma("unroll") for (int _i = 0; _i < 2; ++_i) G8_LDS((const char*)(gbase) + voff[_i], bufoff, _i); } while (0)
#define G8_STAGE_A(bufoff, h, nx, ko) do { _Pragma("unroll") for (int _i = 0; _i < 2; ++_i) { \
        const char* _gp = GATHER ? Abase + (size_t)((nx) ? ng[h][_i] : cg[h][_i]) + (ko) : ((nx) ? nA : cA) + (size_t)(h) * hstep + (ko) + voff[_i]; G8_LDS(_gp, bufoff, _i); } } while (0)
#define G8_LDA(dst, b, h) do { _Pragma("unroll") for (int m = 0; m < 4; ++m) _Pragma("unroll") for (int k = 0; k < 2; ++k) dst[m][k] = *(const LAS bf16x8*)(lds + G8_SA(b, h) + aoff + m * 2048 + k * 1024); } while (0)
#define G8_LDB(dst, b, h) do { _Pragma("unroll") for (int n = 0; n < 2; ++n) _Pragma("unroll") for (int k = 0; k < 2; ++k) dst[n][k] = *(const LAS bf16x8*)(lds + G8_SB(b, h) + boff + n * 2048 + k * 1024); } while (0)
#define G8_MMA(ai, bj, At, Bt) do { __builtin_amdgcn_s_setprio(1); _Pragma("unroll") for (int m = 0; m < 4; ++m) _Pragma("unroll") for (int n = 0; n < 2; ++n) _Pragma("unroll") for (int k = 0; k < 2; ++k) \
        acc[ai][bj][m][n] = __builtin_amdgcn_mfma_f32_16x16x32_bf16(Bt[n][k], At[m][k], acc[ai][bj][m][n], 0, 0, 0); __builtin_amdgcn_s_setprio(0); } while (0)
#define G8_WAIT_V(n) asm volatile("s_waitcnt vmcnt(" #n ")" ::: "memory")
#define G8_WAIT_L(n) asm volatile("s_waitcnt lgkmcnt(" #n ")" ::: "memory")
#define G8_BAR __builtin_amdgcn_s_barrier()
#define G8_SCHED __builtin_amdgcn_sched_barrier(0)
#define G8_GOFF(dst, u) do { if (GATHER) { int _tz = tid; asm volatile("" : "+v"(_tz)); _Pragma("unroll") for (int _i = 0; _i < 2; ++_i) { int _R, _C; stage_rc(_tz * 16 + _i * 8192, _R, _C); \
        _Pragma("unroll") for (int _h = 0; _h < 2; ++_h) dst[_h][_i] = S.arow(u, _h * HALF + _R) * (unsigned)(K * 2) + (unsigned)(_C * 2); } } } while (0)
    GU cur, nxt; int ui = 0;
    __syncthreads();
    if (!S.next(0, cur)) return;
    f32x4 acc[2][2][4][2];
    { const f32x4 z4 = zero4();
#pragma unroll
    for (int a = 0; a < 2; ++a)
#pragma unroll
        for (int b = 0; b < 2; ++b)
#pragma unroll
            for (int m = 0; m < 4; ++m)
#pragma unroll
                for (int n = 0; n < 2; ++n) acc[a][b][m][n] = z4; }
    bf16x8 At[4][2], B0[2][2], B1[2][2];
    const char* cA = cur.a; const char* cB = cur.b; const char* nA = cA; const char* nB = cB;
    G8_GOFF(cg, cur);
#pragma unroll
    for (int _h = 0; _h < 2; ++_h)
#pragma unroll
        for (int _i = 0; _i < 2; ++_i) ng[_h][_i] = cg[_h][_i];
    G8_STAGE_B(G8_SB(0, 0), cB); G8_STAGE_B(G8_SB(0, 1), cB + hstep); G8_STAGE_A(G8_SA(0, 0), 0, false, (size_t)0); G8_STAGE_A(G8_SA(0, 1), 1, false, (size_t)0);
    if (wr == 1) G8_BAR;
    G8_WAIT_V(2); G8_BAR;
    G8_STAGE_B(G8_SB(1, 0), cB + kstep); G8_STAGE_A(G8_SA(1, 0), 0, false, kstep); G8_STAGE_B(G8_SB(1, 1), cB + hstep + kstep);
    G8_WAIT_V(6); G8_BAR;
    for (;;) {
        const bool has_next = S.next(ui + 1, nxt);
        nA = has_next ? nxt.a : cA; nB = has_next ? nxt.b : cB;
        if (has_next) { G8_GOFF(ng, nxt); } else {
#pragma unroll
            for (int _h = 0; _h < 2; ++_h)
#pragma unroll
                for (int _i = 0; _i < 2; ++_i) ng[_h][_i] = cg[_h][_i]; }
        for (int t = 0; t < nt; t += 2) {
            const bool last = (t == nt - 2);
            const size_t k1 = (size_t)(t + 1) * kstep, k2 = last ? (size_t)0 : (size_t)(t + 2) * kstep, k3 = k2 + kstep;
            const char* b2 = last ? nB : cB + (size_t)(t + 2) * kstep; const char* b3 = b2 + kstep;
            G8_LDB(B0, 0, 0); G8_LDB(B1, 0, 1); G8_SCHED; G8_LDA(At, 0, 0); G8_STAGE_A(G8_SA(1, 1), 1, false, k1);
            G8_WAIT_V(8); G8_WAIT_L(0); G8_BAR; G8_MMA(0, 0, At, B0); G8_MMA(0, 1, At, B1); G8_BAR; G8_SCHED;
            G8_LDA(At, 0, 1); G8_STAGE_B(G8_SB(0, 0), b2); G8_STAGE_B(G8_SB(0, 1), b2 + hstep); G8_STAGE_A(G8_SA(0, 0), 0, last, k2);
            G8_WAIT_V(8); G8_WAIT_L(0); G8_BAR; G8_MMA(1, 0, At, B0); G8_MMA(1, 1, At, B1); G8_BAR; G8_SCHED;
            G8_LDB(B0, 1, 0); G8_LDB(B1, 1, 1); G8_SCHED; G8_LDA(At, 1, 0); G8_STAGE_A(G8_SA(0, 1), 1, last, k2);
            G8_WAIT_V(8); G8_WAIT_L(0); G8_BAR; G8_MMA(0, 0, At, B0); G8_MMA(0, 1, At, B1); G8_BAR; G8_SCHED;
            G8_LDA(At, 1, 1); G8_STAGE_B(G8_SB(1, 0), b3); G8_STAGE_B(G8_SB(1, 1), b3 + hstep); G8_STAGE_A(G8_SA(1, 0), 0, last, k3);
            G8_WAIT_V(8); G8_WAIT_L(0); G8_BAR; G8_MMA(1, 0, At, B0); G8_MMA(1, 1, At, B1); G8_BAR; G8_SCHED;
        }
        if (wr == 0) G8_BAR;
        E(acc, cur, wr, wc, fr, fq);
        if (!has_next) break;
        const f32x4 z4 = zero4();
#pragma unroll
        for (int a = 0; a < 2; ++a)
#pragma unroll
            for (int b = 0; b < 2; ++b)
#pragma unroll
                for (int m = 0; m < 4; ++m)
#pragma unroll
                    for (int n = 0; n < 2; ++n) acc[a][b][m][n] = z4;
        cur = nxt; cA = nA; cB = nB; ++ui;
#pragma unroll
        for (int _h = 0; _h < 2; ++_h)
#pragma unroll
            for (int _i = 0; _i < 2; ++_i) cg[_h][_i] = ng[_h][_i];
        if (wr == 1) G8_BAR;
    }
    G8_WAIT_V(0);
    G8_BAR;
#undef G8_SA
#undef G8_SB
#undef G8_LDS
#undef G8_STAGE_A
#undef G8_STAGE_B
#undef G8_LDA
#undef G8_LDB
#undef G8_MMA
#undef G8_WAIT_V
#undef G8_WAIT_L
#undef G8_BAR
#undef G8_SCHED
#undef G8_GOFF
}
}

#define INPROJ_LOOP(BODY) _Pragma("unroll") for (int ai = 0; ai < 2; ++ai) _Pragma("unroll") for (int m = 0; m < 4; ++m) _Pragma("unroll") for (int n = 0; n < 2; ++n) { \
        const int row = row0 + 128 * ai + 16 * m, col = col0 + 16 * n; f32x4 v = acc[ai][bj][m][n]; BODY }
template <int bj>
DI void inproj_half(CParams& p, int l, int nt, const f32x4 (&acc)[2][2][4][2], int row0  , int col0  , int fq) {
    if (nt < 4) {
        INPROJ_LOOP({
            _Pragma("unroll") for (int r = 0; r < 4; ++r) v[r] = 0.5f * v[r] * (1.0f + erff(v[r] * 0.70710678118654752f));
            store4_bf16(p.Puv + (size_t)row * 512 + col, v); })
    } else if (nt < 6) {
        INPROJ_LOOP({ v = rope_tile(p, v, row, n, fq) * (0.17677669529663687f * LOG2E); store4_bf16(p.Qd + (size_t)row * 256 + (col - 512), v); })
    } else if (nt < 8) {
        INPROJ_LOOP({ v = rope_tile(p, v, row, n, fq); store4_bf16(p.Kd + (size_t)row * 256 + (col - 768), v); })
    } else if (nt < 12) {
        INPROJ_LOOP({
            _Pragma("unroll") for (int r = 0; r < 4; ++r) v[r] = siluf_(v[r]);
            store4_bf16(p.Hq + (size_t)row * 256 + (col - 1280), v); })
    } else if (nt < 18) {
        const int dir = nt >= 16, cb = dir ? 2048 : 1792;
        INPROJ_LOOP({
            const int cc = col - cb;
            const f32x4 lb = *(const f32x4*)(p.lball + (l * 2 + dir) * 256 + cc);
            _Pragma("unroll") for (int r = 0; r < 4; ++r) v[r] = __logf(lb[r] + (1.0f - lb[r]) * sigmoidf_(v[r]));
            store4_bf16(p.Lf + ((size_t)dir * MR + row) * 256 + cc, v); })
    } else if (nt < 20) {
        INPROJ_LOOP({
            _Pragma("unroll") for (int r = 0; r < 4; ++r) v[r] = siluf_(v[r]);
            store4_bf16(p.Hg + (size_t)row * 256 + (col - 2304), v); })
    } else if (nt < 22) {
        INPROJ_LOOP({ store4_bf16(p.Cq + (size_t)row * 256 + (col - 2560), v); })
    } else if (nt == 22) {
        INPROJ_LOOP({ store4_bf16(p.Ckv + (size_t)row * 128 + (col - 2816), v); })
    } else {
        INPROJ_LOOP({ v = rope_tile(p, v, row, n, fq); if (col < 2976) store4_bf16(p.Kr + (size_t)row * 32 + (col - 2944), v); })
    }
}
struct SchedIn {
    const char* H; const char* W;
    DI bool next(int i, g8::GU& u) const {
        int pm, pn; if (!g8::order_next(i, MR / 256, 12, pm, pn)) return false;
        const bool sw = (pn == 4 || pn == 6);
        u.pm = pm; u.pn = pn; u.e = sw ? 1 : 0; u.j0 = 0;
        const char* ht = H + (size_t)pm * 256 * 2048; const char* wt = W + (size_t)pn * 256 * 2048;
        u.a = sw ? wt : ht; u.b = sw ? ht : wt; return true;
    }
    DI unsigned arow(const g8::GU&, int) const { return 0u; }
};
struct EpiIn {
    CParams* pp; int l;
    DI void operator()(const f32x4 (&acc)[2][2][4][2], const g8::GU& u, int wr, int wc, int fr, int fq) const {
        CParams& p = *pp;
        if (u.e) {
            bf16_t* dst = (u.pn == 4) ? p.Vdt : p.Vht;
            const int m0 = u.pm * 256, b = m0 / TP, t0 = m0 - b * TP;
#pragma unroll
            for (int ai = 0; ai < 2; ++ai)
#pragma unroll
                for (int bj = 0; bj < 2; ++bj)
#pragma unroll
                    for (int m = 0; m < 4; ++m)
#pragma unroll
                        for (int n = 0; n < 2; ++n) {
                            const int f = 128 * ai + 64 * wr + 16 * m + fr, t = t0 + 128 * bj + 32 * wc + 16 * n + 4 * fq;
                            store4_bf16(dst + ((size_t)(b * 256 + f)) * TP + t, acc[ai][bj][m][n]);
                        }
        } else {
            inproj_half<0>(p, l, 2 * u.pn, acc, u.pm * 256 + 64 * wr + fr, u.pn * 256 + 32 * wc + 4 * fq, fq);
            inproj_half<1>(p, l, 2 * u.pn + 1, acc, u.pm * 256 + 64 * wr + fr, u.pn * 256 + 128 + 32 * wc + 4 * fq, fq);
        }
    }
};
DI void phase_inproj(CParams& p, int l, char* lds) {
    SchedIn S; S.H = (const char*)p.H; S.W = (const char*)(p.WinT + (size_t)l * NINP * DM);
    EpiIn E; E.pp = &p; E.l = l;
    g8::gemm8<EpiIn, SchedIn, false>(lds, DM, nullptr, S, E);
}

DI void phase_sgu_prep(CParams& p, int l, char* lds) {
    const int tid = otid(), wid = tid >> 6, lane = tid & 63, fr = lane & 15, fq = lane >> 4;
    constexpr int U_SGU = (MR / 128) * 4, U_PREP = MR / 64;
    float* stats = (float*)(lds + 16384);
    for (int u = blockIdx.x; u < U_SGU + U_PREP; u += gridDim.x) {
        if (u < U_SGU) {
            const int ch = u >> 2, g = u & 3, row0 = ch * 128;
            __syncthreads();
#pragma unroll 1
            for (int i = 0; i < 16; ++i) {
                const int r = wid * 16 + i;
                const u32x2 w = *(const u32x2*)(p.Puv + (size_t)(row0 + r) * 512 + 256 + lane * 4);
                const float a0 = lo2f(w.x), a1 = hi2f(w.x), a2 = lo2f(w.y), a3 = hi2f(w.y);
                const float mean = wave_sum((a0 + a1) + (a2 + a3)) * (1.f / 256.f);
                const float d0 = a0 - mean, d1 = a1 - mean, d2 = a2 - mean, d3 = a3 - mean;
                const float var = wave_sum((d0 * d0 + d1 * d1) + (d2 * d2 + d3 * d3)) * (1.f / 256.f);
                if (lane == 0) { stats[r * 2] = mean; stats[r * 2 + 1] = rsqrtf(var + LN_EPS); }
            }
            __syncthreads();
            {
                const int s = tid >> 2, c0 = (tid & 3) * 16;
                const float mean = stats[s * 2], rstd = stats[s * 2 + 1];
                const bf16_t* src = p.Puv + (size_t)(row0 + s) * 512 + 256 + g * 64 + c0;
                const u32x4 w0 = *(const u32x4*)src, w1 = *(const u32x4*)(src + 8);
                const unsigned ww[8] = {w0.x, w0.y, w0.z, w0.w, w1.x, w1.y, w1.z, w1.w};
                const float* lw = p.sgu_ln_w + l * 256 + g * 64 + c0; const float* lb = p.sgu_ln_b + l * 256 + g * 64 + c0;
#pragma unroll
                for (int j = 0; j < 16; ++j) {
                    const float xv = (j & 1) ? hi2f(ww[j >> 1]) : lo2f(ww[j >> 1]);
                    const float y = (xv - mean) * rstd * lw[j] + lb[j];
                    const int c = c0 + j;
                    const unsigned pk = pk2(y, 0.f);
                    *(bf16_t*)(lds + c * 256 + ((((s >> 3) ^ (c & 15)) << 4) | ((s & 7) * 2))) = (bf16_t)(pk & 0xffffu);
                }
            }
            __syncthreads();
            f32x4 acc[4];
#pragma unroll
            for (int ni = 0; ni < 4; ++ni) acc[ni] = zero4();
            const float* Wg = p.sgu_w + ((size_t)(l * 4 + g) * 128 + wid * 16 + fr) * 128;
#pragma unroll
            for (int ks = 0; ks < 4; ++ks) {
                const f32x4 a0 = *(const f32x4*)(Wg + ks * 32 + fq * 8), a1 = *(const f32x4*)(Wg + ks * 32 + fq * 8 + 4);
                const float av[8] = {a0[0], a0[1], a0[2], a0[3], a1[0], a1[1], a1[2], a1[3]};
                const bf16x8 af = pack8(av);
#pragma unroll
                for (int ni = 0; ni < 4; ++ni) {
                    const int c = ni * 16 + fr;
                    const bf16x8 bfr = *(const bf16x8*)(lds + c * 256 + (((ks * 4 + fq) ^ (c & 15)) << 4));
                    acc[ni] = MFMA16(bfr, af, acc[ni]);
                }
            }
            const int t = wid * 16 + fr, row = row0 + t;
            const float bs = p.sgu_b[(l * 4 + g) * 128 + t];
#pragma unroll
            for (int ni = 0; ni < 4; ++ni) {
                const int c = g * 64 + ni * 16 + fq * 4;
                const u32x2 w = *(const u32x2*)(p.Puv + (size_t)row * 512 + c);
                f32x4 o;
                o[0] = (acc[ni][0] + bs) * lo2f(w.x); o[1] = (acc[ni][1] + bs) * hi2f(w.x);
                o[2] = (acc[ni][2] + bs) * lo2f(w.y); o[3] = (acc[ni][3] + bs) * hi2f(w.y);
                store4_bf16(p.O + (size_t)row * DM + c, o);
            }
        } else {
            const int rbase = (u - U_SGU) * 64 + wid * 8;
#pragma unroll 1
            for (int i = 0; i < 8; ++i) {
                const int row = rbase + i;
                const u32x2 wq = *(const u32x2*)(p.Cq + (size_t)row * 256 + lane * 4);
                const unsigned wk = *(const unsigned*)(p.Ckv + (size_t)row * 128 + lane * 2);
                const float q0 = lo2f(wq.x), q1 = hi2f(wq.x), q2 = lo2f(wq.y), q3 = hi2f(wq.y), k0 = lo2f(wk), k1 = hi2f(wk);
                const float sq = wave_sum((q0 * q0 + q1 * q1) + (q2 * q2 + q3 * q3));
                const float sk = wave_sum(k0 * k0 + k1 * k1);
                if (lane == 0) { p.RS[row * 2] = rsqrtf(sq * (1.f / 256.f) + LN_EPS); p.RS[row * 2 + 1] = rsqrtf(sk * (1.f / 128.f) + LN_EPS); }
            }
        }
    }
}

DI void hgrn_h1_unit(CParams& p, int wu, int lane) {
    const int c = wu % NCH; int t = wu / NCH; const int dir = t & 1, h = (t >> 1) & 3, b = t >> 3;
    const int row0 = b * TP + c * 32, hh = lane >> 5, l31 = lane & 31;
    const bf16_t* Lf = p.Lf + ((size_t)dir * MR + row0) * 256 + h * 64;
    bf16x8 Bf[2][2];
    float* decp = p.DEC + (size_t)wu * 64;
#pragma unroll
    for (int kt = 0; kt < 2; ++kt) {
        const int k = kt * 32 + l31;
        float lf[32], kd[32];
#pragma unroll
        for (int j = 0; j < 32; ++j) lf[j] = bf2f(Lf[(size_t)j * 256 + k]);
        float tot = 0.f;
#pragma unroll
        for (int j = 0; j < 32; ++j) tot += lf[j];
        float run = 0.f;
        if (dir == 0) {
#pragma unroll
            for (int j = 0; j < 32; ++j) { run += lf[j]; kd[j] = (1.0f - __expf(lf[j])) * __expf(tot - run); }
        } else {
#pragma unroll
            for (int j = 31; j >= 0; --j) { run += lf[j]; kd[j] = (1.0f - __expf(lf[j])) * __expf(tot - run); }
        }
        if (hh == 0) decp[k] = __expf(tot);
#pragma unroll
        for (int s = 0; s < 2; ++s) {
            float v8[8];
#pragma unroll
            for (int jj = 0; jj < 8; ++jj) v8[jj] = hh ? kd[16 * s + 8 + jj] : kd[16 * s + jj];
            Bf[kt][s] = pack8(v8);
        }
    }
    const bf16_t* Vt = p.Vht + ((size_t)(b * 4 + h) * 64) * TP + c * 32;
    float* dst = p.DST + (size_t)wu * 4096;
#pragma unroll
    for (int vt = 0; vt < 2; ++vt) {
        bf16x8 Af[2];
#pragma unroll
        for (int s = 0; s < 2; ++s) Af[s] = *(const bf16x8*)(Vt + (size_t)(vt * 32 + l31) * TP + 16 * s + 8 * hh);
#pragma unroll
        for (int kt = 0; kt < 2; ++kt) {
            f32x16 d;
#pragma unroll
            for (int i = 0; i < 16; ++i) d[i] = zf();
            d = MFMA32(Af[0], Bf[kt][0], d);
            d = MFMA32(Af[1], Bf[kt][1], d);
#pragma unroll
            for (int r = 0; r < 16; ++r) dst[(vt * 32 + crow(r, hh)) * 64 + kt * 32 + l31] = d[r];
        }
    }
}

DI void phase_upproj_h1(CParams& p, int l, char* lds) {
    const int tid = otid(), wid = tid >> 6, lane = tid & 63, wr = wid >> 1, wc = wid & 1, fr = lane & 15, fq = lane >> 4;
    constexpr int U_Q = (MR / 256) * 3, U_KV = (MR / 256) * 4, U_H1 = NB * 4 * 2 * NCH / 8;
    for (int u = blockIdx.x; u < U_Q + U_KV + U_H1; u += gridDim.x) {
        if (u < U_Q) {
            const int mt = u / 3, nt = u % 3, m0 = mt * 256, n0 = nt * 128;
            const bf16_t* pa[4]; const bf16_t* pb[2];
            gemm_ptrs(p.Cq, 256, m0, p.WuqT + (size_t)l * 384 * 256, 256, n0, pa, pb);
            f32x4 acc[4][4];
            gemm_core<0>(pa, pb, 256, lds, acc);
#pragma unroll
            for (int mi = 0; mi < 4; ++mi)
#pragma unroll
                for (int ni = 0; ni < 4; ++ni) {
                    const int row = m0 + wr * 64 + mi * 16 + fr, col = n0 + wc * 64 + ni * 16 + fq * 4;
                    f32x4 v = acc[mi][ni] * (p.RS[row * 2] * (0.10206207261596577f * LOG2E));
                    const int cm = col % 96;
                    const f32x4 vr = rope_tile(p, v, row, (cm >> 4) & 1, fq);
                    if (cm >= 64) v = vr;
                    store4_bf16(p.Qm + (size_t)row * 384 + col, v);
                }
        } else if (u < U_Q + U_KV) {
            const int uu = u - U_Q, mt = uu >> 2, nt = uu & 3, m0 = mt * 256, n0 = nt * 128;
            const bf16_t* pa[4]; const bf16_t* pb[2];
            gemm_ptrs(p.Ckv, 128, m0, p.WukvT + (size_t)l * 512 * 128, 128, n0, pa, pb);
            f32x4 acc[4][4];
            if (nt < 2) {
                gemm_core<0>(pa, pb, 128, lds, acc);
#pragma unroll
                for (int mi = 0; mi < 4; ++mi)
#pragma unroll
                    for (int ni = 0; ni < 4; ++ni) {
                        const int row = m0 + wr * 64 + mi * 16 + fr, col = n0 + wc * 64 + ni * 16 + fq * 4;
                        store4_bf16(p.Kn + (size_t)row * 256 + col, acc[mi][ni] * p.RS[row * 2 + 1]);
                    }
            } else {
                gemm_core<1>(pa, pb, 128, lds, acc);
                const int b = m0 / TP, t0 = m0 - b * TP;
#pragma unroll
                for (int mi = 0; mi < 4; ++mi)
#pragma unroll
                    for (int ni = 0; ni < 4; ++ni) {
                        const int f = n0 - 256 + wc * 64 + ni * 16 + fr;
                        const int rl = wr * 64 + mi * 16 + fq * 4;
                        const f32x4 rs = {p.RS[(m0 + rl) * 2 + 1], p.RS[(m0 + rl + 1) * 2 + 1], p.RS[(m0 + rl + 2) * 2 + 1], p.RS[(m0 + rl + 3) * 2 + 1]};
                        store4_bf16(p.Vmt + ((size_t)(b * 256 + f)) * TP + t0 + rl, acc[mi][ni] * rs);
                    }
            }
        } else {
            hgrn_h1_unit(p, (u - U_Q - U_KV) * 8 + wid, lane);
        }
    }
}

DI void hgrn_h2_unit(CParams& p, int cu  ) {
    const int tid = otid();
    if (tid >= 256) return;
    const int gid = cu * 256 + tid;
    const int seq = gid >> 10, e4 = gid & 1023;
    const int dir = seq & 1, k4 = (e4 & 15) * 4;
    f32x4 st = zero4();
    for (int t0 = 0; t0 < NCH; t0 += 8) {
        f32x4 ds[8], dc[8]; float* ptr[8];
#pragma unroll
        for (int j = 0; j < 8; ++j) {
            const int t = t0 + j, pc = dir == 0 ? t : (t < 8 ? 7 - t : 143 - t);
            ptr[j] = p.DST + ((size_t)(seq * NCH + pc)) * 4096 + e4 * 4;
            ds[j] = *(const f32x4*)ptr[j];
            dc[j] = *(const f32x4*)(p.DEC + (size_t)(seq * NCH + pc) * 64 + k4);
        }
#pragma unroll
        for (int j = 0; j < 8; ++j) { *(f32x4*)ptr[j] = st; st = dc[j] * st + ds[j]; }
    }
}

DI void hgrn_h3_unit(CParams& p, int l, int wu, int lane, char* wl) {
    const int pc = wu % NCH; const int t_ = wu / NCH; const int h = t_ & 3, b = t_ >> 2;
    const int row0 = b * TP + pc * 32, hh = lane >> 5, i = lane & 31;
    float* Bl = (float*)wl;
    f32x16 Y[2];
    { const float z = zf();
#pragma unroll
    for (int r = 0; r < 16; ++r) { Y[0][r] = z; Y[1][r] = z; } }
#pragma unroll 1
    for (int dir = 0; dir < 2; ++dir) {
        const bf16_t* Lf = p.Lf + ((size_t)dir * MR + row0) * 256 + h * 64;
        {
            float lf[32];
#pragma unroll
            for (int j = 0; j < 32; ++j) lf[j] = bf2f(Lf[(size_t)j * 256 + lane]);
            float run = 0.f;
            if (dir == 0) {
#pragma unroll
                for (int j = 0; j < 32; ++j) { run += lf[j]; Bl[j * 68 + lane] = run; }
            } else {
#pragma unroll
                for (int j = 31; j >= 0; --j) { run += lf[j]; Bl[j * 68 + lane] = run; }
            }
        }
        __syncthreads();
        bf16x8 Qf[4], Kf[4];
#pragma unroll
        for (int s = 0; s < 4; ++s) {
            const int kb = 16 * s + 8 * hh;
            const u32x4 qw = *(const u32x4*)(p.Hq + (size_t)(row0 + i) * 256 + h * 64 + kb);
            const u32x4 fw = *(const u32x4*)(Lf + (size_t)i * 256 + kb);
            const f32x4 b0 = *(const f32x4*)(Bl + i * 68 + kb), b1 = *(const f32x4*)(Bl + i * 68 + kb + 4);
            const float bb[8] = {b0[0], b0[1], b0[2], b0[3], b1[0], b1[1], b1[2], b1[3]};
            const unsigned qq[4] = {qw.x, qw.y, qw.z, qw.w}, ff[4] = {fw.x, fw.y, fw.z, fw.w};
            float qd[8], kd[8];
#pragma unroll
            for (int j = 0; j < 8; ++j) {
                const float qv = (j & 1) ? hi2f(qq[j >> 1]) : lo2f(qq[j >> 1]);
                const float fv = (j & 1) ? hi2f(ff[j >> 1]) : lo2f(ff[j >> 1]);
                qd[j] = qv * __expf(bb[j]);
                kd[j] = (1.0f - __expf(fv)) * __expf(-bb[j]);
            }
            Qf[s] = pack8(qd); Kf[s] = pack8(kd);
        }
        f32x16 X;
#pragma unroll
        for (int r = 0; r < 16; ++r) X[r] = zf();
#pragma unroll
        for (int s = 0; s < 4; ++s) X = MFMA32(Kf[s], Qf[s], X);
#pragma unroll
        for (int r = 0; r < 16; ++r) { const int j = crow(r, hh); const bool keep = dir == 0 ? (j <= i) : (j >= i); X[r] = keep ? X[r] : 0.f; }
        bf16x8 Xs[2];
#pragma unroll
        for (int s = 0; s < 2; ++s) { const float v8[8] = {X[8 * s], X[8 * s + 1], X[8 * s + 2], X[8 * s + 3], X[8 * s + 4], X[8 * s + 5], X[8 * s + 6], X[8 * s + 7]}; Xs[s] = pack8(v8); }
        const bf16_t* Vt = p.Vht + ((size_t)(b * 4 + h) * 64) * TP + pc * 32;
        const float* ST = p.DST + ((size_t)(((b * 4 + h) * 2 + dir) * NCH + pc)) * 4096;
#pragma unroll
        for (int vt = 0; vt < 2; ++vt) {
            const bf16_t* vrow = Vt + (size_t)(vt * 32 + i) * TP;
#pragma unroll
            for (int s = 0; s < 2; ++s) {
                const u32x2 lo = *(const u32x2*)(vrow + 16 * s + 4 * hh), hi = *(const u32x2*)(vrow + 16 * s + 8 + 4 * hh);
                u32x4 w; w.x = lo.x; w.y = lo.y; w.z = hi.x; w.w = hi.y;
                Y[vt] = MFMA32(__builtin_bit_cast(bf16x8, w), Xs[s], Y[vt]);
            }
            const float* srow = ST + (vt * 32 + i) * 64;
#pragma unroll
            for (int s = 0; s < 4; ++s) {
                const f32x4 a0 = *(const f32x4*)(srow + 16 * s + 8 * hh), a1 = *(const f32x4*)(srow + 16 * s + 8 * hh + 4);
                const float v8[8] = {a0[0], a0[1], a0[2], a0[3], a1[0], a1[1], a1[2], a1[3]};
                Y[vt] = MFMA32(pack8(v8), Qf[s], Y[vt]);
            }
        }
        __syncthreads();
    }
    float ss = 0.f;
#pragma unroll
    for (int r = 0; r < 16; ++r) ss += Y[0][r] * Y[0][r] + Y[1][r] * Y[1][r];
    ss += shx<32>(ss);
    const float rs = rsqrtf(ss * (1.f / 64.f) + LN_EPS);
    const int row = row0 + i;
#pragma unroll
    for (int vt = 0; vt < 2; ++vt)
#pragma unroll
        for (int g4 = 0; g4 < 4; ++g4) {
            const int v0 = vt * 32 + 8 * g4 + 4 * hh;
            const f32x4 nw = *(const f32x4*)(p.hgrn_norm_w + l * 64 + v0);
            const u32x2 gw = *(const u32x2*)(p.Hg + (size_t)row * 256 + h * 64 + v0);
            f32x4 o;
            o[0] = Y[vt][g4 * 4 + 0] * rs * nw[0] * lo2f(gw.x); o[1] = Y[vt][g4 * 4 + 1] * rs * nw[1] * hi2f(gw.x);
            o[2] = Y[vt][g4 * 4 + 2] * rs * nw[2] * lo2f(gw.y); o[3] = Y[vt][g4 * 4 + 3] * rs * nw[3] * hi2f(gw.y);
            store4_bf16(p.O + (size_t)row * DM + 512 + h * 64 + v0, o);
        }
}

template <bool DIFF>
DI void attn_unit(CParams& p, int l, int b, int h, int qrow0  , int nkt  , char* lds) {
    const int tid = otid(), wid = tid >> 6, lane = tid & 63, hh = lane >> 5, q31 = lane & 31;
    constexpr int NS = DIFF ? 2 : 1;
    constexpr int NQF = DIFF ? 4 : 6;
    constexpr int BUF = 8192 + 8192 + (DIFF ? 0 : 4096);
    const int qrow = qrow0 + wid * 32 + q31;
    bf16x8 Qf[NQF];
    {
        const bf16_t* qp = DIFF ? p.Qd + (size_t)qrow * 256 + h * 64 : p.Qm + (size_t)qrow * 384 + h * 96;
#pragma unroll
        for (int s = 0; s < NQF; ++s) Qf[s] = *(const bf16x8*)(qp + 16 * s + 8 * hh);
    }
    const size_t krow0 = (size_t)b * TP;
    const bf16_t* kptr = (DIFF ? p.Kd : p.Kn) + (krow0 + (tid >> 3)) * 256 + h * 64 + (tid & 7) * 8;
    const bf16_t* vptr = (DIFF ? p.Vdt : p.Vmt) + ((size_t)(b * 4 + h) * 64 + (tid >> 3)) * TP + (tid & 7) * 8;
    const bf16_t* rptr = p.Kr + (krow0 + ((tid & 255) >> 2)) * 32 + (tid & 3) * 8;
    const int key_w = tid >> 3, c_w = tid & 7;
    const int kwoff = key_w * 128 + ((c_w ^ ((key_w >> 1) & 7)) << 4);
    const int d_w = tid >> 3;
    const int vwoff0 = 8192 + d_w * 128 + (((2 * c_w) ^ ((d_w >> 1) & 15)) << 3), vwoff1 = 8192 + d_w * 128 + (((2 * c_w + 1) ^ ((d_w >> 1) & 15)) << 3);
    const int rkey = (tid & 255) >> 2, rc = tid & 3;
    const int rwoff = 16384 + rkey * 64 + ((rc ^ ((rkey >> 2) & 3)) << 4);
    const int krd = q31 * 128, ksw = (q31 >> 1) & 7;
    const int rrd = 16384 + q31 * 64, rsw = (q31 >> 2) & 3;
    const int vrd = 8192 + q31 * 128, vsw = (q31 >> 1) & 15;
    f32x16 ot[NS][2];
    float m[NS], lsum[NS];
#pragma unroll
    for (int a = 0; a < NS; ++a) { m[a] = -1e30f; lsum[a] = 0.f;
#pragma unroll
        for (int r = 0; r < 16; ++r) { ot[a][0][r] = zf(); ot[a][1][r] = zf(); } }
    u32x4 rk, rv, rr;
    rk = *(const u32x4*)kptr; rv = *(const u32x4*)vptr;
    if (!DIFF) { if (tid < 256) rr = *(const u32x4*)rptr; }
    __syncthreads();
    *(u32x4*)(lds + kwoff) = rk;
    *(u32x2*)(lds + vwoff0) = (u32x2){rv.x, rv.y}; *(u32x2*)(lds + vwoff1) = (u32x2){rv.z, rv.w};
    if (!DIFF) { if (tid < 256) *(u32x4*)(lds + rwoff) = rr; }
    __syncthreads();
    for (int kt = 0; kt < nkt; ++kt) {
        const char* cur = lds + (kt & 1) * BUF;
        const bool more = kt + 1 < nkt;
        if (more) {
            rk = *(const u32x4*)(kptr + (size_t)(kt + 1) * 64 * 256);
            rv = *(const u32x4*)(vptr + (kt + 1) * 64);
            if (!DIFF) { if (tid < 256) rr = *(const u32x4*)(rptr + (size_t)(kt + 1) * 64 * 32); }
        }
        bf16x8 Pf[NS][2][2];
#pragma unroll
        for (int a = 0; a < NS; ++a) {
            f32x16 st[2];
#pragma unroll
            for (int t = 0; t < 2; ++t) {
                f32x16 acc;
                { const float z = zf();
#pragma unroll
                for (int r = 0; r < 16; ++r) acc[r] = z; }
                if (DIFF) {
#pragma unroll
                    for (int s = 0; s < 2; ++s) {
                        const int c = 4 * a + 2 * s + hh;
                        const bf16x8 kf = *(const bf16x8*)(cur + t * 4096 + krd + ((c ^ ksw) << 4));
                        acc = MFMA32(kf, Qf[2 * a + s], acc);
                    }
                } else {
#pragma unroll
                    for (int s = 0; s < 4; ++s) {
                        const int c = 2 * s + hh;
                        const bf16x8 kf = *(const bf16x8*)(cur + t * 4096 + krd + ((c ^ ksw) << 4));
                        acc = MFMA32(kf, Qf[s], acc);
                    }
#pragma unroll
                    for (int s = 0; s < 2; ++s) {
                        const int c = 2 * s + hh;
                        const bf16x8 kf = *(const bf16x8*)(cur + t * 2048 + rrd + ((c ^ rsw) << 4));
                        acc = MFMA32(kf, Qf[4 + s], acc);
                    }
                }
                st[t] = acc;
            }
            float tm = st[0][0];
#pragma unroll
            for (int r = 1; r < 16; ++r) tm = fmaxf(tm, st[0][r]);
#pragma unroll
            for (int r = 0; r < 16; ++r) tm = fmaxf(tm, st[1][r]);
            tm = fmaxf(tm, shx<32>(tm));
            const float mn = fmaxf(m[a], tm);
            const float alpha = __builtin_amdgcn_exp2f(m[a] - mn);
            m[a] = mn;
            float ps = 0.f;
#pragma unroll
            for (int t = 0; t < 2; ++t) {
#pragma unroll
                for (int r = 0; r < 16; ++r) { const float e = __builtin_amdgcn_exp2f(st[t][r] - mn); st[t][r] = e; ps += e; }
#pragma unroll
                for (int s = 0; s < 2; ++s) {
                    const float v8[8] = {st[t][8 * s], st[t][8 * s + 1], st[t][8 * s + 2], st[t][8 * s + 3], st[t][8 * s + 4], st[t][8 * s + 5], st[t][8 * s + 6], st[t][8 * s + 7]};
                    Pf[a][t][s] = pack8(v8);
                }
            }
            lsum[a] = lsum[a] * alpha + ps;
#pragma unroll
            for (int r = 0; r < 16; ++r) { ot[a][0][r] *= alpha; ot[a][1][r] *= alpha; }
            if (DIFF) __builtin_amdgcn_sched_barrier(0);
        }
#pragma unroll
        for (int dt = 0; dt < 2; ++dt)
#pragma unroll
            for (int t = 0; t < 2; ++t)
#pragma unroll
                for (int s = 0; s < 2; ++s) {
                    const int c8 = 8 * t + 4 * s + hh;
                    const u32x2 lo = *(const u32x2*)(cur + dt * 4096 + vrd + ((c8 ^ vsw) << 3));
                    const u32x2 hi = *(const u32x2*)(cur + dt * 4096 + vrd + (((c8 + 2) ^ vsw) << 3));
                    u32x4 w; w.x = lo.x; w.y = lo.y; w.z = hi.x; w.w = hi.y;
                    const bf16x8 vf = __builtin_bit_cast(bf16x8, w);
#pragma unroll
                    for (int a = 0; a < NS; ++a) ot[a][dt] = MFMA32(vf, Pf[a][t][s], ot[a][dt]);
                }
        if (more) {
            char* nxt = lds + ((kt + 1) & 1) * BUF;
            *(u32x4*)(nxt + kwoff) = rk;
            *(u32x2*)(nxt + vwoff0) = (u32x2){rv.x, rv.y}; *(u32x2*)(nxt + vwoff1) = (u32x2){rv.z, rv.w};
            if (!DIFF) { if (tid < 256) *(u32x4*)(nxt + rwoff) = rr; }
        }
        __syncthreads();
    }
    float linv[NS];
#pragma unroll
    for (int a = 0; a < NS; ++a) { const float lt = lsum[a] + shx<32>(lsum[a]); linv[a] = 1.0f / lt; }
    f32x16 o[2];
    if (DIFF) {
        const float lam = p.lam[l];
#pragma unroll
        for (int dt = 0; dt < 2; ++dt)
#pragma unroll
            for (int r = 0; r < 16; ++r) o[dt][r] = ot[0][dt][r] * linv[0] - lam * (ot[NS - 1][dt][r] * linv[NS - 1]);
        float ss = 0.f;
#pragma unroll
        for (int r = 0; r < 16; ++r) ss += o[0][r] * o[0][r] + o[1][r] * o[1][r];
        ss += shx<32>(ss);
        const float lam_init = 0.8f - 0.6f * __expf(-0.3f * (float)l);
        const float rs = rsqrtf(ss * (1.f / 64.f) + LN_EPS) * (1.0f - lam_init);
#pragma unroll
        for (int dt = 0; dt < 2; ++dt)
#pragma unroll
            for (int r = 0; r < 16; ++r) o[dt][r] *= rs;
    } else {
#pragma unroll
        for (int dt = 0; dt < 2; ++dt)
#pragma unroll
            for (int r = 0; r < 16; ++r) o[dt][r] = ot[0][dt][r] * linv[0];
    }
    bf16_t* orow = p.O + (size_t)qrow * DM + (DIFF ? 256 : 768) + h * 64;
#pragma unroll
    for (int dt = 0; dt < 2; ++dt)
#pragma unroll
        for (int g4 = 0; g4 < 4; ++g4) {
            const int d0 = dt * 32 + 8 * g4 + 4 * hh;
            f32x4 v = {o[dt][g4 * 4], o[dt][g4 * 4 + 1], o[dt][g4 * 4 + 2], o[dt][g4 * 4 + 3]};
            if (DIFF) { const f32x4 sw = *(const f32x4*)(p.diff_subln_w + l * 64 + d0); v = v * sw; }
            store4_bf16(orow + d0, v);
        }
}

DI void phase_attn_diff_h2(CParams& p, int l, char* lds, bool h2skip) {
    const int U_H2 = 256, U_LAT = NB * 4 * 16, U_CTX = (l == 0) ? NB * 4 : 0;
    for (int u = blockIdx.x; u < U_H2 + U_LAT + U_CTX; u += gridDim.x) {
        if (u < U_H2) { if (!h2skip) hgrn_h2_unit(p, u); }
        else {
            int b, h, q0, nkt; const int v = u - U_H2;
            if (v < U_LAT) { b = v >> 6; h = (v >> 4) & 3; q0 = b * TP + CTX + (v & 15) * 256; nkt = TP / 64; }
            else { const int w = v - U_LAT; b = w >> 2; h = w & 3; q0 = b * TP; nkt = CTX / 64; }
            attn_unit<true>(p, l, b, h, q0, nkt, lds);
        }
    }
}
DI void phase_attn_mla_h3(CParams& p, int l, char* lds) {
    const int tid_ = otid(); const int wid = tid_ >> 6, lane = tid_ & 63;
    const int U_LAT = NB * 4 * 16, U_CTX = (l == 0) ? NB * 4 : 0, U_H3 = NB * 4 * NCH / 8;
    for (int u = blockIdx.x; u < U_LAT + U_CTX + U_H3; u += gridDim.x) {
        if (u < U_LAT + U_CTX) {
            int b, h, q0, nkt;
            if (u < U_LAT) { b = u >> 6; h = (u >> 4) & 3; q0 = b * TP + CTX + (u & 15) * 256; nkt = TP / 64; }
            else { const int w = u - U_LAT; b = w >> 2; h = w & 3; q0 = b * TP; nkt = CTX / 64; }
            attn_unit<false>(p, l, b, h, q0, nkt, lds);
        } else { __syncthreads(); hgrn_h3_unit(p, l, (u - U_LAT - U_CTX) * 8 + wid, lane, lds + 65536 + wid * 8704); }
    }
}

struct SchedOut {
    const char* O; const char* W; int l;
    DI bool next(int i, g8::GU& u) const {
        int pm, pn;
        if (l == 0) { if (!g8::order_next(i, MR / 256, 4, pm, pn)) return false; }
        else { if (!g8::order_next(i, NB * 16, 4, pm, pn)) return false; pm = (pm >> 4) * 17 + 1 + (pm & 15); }
        u.pm = pm; u.pn = pn; u.e = 0; u.j0 = 0; u.a = O + (size_t)pm * 256 * 2048; u.b = W + (size_t)pn * 256 * 2048; return true;
    }
    DI unsigned arow(const g8::GU&, int) const { return 0u; }
};
struct EpiOut {
    float* Y;
    DI void operator()(const f32x4 (&acc)[2][2][4][2], const g8::GU& u, int wr, int wc, int fr, int fq) const {
#pragma unroll
        for (int ai = 0; ai < 2; ++ai)
#pragma unroll
            for (int bj = 0; bj < 2; ++bj)
#pragma unroll
                for (int m = 0; m < 4; ++m)
#pragma unroll
                    for (int n = 0; n < 2; ++n) {
                        const int row = u.pm * 256 + 128 * ai + 64 * wr + 16 * m + fr, col = u.pn * 256 + 128 * bj + 32 * wc + 16 * n + 4 * fq;
                        *(f32x4*)(Y + (size_t)row * DM + col) = acc[ai][bj][m][n];
                    }
    }
};
DI void phase_outproj(CParams& p, int l, char* lds) {
    SchedOut S; S.O = (const char*)p.O; S.W = (const char*)(p.WoutT + (size_t)l * DM * DM); S.l = l;
    EpiOut E; E.Y = p.Y;
    g8::gemm8<EpiOut, SchedOut, false>(lds, DM, nullptr, S, E);
}

DI void phase_postmix(CParams& p, int l, char* lds) {
    const int tid = otid(), wid = tid >> 6, lane = tid & 63;
    float* WrT = (float*)lds;
    int* lcnt = (int*)(lds + 131072);
    int* lbase = lcnt + 32;
    unsigned* ent = (unsigned*)(lds + 131072 + 256);
    const int G = gridDim.x, nrb = (MR + G - 1) / G;
    const float* rw = p.router_w + (size_t)l * DM * NE;
    __syncthreads();
    for (int i = tid; i < DM * NE / 4; i += NTHREADS) {
        const f32x4 v = *(const f32x4*)(rw + i * 4);
        const int d = i >> 3, e0 = (i & 7) * 4;
#pragma unroll
        for (int j = 0; j < 4; ++j) WrT[(e0 + j) * DM + d] = v[j];
    }
    if (tid < 32) lcnt[tid] = 0;
    __syncthreads();
    const int rbeg = blockIdx.x * nrb;
    const float* lw = p.ln_mix_w + l * DM; const float* lb = p.ln_mix_b + l * DM;
    for (int i = wid; i < nrb; i += 8) {
        const int row = rbeg + i;
        if (row >= MR) break;
        const int t = row % TP;
        const bool skip = (l == 1 && t < CTX);
        if (skip) { if (lane < 4) ent[(i * 4 + lane) * 2] = 0xffffffffu; continue; }
        const float* xr = l == 0 ? in_row(p, row) : p.X + (size_t)row * DM;
        const float* yr = p.Y + (size_t)row * DM;
        const float* g1 = mod_vec(p, l, row, 2); const float* sh2 = mod_vec(p, l, row, 3); const float* sc2 = mod_vec(p, l, row, 4);
        float v[16]; float s = 0.f;
#pragma unroll
        for (int j = 0; j < 16; ++j) { const int c = lane + 64 * j; v[j] = DN_ALPHA * xr[c] + g1[c] * yr[c]; s += v[j]; }
        float mean = wave_sum(s) * (1.f / DM); float q = 0.f;
#pragma unroll
        for (int j = 0; j < 16; ++j) { v[j] -= mean; q += v[j] * v[j]; }
        float rstd = rsqrtf(wave_sum(q) * (1.f / DM) + LN_EPS);
        s = 0.f;
#pragma unroll
        for (int j = 0; j < 16; ++j) { const int c = lane + 64 * j; v[j] = v[j] * rstd * lw[c] + lb[c]; p.X[(size_t)row * DM + c] = v[j]; s += v[j]; }
        mean = wave_sum(s) * (1.f / DM); q = 0.f;
#pragma unroll
        for (int j = 0; j < 16; ++j) { v[j] -= mean; q += v[j] * v[j]; }
        rstd = rsqrtf(wave_sum(q) * (1.f / DM) + LN_EPS);
#pragma unroll
        for (int j = 0; j < 16; ++j) { const int c = lane + 64 * j; v[j] = v[j] * rstd * (1.0f + sc2[c]) + sh2[c]; }
#pragma unroll
        for (int j = 0; j < 16; ++j) { const int c = lane + 64 * j; const unsigned w = pk2(v[j], 0.f); p.H[(size_t)row * DM + c] = (bf16_t)(w & 0xffffu); }
        float lh[2];
#pragma unroll
        for (int half = 0; half < 2; ++half) {
            float pl[16];
#pragma unroll
            for (int e = 0; e < 16; ++e) { float a = 0.f;
#pragma unroll
                for (int j = 0; j < 16; ++j) a += v[j] * WrT[(half * 16 + e) * DM + lane + 64 * j];
                pl[e] = a; if ((e & 3) == 3) __builtin_amdgcn_sched_barrier(0); }
#pragma unroll
            for (int e = 0; e < 16; ++e) { pl[e] += shx<32>(pl[e]); pl[e] += shx<16>(pl[e]); }
            float r8[8];
#pragma unroll
            for (int e = 0; e < 8; ++e) { const bool up = (lane & 8) != 0; const float keep = up ? pl[e + 8] : pl[e]; const float send = up ? pl[e] : pl[e + 8]; r8[e] = keep + shx<8>(send); }
            float r4[4];
#pragma unroll
            for (int e = 0; e < 4; ++e) { const bool up = (lane & 4) != 0; const float keep = up ? r8[e + 4] : r8[e]; const float send = up ? r8[e] : r8[e + 4]; r4[e] = keep + shx<4>(send); }
            float r2[2];
#pragma unroll
            for (int e = 0; e < 2; ++e) { const bool up = (lane & 2) != 0; const float keep = up ? r4[e + 2] : r4[e]; const float send = up ? r4[e] : r4[e + 2]; r2[e] = keep + shx<2>(send); }
            { const bool up = (lane & 1) != 0; const float keep = up ? r2[1] : r2[0]; const float send = up ? r2[0] : r2[1]; lh[half] = keep + shx<1>(send); }
            __builtin_amdgcn_sched_barrier(0);
        }
        float logit = (lane & 16) ? lh[1] : lh[0];
        const int e_me = lane & 31;
        logit += p.router_b[l * NE + e_me];
        logit = (logit == logit) ? fminf(fmaxf(logit, -1e30f), 1e30f) : -1e30f;
        int rank = 0;
#pragma unroll
        for (int e = 0; e < 32; ++e) { const float o = rdlane(logit, e); rank += (o > logit || (o == logit && e < e_me)) ? 1 : 0; }
        const unsigned long long sel = __ballot(rank < 4 && lane < 32);
        const float vmax = rdlane(logit, __builtin_amdgcn_readfirstlane(__ffsll((long long)__ballot(rank == 0 && lane < 32)) - 1));
        const float ex = (rank < 4) ? __expf(logit - vmax) : 0.f;
        float den = (lane < 32) ? ex : 0.f;
        den = wave_sum(den);
        if (lane < 32 && rank < 4) {
            const int lp = atomicAdd(&lcnt[e_me], 1);
            ent[(i * 4 + rank) * 2] = (unsigned)e_me | ((unsigned)lp << 8);
            ent[(i * 4 + rank) * 2 + 1] = __float_as_uint(ex / den);
        }
        (void)sel;
    }
    __syncthreads();
    if (tid < 32) lbase[tid] = (int)atomicAdd(&p.gcnt[l * NE + tid], (unsigned)lcnt[tid]);
    __syncthreads();
    for (int j = tid; j < nrb * 4; j += NTHREADS) {
        const int row = rbeg + (j >> 2);
        if (row >= MR) break;
        const unsigned w = ent[j * 2];
        if (w == 0xffffffffu) continue;
        const int e = w & 255, pos = lbase[e] + (int)(w >> 8);
        p.ltok[(size_t)e * MR + pos] = row;
        p.lgate[(size_t)e * MR + pos] = __uint_as_float(ent[j * 2 + 1]);
        p.rslot[(size_t)row * 4 + (j & 3)] = (e << 24) | pos;
    }
}

DI int moe_prefix(CParams& p, int l, int* tpre  ) {
    __syncthreads();
    if (otid() == 0) {
        int acc = 0;
        for (int e = 0; e < NE; ++e) { tpre[e] = acc; acc += ((int)p.gcnt[l * NE + e] + 255) >> 8; }
        tpre[NE] = acc;
    }
    __syncthreads();
    return tpre[NE];
}
DI int moe_find(const int* tpre, int mt) { int e = 0;
#pragma unroll 1
    for (int j = 0; j < NE; ++j) if (tpre[j + 1] <= mt) e = j + 1;
    return e; }

constexpr int TPRE_OFF = 135168;
struct SchedMoe {
    const int* tpre; const unsigned* cnt; const int* ltok; const char* A; const char* W; int nN; size_t wstride;
    DI bool next(int i, g8::GU& u) const {
        int pm, pn; if (!g8::order_next(i, __builtin_amdgcn_readfirstlane(tpre[NE]), nN, pm, pn)) return false;
        const int e = __builtin_amdgcn_readfirstlane(moe_find(tpre, pm));
        u.pm = pm; u.pn = pn; u.e = e; u.j0 = __builtin_amdgcn_readfirstlane((pm - tpre[e]) * 256);
        u.a = A + (size_t)pm * 256 * 2048; u.b = W + (size_t)e * wstride + (size_t)pn * 256 * 2048; return true;
    }
    DI unsigned arow(const g8::GU& u, int r) const { const int pos = u.j0 + r; return pos < (int)cnt[u.e] ? (unsigned)ltok[(size_t)u.e * MR + pos] : 0u; }
};
struct EpiMoe1 {
    const float* b1; bf16_t* ACT;
    DI void operator()(const f32x4 (&acc)[2][2][4][2], const g8::GU& u, int wr, int wc, int fr, int fq) const {
        const float* bb1 = b1 + (size_t)u.e * 2048;
#pragma unroll
        for (int ai = 0; ai < 2; ++ai)
#pragma unroll
            for (int bj = 0; bj < 2; ++bj)
#pragma unroll
                for (int m = 0; m < 4; ++m)
#pragma unroll
                    for (int n = 0; n < 2; ++n) {
                        const int rl = 128 * ai + 64 * wr + 16 * m + fr, col = u.pn * 256 + 128 * bj + 32 * wc + 16 * n + 4 * fq;
                        const f32x4 hv = acc[ai][bj][m][n] + *(const f32x4*)(bb1 + col);
                        float o[2];
#pragma unroll
                        for (int q = 0; q < 2; ++q) {
                            const float glu = fminf(hv[2 * q], 7.0f), lin = fminf(fmaxf(hv[2 * q + 1], -7.0f), 7.0f);
                            o[q] = glu * sigmoidf_(1.702f * glu) * (lin + 1.0f);
                        }
                        *(unsigned*)(ACT + ((size_t)u.pm * 256 + rl) * 1024 + (col >> 1)) = pk2(o[0], o[1]);
                    }
    }
};
struct EpiMoe2 {
    const float* b2; const float* lgate; const unsigned* cnt; bf16_t* YS;
    DI void operator()(const f32x4 (&acc)[2][2][4][2], const g8::GU& u, int wr, int wc, int fr, int fq) const {
        const float* bb2 = b2 + (size_t)u.e * DM;
        const int cn = (int)cnt[u.e];
#pragma unroll
        for (int ai = 0; ai < 2; ++ai)
#pragma unroll
            for (int m = 0; m < 4; ++m) {
                const int rl = 128 * ai + 64 * wr + 16 * m + fr, pos = u.j0 + rl;
                const float gate = pos < cn ? lgate[(size_t)u.e * MR + pos] : 0.f;
#pragma unroll
                for (int bj = 0; bj < 2; ++bj)
#pragma unroll
                    for (int n = 0; n < 2; ++n) {
                        const int col = u.pn * 256 + 128 * bj + 32 * wc + 16 * n + 4 * fq;
                        store4_bf16(YS + ((size_t)u.pm * 256 + rl) * 1024 + col, (acc[ai][bj][m][n] + *(const f32x4*)(bb2 + col)) * gate);
                    }
                __builtin_amdgcn_sched_barrier(0);
            }
    }
};
DI void phase_moe1(CParams& p, int l, char* lds) {
    int* tpre = (int*)(lds + TPRE_OFF);
    moe_prefix(p, l, tpre);
    SchedMoe S; S.tpre = tpre; S.cnt = p.gcnt + l * NE; S.ltok = p.ltok; S.A = nullptr; S.W = (const char*)(p.W1T + (size_t)l * NE * 2048 * DM); S.nN = 8; S.wstride = (size_t)2048 * DM * 2;
    EpiMoe1 E; E.b1 = p.b1 + (size_t)l * NE * 2048; E.ACT = p.ACT;
    g8::gemm8<EpiMoe1, SchedMoe, true>(lds, DM, (const char*)p.H, S, E);
}
DI void phase_moe2(CParams& p, int l, char* lds) {
    int* tpre = (int*)(lds + TPRE_OFF);
    moe_prefix(p, l, tpre);
    SchedMoe S; S.tpre = tpre; S.cnt = p.gcnt + l * NE; S.ltok = p.ltok; S.A = (const char*)p.ACT; S.W = (const char*)(p.W2T + (size_t)l * NE * DM * DM); S.nN = 4; S.wstride = (size_t)DM * DM * 2;
    EpiMoe2 E; E.b2 = p.b2 + (size_t)l * NE * DM; E.lgate = p.lgate; E.cnt = p.gcnt + l * NE; E.YS = p.YS;
    g8::gemm8<EpiMoe2, SchedMoe, false>(lds, DM, nullptr, S, E);
}

DI void phase_final(CParams& p, int l, char* lds) {
    const int tid = otid(), wid = tid >> 6, lane = tid & 63;
    int* tpre = (int*)(lds + TPRE_OFF);
    moe_prefix(p, l, tpre);
    const float* lw = p.ln_ffn_w + l * DM; const float* lb = p.ln_ffn_b + l * DM;
    for (int row = blockIdx.x * 8 + wid; row < MR; row += gridDim.x * 8) {
        const int b = row / TP, t = row - b * TP;
        if (l == 1 && t < CTX) continue;
        const float* g2 = mod_vec(p, l, row, 5);
        const bf16_t* ys[4];
#pragma unroll
        for (int k = 0; k < 4; ++k) { const int rs = p.rslot[(size_t)row * 4 + k]; const int e = rs >> 24, pos = rs & 0xffffff; ys[k] = p.YS + ((size_t)tpre[e] * 256 + pos) * 1024; }
        f32x4 v[4]; float s = 0.f;
#pragma unroll
        for (int j = 0; j < 4; ++j) {
            const int c = j * 256 + lane * 4;
            f32x4 y = zero4();
#pragma unroll
            for (int k = 0; k < 4; ++k) { const u32x2 w = *(const u32x2*)(ys[k] + c); y[0] += lo2f(w.x); y[1] += hi2f(w.x); y[2] += lo2f(w.y); y[3] += hi2f(w.y); }
            const f32x4 xv = *(const f32x4*)(p.X + (size_t)row * DM + c), gg = *(const f32x4*)(g2 + c);
            v[j] = xv * DN_ALPHA + gg * y;
            s += (v[j][0] + v[j][1]) + (v[j][2] + v[j][3]);
        }
        float mean = wave_sum(s) * (1.f / DM); float q = 0.f;
#pragma unroll
        for (int j = 0; j < 4; ++j) { v[j] = v[j] - mean; q += (v[j][0] * v[j][0] + v[j][1] * v[j][1]) + (v[j][2] * v[j][2] + v[j][3] * v[j][3]); }
        float rstd = rsqrtf(wave_sum(q) * (1.f / DM) + LN_EPS);
        s = 0.f;
#pragma unroll
        for (int j = 0; j < 4; ++j) {
            const int c = j * 256 + lane * 4;
            v[j] = v[j] * rstd * *(const f32x4*)(lw + c) + *(const f32x4*)(lb + c);
            s += (v[j][0] + v[j][1]) + (v[j][2] + v[j][3]);
        }
        if (l == 1) {
            float* o = p.out + ((size_t)b * SEQ + (t - CTX)) * DM;
#pragma unroll
            for (int j = 0; j < 4; ++j) *(f32x4*)(o + j * 256 + lane * 4) = v[j];
        } else {
#pragma unroll
            for (int j = 0; j < 4; ++j) *(f32x4*)(p.X + (size_t)row * DM + j * 256 + lane * 4) = v[j];
            mean = wave_sum(s) * (1.f / DM); q = 0.f;
#pragma unroll
            for (int j = 0; j < 4; ++j) { v[j] = v[j] - mean; q += (v[j][0] * v[j][0] + v[j][1] * v[j][1]) + (v[j][2] * v[j][2] + v[j][3] * v[j][3]); }
            rstd = rsqrtf(wave_sum(q) * (1.f / DM) + LN_EPS);
            const float* sh = mod_vec(p, 1, row, 0); const float* sc = mod_vec(p, 1, row, 1);
#pragma unroll
            for (int j = 0; j < 4; ++j) {
                const int c = j * 256 + lane * 4;
                const f32x4 h = v[j] * rstd * (*(const f32x4*)(sc + c) + 1.0f) + *(const f32x4*)(sh + c);
                store4_bf16(p.H + (size_t)row * DM + c, h);
            }
        }
    }
}

constexpr int PH_PER_LAYER = 11, N_PHASES = 1 + 2 * PH_PER_LAYER;

__global__ void __launch_bounds__(NTHREADS, 2) mega(Params p_unused, int ph_lo, int ph_hi) {
    extern __shared__ __attribute__((aligned(16))) char smem[];
    CParams* kp0 = (CParams*)__builtin_amdgcn_kernarg_segment_ptr();
    CParams& p = *kp0;
    ((volatile int*)(smem + WVTAB_OFF))[hw_slot()] = (int)(threadIdx.x >> 6);
    __syncthreads();
    const bool fused = (ph_hi - ph_lo) > 1;
    XcdBarrier bar; bar.bar = p.bar; bar.x = 0; bar.st = (volatile LAS unsigned*)(smem + LDS_BYTES - 16);
    if (fused) {
        if (otid() == 0) *(uint4*)(smem + LDS_BYTES - 16) = make_uint4(0u, 0u, 0u, 0u);
        __syncthreads();
        bar = xcd_barrier_post(p.bar, (volatile LAS unsigned*)(smem + LDS_BYTES - 16));
    }
#if MK_DEBUG == 2
#define PH_STAMP(i) if (blockIdx.x == 0 && threadIdx.x == 0) ((unsigned long long*)(p.gcnt + 1024))[(i) + 1] = wall_clock64();
#else
#define PH_STAMP(i)
#endif
#ifndef MK_REP
#define MK_REP 0u
#endif
#define PH(idx, call) do { const int _i = (idx); if (ph_lo <= _i && _i < ph_hi) { CParams* _kp = kp0; asm volatile("" : "+s"(_kp)); CParams& p = *_kp; call; if (_i > 0 && ((MK_REP >> (1 + (_i - 1) % 11)) & 1u)) { xcd_barrier(bar); h2skip = true; call; h2skip = false; } if (_i + 1 < ph_hi) xcd_barrier(bar); PH_STAMP(_i) } } while (0)
    bool h2skip = false;
    PH_STAMP(-1)
    PH(0, phase_prologue(p, smem));
#pragma unroll 1
    for (int l = 0; l < 2; ++l) {
        const int base = 1 + l * PH_PER_LAYER;
        PH(base + 0, if (l == 0) phase_ln1(p, smem));
        PH(base + 1, phase_inproj(p, l, smem));
        PH(base + 2, phase_sgu_prep(p, l, smem));
        PH(base + 3, phase_upproj_h1(p, l, smem));
        PH(base + 4, phase_attn_diff_h2(p, l, smem, h2skip));
        PH(base + 5, phase_attn_mla_h3(p, l, smem));
        PH(base + 6, phase_outproj(p, l, smem));
        PH(base + 7, phase_postmix(p, l, smem));
        PH(base + 8, phase_moe1(p, l, smem));
        PH(base + 9, phase_moe2(p, l, smem));
        PH(base + 10, phase_final(p, l, smem));
    }
#undef PH
}


#ifndef MK_DEBUG
#define MK_DEBUG 0
#define MK_REP 0u
#endif
#if MK_DEBUG
struct DbgItem { const void* ptr; unsigned long long n; int f32; int ld; int c0; int c1; int mode; int pad; };
struct DbgList { DbgItem it[40]; int count; int pad; };
__global__ void dbg_scan(DbgList L, unsigned* flag) {
    for (int i = 0; i < L.count; ++i) {
        const DbgItem d = L.it[i];
        bool bad = false;
        for (unsigned long long e = (unsigned long long)blockIdx.x * blockDim.x + threadIdx.x; e < d.n; e += (unsigned long long)gridDim.x * blockDim.x) {
            if (d.ld > 0) { const int c = (int)(e % d.ld); if (c < d.c0 || c >= d.c1) continue; }
            if (d.f32) { const unsigned u = ((const unsigned*)d.ptr)[e]; if (((d.mode & 1) && (u & 0x7f800000u) == 0x7f800000u) || ((d.mode & 2) && u == 0xAAAAAAAAu) || ((d.mode & 4) && (u & 0x7f800000u) >= 0x46800000u)) bad = true; }
            else { const unsigned short u = ((const unsigned short*)d.ptr)[e]; if (((d.mode & 1) && (u & 0x7f80u) == 0x7f80u) || ((d.mode & 2) && u == 0xAAAAu) || ((d.mode & 4) && (u & 0x7f80u) >= 0x4680u)) bad = true; }
        }
        if (bad) atomicMin(flag, (unsigned)i);
    }
}
__global__ void dbg_time(float* out, unsigned long long n, const unsigned long long* ts, unsigned maskA, unsigned maskB) {
    float ta = 0.f, tb = 0.f;
    for (int i = 0; i < 23; ++i) { const float d = (float)(ts[i + 1] - ts[i]) * 0.01f; const int cls = i == 0 ? 0 : 1 + (i - 1) % 11; if (maskA >> cls & 1) ta += d; if (maskB >> cls & 1) tb += d; }
    for (unsigned long long e = (unsigned long long)blockIdx.x * blockDim.x + threadIdx.x; e < n; e += (unsigned long long)gridDim.x * blockDim.x) out[e] = e == 0 ? ta : tb;
}
__global__ void dbg_fill(float* out, unsigned long long n, const unsigned* flag, float hostcode) {
    const unsigned f = *flag;
    float v = f < 1000u ? 100.0f * (float)(f + 1u) : 0.0f;
    if (hostcode != 0.f) v = hostcode;
    for (unsigned long long e = (unsigned long long)blockIdx.x * blockDim.x + threadIdx.x; e < n; e += (unsigned long long)gridDim.x * blockDim.x) out[e] = v;
}
#endif

#ifndef MK_MULTI
#define MK_MULTI 0
#endif

extern "C" void kernel_launch(void* const* d_in, const int* in_sizes, int n_in, void* d_out, int out_size, void* d_ws, size_t ws_size, hipStream_t stream) {
    (void)in_sizes; (void)n_in; (void)out_size; (void)ws_size;
    Params p;
    memset(&p, 0, sizeof(p));
    const float* const* in = (const float* const*)d_in;
    p.x = in[0]; p.c = in[1]; p.ctx = in[2]; p.c_ctx = in[3]; p.ada_w = in[4]; p.ada_b = in[5]; p.w_in = in[6]; p.w_out = in[7];
    p.sgu_ln_w = in[8]; p.sgu_ln_b = in[9]; p.sgu_w = in[10]; p.sgu_b = in[11]; p.diff_lambda = in[12]; p.diff_subln_w = in[13];
    p.hgrn_lb = in[14]; p.hgrn_norm_w = in[15]; p.mla_q_norm_w = in[16]; p.mla_w_uq = in[17]; p.mla_kv_norm_w = in[18]; p.mla_w_ukv = in[19];
    p.ln_mix_w = in[20]; p.ln_mix_b = in[21]; p.ln_ffn_w = in[22]; p.ln_ffn_b = in[23]; p.router_w = in[24]; p.router_b = in[25];
    p.w1 = in[26]; p.b1 = in[27]; p.w2 = in[28]; p.b2 = in[29];
    p.out = (float*)d_out;
    char* ws = (char*)d_ws; size_t off = 0;
    auto take = [&](size_t bytes) { char* r = ws + off; off += (bytes + 255) & ~(size_t)255; return r; };
    constexpr size_t CTRL_BYTES = 65536;
    char* ctrl = take(CTRL_BYTES);
    p.bar = (unsigned*)ctrl; p.gcnt = (unsigned*)(ctrl + 16384);
    p.mod = (float*)take((size_t)2 * 9 * 6144 * 4); p.lball = (float*)take(2 * 512 * 4); p.lam = (float*)take(256); p.ropec = (float*)take(512 * 4); p.ropes = (float*)take(512 * 4);
    p.WinT = (bf16_t*)take((size_t)2 * NINP * DM * 2); p.WoutT = (bf16_t*)take((size_t)2 * DM * DM * 2);
    p.WuqT = (bf16_t*)take((size_t)2 * 384 * 256 * 2); p.WukvT = (bf16_t*)take((size_t)2 * 512 * 128 * 2);
    p.W1T = (bf16_t*)take((size_t)2 * NE * 2048 * DM * 2); p.W2T = (bf16_t*)take((size_t)2 * NE * DM * DM * 2);
    p.X = (float*)take((size_t)MR * DM * 4); p.H = (bf16_t*)take((size_t)MR * DM * 2);
    p.Puv = (bf16_t*)take((size_t)MR * 512 * 2); p.Qd = (bf16_t*)take((size_t)MR * 256 * 2); p.Kd = (bf16_t*)take((size_t)MR * 256 * 2); p.Vdt = (bf16_t*)take((size_t)MR * 256 * 2);
    p.Hq = (bf16_t*)take((size_t)MR * 256 * 2); p.Vht = (bf16_t*)take((size_t)MR * 256 * 2); p.Lf = (bf16_t*)take((size_t)2 * MR * 256 * 2); p.Hg = (bf16_t*)take((size_t)MR * 256 * 2);
    p.Cq = (bf16_t*)take((size_t)MR * 256 * 2); p.Ckv = (bf16_t*)take((size_t)MR * 128 * 2); p.Kr = (bf16_t*)take((size_t)MR * 32 * 2);
    p.Qm = (bf16_t*)take((size_t)MR * 384 * 2); p.Kn = (bf16_t*)take((size_t)MR * 256 * 2); p.Vmt = (bf16_t*)take((size_t)MR * 256 * 2);
    p.O = (bf16_t*)take((size_t)MR * DM * 2);
    p.RS = (float*)take((size_t)MR * 2 * 4); p.DST = (float*)take((size_t)NB * 4 * 2 * NCH * 4096 * 4); p.DEC = (float*)take((size_t)NB * 4 * 2 * NCH * 64 * 4);
    p.Y = (float*)take((size_t)MR * DM * 4);
    p.ltok = (int*)take((size_t)NE * MR * 4); p.lgate = (float*)take((size_t)NE * MR * 4); p.rslot = (int*)take((size_t)MR * 4 * 4);
    p.ACT = (bf16_t*)take((size_t)NSLOT * 1024 * 2); p.YS = (bf16_t*)take((size_t)NSLOT * 1024 * 2);

    static int grid = 0;
    if (!grid) {
        int dev = 0, cus = 0, per_cu = 0;
        hipGetDevice(&dev);
        hipDeviceGetAttribute(&cus, hipDeviceAttributeMultiprocessorCount, dev);
        hipFuncSetAttribute((const void*)mega, hipFuncAttributeMaxDynamicSharedMemorySize, LDS_BYTES);
        hipOccupancyMaxActiveBlocksPerMultiprocessor(&per_cu, mega, NTHREADS, LDS_BYTES);
        if (cus <= 0) cus = 256;
        grid = cus * (per_cu < 1 ? 1 : 1);
    }
    hipMemsetAsync(ctrl, 0, CTRL_BYTES, stream);
#if MK_MULTI
#ifndef MK_NPH
#define MK_NPH N_PHASES
#endif
    for (int ph = 0; ph < MK_NPH; ++ph) {
        if (ph == 1 + PH_PER_LAYER) continue;
        hipLaunchKernelGGL(mega, dim3(grid), dim3(NTHREADS), LDS_BYTES, stream, p, ph, ph + 1);
    }
#else
    hipLaunchKernelGGL(mega, dim3(grid), dim3(NTHREADS), LDS_BYTES, stream, p, 0, N_PHASES);
#endif

#if MK_DEBUG == 2
    hipLaunchKernelGGL(dbg_time, dim3(2048), dim3(256), 0, stream, (float*)d_out, (unsigned long long)NB * SEQ * DM, (const unsigned long long*)(p.gcnt + 1024), (unsigned)MK_TMASK_A, (unsigned)MK_TMASK_B);
#elif MK_DEBUG
    {
        DbgList L; memset(&L, 0, sizeof(L));
        int n = 0;
        auto add = [&](const void* ptr, unsigned long long cnt, int f32, int ld = 0, int c0 = 0, int c1 = 0, int mode = 3) { L.it[n].ptr = ptr; L.it[n].n = cnt; L.it[n].f32 = f32; L.it[n].ld = ld; L.it[n].c0 = c0; L.it[n].c1 = c1; L.it[n].mode = mode; ++n; };
        MK_DEBUG_LIST
        L.count = n;
        unsigned* flag = (unsigned*)(ctrl + 32768);
        hipMemsetAsync(flag, 0x7f, 4, stream);
        hipLaunchKernelGGL(dbg_scan, dim3(2048), dim3(256), 0, stream, L, flag);
        hipLaunchKernelGGL(dbg_fill, dim3(2048), dim3(256), 0, stream, (float*)d_out, (unsigned long long)NB * SEQ * DM, (const unsigned*)flag, 0.0f);
    }
#endif
}
```

```cpp
#include <hip/hip_runtime.h>
#include <stdint.h>
#include <string.h>

#define MK_MULTI 0
#define MK_NPH N_PHASES
#define MK_DEBUG 0
#define MK_REP 0u
#define MK_DEBUG_LIST \
  add(p.mod, 2*9*6144, 1,0,0,0,7); add(p.WinT, 2ull*NINP*DM, 0,0,0,0,7); add(p.H, (unsigned long long)MR*DM, 0,0,0,0,7); add(p.Puv, (unsigned long long)MR*512, 0,0,0,0,7); \
  add(p.Cq, (unsigned long long)MR*256, 0,0,0,0,7); add(p.Ckv, (unsigned long long)MR*128, 0,0,0,0,7); add(p.RS, (unsigned long long)MR*2, 1,0,0,0,7); \
  add(p.Kn, (unsigned long long)MR*256, 0,0,0,0,7); add(p.Vmt, (unsigned long long)MR*256, 0,0,0,0,7); \
  add(p.O, (unsigned long long)MR*DM, 0, DM, 0, 256, 1); \
  add(p.Y, (unsigned long long)MR*DM, 1);

#define DI __device__ __forceinline__
typedef unsigned short bf16_t;
typedef short bf16x8 __attribute__((ext_vector_type(8)));
typedef float f32x4 __attribute__((ext_vector_type(4)));
typedef float f32x2 __attribute__((ext_vector_type(2)));
typedef float f32x16 __attribute__((ext_vector_type(16)));
typedef unsigned u32x4 __attribute__((ext_vector_type(4)));
typedef unsigned u32x2 __attribute__((ext_vector_type(2)));

constexpr int DM = 1024, NB = 8, SEQ = 4096, CTX = 256, TP = 4352, MR = NB * TP;
constexpr int NIN = 2976, NINP = 3072;
constexpr int NE = 32;
constexpr int NCH = TP / 32;
constexpr int NSLOT = 147456;
constexpr float LN_EPS = 1e-6f;
constexpr float DN_ALPHA = 1.4142135623730951f;
constexpr float LOG2E = 1.4426950408889634f;
constexpr int NTHREADS = 512;
constexpr int LDS_BYTES = 147456;

#define XB_TMO      128
#define XB_XCNT(j)  (256  + 64 * (j))
#define XB_XSUB(j)  (1280 + 64 * (j))
#define XB_XGEN(j)  (2304 + 64 * (j))
#define XB_TOP      3328
#define XB_TOPGEN   3392
#define XCD_BAR_WORDS 3456
#define XB_SPIN_CAP (1u << 22)
#define LAS __attribute__((address_space(3)))
__device__ __forceinline__ int otid();

DI unsigned xb_ld(unsigned* p)              { return __hip_atomic_load(p, __ATOMIC_RELAXED, __HIP_MEMORY_SCOPE_AGENT); }
DI unsigned xb_add(unsigned* p, unsigned v) { return __hip_atomic_fetch_add(p, v, __ATOMIC_RELAXED, __HIP_MEMORY_SCOPE_AGENT); }
DI unsigned xb_xcc_id() { return (unsigned)__builtin_amdgcn_s_getreg((3 << 11) | 20) & 0xFu; }
#define XB_SPIN(cond, bar) do { unsigned _sp = 0; while (cond) { __builtin_amdgcn_s_sleep(1); \
    if ((++_sp & 255u) == 0u) { if (xb_ld(&(bar)[XB_TMO])) break; if (_sp > XB_SPIN_CAP) { atomicAdd(&(bar)[XB_TMO], 1u); break; } } } } while (0)

struct XcdBarrier { unsigned* bar; unsigned x; volatile LAS unsigned* st; };

DI XcdBarrier xcd_barrier_post(unsigned* bar, volatile LAS unsigned* st) {
    XcdBarrier b; b.bar = bar; b.x = xb_xcc_id(); b.st = st;
    if (otid() == 0) (void)xb_add(&bar[XB_XCNT(b.x)], 1u);
    return b;
}
DI void xcd_barrier_complete(unsigned* bar, unsigned x, unsigned& nloc, unsigned& nx) {
    const unsigned G = gridDim.x * gridDim.y * gridDim.z;
    unsigned sum, cnt, mine, sp = 0u;
    for (;;) {
        sum = 0u; cnt = 0u; mine = 0u;
#pragma unroll
        for (unsigned j = 0; j < 16; ++j) { const unsigned c = xb_ld(&bar[XB_XCNT(j)]); sum += c; cnt += (c > 0u) ? 1u : 0u; mine = (j == x) ? c : mine; }
        if (sum == G) break;
        __builtin_amdgcn_s_sleep(1);
        if ((++sp & 255u) == 0u) { if (xb_ld(&bar[XB_TMO])) break; if (sp > XB_SPIN_CAP) { atomicAdd(&bar[XB_TMO], 1u); break; } }
    }
    nloc = mine > 0u ? mine : 1u; nx = cnt > 0u ? cnt : 1u;
}
DI void xcd_barrier(const XcdBarrier& b) {
    asm volatile("s_waitcnt vmcnt(0)" ::: "memory");
    __syncthreads();
    if (otid() == 0) {
        unsigned* bar = b.bar;
        __builtin_amdgcn_s_waitcnt(0);
        unsigned nloc = b.st[0], nx = b.st[1];
        if (nloc == 0u) { xcd_barrier_complete(bar, b.x, nloc, nx); b.st[0] = nloc; b.st[1] = nx; }
        const unsigned old = xb_add(&bar[XB_XSUB(b.x)], 1u);
        const unsigned gen = old / nloc;
        if (old + 1u == (gen + 1u) * nloc) {
            __builtin_amdgcn_fence(__ATOMIC_RELEASE, "agent");
            asm volatile("s_waitcnt vmcnt(0)" ::: "memory");
            const unsigned og = xb_add(&bar[XB_TOP], 1u);
            const unsigned tg = og / nx;
            if (og + 1u == (tg + 1u) * nx) xb_add(&bar[XB_TOPGEN], 1u);
            else XB_SPIN(xb_ld(&bar[XB_TOPGEN]) == tg, bar);
            __builtin_amdgcn_fence(__ATOMIC_ACQUIRE, "agent");
            xb_add(&bar[XB_XGEN(b.x)], 1u);
            asm volatile("s_waitcnt vmcnt(0)" ::: "memory");
        } else {
            XB_SPIN(xb_ld(&bar[XB_XGEN(b.x)]) == gen, bar);
            __builtin_amdgcn_fence(__ATOMIC_ACQUIRE, "agent");
            asm volatile("s_waitcnt vmcnt(0)" ::: "memory");
        }
    }
    __syncthreads();
}

struct Params {
    const float *x, *c, *ctx, *c_ctx, *ada_w, *ada_b, *w_in, *w_out, *sgu_ln_w, *sgu_ln_b, *sgu_w, *sgu_b,
                *diff_lambda, *diff_subln_w, *hgrn_lb, *hgrn_norm_w, *mla_q_norm_w, *mla_w_uq, *mla_kv_norm_w, *mla_w_ukv,
                *ln_mix_w, *ln_mix_b, *ln_ffn_w, *ln_ffn_b, *router_w, *router_b, *w1, *b1, *w2, *b2;
    float* out;
    unsigned* bar; unsigned* gcnt;
    float *mod, *lball, *lam, *ropec, *ropes;
    bf16_t *WinT, *WoutT, *WuqT, *WukvT, *W1T, *W2T;
    float* X; bf16_t* H;
    bf16_t *Puv, *Qd, *Kd, *Vdt, *Hq, *Vht, *Lf, *Hg, *Cq, *Ckv, *Kr, *Qm, *Kn, *Vmt, *O;
    float *RS, *DST, *DEC, *Y;
    int* ltok; float* lgate; int* rslot; bf16_t *ACT, *YS;
};

typedef const __attribute__((address_space(4))) Params CParams;
extern __shared__ __attribute__((aligned(16))) char smem_all[];
constexpr int WVTAB_OFF = 147456 - 16 - 256;
DI int hw_slot() { return (int)(__builtin_amdgcn_s_getreg((6 << 11) | 4) & 63u); }
DI int otid() {
    int l = (int)__builtin_amdgcn_mbcnt_hi(~0u, __builtin_amdgcn_mbcnt_lo(~0u, 0u));
    const int w = __builtin_amdgcn_readfirstlane(((volatile int*)(smem_all + WVTAB_OFF))[hw_slot()]);
    int t = w * 64 + l; asm volatile("" : "+v"(t)); return t;
}
DI float bf2f(bf16_t v) { return __uint_as_float(((unsigned)v) << 16); }
typedef __bf16 bf16x2_t __attribute__((ext_vector_type(2)));
DI unsigned pk2(float lo, float hi) { const bf16x2_t v = {(__bf16)lo, (__bf16)hi}; return __builtin_bit_cast(unsigned, v); }
DI float lo2f(unsigned w) { return __uint_as_float(w << 16); }
DI float hi2f(unsigned w) { return __uint_as_float(w & 0xffff0000u); }
DI bf16x8 pack8(const float (&v)[8]) { u32x4 w; w.x = pk2(v[0], v[1]); w.y = pk2(v[2], v[3]); w.z = pk2(v[4], v[5]); w.w = pk2(v[6], v[7]); return __builtin_bit_cast(bf16x8, w); }
template <int MASK> DI float shx(float v) {
    if (MASK < 32) return __int_as_float(__builtin_amdgcn_ds_swizzle(__float_as_int(v), (MASK << 10) | 0x1f));
    int l = (int)__builtin_amdgcn_mbcnt_hi(~0u, __builtin_amdgcn_mbcnt_lo(~0u, 0u)); asm volatile("" : "+v"(l));
    return __int_as_float(__builtin_amdgcn_ds_bpermute((l ^ 32) << 2, __float_as_int(v)));
}
DI float zf() { float z = 0.f; asm volatile("" : "+v"(z)); return z; }
DI f32x4 zero4() { const float z = zf(); return (f32x4){z, z, z, z}; }
DI float rdlane(float v, int l) { return __int_as_float(__builtin_amdgcn_readlane(__float_as_int(v), l)); }
template <int CTRL> DI float dpp(float v) { return __int_as_float(__builtin_amdgcn_update_dpp(0, __float_as_int(v), CTRL, 0xf, 0xf, false)); }
constexpr int DPP_X1 = 0xB1, DPP_X2 = 0x4E, DPP_HM = 0x141, DPP_RM = 0x140;
DI float wave_sum(float v) { v += dpp<DPP_X1>(v); v += dpp<DPP_X2>(v); v += dpp<DPP_HM>(v); v += dpp<DPP_RM>(v); v += shx<16>(v); v += shx<32>(v); return v; }
DI float sigmoidf_(float x) { return __builtin_amdgcn_rcpf(1.0f + __builtin_amdgcn_exp2f(-LOG2E * x)); }
DI float geluf_(float v) {
    const float av = fabsf(v), t = __builtin_amdgcn_rcpf(av * 0.2316418882f + 1.0f);
    float q = t * 0.5307027145f + (-0.7265760135f); q = q * t + 0.7107068705f; q = q * t + (-0.142248368f); q = q * t + 0.127414796f; q = q * t;
    const float e = __builtin_amdgcn_exp2f((v * v) * (-0.72134752044f));
    const float m = v * (q * e);
    return v < 0.f ? m : v - m;
}
DI float siluf_(float x) { return x * sigmoidf_(x); }
DI int crow(int r, int hh) { return (r & 3) + 8 * (r >> 2) + 4 * hh; }
#define MFMA16(a, b, c) __builtin_amdgcn_mfma_f32_16x16x32_bf16((a), (b), (c), 0, 0, 0)
#define MFMA32(a, b, c) __builtin_amdgcn_mfma_f32_32x32x16_bf16((a), (b), (c), 0, 0, 0)

DI const float* in_row(CParams& p, int row) {
    const int b = row / TP, t = row - b * TP;
    return t < CTX ? p.ctx + ((size_t)b * CTX + t) * DM : p.x + ((size_t)b * SEQ + (t - CTX)) * DM;
}
DI const float* mod_vec(CParams& p, int l, int row, int j) {
    const int b = row / TP, t = row - b * TP;
    const int r = t < CTX ? 8 : b;
    return p.mod + ((size_t)(l * 9 + r) * 6 + j) * DM;
}

DI void transpose_tile(const float* __restrict__ src, int K, int N, bf16_t* __restrict__ dst, int k0, int n0, const float* __restrict__ kscale, int perm_ukv, char* wl, int lane) {
    bf16_t* S = (bf16_t*)wl;
#pragma unroll 4
    for (int it = 0; it < 16; ++it) {
        const int kk = it * 4 + (lane >> 4), nn = (lane & 15) * 4;
        f32x4 v = {0.f, 0.f, 0.f, 0.f};
        if (n0 + nn < N) v = *(const f32x4*)(src + (size_t)(k0 + kk) * N + n0 + nn);
        if (kscale) { const float s = kscale[k0 + kk]; v = v * s; }
        unsigned* d = (unsigned*)(S + kk * 66 + nn);
        d[0] = pk2(v[0], v[1]); d[1] = pk2(v[2], v[3]);
    }
    __builtin_amdgcn_fence(__ATOMIC_RELEASE, "workgroup");
    __builtin_amdgcn_wave_barrier();
    __builtin_amdgcn_fence(__ATOMIC_ACQUIRE, "workgroup");
#pragma unroll 2
    for (int it = 0; it < 8; ++it) {
        const int nn = it * 8 + (lane >> 3), kc = lane & 7;
        unsigned short e[8];
#pragma unroll
        for (int j = 0; j < 8; ++j) e[j] = S[(kc * 8 + j) * 66 + nn];
        u32x4 w; w.x = e[0] | ((unsigned)e[1] << 16); w.y = e[2] | ((unsigned)e[3] << 16); w.z = e[4] | ((unsigned)e[5] << 16); w.w = e[6] | ((unsigned)e[7] << 16);
        int n = n0 + nn;
        if (perm_ukv) { const int hh = n >> 7, t = n & 127; n = t < 64 ? hh * 64 + t : 256 + hh * 64 + (t - 64); }
        *(u32x4*)(dst + (size_t)n * K + k0 + kc * 8) = w;
    }
    __builtin_amdgcn_fence(__ATOMIC_RELEASE, "workgroup");
    __builtin_amdgcn_wave_barrier();
}

DI void phase_prologue(CParams& p, char* lds) {
    const int tid = otid(), wid = tid >> 6, lane = tid & 63;
    char* wl = lds + wid * 8704;
    constexpr int T_IN = 16 * 48, T_OUT = 16 * 16, T_UQ = 4 * 6, T_UKV = 2 * 8, T_W1 = 32 * 16 * 32, T_W2 = 32 * 16 * 16;
    constexpr int T_LAYER = T_IN + T_OUT + T_UQ + T_UKV + T_W1 + T_W2;
    constexpr int T_ALL = 2 * T_LAYER;
    constexpr int U_TR = (T_ALL + 7) / 8;
    constexpr int U_GEMV = 2 * 6144 / 64;
    const int nunits = U_GEMV + U_TR + 1;
    for (int u = blockIdx.x; u < nunits; u += gridDim.x) {
        if (u < U_GEMV) {
            const int l = u / 96, n = (u % 96) * 64 + lane;
            const float* W = p.ada_w + (size_t)l * DM * 6144 + (size_t)(wid * 128) * 6144 + n;
            float* sc = (float*)(lds + 73728);
            float* part = (float*)lds;
            __syncthreads();
            for (int i = tid; i < 9 * DM; i += NTHREADS) { const float cv = i < 8 * DM ? p.c[i] : p.c_ctx[i - 8 * DM]; sc[i] = siluf_(cv); }
            __syncthreads();
            float acc[9];
#pragma unroll
            for (int r = 0; r < 9; ++r) acc[r] = 0.f;
#pragma unroll 2
            for (int k = 0; k < 128; k += 4) {
                float w[4];
#pragma unroll
                for (int j = 0; j < 4; ++j) w[j] = W[(size_t)(k + j) * 6144];
#pragma unroll
                for (int r = 0; r < 9; ++r) {
                    const f32x4 cc = *(const f32x4*)(sc + r * DM + wid * 128 + k);
#pragma unroll
                    for (int j = 0; j < 4; ++j) acc[r] += cc[j] * w[j];
                }
            }
#pragma unroll
            for (int r = 0; r < 9; ++r) part[(wid * 9 + r) * 64 + lane] = acc[r];
            __syncthreads();
            for (int i = tid; i < 9 * 64; i += NTHREADS) {
                const int r = i >> 6, c = i & 63;
                float sum = p.ada_b[l * 6144 + (u % 96) * 64 + c];
#pragma unroll
                for (int w8 = 0; w8 < 8; ++w8) sum += part[(w8 * 9 + r) * 64 + c];
                p.mod[(size_t)(l * 9 + r) * 6144 + (u % 96) * 64 + c] = sum;
            }
            __syncthreads();
        } else if (u < U_GEMV + U_TR) {
            int t = (u - U_GEMV) * 8 + wid;
            if (t < T_ALL) {
                const int l = t / T_LAYER; t -= l * T_LAYER;
                if (t < T_IN) { const int kt = t / 48, nt = t % 48;
                    transpose_tile(p.w_in + (size_t)l * DM * NIN, DM, NIN, p.WinT + (size_t)l * NINP * DM, kt * 64, nt * 64, nullptr, 0, wl, lane);
                } else if ((t -= T_IN) < T_OUT) { const int kt = t / 16, nt = t % 16;
                    transpose_tile(p.w_out + (size_t)l * DM * DM, DM, DM, p.WoutT + (size_t)l * DM * DM, kt * 64, nt * 64, nullptr, 0, wl, lane);
                } else if ((t -= T_OUT) < T_UQ) { const int kt = t / 6, nt = t % 6;
                    transpose_tile(p.mla_w_uq + (size_t)l * 256 * 384, 256, 384, p.WuqT + (size_t)l * 384 * 256, kt * 64, nt * 64, p.mla_q_norm_w + l * 256, 0, wl, lane);
                } else if ((t -= T_UQ) < T_UKV) { const int kt = t / 8, nt = t % 8;
                    transpose_tile(p.mla_w_ukv + (size_t)l * 128 * 512, 128, 512, p.WukvT + (size_t)l * 512 * 128, kt * 64, nt * 64, p.mla_kv_norm_w + l * 128, 1, wl, lane);
                } else if ((t -= T_UKV) < T_W1) { const int e = t / 512, r = t % 512, kt = r / 32, nt = r % 32;
                    transpose_tile(p.w1 + ((size_t)l * NE + e) * DM * 2048, DM, 2048, p.W1T + ((size_t)l * NE + e) * 2048 * DM, kt * 64, nt * 64, nullptr, 0, wl, lane);
                } else { t -= T_W1; const int e = t / 256, r = t % 256, kt = r / 16, nt = r % 16;
                    transpose_tile(p.w2 + ((size_t)l * NE + e) * DM * DM, DM, DM, p.W2T + ((size_t)l * NE + e) * DM * DM, kt * 64, nt * 64, nullptr, 0, wl, lane);
                }
            }
        } else {
            if (tid < 512) {
                const int j = tid;
                const float a0 = p.hgrn_lb[j], a1 = p.hgrn_lb[512 + j];
                const float m = fmaxf(a0, a1), e0 = expf(a0 - m), e1 = expf(a1 - m);
                p.lball[j] = 0.f;
                p.lball[512 + j] = e1 / (e0 + e1);
            }
            if (tid < 2) {
                const float* lp = p.diff_lambda + tid * 4 * 32;
                float s01 = 0.f, s23 = 0.f;
                for (int i = 0; i < 32; ++i) { s01 += lp[i] * lp[32 + i]; s23 += lp[64 + i] * lp[96 + i]; }
                const float lam_init = 0.8f - 0.6f * expf(-0.3f * (float)tid);
                p.lam[tid] = expf(s01) - expf(s23) + lam_init;
            }
            {
                const int pos = tid >> 3, i = tid & 7;
                const float inv = powf(10000.0f, -(float)(2 * i) / 16.0f);
                float sn, cs; sincosf((float)pos * inv, &sn, &cs);
                p.ropec[tid] = cs; p.ropes[tid] = sn;
            }
        }
    }
}

DI void phase_ln1(CParams& p, char* lds) {
    const int tid = otid(), wid = tid >> 6, lane = tid & 63;
    for (int row = blockIdx.x * 8 + wid; row < MR; row += gridDim.x * 8) {
        const float* xr = in_row(p, row);
        f32x4 v[4]; float s = 0.f;
#pragma unroll
        for (int j = 0; j < 4; ++j) { v[j] = *(const f32x4*)(xr + j * 256 + lane * 4); s += (v[j][0] + v[j][1]) + (v[j][2] + v[j][3]); }
        const float mean = wave_sum(s) * (1.f / DM);
        float q = 0.f;
#pragma unroll
        for (int j = 0; j < 4; ++j) { v[j] = v[j] - mean; q += (v[j][0] * v[j][0] + v[j][1] * v[j][1]) + (v[j][2] * v[j][2] + v[j][3] * v[j][3]); }
        const float rstd = rsqrtf(wave_sum(q) * (1.f / DM) + LN_EPS);
        const float* sh = mod_vec(p, 0, row, 0); const float* sc = mod_vec(p, 0, row, 1);
#pragma unroll
        for (int j = 0; j < 4; ++j) {
            const int c = j * 256 + lane * 4;
            const f32x4 a = *(const f32x4*)(sh + c), b = *(const f32x4*)(sc + c);
            const f32x4 h = v[j] * rstd * (b + 1.0f) + a;
            u32x2 w; w.x = pk2(h[0], h[1]); w.y = pk2(h[2], h[3]);
            *(u32x2*)(p.H + (size_t)row * DM + c) = w;
        }
    }
}

template <int ORI>
DI void gemm_core(const bf16_t* const (&pa)[4], const bf16_t* const (&pb)[2], int K, char* lds, f32x4 (&acc)[4][4]) {
    const int tid = otid(), wid = tid >> 6, lane = tid & 63, wr = wid >> 1, wc = wid & 1, fr = lane & 15, fq = lane >> 4;
    const int sw = ((tid & 7) ^ ((tid >> 4) & 7)) << 4;
    const int offA = (tid >> 3) * 128 + sw, offB = 32768 + (tid >> 3) * 128 + sw;
    const int rdA = (wr * 64 + fr) * 128 + ((fq ^ (fr >> 1)) << 4), rdB = 32768 + (wc * 64 + fr) * 128 + ((fq ^ (fr >> 1)) << 4);
#pragma unroll
    for (int mi = 0; mi < 4; ++mi)
#pragma unroll
        for (int ni = 0; ni < 4; ++ni) acc[mi][ni] = zero4();
    u32x4 ra[4], rb[2];
#pragma unroll
    for (int i = 0; i < 4; ++i) ra[i] = *(const u32x4*)(pa[i]);
#pragma unroll
    for (int j = 0; j < 2; ++j) rb[j] = *(const u32x4*)(pb[j]);
#pragma unroll
    for (int i = 0; i < 4; ++i) *(u32x4*)(lds + offA + i * 8192) = ra[i];
#pragma unroll
    for (int j = 0; j < 2; ++j) *(u32x4*)(lds + offB + j * 8192) = rb[j];
    __syncthreads();
    const int nk = K >> 6;
    for (int kt = 0; kt < nk; ++kt) {
        const char* cur = lds + (kt & 1) * 49152;
        const bool more = kt + 1 < nk;
        if (more) {
#pragma unroll
            for (int i = 0; i < 4; ++i) ra[i] = *(const u32x4*)(pa[i] + (kt + 1) * 64);
#pragma unroll
            for (int j = 0; j < 2; ++j) rb[j] = *(const u32x4*)(pb[j] + (kt + 1) * 64);
        }
#pragma unroll
        for (int kk = 0; kk < 2; ++kk) {
            bf16x8 af[4], bfr[4];
#pragma unroll
            for (int mi = 0; mi < 4; ++mi) af[mi] = *(const bf16x8*)(cur + ((rdA + mi * 2048) ^ (kk * 64)));
#pragma unroll
            for (int ni = 0; ni < 4; ++ni) bfr[ni] = *(const bf16x8*)(cur + ((rdB + ni * 2048) ^ (kk * 64)));
#pragma unroll
            for (int mi = 0; mi < 4; ++mi)
#pragma unroll
                for (int ni = 0; ni < 4; ++ni) {
                    if (ORI == 0) acc[mi][ni] = MFMA16(bfr[ni], af[mi], acc[mi][ni]);
                    else          acc[mi][ni] = MFMA16(af[mi], bfr[ni], acc[mi][ni]);
                }
        }
        if (more) {
            char* nxt = lds + ((kt + 1) & 1) * 49152;
#pragma unroll
            for (int i = 0; i < 4; ++i) *(u32x4*)(nxt + offA + i * 8192) = ra[i];
#pragma unroll
            for (int j = 0; j < 2; ++j) *(u32x4*)(nxt + offB + j * 8192) = rb[j];
        }
        __syncthreads();
    }
}

DI void gemm_ptrs(const bf16_t* A, int lda, int row0, const bf16_t* Bt, int ldb, int n0, const bf16_t* (&pa)[4], const bf16_t* (&pb)[2]) {
    const int tid = otid(), r = tid >> 3, c = (tid & 7) * 8;
#pragma unroll
    for (int i = 0; i < 4; ++i) pa[i] = A + (size_t)(row0 + r + 64 * i) * lda + c;
#pragma unroll
    for (int j = 0; j < 2; ++j) pb[j] = Bt + (size_t)(n0 + r + 64 * j) * ldb + c;
}

DI void store4_bf16(bf16_t* dst, const f32x4& v) { u32x2 w; w.x = pk2(v[0], v[1]); w.y = pk2(v[2], v[3]); *(u32x2*)dst = w; }

DI f32x4 rope_tile(CParams& p, f32x4 v, int row, int axis_is_col, int fq) {
    f32x4 o;
    const int b = row / TP, t = row - b * TP;
    const int pos = t - CTX;
    const int ax = axis_is_col ? (pos & 63) : (pos >> 6);
#pragma unroll
    for (int r = 0; r < 4; ++r) {
        const float pr = shx<32>(v[r]);
        float cs = 1.f, sn = 0.f;
        if (t >= CTX) { const int i = (fq & 1) * 4 + r; cs = p.ropec[ax * 8 + i]; sn = p.ropes[ax * 8 + i]; }
        o[r] = fq < 2 ? v[r] * cs - pr * sn : v[r] * cs + pr * sn;
    }
    return o;
}


namespace g8 {
constexpr int BK = 64, HALF = 128, HTB = HALF * BK * 2, STAGE_BYTES = 8 * HTB;
DI int lds_byte(int r, int c) { const int st = (r >> 4) * 2 + (c >> 5), rr = r & 15, cc = c & 31, ob = rr * 64 + cc * 2; return st * 1024 + (ob ^ (((ob >> 9) & 1) << 5)); }
DI void stage_rc(int b, int& R, int& C) { const int st = b / 1024, sb = b % 1024, swz = sb ^ (((sb >> 9) & 1) << 5); R = (st >> 1) * 16 + swz / 64; C = (st & 1) * 32 + (swz % 64) / 2; }
struct GU { const char* a; const char* b; int pm, pn, e, j0; };
DI bool order_next(int i, int nM, int nN, int& pm, int& pn) {
    const int nwg = nM * nN; const long L = (long)i * gridDim.x + blockIdx.x; if (L >= nwg) return false;
    int wgid = (int)L; { const int q = nwg / 8, r = nwg % 8, xcd = wgid % 8, off = wgid / 8; wgid = (xcd < r ? xcd * (q + 1) : r * (q + 1) + (xcd - r) * q) + off; }
    const int nig = 8 * nN, gid = wgid / nig, fm = gid * 8, gsz = (nM - fm) < 8 ? (nM - fm) : 8;
    pm = fm + ((wgid % nig) % gsz); pn = (wgid % nig) / gsz; return true;
}

template <class Epi, class Sched, bool GATHER>
DI void gemm8(char* lds_generic, const int K, const char* Abase, const Sched& S, const Epi& E) {
    LAS unsigned char* lds = (LAS unsigned char*)lds_generic;
    const int tid = otid(), wid = __builtin_amdgcn_readfirstlane(tid >> 6), lane = tid & 63, wr = wid >> 2, wc = wid & 3, fr = lane & 15, fq = lane >> 4;
    const int nt = K / BK;
    int R[2], C[2];
#pragma unroll
    for (int i = 0; i < 2; ++i) stage_rc(tid * 16 + i * 8192, R[i], C[i]);
    unsigned voff[2];
#pragma unroll
    for (int i = 0; i < 2; ++i) voff[i] = (unsigned)(R[i] * K + C[i]) * 2u;
    const size_t kstep = (size_t)(BK * 2), hstep = (size_t)HALF * K * 2;
    const unsigned ldsw = (unsigned)wid * 1024u;
    const int aoff = lds_byte(wr * 64 + fr, fq * 8), boff = lds_byte(wc * 32 + fr, fq * 8);
    unsigned cg[2][2], ng[2][2];
#define G8_SA(b, h) (((b) * 2 + (h)) * HTB)
#define G8_SB(b, h) ((4 + (b) * 2 + (h)) * HTB)
#define G8_LDS(gp, bufoff, i) __builtin_amdgcn_global_load_lds((const unsigned*)(gp), (LAS unsigned*)(lds + (bufoff) + ldsw + (i) * 8192), 16, 0, 0)
#define G8_STAGE_B(bufoff, gbase) do { _Pragma("unroll") for (int _i = 0; _i < 2; ++_i) G8_LDS((const char*)(gbase) + voff[_i], bufoff, _i); } while (0)
#define G8_STAGE_A(bufoff, h, nx, ko) do { _Pragma("unroll") for (int _i = 0; _i < 2; ++_i) { \
        const char* _gp = GATHER ? Abase + (size_t)((nx) ? ng[h][_i] : cg[h][_i]) + (ko) : ((nx) ? nA : cA) + (size_t)(h) * hstep + (ko) + voff[_i]; G8_LDS(_gp, bufoff, _i); } } while (0)
#define G8_LDA(dst, b, h) do { _Pragma("unroll") for (int m = 0; m < 4; ++m) _Pragma("unroll") for (int k = 0; k < 2; ++k) dst[m][k] = *(const LAS bf16x8*)(lds + G8_SA(b, h) + aoff + m * 2048 + k * 1024); } while (0)
#define G8_LDB(dst, b, h) do { _Pragma("unroll") for (int n = 0; n < 2; ++n) _Pragma("unroll") for (int k = 0; k < 2; ++k) dst[n][k] = *(const LAS bf16x8*)(lds + G8_SB(b, h) + boff + n * 2048 + k * 1024); } while (0)
#define G8_MMA(ai, bj, At, Bt) do { __builtin_amdgcn_s_setprio(1); _Pragma("unroll") for (int m = 0; m < 4; ++m) _Pragma("unroll") for (int n = 0; n < 2; ++n) _Pragma("unroll") for (int k = 0; k < 2; ++k) \
        acc[ai][bj][m][n] = __builtin_amdgcn_mfma_f32_16x16x32_bf16(Bt[n][k], At[m][k], acc[ai][bj][m][n], 0, 0, 0); __builtin_amdgcn_s_setprio(0); } while (0)
#define G8_WAIT_V(n) asm volatile("s_waitcnt vmcnt(" #n ")" ::: "memory")
#define G8_WAIT_L(n) asm volatile("s_waitcnt lgkmcnt(" #n ")" ::: "memory")
#define G8_BAR __builtin_amdgcn_s_barrier()
#define G8_SCHED __builtin_amdgcn_sched_barrier(0)
#define G8_GOFF(dst, u) do { if (GATHER) { int _tz = tid; asm volatile("" : "+v"(_tz)); _Pragma("unroll") for (int _i = 0; _i < 2; ++_i) { int _R, _C; stage_rc(_tz * 16 + _i * 8192, _R, _C); \
        _Pragma("unroll") for (int _h = 0; _h < 2; ++_h) dst[_h][_i] = S.arow(u, _h * HALF + _R) * (unsigned)(K * 2) + (unsigned)(_C * 2); } } } while (0)
    GU cur, nxt; int ui = 0;
    __syncthreads();
    if (!S.next(0, cur)) return;
    f32x4 acc[2][2][4][2];
    { const f32x4 z4 = zero4();
#pragma unroll
    for (int a = 0; a < 2; ++a)
#pragma unroll
        for (int b = 0; b < 2; ++b)
#pragma unroll
            for (int m = 0; m < 4; ++m)
#pragma unroll
                for (int n = 0; n < 2; ++n) acc[a][b][m][n] = z4; }
    bf16x8 At[4][2], B0[2][2], B1[2][2];
    const char* cA = cur.a; const char* cB = cur.b; const char* nA = cA; const char* nB = cB;
    G8_GOFF(cg, cur);
#pragma unroll
    for (int _h = 0; _h < 2; ++_h)
#pragma unroll
        for (int _i = 0; _i < 2; ++_i) ng[_h][_i] = cg[_h][_i];
    G8_STAGE_B(G8_SB(0, 0), cB); G8_STAGE_B(G8_SB(0, 1), cB + hstep); G8_STAGE_A(G8_SA(0, 0), 0, false, (size_t)0); G8_STAGE_A(G8_SA(0, 1), 1, false, (size_t)0);
    if (wr == 1) G8_BAR;
    G8_WAIT_V(2); G8_BAR;
    G8_STAGE_B(G8_SB(1, 0), cB + kstep); G8_STAGE_A(G8_SA(1, 0), 0, false, kstep); G8_STAGE_B(G8_SB(1, 1), cB + hstep + kstep);
    G8_WAIT_V(6); G8_BAR;
    for (;;) {
        const bool has_next = S.next(ui + 1, nxt);
        nA = has_next ? nxt.a : cA; nB = has_next ? nxt.b : cB;
        if (has_next) { G8_GOFF(ng, nxt); } else {
#pragma unroll
            for (int _h = 0; _h < 2; ++_h)
#pragma unroll
                for (int _i = 0; _i < 2; ++_i) ng[_h][_i] = cg[_h][_i]; }
        for (int t = 0; t < nt; t += 2) {
            const bool last = (t == nt - 2);
            const size_t k1 = (size_t)(t + 1) * kstep, k2 = last ? (size_t)0 : (size_t)(t + 2) * kstep, k3 = k2 + kstep;
            const char* b2 = last ? nB : cB + (size_t)(t + 2) * kstep; const char* b3 = b2 + kstep;
            G8_LDB(B0, 0, 0); G8_LDB(B1, 0, 1); G8_SCHED; G8_LDA(At, 0, 0); G8_STAGE_A(G8_SA(1, 1), 1, false, k1);
            G8_WAIT_V(8); G8_WAIT_L(0); G8_BAR; G8_MMA(0, 0, At, B0); G8_MMA(0, 1, At, B1); G8_BAR; G8_SCHED;
            G8_LDA(At, 0, 1); G8_STAGE_B(G8_SB(0, 0), b2); G8_STAGE_B(G8_SB(0, 1), b2 + hstep); G8_STAGE_A(G8_SA(0, 0), 0, last, k2);
            G8_WAIT_V(8); G8_WAIT_L(0); G8_BAR; G8_MMA(1, 0, At, B0); G8_MMA(1, 1, At, B1); G8_BAR; G8_SCHED;
            G8_LDB(B0, 1, 0); G8_LDB(B1, 1, 1); G8_SCHED; G8_LDA(At, 1, 0); G8_STAGE_A(G8_SA(0, 1), 1, last, k2);
            G8_WAIT_V(8); G8_WAIT_L(0); G8_BAR; G8_MMA(0, 0, At, B0); G8_MMA(0, 1, At, B1); G8_BAR; G8_SCHED;
            G8_LDA(At, 1, 1); G8_STAGE_B(G8_SB(1, 0), b3); G8_STAGE_B(G8_SB(1, 1), b3 + hstep); G8_STAGE_A(G8_SA(1, 0), 0, last, k3);
            G8_WAIT_V(8); G8_WAIT_L(0); G8_BAR; G8_MMA(1, 0, At, B0); G8_MMA(1, 1, At, B1); G8_BAR; G8_SCHED;
        }
        if (wr == 0) G8_BAR;
        E(acc, cur, wr, wc, fr, fq);
        if (!has_next) break;
        const f32x4 z4 = zero4();
#pragma unroll
        for (int a = 0; a < 2; ++a)
#pragma unroll
            for (int b = 0; b < 2; ++b)
#pragma unroll
                for (int m = 0; m < 4; ++m)
#pragma unroll
                    for (int n = 0; n < 2; ++n) acc[a][b][m][n] = z4;
        cur = nxt; cA = nA; cB = nB; ++ui;
#pragma unroll
        for (int _h = 0; _h < 2; ++_h)
#pragma unroll
            for (int _i = 0; _i < 2; ++_i) cg[_h][_i] = ng[_h][_i];
        if (wr == 1) G8_BAR;
    }
    G8_WAIT_V(0);
    G8_BAR;
#undef G8_SA
#undef G8_SB
#undef G8_LDS
#undef G8_STAGE_A
#undef G8_STAGE_B
#undef G8_LDA
#undef G8_LDB
#undef G8_MMA
#undef G8_WAIT_V
#undef G8_WAIT_L
#undef G8_BAR
#undef G8_SCHED
#undef G8_GOFF
}
}

#define INPROJ_LOOP(BODY) _Pragma("unroll") for (int ai = 0; ai < 2; ++ai) _Pragma("unroll") for (int m = 0; m < 4; ++m) _Pragma("unroll") for (int n = 0; n < 2; ++n) { \
        const int row = row0 + 128 * ai + 16 * m, col = col0 + 16 * n; f32x4 v = acc[ai][bj][m][n]; BODY }
template <int bj>
DI void inproj_half(CParams& p, int l, int nt, const f32x4 (&acc)[2][2][4][2], int row0  , int col0  , int fq) {
    if (nt < 4) {
        INPROJ_LOOP({
            _Pragma("unroll") for (int r = 0; r < 4; ++r) v[r] = geluf_(v[r]);
            store4_bf16(p.Puv + (size_t)row * 512 + col, v); })
    } else if (nt < 6) {
        INPROJ_LOOP({ v = rope_tile(p, v, row, n, fq) * (0.17677669529663687f * LOG2E); store4_bf16(p.Qd + (size_t)row * 256 + (col - 512), v); })
    } else if (nt < 8) {
        INPROJ_LOOP({ v = rope_tile(p, v, row, n, fq); store4_bf16(p.Kd + (size_t)row * 256 + (col - 768), v); })
    } else if (nt < 12) {
        INPROJ_LOOP({
            _Pragma("unroll") for (int r = 0; r < 4; ++r) v[r] = siluf_(v[r]);
            store4_bf16(p.Hq + (size_t)row * 256 + (col - 1280), v); })
    } else if (nt < 18) {
        const int dir = nt >= 16, cb = dir ? 2048 : 1792;
        INPROJ_LOOP({
            const int cc = col - cb;
            const f32x4 lb = *(const f32x4*)(p.lball + (l * 2 + dir) * 256 + cc);
            _Pragma("unroll") for (int r = 0; r < 4; ++r) v[r] = 0.69314718056f * __builtin_amdgcn_logf(lb[r] + (1.0f - lb[r]) * sigmoidf_(v[r]));
            store4_bf16(p.Lf + ((size_t)dir * MR + row) * 256 + cc, v); })
    } else if (nt < 20) {
        INPROJ_LOOP({
            _Pragma("unroll") for (int r = 0; r < 4; ++r) v[r] = siluf_(v[r]);
            store4_bf16(p.Hg + (size_t)row * 256 + (col - 2304), v); })
    } else if (nt < 22) {
        INPROJ_LOOP({ store4_bf16(p.Cq + (size_t)row * 256 + (col - 2560), v); })
    } else if (nt == 22) {
        INPROJ_LOOP({ store4_bf16(p.Ckv + (size_t)row * 128 + (col - 2816), v); })
    } else {
        INPROJ_LOOP({ v = rope_tile(p, v, row, n, fq); if (col < 2976) store4_bf16(p.Kr + (size_t)row * 32 + (col - 2944), v); })
    }
}
struct SchedIn {
    const char* H; const char* W;
    DI bool next(int i, g8::GU& u) const {
        int pm, pn; if (!g8::order_next(i, MR / 256, 12, pm, pn)) return false;
        const bool sw = (pn == 4 || pn == 6);
        u.pm = pm; u.pn = pn; u.e = sw ? 1 : 0; u.j0 = 0;
        const char* ht = H + (size_t)pm * 256 * 2048; const char* wt = W + (size_t)pn * 256 * 2048;
        u.a = sw ? wt : ht; u.b = sw ? ht : wt; return true;
    }
    DI unsigned arow(const g8::GU&, int) const { return 0u; }
};
struct EpiIn {
    CParams* pp; int l;
    DI void operator()(const f32x4 (&acc)[2][2][4][2], const g8::GU& u, int wr, int wc, int fr, int fq) const {
        CParams& p = *pp;
        if (u.e) {
            bf16_t* dst = (u.pn == 4) ? p.Vdt : p.Vht;
            const int m0 = u.pm * 256, b = m0 / TP, t0 = m0 - b * TP;
#pragma unroll
            for (int ai = 0; ai < 2; ++ai)
#pragma unroll
                for (int bj = 0; bj < 2; ++bj)
#pragma unroll
                    for (int m = 0; m < 4; ++m)
#pragma unroll
                        for (int n = 0; n < 2; ++n) {
                            const int f = 128 * ai + 64 * wr + 16 * m + fr, t = t0 + 128 * bj + 32 * wc + 16 * n + 4 * fq;
                            store4_bf16(dst + ((size_t)(b * 256 + f)) * TP + t, acc[ai][bj][m][n]);
                        }
        } else {
            inproj_half<0>(p, l, 2 * u.pn, acc, u.pm * 256 + 64 * wr + fr, u.pn * 256 + 32 * wc + 4 * fq, fq);
            inproj_half<1>(p, l, 2 * u.pn + 1, acc, u.pm * 256 + 64 * wr + fr, u.pn * 256 + 128 + 32 * wc + 4 * fq, fq);
        }
    }
};
DI void phase_inproj(CParams& p, int l, char* lds) {
    SchedIn S; S.H = (const char*)p.H; S.W = (const char*)(p.WinT + (size_t)l * NINP * DM);
    EpiIn E; E.pp = &p; E.l = l;
    g8::gemm8<EpiIn, SchedIn, false>(lds, DM, nullptr, S, E);
}

DI void phase_sgu_prep(CParams& p, int l, char* lds) {
    const int tid = otid(), wid = tid >> 6, lane = tid & 63, fr = lane & 15, fq = lane >> 4;
    constexpr int U_SGU = (MR / 128) * 4, U_PREP = MR / 64;
    float* stats = (float*)(lds + 16384);
    for (int u = blockIdx.x; u < U_SGU + U_PREP; u += gridDim.x) {
        if (u < U_SGU) {
            const int ch = u >> 2, g = u & 3, row0 = ch * 128;
            __syncthreads();
#pragma unroll 1
            for (int i = 0; i < 16; ++i) {
                const int r = wid * 16 + i;
                const u32x2 w = *(const u32x2*)(p.Puv + (size_t)(row0 + r) * 512 + 256 + lane * 4);
                const float a0 = lo2f(w.x), a1 = hi2f(w.x), a2 = lo2f(w.y), a3 = hi2f(w.y);
                const float mean = wave_sum((a0 + a1) + (a2 + a3)) * (1.f / 256.f);
                const float d0 = a0 - mean, d1 = a1 - mean, d2 = a2 - mean, d3 = a3 - mean;
                const float var = wave_sum((d0 * d0 + d1 * d1) + (d2 * d2 + d3 * d3)) * (1.f / 256.f);
                if (lane == 0) { stats[r * 2] = mean; stats[r * 2 + 1] = rsqrtf(var + LN_EPS); }
            }
            __syncthreads();
            {
                const int s = tid >> 2, c0 = (tid & 3) * 16;
                const float mean = stats[s * 2], rstd = stats[s * 2 + 1];
                const bf16_t* src = p.Puv + (size_t)(row0 + s) * 512 + 256 + g * 64 + c0;
                const u32x4 w0 = *(const u32x4*)src, w1 = *(const u32x4*)(src + 8);
                const unsigned ww[8] = {w0.x, w0.y, w0.z, w0.w, w1.x, w1.y, w1.z, w1.w};
                const float* lw = p.sgu_ln_w + l * 256 + g * 64 + c0; const float* lb = p.sgu_ln_b + l * 256 + g * 64 + c0;
#pragma unroll
                for (int j = 0; j < 16; ++j) {
                    const float xv = (j & 1) ? hi2f(ww[j >> 1]) : lo2f(ww[j >> 1]);
                    const float y = (xv - mean) * rstd * lw[j] + lb[j];
                    const int c = c0 + j;
                    const unsigned pk = pk2(y, 0.f);
                    *(bf16_t*)(lds + c * 256 + ((((s >> 3) ^ (c & 15)) << 4) | ((s & 7) * 2))) = (bf16_t)(pk & 0xffffu);
                }
            }
            __syncthreads();
            f32x4 acc[4];
#pragma unroll
            for (int ni = 0; ni < 4; ++ni) acc[ni] = zero4();
            const float* Wg = p.sgu_w + ((size_t)(l * 4 + g) * 128 + wid * 16 + fr) * 128;
#pragma unroll
            for (int ks = 0; ks < 4; ++ks) {
                const f32x4 a0 = *(const f32x4*)(Wg + ks * 32 + fq * 8), a1 = *(const f32x4*)(Wg + ks * 32 + fq * 8 + 4);
                const float av[8] = {a0[0], a0[1], a0[2], a0[3], a1[0], a1[1], a1[2], a1[3]};
                const bf16x8 af = pack8(av);
#pragma unroll
                for (int ni = 0; ni < 4; ++ni) {
                    const int c = ni * 16 + fr;
                    const bf16x8 bfr = *(const bf16x8*)(lds + c * 256 + (((ks * 4 + fq) ^ (c & 15)) << 4));
                    acc[ni] = MFMA16(bfr, af, acc[ni]);
                }
            }
            const int t = wid * 16 + fr, row = row0 + t;
            const float bs = p.sgu_b[(l * 4 + g) * 128 + t];
#pragma unroll
            for (int ni = 0; ni < 4; ++ni) {
                const int c = g * 64 + ni * 16 + fq * 4;
                const u32x2 w = *(const u32x2*)(p.Puv + (size_t)row * 512 + c);
                f32x4 o;
                o[0] = (acc[ni][0] + bs) * lo2f(w.x); o[1] = (acc[ni][1] + bs) * hi2f(w.x);
                o[2] = (acc[ni][2] + bs) * lo2f(w.y); o[3] = (acc[ni][3] + bs) * hi2f(w.y);
                store4_bf16(p.O + (size_t)row * DM + c, o);
            }
        } else {
            const int rbase = (u - U_SGU) * 64 + wid * 8;
#pragma unroll 1
            for (int i = 0; i < 8; ++i) {
                const int row = rbase + i;
                const u32x2 wq = *(const u32x2*)(p.Cq + (size_t)row * 256 + lane * 4);
                const unsigned wk = *(const unsigned*)(p.Ckv + (size_t)row * 128 + lane * 2);
                const float q0 = lo2f(wq.x), q1 = hi2f(wq.x), q2 = lo2f(wq.y), q3 = hi2f(wq.y), k0 = lo2f(wk), k1 = hi2f(wk);
                const float sq = wave_sum((q0 * q0 + q1 * q1) + (q2 * q2 + q3 * q3));
                const float sk = wave_sum(k0 * k0 + k1 * k1);
                if (lane == 0) { p.RS[row * 2] = rsqrtf(sq * (1.f / 256.f) + LN_EPS); p.RS[row * 2 + 1] = rsqrtf(sk * (1.f / 128.f) + LN_EPS); }
            }
        }
    }
}

DI void hgrn_h1_unit(CParams& p, int wu, int lane) {
    const int c = wu % NCH; int t = wu / NCH; const int dir = t & 1, h = (t >> 1) & 3, b = t >> 3;
    const int row0 = b * TP + c * 32, hh = lane >> 5, l31 = lane & 31;
    const bf16_t* Lf = p.Lf + ((size_t)dir * MR + row0) * 256 + h * 64;
    bf16x8 Bf[2][2];
    float* decp = p.DEC + (size_t)wu * 64;
#pragma unroll
    for (int kt = 0; kt < 2; ++kt) {
        const int k = kt * 32 + l31;
        float lf[32], kd[32];
#pragma unroll
        for (int j = 0; j < 32; ++j) lf[j] = bf2f(Lf[(size_t)j * 256 + k]);
        float tot = 0.f;
#pragma unroll
        for (int j = 0; j < 32; ++j) tot += lf[j];
        float run = 0.f;
        if (dir == 0) {
#pragma unroll
            for (int j = 0; j < 32; ++j) { run += lf[j]; kd[j] = (1.0f - __expf(lf[j])) * __expf(tot - run); }
        } else {
#pragma unroll
            for (int j = 31; j >= 0; --j) { run += lf[j]; kd[j] = (1.0f - __expf(lf[j])) * __expf(tot - run); }
        }
        if (hh == 0) decp[k] = __expf(tot);
#pragma unroll
        for (int s = 0; s < 2; ++s) {
            float v8[8];
#pragma unroll
            for (int jj = 0; jj < 8; ++jj) v8[jj] = hh ? kd[16 * s + 8 + jj] : kd[16 * s + jj];
            Bf[kt][s] = pack8(v8);
        }
    }
    const bf16_t* Vt = p.Vht + ((size_t)(b * 4 + h) * 64) * TP + c * 32;
    float* dst = p.DST + (size_t)wu * 4096;
#pragma unroll
    for (int vt = 0; vt < 2; ++vt) {
        bf16x8 Af[2];
#pragma unroll
        for (int s = 0; s < 2; ++s) Af[s] = *(const bf16x8*)(Vt + (size_t)(vt * 32 + l31) * TP + 16 * s + 8 * hh);
#pragma unroll
        for (int kt = 0; kt < 2; ++kt) {
            f32x16 d;
#pragma unroll
            for (int i = 0; i < 16; ++i) d[i] = zf();
            d = MFMA32(Af[0], Bf[kt][0], d);
            d = MFMA32(Af[1], Bf[kt][1], d);
#pragma unroll
            for (int r = 0; r < 16; ++r) dst[(vt * 32 + crow(r, hh)) * 64 + kt * 32 + l31] = d[r];
        }
    }
}

DI void phase_upproj_h1(CParams& p, int l, char* lds) {
    const int tid = otid(), wid = tid >> 6, lane = tid & 63, wr = wid >> 1, wc = wid & 1, fr = lane & 15, fq = lane >> 4;
    constexpr int U_Q = (MR / 256) * 3, U_KV = (MR / 256) * 4, U_H1 = NB * 4 * 2 * NCH / 8;
    for (int u = blockIdx.x; u < U_Q + U_KV + U_H1; u += gridDim.x) {
        if (u < U_Q) {
            const int mt = u / 3, nt = u % 3, m0 = mt * 256, n0 = nt * 128;
            const bf16_t* pa[4]; const bf16_t* pb[2];
            gemm_ptrs(p.Cq, 256, m0, p.WuqT + (size_t)l * 384 * 256, 256, n0, pa, pb);
            f32x4 acc[4][4];
            gemm_core<0>(pa, pb, 256, lds, acc);
#pragma unroll
            for (int mi = 0; mi < 4; ++mi)
#pragma unroll
                for (int ni = 0; ni < 4; ++ni) {
                    const int row = m0 + wr * 64 + mi * 16 + fr, col = n0 + wc * 64 + ni * 16 + fq * 4;
                    f32x4 v = acc[mi][ni] * (p.RS[row * 2] * (0.10206207261596577f * LOG2E));
                    const int cm = col % 96;
                    const f32x4 vr = rope_tile(p, v, row, (cm >> 4) & 1, fq);
                    if (cm >= 64) v = vr;
                    store4_bf16(p.Qm + (size_t)row * 384 + col, v);
                }
        } else if (u < U_Q + U_KV) {
            const int uu = u - U_Q, mt = uu >> 2, nt = uu & 3, m0 = mt * 256, n0 = nt * 128;
            const bf16_t* pa[4]; const bf16_t* pb[2];
            gemm_ptrs(p.Ckv, 128, m0, p.WukvT + (size_t)l * 512 * 128, 128, n0, pa, pb);
            f32x4 acc[4][4];
            if (nt < 2) {
                gemm_core<0>(pa, pb, 128, lds, acc);
#pragma unroll
                for (int mi = 0; mi < 4; ++mi)
#pragma unroll
                    for (int ni = 0; ni < 4; ++ni) {
                        const int row = m0 + wr * 64 + mi * 16 + fr, col = n0 + wc * 64 + ni * 16 + fq * 4;
                        store4_bf16(p.Kn + (size_t)row * 256 + col, acc[mi][ni] * p.RS[row * 2 + 1]);
                    }
            } else {
                gemm_core<1>(pa, pb, 128, lds, acc);
                const int b = m0 / TP, t0 = m0 - b * TP;
#pragma unroll
                for (int mi = 0; mi < 4; ++mi)
#pragma unroll
                    for (int ni = 0; ni < 4; ++ni) {
                        const int f = n0 - 256 + wc * 64 + ni * 16 + fr;
                        const int rl = wr * 64 + mi * 16 + fq * 4;
                        const f32x4 rs = {p.RS[(m0 + rl) * 2 + 1], p.RS[(m0 + rl + 1) * 2 + 1], p.RS[(m0 + rl + 2) * 2 + 1], p.RS[(m0 + rl + 3) * 2 + 1]};
                        store4_bf16(p.Vmt + ((size_t)(b * 256 + f)) * TP + t0 + rl, acc[mi][ni] * rs);
                    }
            }
        } else {
            hgrn_h1_unit(p, (u - U_Q - U_KV) * 8 + wid, lane);
        }
    }
}

DI void hgrn_h2_unit(CParams& p, int cu  ) {
    const int tid = otid();
    if (tid >= 256) return;
    const int gid = cu * 256 + tid;
    const int seq = gid >> 10, e4 = gid & 1023;
    const int dir = seq & 1, k4 = (e4 & 15) * 4;
    f32x4 st = zero4();
    for (int t0 = 0; t0 < NCH; t0 += 8) {
        f32x4 ds[8], dc[8]; float* ptr[8];
#pragma unroll
        for (int j = 0; j < 8; ++j) {
            const int t = t0 + j, pc = dir == 0 ? t : (t < 8 ? 7 - t : 143 - t);
            ptr[j] = p.DST + ((size_t)(seq * NCH + pc)) * 4096 + e4 * 4;
            ds[j] = *(const f32x4*)ptr[j];
            dc[j] = *(const f32x4*)(p.DEC + (size_t)(seq * NCH + pc) * 64 + k4);
        }
#pragma unroll
        for (int j = 0; j < 8; ++j) { *(f32x4*)ptr[j] = st; st = dc[j] * st + ds[j]; }
    }
}

DI void hgrn_h3_unit(CParams& p, int l, int wu, int lane, char* wl) {
    const int pc = wu % NCH; const int t_ = wu / NCH; const int h = t_ & 3, b = t_ >> 2;
    const int row0 = b * TP + pc * 32, hh = lane >> 5, i = lane & 31;
    float* Bl = (float*)wl;
    f32x16 Y[2];
    { const float z = zf();
#pragma unroll
    for (int r = 0; r < 16; ++r) { Y[0][r] = z; Y[1][r] = z; } }
#pragma unroll 1
    for (int dir = 0; dir < 2; ++dir) {
        const bf16_t* Lf = p.Lf + ((size_t)dir * MR + row0) * 256 + h * 64;
        {
            float lf[32];
#pragma unroll
            for (int j = 0; j < 32; ++j) lf[j] = bf2f(Lf[(size_t)j * 256 + lane]);
            float run = 0.f;
            if (dir == 0) {
#pragma unroll
                for (int j = 0; j < 32; ++j) { run += lf[j]; Bl[j * 68 + lane] = run; }
            } else {
#pragma unroll
                for (int j = 31; j >= 0; --j) { run += lf[j]; Bl[j * 68 + lane] = run; }
            }
        }
        __syncthreads();
        bf16x8 Qf[4], Kf[4];
#pragma unroll
        for (int s = 0; s < 4; ++s) {
            const int kb = 16 * s + 8 * hh;
            const u32x4 qw = *(const u32x4*)(p.Hq + (size_t)(row0 + i) * 256 + h * 64 + kb);
            const u32x4 fw = *(const u32x4*)(Lf + (size_t)i * 256 + kb);
            const f32x4 b0 = *(const f32x4*)(Bl + i * 68 + kb), b1 = *(const f32x4*)(Bl + i * 68 + kb + 4);
            const float bb[8] = {b0[0], b0[1], b0[2], b0[3], b1[0], b1[1], b1[2], b1[3]};
            const unsigned qq[4] = {qw.x, qw.y, qw.z, qw.w}, ff[4] = {fw.x, fw.y, fw.z, fw.w};
            float qd[8], kd[8];
#pragma unroll
            for (int j = 0; j < 8; ++j) {
                const float qv = (j & 1) ? hi2f(qq[j >> 1]) : lo2f(qq[j >> 1]);
                const float fv = (j & 1) ? hi2f(ff[j >> 1]) : lo2f(ff[j >> 1]);
                qd[j] = qv * __expf(bb[j]);
                kd[j] = (1.0f - __expf(fv)) * __expf(-bb[j]);
            }
            Qf[s] = pack8(qd); Kf[s] = pack8(kd);
        }
        f32x16 X;
#pragma unroll
        for (int r = 0; r < 16; ++r) X[r] = zf();
#pragma unroll
        for (int s = 0; s < 4; ++s) X = MFMA32(Kf[s], Qf[s], X);
#pragma unroll
        for (int r = 0; r < 16; ++r) { const int j = crow(r, hh); const bool keep = dir == 0 ? (j <= i) : (j >= i); X[r] = keep ? X[r] : 0.f; }
        bf16x8 Xs[2];
#pragma unroll
        for (int s = 0; s < 2; ++s) { const float v8[8] = {X[8 * s], X[8 * s + 1], X[8 * s + 2], X[8 * s + 3], X[8 * s + 4], X[8 * s + 5], X[8 * s + 6], X[8 * s + 7]}; Xs[s] = pack8(v8); }
        const bf16_t* Vt = p.Vht + ((size_t)(b * 4 + h) * 64) * TP + pc * 32;
        const float* ST = p.DST + ((size_t)(((b * 4 + h) * 2 + dir) * NCH + pc)) * 4096;
#pragma unroll
        for (int vt = 0; vt < 2; ++vt) {
            const bf16_t* vrow = Vt + (size_t)(vt * 32 + i) * TP;
#pragma unroll
            for (int s = 0; s < 2; ++s) {
                const u32x2 lo = *(const u32x2*)(vrow + 16 * s + 4 * hh), hi = *(const u32x2*)(vrow + 16 * s + 8 + 4 * hh);
                u32x4 w; w.x = lo.x; w.y = lo.y; w.z = hi.x; w.w = hi.y;
                Y[vt] = MFMA32(__builtin_bit_cast(bf16x8, w), Xs[s], Y[vt]);
            }
            const float* srow = ST + (vt * 32 + i) * 64;
#pragma unroll
            for (int s = 0; s < 4; ++s) {
                const f32x4 a0 = *(const f32x4*)(srow + 16 * s + 8 * hh), a1 = *(const f32x4*)(srow + 16 * s + 8 * hh + 4);
                const float v8[8] = {a0[0], a0[1], a0[2], a0[3], a1[0], a1[1], a1[2], a1[3]};
                Y[vt] = MFMA32(pack8(v8), Qf[s], Y[vt]);
            }
        }
        __syncthreads();
    }
    float ss = 0.f;
#pragma unroll
    for (int r = 0; r < 16; ++r) ss += Y[0][r] * Y[0][r] + Y[1][r] * Y[1][r];
    ss += shx<32>(ss);
    const float rs = rsqrtf(ss * (1.f / 64.f) + LN_EPS);
    const int row = row0 + i;
#pragma unroll
    for (int vt = 0; vt < 2; ++vt)
#pragma unroll
        for (int g4 = 0; g4 < 4; ++g4) {
            const int v0 = vt * 32 + 8 * g4 + 4 * hh;
            const f32x4 nw = *(const f32x4*)(p.hgrn_norm_w + l * 64 + v0);
            const u32x2 gw = *(const u32x2*)(p.Hg + (size_t)row * 256 + h * 64 + v0);
            f32x4 o;
            o[0] = Y[vt][g4 * 4 + 0] * rs * nw[0] * lo2f(gw.x); o[1] = Y[vt][g4 * 4 + 1] * rs * nw[1] * hi2f(gw.x);
            o[2] = Y[vt][g4 * 4 + 2] * rs * nw[2] * lo2f(gw.y); o[3] = Y[vt][g4 * 4 + 3] * rs * nw[3] * hi2f(gw.y);
            store4_bf16(p.O + (size_t)row * DM + 512 + h * 64 + v0, o);
        }
}

template <bool DIFF>
DI void attn_unit(CParams& p, int l, int b, int h, int qrow0  , int nkt  , char* lds) {
    const int tid = otid(), wid = tid >> 6, lane = tid & 63, hh = lane >> 5, q31 = lane & 31;
    constexpr int NS = DIFF ? 2 : 1;
    constexpr int NQF = DIFF ? 4 : 6;
    constexpr int BUF = 8192 + 8192 + (DIFF ? 0 : 4096);
    const int qrow = qrow0 + wid * 32 + q31;
    bf16x8 Qf[NQF];
    {
        const bf16_t* qp = DIFF ? p.Qd + (size_t)qrow * 256 + h * 64 : p.Qm + (size_t)qrow * 384 + h * 96;
#pragma unroll
        for (int s = 0; s < NQF; ++s) Qf[s] = *(const bf16x8*)(qp + 16 * s + 8 * hh);
    }
    const size_t krow0 = (size_t)b * TP;
    const bf16_t* kptr = (DIFF ? p.Kd : p.Kn) + (krow0 + (tid >> 3)) * 256 + h * 64 + (tid & 7) * 8;
    const bf16_t* vptr = (DIFF ? p.Vdt : p.Vmt) + ((size_t)(b * 4 + h) * 64 + (tid >> 3)) * TP + (tid & 7) * 8;
    const bf16_t* rptr = p.Kr + (krow0 + ((tid & 255) >> 2)) * 32 + (tid & 3) * 8;
    const int key_w = tid >> 3, c_w = tid & 7;
    const int kwoff = key_w * 128 + ((c_w ^ ((key_w >> 1) & 7)) << 4);
    const int d_w = tid >> 3;
    const int vwoff0 = 8192 + d_w * 128 + (((2 * c_w) ^ ((d_w >> 1) & 15)) << 3), vwoff1 = 8192 + d_w * 128 + (((2 * c_w + 1) ^ ((d_w >> 1) & 15)) << 3);
    const int rkey = (tid & 255) >> 2, rc = tid & 3;
    const int rwoff = 16384 + rkey * 64 + ((rc ^ ((rkey >> 2) & 3)) << 4);
    const int krd = q31 * 128, ksw = (q31 >> 1) & 7;
    const int rrd = 16384 + q31 * 64, rsw = (q31 >> 2) & 3;
    const int vrd = 8192 + q31 * 128, vsw = (q31 >> 1) & 15;
    f32x16 ot[NS][2];
    float m[NS], lsum[NS];
#pragma unroll
    for (int a = 0; a < NS; ++a) { m[a] = -1e30f; lsum[a] = 0.f;
#pragma unroll
        for (int r = 0; r < 16; ++r) { ot[a][0][r] = zf(); ot[a][1][r] = zf(); } }
    u32x4 rk, rv, rr;
    rk = *(const u32x4*)kptr; rv = *(const u32x4*)vptr;
    if (!DIFF) { if (tid < 256) rr = *(const u32x4*)rptr; }
    __syncthreads();
    *(u32x4*)(lds + kwoff) = rk;
    *(u32x2*)(lds + vwoff0) = (u32x2){rv.x, rv.y}; *(u32x2*)(lds + vwoff1) = (u32x2){rv.z, rv.w};
    if (!DIFF) { if (tid < 256) *(u32x4*)(lds + rwoff) = rr; }
    __syncthreads();
    for (int kt = 0; kt < nkt; ++kt) {
        const char* cur = lds + (kt & 1) * BUF;
        const bool more = kt + 1 < nkt;
        if (more) {
            rk = *(const u32x4*)(kptr + (size_t)(kt + 1) * 64 * 256);
            rv = *(const u32x4*)(vptr + (kt + 1) * 64);
            if (!DIFF) { if (tid < 256) rr = *(const u32x4*)(rptr + (size_t)(kt + 1) * 64 * 32); }
        }
        bf16x8 Pf[NS][2][2];
#pragma unroll
        for (int a = 0; a < NS; ++a) {
            f32x16 st[2];
#pragma unroll
            for (int t = 0; t < 2; ++t) {
                f32x16 acc;
                { const float z = zf();
#pragma unroll
                for (int r = 0; r < 16; ++r) acc[r] = z; }
                if (DIFF) {
#pragma unroll
                    for (int s = 0; s < 2; ++s) {
                        const int c = 4 * a + 2 * s + hh;
                        const bf16x8 kf = *(const bf16x8*)(cur + t * 4096 + krd + ((c ^ ksw) << 4));
                        acc = MFMA32(kf, Qf[2 * a + s], acc);
                    }
                } else {
#pragma unroll
                    for (int s = 0; s < 4; ++s) {
                        const int c = 2 * s + hh;
                        const bf16x8 kf = *(const bf16x8*)(cur + t * 4096 + krd + ((c ^ ksw) << 4));
                        acc = MFMA32(kf, Qf[s], acc);
                    }
#pragma unroll
                    for (int s = 0; s < 2; ++s) {
                        const int c = 2 * s + hh;
                        const bf16x8 kf = *(const bf16x8*)(cur + t * 2048 + rrd + ((c ^ rsw) << 4));
                        acc = MFMA32(kf, Qf[4 + s], acc);
                    }
                }
                st[t] = acc;
            }
            float tm = st[0][0];
#pragma unroll
            for (int r = 1; r < 16; ++r) tm = fmaxf(tm, st[0][r]);
#pragma unroll
            for (int r = 0; r < 16; ++r) tm = fmaxf(tm, st[1][r]);
            tm = fmaxf(tm, shx<32>(tm));
            const float mn = fmaxf(m[a], tm);
            const float alpha = __builtin_amdgcn_exp2f(m[a] - mn);
            m[a] = mn;
            float ps = 0.f;
#pragma unroll
            for (int t = 0; t < 2; ++t) {
#pragma unroll
                for (int r = 0; r < 16; ++r) { const float e = __builtin_amdgcn_exp2f(st[t][r] - mn); st[t][r] = e; ps += e; }
#pragma unroll
                for (int s = 0; s < 2; ++s) {
                    const float v8[8] = {st[t][8 * s], st[t][8 * s + 1], st[t][8 * s + 2], st[t][8 * s + 3], st[t][8 * s + 4], st[t][8 * s + 5], st[t][8 * s + 6], st[t][8 * s + 7]};
                    Pf[a][t][s] = pack8(v8);
                }
            }
            lsum[a] = lsum[a] * alpha + ps;
#pragma unroll
            for (int r = 0; r < 16; ++r) { ot[a][0][r] *= alpha; ot[a][1][r] *= alpha; }
            if (DIFF) __builtin_amdgcn_sched_barrier(0);
        }
#pragma unroll
        for (int dt = 0; dt < 2; ++dt)
#pragma unroll
            for (int t = 0; t < 2; ++t)
#pragma unroll
                for (int s = 0; s < 2; ++s) {
                    const int c8 = 8 * t + 4 * s + hh;
                    const u32x2 lo = *(const u32x2*)(cur + dt * 4096 + vrd + ((c8 ^ vsw) << 3));
                    const u32x2 hi = *(const u32x2*)(cur + dt * 4096 + vrd + (((c8 + 2) ^ vsw) << 3));
                    u32x4 w; w.x = lo.x; w.y = lo.y; w.z = hi.x; w.w = hi.y;
                    const bf16x8 vf = __builtin_bit_cast(bf16x8, w);
#pragma unroll
                    for (int a = 0; a < NS; ++a) ot[a][dt] = MFMA32(vf, Pf[a][t][s], ot[a][dt]);
                }
        if (more) {
            char* nxt = lds + ((kt + 1) & 1) * BUF;
            *(u32x4*)(nxt + kwoff) = rk;
            *(u32x2*)(nxt + vwoff0) = (u32x2){rv.x, rv.y}; *(u32x2*)(nxt + vwoff1) = (u32x2){rv.z, rv.w};
            if (!DIFF) { if (tid < 256) *(u32x4*)(nxt + rwoff) = rr; }
        }
        __syncthreads();
    }
    float linv[NS];
#pragma unroll
    for (int a = 0; a < NS; ++a) { const float lt = lsum[a] + shx<32>(lsum[a]); linv[a] = 1.0f / lt; }
    f32x16 o[2];
    if (DIFF) {
        const float lam = p.lam[l];
#pragma unroll
        for (int dt = 0; dt < 2; ++dt)
#pragma unroll
            for (int r = 0; r < 16; ++r) o[dt][r] = ot[0][dt][r] * linv[0] - lam * (ot[NS - 1][dt][r] * linv[NS - 1]);
        float ss = 0.f;
#pragma unroll
        for (int r = 0; r < 16; ++r) ss += o[0][r] * o[0][r] + o[1][r] * o[1][r];
        ss += shx<32>(ss);
        const float lam_init = 0.8f - 0.6f * __expf(-0.3f * (float)l);
        const float rs = rsqrtf(ss * (1.f / 64.f) + LN_EPS) * (1.0f - lam_init);
#pragma unroll
        for (int dt = 0; dt < 2; ++dt)
#pragma unroll
            for (int r = 0; r < 16; ++r) o[dt][r] *= rs;
    } else {
#pragma unroll
        for (int dt = 0; dt < 2; ++dt)
#pragma unroll
            for (int r = 0; r < 16; ++r) o[dt][r] = ot[0][dt][r] * linv[0];
    }
    bf16_t* orow = p.O + (size_t)qrow * DM + (DIFF ? 256 : 768) + h * 64;
#pragma unroll
    for (int dt = 0; dt < 2; ++dt)
#pragma unroll
        for (int g4 = 0; g4 < 4; ++g4) {
            const int d0 = dt * 32 + 8 * g4 + 4 * hh;
            f32x4 v = {o[dt][g4 * 4], o[dt][g4 * 4 + 1], o[dt][g4 * 4 + 2], o[dt][g4 * 4 + 3]};
            if (DIFF) { const f32x4 sw = *(const f32x4*)(p.diff_subln_w + l * 64 + d0); v = v * sw; }
            store4_bf16(orow + d0, v);
        }
}

DI void phase_attn_diff_h2(CParams& p, int l, char* lds, bool h2skip) {
    const int U_H2 = 256, U_LAT = NB * 4 * 16, U_CTX = (l == 0) ? NB * 4 : 0;
    for (int u = blockIdx.x; u < U_H2 + U_LAT + U_CTX; u += gridDim.x) {
        if (u < U_H2) { if (!h2skip) hgrn_h2_unit(p, u); }
        else {
            int b, h, q0, nkt; const int v = u - U_H2;
            if (v < U_LAT) { b = v >> 6; h = (v >> 4) & 3; q0 = b * TP + CTX + (v & 15) * 256; nkt = TP / 64; }
            else { const int w = v - U_LAT; b = w >> 2; h = w & 3; q0 = b * TP; nkt = CTX / 64; }
            attn_unit<true>(p, l, b, h, q0, nkt, lds);
        }
    }
}
DI void phase_attn_mla_h3(CParams& p, int l, char* lds) {
    const int tid_ = otid(); const int wid = tid_ >> 6, lane = tid_ & 63;
    const int U_LAT = NB * 4 * 16, U_CTX = (l == 0) ? NB * 4 : 0, U_H3 = NB * 4 * NCH / 8;
    for (int u = blockIdx.x; u < U_LAT + U_CTX + U_H3; u += gridDim.x) {
        if (u < U_LAT + U_CTX) {
            int b, h, q0, nkt;
            if (u < U_LAT) { b = u >> 6; h = (u >> 4) & 3; q0 = b * TP + CTX + (u & 15) * 256; nkt = TP / 64; }
            else { const int w = u - U_LAT; b = w >> 2; h = w & 3; q0 = b * TP; nkt = CTX / 64; }
            attn_unit<false>(p, l, b, h, q0, nkt, lds);
        } else { __syncthreads(); hgrn_h3_unit(p, l, (u - U_LAT - U_CTX) * 8 + wid, lane, lds + 65536 + wid * 8704); }
    }
}

struct SchedOut {
    const char* O; const char* W; int l;
    DI bool next(int i, g8::GU& u) const {
        int pm, pn;
        if (l == 0) { if (!g8::order_next(i, MR / 256, 4, pm, pn)) return false; }
        else { if (!g8::order_next(i, NB * 16, 4, pm, pn)) return false; pm = (pm >> 4) * 17 + 1 + (pm & 15); }
        u.pm = pm; u.pn = pn; u.e = 0; u.j0 = 0; u.a = O + (size_t)pm * 256 * 2048; u.b = W + (size_t)pn * 256 * 2048; return true;
    }
    DI unsigned arow(const g8::GU&, int) const { return 0u; }
};
struct EpiOut {
    float* Y;
    DI void operator()(const f32x4 (&acc)[2][2][4][2], const g8::GU& u, int wr, int wc, int fr, int fq) const {
#pragma unroll
        for (int ai = 0; ai < 2; ++ai)
#pragma unroll
            for (int bj = 0; bj < 2; ++bj)
#pragma unroll
                for (int m = 0; m < 4; ++m)
#pragma unroll
                    for (int n = 0; n < 2; ++n) {
                        const int row = u.pm * 256 + 128 * ai + 64 * wr + 16 * m + fr, col = u.pn * 256 + 128 * bj + 32 * wc + 16 * n + 4 * fq;
                        *(f32x4*)(Y + (size_t)row * DM + col) = acc[ai][bj][m][n];
                    }
    }
};
DI void phase_outproj(CParams& p, int l, char* lds) {
    SchedOut S; S.O = (const char*)p.O; S.W = (const char*)(p.WoutT + (size_t)l * DM * DM); S.l = l;
    EpiOut E; E.Y = p.Y;
    g8::gemm8<EpiOut, SchedOut, false>(lds, DM, nullptr, S, E);
}

DI void phase_postmix(CParams& p, int l, char* lds) {
    const int tid = otid(), wid = tid >> 6, lane = tid & 63;
    float* WrT = (float*)lds;
    int* lcnt = (int*)(lds + 131072);
    int* lbase = lcnt + 32;
    unsigned* ent = (unsigned*)(lds + 131072 + 256);
    const int G = gridDim.x, nrb = (MR + G - 1) / G;
    const float* rw = p.router_w + (size_t)l * DM * NE;
    __syncthreads();
    for (int i = tid; i < DM * NE / 4; i += NTHREADS) {
        const f32x4 v = *(const f32x4*)(rw + i * 4);
        const int d = i >> 3, e0 = (i & 7) * 4;
#pragma unroll
        for (int j = 0; j < 4; ++j) WrT[(e0 + j) * DM + d] = v[j];
    }
    if (tid < 32) lcnt[tid] = 0;
    __syncthreads();
    const int rbeg = blockIdx.x * nrb;
    const float* lw = p.ln_mix_w + l * DM; const float* lb = p.ln_mix_b + l * DM;
    for (int i0 = wid * 2; i0 < nrb; i0 += 16) {
        f32x4 v[2][4]; bool act[2];
#pragma unroll
        for (int rr = 0; rr < 2; ++rr) {
            const int i = i0 + rr; int row = rbeg + i;
            act[rr] = (i < nrb) && (row < MR);
            if (!act[rr]) row = rbeg;
            const int t = row % TP;
            if (l == 1 && t < CTX) { if (act[rr] && lane < 4) ent[(i * 4 + lane) * 2] = 0xffffffffu; act[rr] = false; }
            const float* xr = l == 0 ? in_row(p, row) : p.X + (size_t)row * DM;
            const float* yr = p.Y + (size_t)row * DM;
            const float* g1 = mod_vec(p, l, row, 2); const float* sh2 = mod_vec(p, l, row, 3); const float* sc2 = mod_vec(p, l, row, 4);
            float s = 0.f;
#pragma unroll
            for (int j = 0; j < 4; ++j) { const int c = j * 256 + lane * 4; v[rr][j] = *(const f32x4*)(xr + c) * DN_ALPHA + *(const f32x4*)(g1 + c) * *(const f32x4*)(yr + c); s += (v[rr][j][0] + v[rr][j][1]) + (v[rr][j][2] + v[rr][j][3]); }
            float mean = wave_sum(s) * (1.f / DM); float q = 0.f;
#pragma unroll
            for (int j = 0; j < 4; ++j) { v[rr][j] = v[rr][j] - mean; q += (v[rr][j][0] * v[rr][j][0] + v[rr][j][1] * v[rr][j][1]) + (v[rr][j][2] * v[rr][j][2] + v[rr][j][3] * v[rr][j][3]); }
            float rstd = rsqrtf(wave_sum(q) * (1.f / DM) + LN_EPS);
            s = 0.f;
#pragma unroll
            for (int j = 0; j < 4; ++j) { const int c = j * 256 + lane * 4; v[rr][j] = v[rr][j] * rstd * *(const f32x4*)(lw + c) + *(const f32x4*)(lb + c);
                if (act[rr]) *(f32x4*)(p.X + (size_t)row * DM + c) = v[rr][j];
                s += (v[rr][j][0] + v[rr][j][1]) + (v[rr][j][2] + v[rr][j][3]); }
            mean = wave_sum(s) * (1.f / DM); q = 0.f;
#pragma unroll
            for (int j = 0; j < 4; ++j) { v[rr][j] = v[rr][j] - mean; q += (v[rr][j][0] * v[rr][j][0] + v[rr][j][1] * v[rr][j][1]) + (v[rr][j][2] * v[rr][j][2] + v[rr][j][3] * v[rr][j][3]); }
            rstd = rsqrtf(wave_sum(q) * (1.f / DM) + LN_EPS);
#pragma unroll
            for (int j = 0; j < 4; ++j) { const int c = j * 256 + lane * 4; v[rr][j] = v[rr][j] * rstd * (*(const f32x4*)(sc2 + c) + 1.0f) + *(const f32x4*)(sh2 + c);
                if (act[rr]) store4_bf16(p.H + (size_t)row * DM + c, v[rr][j]); }
            __builtin_amdgcn_sched_barrier(0);
        }
        float lq[2][4];
#pragma unroll
        for (int qt = 0; qt < 4; ++qt) {
            float pl[2][8];
#pragma unroll
            for (int e = 0; e < 8; ++e) {
                float a0 = 0.f, a1 = 0.f;
#pragma unroll
                for (int j = 0; j < 4; ++j) {
                    const f32x4 w = *(const f32x4*)(WrT + (qt * 8 + e) * DM + j * 256 + lane * 4);
                    a0 += (v[0][j][0] * w[0] + v[0][j][1] * w[1]) + (v[0][j][2] * w[2] + v[0][j][3] * w[3]);
                    a1 += (v[1][j][0] * w[0] + v[1][j][1] * w[1]) + (v[1][j][2] * w[2] + v[1][j][3] * w[3]);
                }
                pl[0][e] = a0; pl[1][e] = a1;
                if ((e & 3) == 3) __builtin_amdgcn_sched_barrier(0);
            }
#pragma unroll
            for (int rr = 0; rr < 2; ++rr) {
                float r4[4], r2[2];
#pragma unroll
                for (int e = 0; e < 4; ++e) { const bool up = (lane & 4) != 0; const float keep = up ? pl[rr][e + 4] : pl[rr][e]; const float send = up ? pl[rr][e] : pl[rr][e + 4]; r4[e] = keep + dpp<DPP_HM>(send); }
#pragma unroll
                for (int e = 0; e < 2; ++e) { const bool up = (lane & 2) != 0; const float keep = up ? r4[e + 2] : r4[e]; const float send = up ? r4[e] : r4[e + 2]; r2[e] = keep + dpp<DPP_X2>(send); }
                float x1; { const bool up = (lane & 1) != 0; const float keep = up ? r2[1] : r2[0]; const float send = up ? r2[0] : r2[1]; x1 = keep + dpp<DPP_X1>(send); }
                x1 += shx<8>(x1); x1 += shx<16>(x1); x1 += shx<32>(x1);
                lq[rr][qt] = x1;
            }
            __builtin_amdgcn_sched_barrier(0);
        }
#pragma unroll
        for (int rr = 0; rr < 2; ++rr) {
            const int i = i0 + rr;
            const int e_me = lane & 31;
            const int qsel = (lane >> 3) & 3;
            float logit = (qsel == 0 ? lq[rr][0] : qsel == 1 ? lq[rr][1] : qsel == 2 ? lq[rr][2] : lq[rr][3]) + p.router_b[l * NE + e_me];
            logit = (logit == logit) ? fminf(fmaxf(logit, -1e30f), 1e30f) : -1e30f;
            int rank = 0;
#pragma unroll
            for (int e = 0; e < 32; ++e) { const float o = rdlane(logit, e); rank += (o > logit || (o == logit && e < e_me)) ? 1 : 0; }
            const float vmax = rdlane(logit, __builtin_amdgcn_readfirstlane(__ffsll((long long)__ballot(rank == 0 && lane < 32)) - 1));
            const float ex = (rank < 4) ? __expf(logit - vmax) : 0.f;
            const float den = wave_sum((lane < 32) ? ex : 0.f);
            if (act[rr] && lane < 32 && rank < 4) {
                const int lp = atomicAdd(&lcnt[e_me], 1);
                ent[(i * 4 + rank) * 2] = (unsigned)e_me | ((unsigned)lp << 8);
                ent[(i * 4 + rank) * 2 + 1] = __float_as_uint(ex / den);
            }
        }
    }
    __syncthreads();
    if (tid < 32) lbase[tid] = (int)atomicAdd(&p.gcnt[l * NE + tid], (unsigned)lcnt[tid]);
    __syncthreads();
    for (int j = tid; j < nrb * 4; j += NTHREADS) {
        const int row = rbeg + (j >> 2);
        if (row >= MR) break;
        const unsigned w = ent[j * 2];
        if (w == 0xffffffffu) continue;
        const int e = w & 255, pos = lbase[e] + (int)(w >> 8);
        p.ltok[(size_t)e * MR + pos] = row;
        p.lgate[(size_t)e * MR + pos] = __uint_as_float(ent[j * 2 + 1]);
        p.rslot[(size_t)row * 4 + (j & 3)] = (e << 24) | pos;
    }
}

DI int moe_prefix(CParams& p, int l, int* tpre  ) {
    __syncthreads();
    if (otid() == 0) {
        int acc = 0;
        for (int e = 0; e < NE; ++e) { tpre[e] = acc; acc += ((int)p.gcnt[l * NE + e] + 255) >> 8; }
        tpre[NE] = acc;
    }
    __syncthreads();
    return tpre[NE];
}
DI int moe_find(const int* tpre, int mt) { int e = 0;
#pragma unroll 1
    for (int j = 0; j < NE; ++j) if (tpre[j + 1] <= mt) e = j + 1;
    return e; }

constexpr int TPRE_OFF = 135168;
struct SchedMoe {
    const int* tpre; const unsigned* cnt; const int* ltok; const char* A; const char* W; int nN; size_t wstride;
    DI bool next(int i, g8::GU& u) const {
        int pm, pn; if (!g8::order_next(i, __builtin_amdgcn_readfirstlane(tpre[NE]), nN, pm, pn)) return false;
        const int e = __builtin_amdgcn_readfirstlane(moe_find(tpre, pm));
        u.pm = pm; u.pn = pn; u.e = e; u.j0 = __builtin_amdgcn_readfirstlane((pm - tpre[e]) * 256);
        u.a = A + (size_t)pm * 256 * 2048; u.b = W + (size_t)e * wstride + (size_t)pn * 256 * 2048; return true;
    }
    DI unsigned arow(const g8::GU& u, int r) const { const int pos = u.j0 + r; return pos < (int)cnt[u.e] ? (unsigned)ltok[(size_t)u.e * MR + pos] : 0u; }
};
struct EpiMoe1 {
    const float* b1; bf16_t* ACT;
    DI void operator()(const f32x4 (&acc)[2][2][4][2], const g8::GU& u, int wr, int wc, int fr, int fq) const {
        const float* bb1 = b1 + (size_t)u.e * 2048;
#pragma unroll
        for (int ai = 0; ai < 2; ++ai)
#pragma unroll
            for (int bj = 0; bj < 2; ++bj)
#pragma unroll
                for (int m = 0; m < 4; ++m)
#pragma unroll
                    for (int n = 0; n < 2; ++n) {
                        const int rl = 128 * ai + 64 * wr + 16 * m + fr, col = u.pn * 256 + 128 * bj + 32 * wc + 16 * n + 4 * fq;
                        const f32x4 hv = acc[ai][bj][m][n] + *(const f32x4*)(bb1 + col);
                        float o[2];
#pragma unroll
                        for (int q = 0; q < 2; ++q) {
                            const float glu = fminf(hv[2 * q], 7.0f), lin = fminf(fmaxf(hv[2 * q + 1], -7.0f), 7.0f);
                            o[q] = glu * sigmoidf_(1.702f * glu) * (lin + 1.0f);
                        }
                        *(unsigned*)(ACT + ((size_t)u.pm * 256 + rl) * 1024 + (col >> 1)) = pk2(o[0], o[1]);
                    }
    }
};
struct EpiMoe2 {
    const float* b2; const float* lgate; const unsigned* cnt; bf16_t* YS;
    DI void operator()(const f32x4 (&acc)[2][2][4][2], const g8::GU& u, int wr, int wc, int fr, int fq) const {
        const float* bb2 = b2 + (size_t)u.e * DM;
        const int cn = (int)cnt[u.e];
#pragma unroll
        for (int ai = 0; ai < 2; ++ai)
#pragma unroll
            for (int m = 0; m < 4; ++m) {
                const int rl = 128 * ai + 64 * wr + 16 * m + fr, pos = u.j0 + rl;
                const float gate = pos < cn ? lgate[(size_t)u.e * MR + pos] : 0.f;
#pragma unroll
                for (int bj = 0; bj < 2; ++bj)
#pragma unroll
                    for (int n = 0; n < 2; ++n) {
                        const int col = u.pn * 256 + 128 * bj + 32 * wc + 16 * n + 4 * fq;
                        store4_bf16(YS + ((size_t)u.pm * 256 + rl) * 1024 + col, (acc[ai][bj][m][n] + *(const f32x4*)(bb2 + col)) * gate);
                    }
                __builtin_amdgcn_sched_barrier(0);
            }
    }
};
DI void phase_moe1(CParams& p, int l, char* lds) {
    int* tpre = (int*)(lds + TPRE_OFF);
    moe_prefix(p, l, tpre);
    SchedMoe S; S.tpre = tpre; S.cnt = p.gcnt + l * NE; S.ltok = p.ltok; S.A = nullptr; S.W = (const char*)(p.W1T + (size_t)l * NE * 2048 * DM); S.nN = 8; S.wstride = (size_t)2048 * DM * 2;
    EpiMoe1 E; E.b1 = p.b1 + (size_t)l * NE * 2048; E.ACT = p.ACT;
    g8::gemm8<EpiMoe1, SchedMoe, true>(lds, DM, (const char*)p.H, S, E);
}
DI void phase_moe2(CParams& p, int l, char* lds) {
    int* tpre = (int*)(lds + TPRE_OFF);
    moe_prefix(p, l, tpre);
    SchedMoe S; S.tpre = tpre; S.cnt = p.gcnt + l * NE; S.ltok = p.ltok; S.A = (const char*)p.ACT; S.W = (const char*)(p.W2T + (size_t)l * NE * DM * DM); S.nN = 4; S.wstride = (size_t)DM * DM * 2;
    EpiMoe2 E; E.b2 = p.b2 + (size_t)l * NE * DM; E.lgate = p.lgate; E.cnt = p.gcnt + l * NE; E.YS = p.YS;
    g8::gemm8<EpiMoe2, SchedMoe, false>(lds, DM, nullptr, S, E);
}

DI void phase_final(CParams& p, int l, char* lds) {
    const int tid = otid(), wid = tid >> 6, lane = tid & 63;
    int* tpre = (int*)(lds + TPRE_OFF);
    moe_prefix(p, l, tpre);
    const float* lw = p.ln_ffn_w + l * DM; const float* lb = p.ln_ffn_b + l * DM;
    for (int row = blockIdx.x * 8 + wid; row < MR; row += gridDim.x * 8) {
        const int b = row / TP, t = row - b * TP;
        if (l == 1 && t < CTX) continue;
        const float* g2 = mod_vec(p, l, row, 5);
        const bf16_t* ys[4];
#pragma unroll
        for (int k = 0; k < 4; ++k) { const int rs = p.rslot[(size_t)row * 4 + k]; const int e = rs >> 24, pos = rs & 0xffffff; ys[k] = p.YS + ((size_t)tpre[e] * 256 + pos) * 1024; }
        f32x4 v[4]; float s = 0.f;
#pragma unroll
        for (int j = 0; j < 4; ++j) {
            const int c = j * 256 + lane * 4;
            f32x4 y = zero4();
#pragma unroll
            for (int k = 0; k < 4; ++k) { const u32x2 w = *(const u32x2*)(ys[k] + c); y[0] += lo2f(w.x); y[1] += hi2f(w.x); y[2] += lo2f(w.y); y[3] += hi2f(w.y); }
            const f32x4 xv = *(const f32x4*)(p.X + (size_t)row * DM + c), gg = *(const f32x4*)(g2 + c);
            v[j] = xv * DN_ALPHA + gg * y;
            s += (v[j][0] + v[j][1]) + (v[j][2] + v[j][3]);
        }
        float mean = wave_sum(s) * (1.f / DM); float q = 0.f;
#pragma unroll
        for (int j = 0; j < 4; ++j) { v[j] = v[j] - mean; q += (v[j][0] * v[j][0] + v[j][1] * v[j][1]) + (v[j][2] * v[j][2] + v[j][3] * v[j][3]); }
        float rstd = rsqrtf(wave_sum(q) * (1.f / DM) + LN_EPS);
        s = 0.f;
#pragma unroll
        for (int j = 0; j < 4; ++j) {
            const int c = j * 256 + lane * 4;
            v[j] = v[j] * rstd * *(const f32x4*)(lw + c) + *(const f32x4*)(lb + c);
            s += (v[j][0] + v[j][1]) + (v[j][2] + v[j][3]);
        }
        if (l == 1) {
            float* o = p.out + ((size_t)b * SEQ + (t - CTX)) * DM;
#pragma unroll
            for (int j = 0; j < 4; ++j) *(f32x4*)(o + j * 256 + lane * 4) = v[j];
        } else {
#pragma unroll
            for (int j = 0; j < 4; ++j) *(f32x4*)(p.X + (size_t)row * DM + j * 256 + lane * 4) = v[j];
            mean = wave_sum(s) * (1.f / DM); q = 0.f;
#pragma unroll
            for (int j = 0; j < 4; ++j) { v[j] = v[j] - mean; q += (v[j][0] * v[j][0] + v[j][1] * v[j][1]) + (v[j][2] * v[j][2] + v[j][3] * v[j][3]); }
            rstd = rsqrtf(wave_sum(q) * (1.f / DM) + LN_EPS);
            const float* sh = mod_vec(p, 1, row, 0); const float* sc = mod_vec(p, 1, row, 1);
#pragma unroll
            for (int j = 0; j < 4; ++j) {
                const int c = j * 256 + lane * 4;
                const f32x4 h = v[j] * rstd * (*(const f32x4*)(sc + c) + 1.0f) + *(const f32x4*)(sh + c);
                store4_bf16(p.H + (size_t)row * DM + c, h);
            }
        }
    }
}

constexpr int PH_PER_LAYER = 11, N_PHASES = 1 + 2 * PH_PER_LAYER;

__global__ void __launch_bounds__(NTHREADS, 2) mega(Params p_unused, int ph_lo, int ph_hi) {
    extern __shared__ __attribute__((aligned(16))) char smem[];
    CParams* kp0 = (CParams*)__builtin_amdgcn_kernarg_segment_ptr();
    CParams& p = *kp0;
    ((volatile int*)(smem + WVTAB_OFF))[hw_slot()] = (int)(threadIdx.x >> 6);
    __syncthreads();
    const bool fused = (ph_hi - ph_lo) > 1;
    XcdBarrier bar; bar.bar = p.bar; bar.x = 0; bar.st = (volatile LAS unsigned*)(smem + LDS_BYTES - 16);
    if (fused) {
        if (otid() == 0) *(uint4*)(smem + LDS_BYTES - 16) = make_uint4(0u, 0u, 0u, 0u);
        __syncthreads();
        bar = xcd_barrier_post(p.bar, (volatile LAS unsigned*)(smem + LDS_BYTES - 16));
    }
#if MK_DEBUG == 2
#define PH_STAMP(i) if (blockIdx.x == 0 && threadIdx.x == 0) ((unsigned long long*)(p.gcnt + 1024))[(i) + 1] = wall_clock64();
#else
#define PH_STAMP(i)
#endif
#ifndef MK_REP
#define MK_REP 0u
#endif
#define PH(idx, call) do { const int _i = (idx); if (ph_lo <= _i && _i < ph_hi) { CParams* _kp = kp0; asm volatile("" : "+s"(_kp)); CParams& p = *_kp; call; if ((MK_REP >> (_i == 0 ? 0 : 1 + (_i - 1) % 11)) & 1u) { xcd_barrier(bar); h2skip = true; call; h2skip = false; } if (_i + 1 < ph_hi) xcd_barrier(bar); PH_STAMP(_i) } } while (0)
    bool h2skip = false;
    PH_STAMP(-1)
    PH(0, phase_prologue(p, smem));
#pragma unroll 1
    for (int l = 0; l < 2; ++l) {
        const int base = 1 + l * PH_PER_LAYER;
        PH(base + 0, if (l == 0) phase_ln1(p, smem));
        PH(base + 1, phase_inproj(p, l, smem));
        PH(base + 2, phase_sgu_prep(p, l, smem));
        PH(base + 3, phase_upproj_h1(p, l, smem));
        PH(base + 4, phase_attn_diff_h2(p, l, smem, h2skip));
        PH(base + 5, phase_attn_mla_h3(p, l, smem));
        PH(base + 6, phase_outproj(p, l, smem));
        PH(base + 7, phase_postmix(p, l, smem));
        PH(base + 8, phase_moe1(p, l, smem));
        PH(base + 9, phase_moe2(p, l, smem));
        PH(base + 10, phase_final(p, l, smem));
    }
#undef PH
}


#ifndef MK_DEBUG
#define MK_DEBUG 0
#define MK_REP 0u
#endif
#if MK_DEBUG
struct DbgItem { const void* ptr; unsigned long long n; int f32; int ld; int c0; int c1; int mode; int pad; };
struct DbgList { DbgItem it[40]; int count; int pad; };
__global__ void dbg_scan(DbgList L, unsigned* flag) {
    for (int i = 0; i < L.count; ++i) {
        const DbgItem d = L.it[i];
        bool bad = false;
        for (unsigned long long e = (unsigned long long)blockIdx.x * blockDim.x + threadIdx.x; e < d.n; e += (unsigned long long)gridDim.x * blockDim.x) {
            if (d.ld > 0) { const int c = (int)(e % d.ld); if (c < d.c0 || c >= d.c1) continue; }
            if (d.f32) { const unsigned u = ((const unsigned*)d.ptr)[e]; if (((d.mode & 1) && (u & 0x7f800000u) == 0x7f800000u) || ((d.mode & 2) && u == 0xAAAAAAAAu) || ((d.mode & 4) && (u & 0x7f800000u) >= 0x46800000u)) bad = true; }
            else { const unsigned short u = ((const unsigned short*)d.ptr)[e]; if (((d.mode & 1) && (u & 0x7f80u) == 0x7f80u) || ((d.mode & 2) && u == 0xAAAAu) || ((d.mode & 4) && (u & 0x7f80u) >= 0x4680u)) bad = true; }
        }
        if (bad) atomicMin(flag, (unsigned)i);
    }
}
__global__ void dbg_time(float* out, unsigned long long n, const unsigned long long* ts, unsigned maskA, unsigned maskB) {
    float ta = 0.f, tb = 0.f;
    for (int i = 0; i < 23; ++i) { const float d = (float)(ts[i + 1] - ts[i]) * 0.01f; const int cls = i == 0 ? 0 : 1 + (i - 1) % 11; if (maskA >> cls & 1) ta += d; if (maskB >> cls & 1) tb += d; }
    for (unsigned long long e = (unsigned long long)blockIdx.x * blockDim.x + threadIdx.x; e < n; e += (unsigned long long)gridDim.x * blockDim.x) out[e] = e == 0 ? ta : tb;
}
__global__ void dbg_fill(float* out, unsigned long long n, const unsigned* flag, float hostcode) {
    const unsigned f = *flag;
    float v = f < 1000u ? 100.0f * (float)(f + 1u) : 0.0f;
    if (hostcode != 0.f) v = hostcode;
    for (unsigned long long e = (unsigned long long)blockIdx.x * blockDim.x + threadIdx.x; e < n; e += (unsigned long long)gridDim.x * blockDim.x) out[e] = v;
}
#endif

#ifndef MK_MULTI
#define MK_MULTI 0
#endif

extern "C" void kernel_launch(void* const* d_in, const int* in_sizes, int n_in, void* d_out, int out_size, void* d_ws, size_t ws_size, hipStream_t stream) {
    (void)in_sizes; (void)n_in; (void)out_size; (void)ws_size;
    Params p;
    memset(&p, 0, sizeof(p));
    const float* const* in = (const float* const*)d_in;
    p.x = in[0]; p.c = in[1]; p.ctx = in[2]; p.c_ctx = in[3]; p.ada_w = in[4]; p.ada_b = in[5]; p.w_in = in[6]; p.w_out = in[7];
    p.sgu_ln_w = in[8]; p.sgu_ln_b = in[9]; p.sgu_w = in[10]; p.sgu_b = in[11]; p.diff_lambda = in[12]; p.diff_subln_w = in[13];
    p.hgrn_lb = in[14]; p.hgrn_norm_w = in[15]; p.mla_q_norm_w = in[16]; p.mla_w_uq = in[17]; p.mla_kv_norm_w = in[18]; p.mla_w_ukv = in[19];
    p.ln_mix_w = in[20]; p.ln_mix_b = in[21]; p.ln_ffn_w = in[22]; p.ln_ffn_b = in[23]; p.router_w = in[24]; p.router_b = in[25];
    p.w1 = in[26]; p.b1 = in[27]; p.w2 = in[28]; p.b2 = in[29];
    p.out = (float*)d_out;
    char* ws = (char*)d_ws; size_t off = 0;
    auto take = [&](size_t bytes) { char* r = ws + off; off += (bytes + 255) & ~(size_t)255; return r; };
    constexpr size_t CTRL_BYTES = 65536;
    char* ctrl = take(CTRL_BYTES);
    p.bar = (unsigned*)ctrl; p.gcnt = (unsigned*)(ctrl + 16384);
    p.mod = (float*)take((size_t)2 * 9 * 6144 * 4); p.lball = (float*)take(2 * 512 * 4); p.lam = (float*)take(256); p.ropec = (float*)take(512 * 4); p.ropes = (float*)take(512 * 4);
    p.WinT = (bf16_t*)take((size_t)2 * NINP * DM * 2); p.WoutT = (bf16_t*)take((size_t)2 * DM * DM * 2);
    p.WuqT = (bf16_t*)take((size_t)2 * 384 * 256 * 2); p.WukvT = (bf16_t*)take((size_t)2 * 512 * 128 * 2);
    p.W1T = (bf16_t*)take((size_t)2 * NE * 2048 * DM * 2); p.W2T = (bf16_t*)take((size_t)2 * NE * DM * DM * 2);
    p.X = (float*)take((size_t)MR * DM * 4); p.H = (bf16_t*)take((size_t)MR * DM * 2);
    p.Puv = (bf16_t*)take((size_t)MR * 512 * 2); p.Qd = (bf16_t*)take((size_t)MR * 256 * 2); p.Kd = (bf16_t*)take((size_t)MR * 256 * 2); p.Vdt = (bf16_t*)take((size_t)MR * 256 * 2);
    p.Hq = (bf16_t*)take((size_t)MR * 256 * 2); p.Vht = (bf16_t*)take((size_t)MR * 256 * 2); p.Lf = (bf16_t*)take((size_t)2 * MR * 256 * 2); p.Hg = (bf16_t*)take((size_t)MR * 256 * 2);
    p.Cq = (bf16_t*)take((size_t)MR * 256 * 2); p.Ckv = (bf16_t*)take((size_t)MR * 128 * 2); p.Kr = (bf16_t*)take((size_t)MR * 32 * 2);
    p.Qm = (bf16_t*)take((size_t)MR * 384 * 2); p.Kn = (bf16_t*)take((size_t)MR * 256 * 2); p.Vmt = (bf16_t*)take((size_t)MR * 256 * 2);
    p.O = (bf16_t*)take((size_t)MR * DM * 2);
    p.RS = (float*)take((size_t)MR * 2 * 4); p.DST = (float*)take((size_t)NB * 4 * 2 * NCH * 4096 * 4); p.DEC = (float*)take((size_t)NB * 4 * 2 * NCH * 64 * 4);
    p.Y = (float*)take((size_t)MR * DM * 4);
    p.ltok = (int*)take((size_t)NE * MR * 4); p.lgate = (float*)take((size_t)NE * MR * 4); p.rslot = (int*)take((size_t)MR * 4 * 4);
    p.ACT = (bf16_t*)take((size_t)NSLOT * 1024 * 2); p.YS = (bf16_t*)take((size_t)NSLOT * 1024 * 2);

    static int grid = 0;
    if (!grid) {
        int dev = 0, cus = 0, per_cu = 0;
        hipGetDevice(&dev);
        hipDeviceGetAttribute(&cus, hipDeviceAttributeMultiprocessorCount, dev);
        hipFuncSetAttribute((const void*)mega, hipFuncAttributeMaxDynamicSharedMemorySize, LDS_BYTES);
        hipOccupancyMaxActiveBlocksPerMultiprocessor(&per_cu, mega, NTHREADS, LDS_BYTES);
        if (cus <= 0) cus = 256;
        grid = cus * (per_cu < 1 ? 1 : 1);
    }
    hipMemsetAsync(ctrl, 0, CTRL_BYTES, stream);
#if MK_MULTI
#ifndef MK_NPH
#define MK_NPH N_PHASES
#endif
    for (int ph = 0; ph < MK_NPH; ++ph) {
        if (ph == 1 + PH_PER_LAYER) continue;
        hipLaunchKernelGGL(mega, dim3(grid), dim3(NTHREADS), LDS_BYTES, stream, p, ph, ph + 1);
    }
#else
    hipLaunchKernelGGL(mega, dim3(grid), dim3(NTHREADS), LDS_BYTES, stream, p, 0, N_PHASES);
#endif

#if MK_DEBUG == 2
    hipLaunchKernelGGL(dbg_time, dim3(2048), dim3(256), 0, stream, (float*)d_out, (unsigned long long)NB * SEQ * DM, (const unsigned long long*)(p.gcnt + 1024), (unsigned)MK_TMASK_A, (unsigned)MK_TMASK_B);
#elif MK_DEBUG
    {
        DbgList L; memset(&L, 0, sizeof(L));
        int n = 0;
        auto add = [&](const void* ptr, unsigned long long cnt, int f32, int ld = 0, int c0 = 0, int c1 = 0, int mode = 3) { L.it[n].ptr = ptr; L.it[n].n = cnt; L.it[n].f32 = f32; L.it[n].ld = ld; L.it[n].c0 = c0; L.it[n].c1 = c1; L.it[n].mode = mode; ++n; };
        MK_DEBUG_LIST
        L.count = n;
        unsigned* flag = (unsigned*)(ctrl + 32768);
        hipMemsetAsync(flag, 0x7f, 4, stream);
        hipLaunchKernelGGL(dbg_scan, dim3(2048), dim3(256), 0, stream, L, flag);
        hipLaunchKernelGGL(dbg_fill, dim3(2048), dim3(256), 0, stream, (float*)d_out, (unsigned long long)NB * SEQ * DM, (const unsigned*)flag, 0.0f);
    }
#endif
}
```

```cpp
#include <hip/hip_runtime.h>
#include <stdint.h>
#include <string.h>

#define MK_MULTI 0
#define MK_NPH N_PHASES
#define MK_DEBUG 0
#define MK_REP 0u
#define MK_DEBUG_LIST \
  add(p.mod, 2*9*6144, 1,0,0,0,7); add(p.WinT, 2ull*NINP*DM, 0,0,0,0,7); add(p.H, (unsigned long long)MR*DM, 0,0,0,0,7); add(p.Puv, (unsigned long long)MR*512, 0,0,0,0,7); \
  add(p.Cq, (unsigned long long)MR*256, 0,0,0,0,7); add(p.Ckv, (unsigned long long)MR*128, 0,0,0,0,7); add(p.RS, (unsigned long long)MR*2, 1,0,0,0,7); \
  add(p.Kn, (unsigned long long)MR*256, 0,0,0,0,7); add(p.Vmt, (unsigned long long)MR*256, 0,0,0,0,7); \
  add(p.O, (unsigned long long)MR*DM, 0, DM, 0, 256, 1); \
  add(p.Y, (unsigned long long)MR*DM, 1);

#define DI __device__ __forceinline__
typedef unsigned short bf16_t;
typedef short bf16x8 __attribute__((ext_vector_type(8)));
typedef float f32x4 __attribute__((ext_vector_type(4)));
typedef float f32x2 __attribute__((ext_vector_type(2)));
typedef float f32x16 __attribute__((ext_vector_type(16)));
typedef unsigned u32x4 __attribute__((ext_vector_type(4)));
typedef unsigned u32x2 __attribute__((ext_vector_type(2)));

constexpr int DM = 1024, NB = 8, SEQ = 4096, CTX = 256, TP = 4352, MR = NB * TP;
constexpr int NIN = 2976, NINP = 3072;
constexpr int NE = 32;
constexpr int NCH = TP / 32;
constexpr int NSLOT = 147456;
constexpr float LN_EPS = 1e-6f;
constexpr float DN_ALPHA = 1.4142135623730951f;
constexpr float LOG2E = 1.4426950408889634f;
constexpr int NTHREADS = 512;
constexpr int LDS_BYTES = 147456;

#define XB_TMO      128
#define XB_XCNT(j)  (256  + 64 * (j))
#define XB_XSUB(j)  (1280 + 64 * (j))
#define XB_XGEN(j)  (2304 + 64 * (j))
#define XB_TOP      3328
#define XB_TOPGEN   3392
#define XCD_BAR_WORDS 3456
#define XB_SPIN_CAP (1u << 22)
#define LAS __attribute__((address_space(3)))
__device__ __forceinline__ int otid();

DI unsigned xb_ld(unsigned* p)              { return __hip_atomic_load(p, __ATOMIC_RELAXED, __HIP_MEMORY_SCOPE_AGENT); }
DI unsigned xb_add(unsigned* p, unsigned v) { return __hip_atomic_fetch_add(p, v, __ATOMIC_RELAXED, __HIP_MEMORY_SCOPE_AGENT); }
DI unsigned xb_xcc_id() { return (unsigned)__builtin_amdgcn_s_getreg((3 << 11) | 20) & 0xFu; }
#define XB_SPIN(cond, bar) do { unsigned _sp = 0; while (cond) { __builtin_amdgcn_s_sleep(1); \
    if ((++_sp & 255u) == 0u) { if (xb_ld(&(bar)[XB_TMO])) break; if (_sp > XB_SPIN_CAP) { atomicAdd(&(bar)[XB_TMO], 1u); break; } } } } while (0)

struct XcdBarrier { unsigned* bar; unsigned x; volatile LAS unsigned* st; };

DI XcdBarrier xcd_barrier_post(unsigned* bar, volatile LAS unsigned* st) {
    XcdBarrier b; b.bar = bar; b.x = xb_xcc_id(); b.st = st;
    if (otid() == 0) (void)xb_add(&bar[XB_XCNT(b.x)], 1u);
    return b;
}
DI void xcd_barrier_complete(unsigned* bar, unsigned x, unsigned& nloc, unsigned& nx) {
    const unsigned G = gridDim.x * gridDim.y * gridDim.z;
    unsigned sum, cnt, mine, sp = 0u;
    for (;;) {
        sum = 0u; cnt = 0u; mine = 0u;
#pragma unroll
        for (unsigned j = 0; j < 16; ++j) { const unsigned c = xb_ld(&bar[XB_XCNT(j)]); sum += c; cnt += (c > 0u) ? 1u : 0u; mine = (j == x) ? c : mine; }
        if (sum == G) break;
        __builtin_amdgcn_s_sleep(1);
        if ((++sp & 255u) == 0u) { if (xb_ld(&bar[XB_TMO])) break; if (sp > XB_SPIN_CAP) { atomicAdd(&bar[XB_TMO], 1u); break; } }
    }
    nloc = mine > 0u ? mine : 1u; nx = cnt > 0u ? cnt : 1u;
}
DI void xcd_barrier(const XcdBarrier& b) {
    asm volatile("s_waitcnt vmcnt(0)" ::: "memory");
    __syncthreads();
    if (otid() == 0) {
        unsigned* bar = b.bar;
        __builtin_amdgcn_s_waitcnt(0);
        unsigned nloc = b.st[0], nx = b.st[1];
        if (nloc == 0u) { xcd_barrier_complete(bar, b.x, nloc, nx); b.st[0] = nloc; b.st[1] = nx; }
        const unsigned old = xb_add(&bar[XB_XSUB(b.x)], 1u);
        const unsigned gen = old / nloc;
        if (old + 1u == (gen + 1u) * nloc) {
            __builtin_amdgcn_fence(__ATOMIC_RELEASE, "agent");
            asm volatile("s_waitcnt vmcnt(0)" ::: "memory");
            const unsigned og = xb_add(&bar[XB_TOP], 1u);
            const unsigned tg = og / nx;
            if (og + 1u == (tg + 1u) * nx) xb_add(&bar[XB_TOPGEN], 1u);
            else XB_SPIN(xb_ld(&bar[XB_TOPGEN]) == tg, bar);
            __builtin_amdgcn_fence(__ATOMIC_ACQUIRE, "agent");
            xb_add(&bar[XB_XGEN(b.x)], 1u);
            asm volatile("s_waitcnt vmcnt(0)" ::: "memory");
        } else {
            XB_SPIN(xb_ld(&bar[XB_XGEN(b.x)]) == gen, bar);
            __builtin_amdgcn_fence(__ATOMIC_ACQUIRE, "agent");
            asm volatile("s_waitcnt vmcnt(0)" ::: "memory");
        }
    }
    __syncthreads();
}

struct Params {
    const float *x, *c, *ctx, *c_ctx, *ada_w, *ada_b, *w_in, *w_out, *sgu_ln_w, *sgu_ln_b, *sgu_w, *sgu_b,
                *diff_lambda, *diff_subln_w, *hgrn_lb, *hgrn_norm_w, *mla_q_norm_w, *mla_w_uq, *mla_kv_norm_w, *mla_w_ukv,
                *ln_mix_w, *ln_mix_b, *ln_ffn_w, *ln_ffn_b, *router_w, *router_b, *w1, *b1, *w2, *b2;
    float* out;
    unsigned* bar; unsigned* gcnt;
    float *mod, *lball, *lam, *ropec, *ropes;
    bf16_t *WinT, *WoutT, *WuqT, *WukvT, *W1T, *W2T;
    float* X; bf16_t* H;
    bf16_t *Puv, *Qd, *Kd, *Vdt, *Hq, *Vht, *Lf, *Hg, *Cq, *Ckv, *Kr, *Qm, *Kn, *Vmt, *O;
    float *RS, *DST, *DEC, *Y;
    int* ltok; float* lgate; int* rslot; bf16_t *ACT, *YS;
};

typedef const __attribute__((address_space(4))) Params CParams;
extern __shared__ __attribute__((aligned(16))) char smem_all[];
constexpr int WVTAB_OFF = 147456 - 16 - 256;
DI int hw_slot() { return (int)(__builtin_amdgcn_s_getreg((6 << 11) | 4) & 63u); }
DI int otid() {
    int l = (int)__builtin_amdgcn_mbcnt_hi(~0u, __builtin_amdgcn_mbcnt_lo(~0u, 0u));
    const int w = __builtin_amdgcn_readfirstlane(((volatile int*)(smem_all + WVTAB_OFF))[hw_slot()]);
    int t = w * 64 + l; asm volatile("" : "+v"(t)); return t;
}
DI float bf2f(bf16_t v) { return __uint_as_float(((unsigned)v) << 16); }
typedef __bf16 bf16x2_t __attribute__((ext_vector_type(2)));
DI unsigned pk2(float lo, float hi) { const bf16x2_t v = {(__bf16)lo, (__bf16)hi}; return __builtin_bit_cast(unsigned, v); }
DI float lo2f(unsigned w) { return __uint_as_float(w << 16); }
DI float hi2f(unsigned w) { return __uint_as_float(w & 0xffff0000u); }
DI bf16x8 pack8(const float (&v)[8]) { u32x4 w; w.x = pk2(v[0], v[1]); w.y = pk2(v[2], v[3]); w.z = pk2(v[4], v[5]); w.w = pk2(v[6], v[7]); return __builtin_bit_cast(bf16x8, w); }
template <int MASK> DI float shx(float v) {
    if (MASK < 32) return __int_as_float(__builtin_amdgcn_ds_swizzle(__float_as_int(v), (MASK << 10) | 0x1f));
    int l = (int)__builtin_amdgcn_mbcnt_hi(~0u, __builtin_amdgcn_mbcnt_lo(~0u, 0u)); asm volatile("" : "+v"(l));
    return __int_as_float(__builtin_amdgcn_ds_bpermute((l ^ 32) << 2, __float_as_int(v)));
}
DI float zf() { float z = 0.f; asm volatile("" : "+v"(z)); return z; }
DI f32x4 zero4() { const float z = zf(); return (f32x4){z, z, z, z}; }
DI float rdlane(float v, int l) { return __int_as_float(__builtin_amdgcn_readlane(__float_as_int(v), l)); }
template <int CTRL> DI float dpp(float v) { return __int_as_float(__builtin_amdgcn_update_dpp(0, __float_as_int(v), CTRL, 0xf, 0xf, false)); }
constexpr int DPP_X1 = 0xB1, DPP_X2 = 0x4E, DPP_HM = 0x141, DPP_RM = 0x140;
DI float wave_sum(float v) { v += dpp<DPP_X1>(v); v += dpp<DPP_X2>(v); v += dpp<DPP_HM>(v); v += dpp<DPP_RM>(v); v += shx<16>(v); v += shx<32>(v); return v; }
DI float sigmoidf_(float x) { return __builtin_amdgcn_rcpf(1.0f + __builtin_amdgcn_exp2f(-LOG2E * x)); }
DI float geluf_(float v) {
    const float av = fabsf(v), t = __builtin_amdgcn_rcpf(av * 0.2316418882f + 1.0f);
    float q = t * 0.5307027145f + (-0.7265760135f); q = q * t + 0.7107068705f; q = q * t + (-0.142248368f); q = q * t + 0.127414796f; q = q * t;
    const float e = __builtin_amdgcn_exp2f((v * v) * (-0.72134752044f));
    const float m = v * (q * e);
    return v < 0.f ? m : v - m;
}
DI float siluf_(float x) { return x * sigmoidf_(x); }
DI int crow(int r, int hh) { return (r & 3) + 8 * (r >> 2) + 4 * hh; }
#define MFMA16(a, b, c) __builtin_amdgcn_mfma_f32_16x16x32_bf16((a), (b), (c), 0, 0, 0)
#define MFMA32(a, b, c) __builtin_amdgcn_mfma_f32_32x32x16_bf16((a), (b), (c), 0, 0, 0)

DI const float* in_row(CParams& p, int row) {
    const int b = row / TP, t = row - b * TP;
    return t < CTX ? p.ctx + ((size_t)b * CTX + t) * DM : p.x + ((size_t)b * SEQ + (t - CTX)) * DM;
}
DI const float* mod_vec(CParams& p, int l, int row, int j) {
    const int b = row / TP, t = row - b * TP;
    const int r = t < CTX ? 8 : b;
    return p.mod + ((size_t)(l * 9 + r) * 6 + j) * DM;
}

DI void transpose_tile(const float* __restrict__ src, int K, int N, bf16_t* __restrict__ dst, int k0, int n0, const float* __restrict__ kscale, int perm_ukv, char* wl, int lane) {
    bf16_t* S = (bf16_t*)wl;
#pragma unroll 4
    for (int it = 0; it < 16; ++it) {
        const int kk = it * 4 + (lane >> 4), nn = (lane & 15) * 4;
        f32x4 v = {0.f, 0.f, 0.f, 0.f};
        if (n0 + nn < N) v = *(const f32x4*)(src + (size_t)(k0 + kk) * N + n0 + nn);
        if (kscale) { const float s = kscale[k0 + kk]; v = v * s; }
        unsigned* d = (unsigned*)(S + kk * 66 + nn);
        d[0] = pk2(v[0], v[1]); d[1] = pk2(v[2], v[3]);
    }
    __builtin_amdgcn_fence(__ATOMIC_RELEASE, "workgroup");
    __builtin_amdgcn_wave_barrier();
    __builtin_amdgcn_fence(__ATOMIC_ACQUIRE, "workgroup");
#pragma unroll 2
    for (int it = 0; it < 8; ++it) {
        const int nn = it * 8 + (lane >> 3), kc = lane & 7;
        unsigned short e[8];
#pragma unroll
        for (int j = 0; j < 8; ++j) e[j] = S[(kc * 8 + j) * 66 + nn];
        u32x4 w; w.x = e[0] | ((unsigned)e[1] << 16); w.y = e[2] | ((unsigned)e[3] << 16); w.z = e[4] | ((unsigned)e[5] << 16); w.w = e[6] | ((unsigned)e[7] << 16);
        int n = n0 + nn;
        if (perm_ukv) { const int hh = n >> 7, t = n & 127; n = t < 64 ? hh * 64 + t : 256 + hh * 64 + (t - 64); }
        *(u32x4*)(dst + (size_t)n * K + k0 + kc * 8) = w;
    }
    __builtin_amdgcn_fence(__ATOMIC_RELEASE, "workgroup");
    __builtin_amdgcn_wave_barrier();
}

DI void phase_prologue(CParams& p, char* lds) {
    const int tid = otid(), wid = tid >> 6, lane = tid & 63;
    char* wl = lds + wid * 8704;
    constexpr int T_IN = 16 * 48, T_OUT = 16 * 16, T_UQ = 4 * 6, T_UKV = 2 * 8, T_W1 = 32 * 16 * 32, T_W2 = 32 * 16 * 16;
    constexpr int T_LAYER = T_IN + T_OUT + T_UQ + T_UKV + T_W1 + T_W2;
    constexpr int T_ALL = 2 * T_LAYER;
    constexpr int U_TR = (T_ALL + 7) / 8;
    constexpr int U_GEMV = 2 * 6144 / 64;
    const int nunits = U_GEMV + U_TR + 1;
    for (int u = blockIdx.x; u < nunits; u += gridDim.x) {
        if (u < U_GEMV) {
            const int l = u / 96, n = (u % 96) * 64 + lane;
            const float* W = p.ada_w + (size_t)l * DM * 6144 + (size_t)(wid * 128) * 6144 + n;
            float* sc = (float*)(lds + 73728);
            float* part = (float*)lds;
            __syncthreads();
            for (int i = tid; i < 9 * DM; i += NTHREADS) { const float cv = i < 8 * DM ? p.c[i] : p.c_ctx[i - 8 * DM]; sc[i] = siluf_(cv); }
            __syncthreads();
            float acc[9];
#pragma unroll
            for (int r = 0; r < 9; ++r) acc[r] = 0.f;
#pragma unroll 2
            for (int k = 0; k < 128; k += 4) {
                float w[4];
#pragma unroll
                for (int j = 0; j < 4; ++j) w[j] = W[(size_t)(k + j) * 6144];
#pragma unroll
                for (int r = 0; r < 9; ++r) {
                    const f32x4 cc = *(const f32x4*)(sc + r * DM + wid * 128 + k);
#pragma unroll
                    for (int j = 0; j < 4; ++j) acc[r] += cc[j] * w[j];
                }
            }
#pragma unroll
            for (int r = 0; r < 9; ++r) part[(wid * 9 + r) * 64 + lane] = acc[r];
            __syncthreads();
            for (int i = tid; i < 9 * 64; i += NTHREADS) {
                const int r = i >> 6, c = i & 63;
                float sum = p.ada_b[l * 6144 + (u % 96) * 64 + c];
#pragma unroll
                for (int w8 = 0; w8 < 8; ++w8) sum += part[(w8 * 9 + r) * 64 + c];
                p.mod[(size_t)(l * 9 + r) * 6144 + (u % 96) * 64 + c] = sum;
            }
            __syncthreads();
        } else if (u < U_GEMV + U_TR) {
            int t = (u - U_GEMV) * 8 + wid;
            if (t < T_ALL) {
                const int l = t / T_LAYER; t -= l * T_LAYER;
                if (t < T_IN) { const int kt = t / 48, nt = t % 48;
                    transpose_tile(p.w_in + (size_t)l * DM * NIN, DM, NIN, p.WinT + (size_t)l * NINP * DM, kt * 64, nt * 64, nullptr, 0, wl, lane);
                } else if ((t -= T_IN) < T_OUT) { const int kt = t / 16, nt = t % 16;
                    transpose_tile(p.w_out + (size_t)l * DM * DM, DM, DM, p.WoutT + (size_t)l * DM * DM, kt * 64, nt * 64, nullptr, 0, wl, lane);
                } else if ((t -= T_OUT) < T_UQ) { const int kt = t / 6, nt = t % 6;
                    transpose_tile(p.mla_w_uq + (size_t)l * 256 * 384, 256, 384, p.WuqT + (size_t)l * 384 * 256, kt * 64, nt * 64, p.mla_q_norm_w + l * 256, 0, wl, lane);
                } else if ((t -= T_UQ) < T_UKV) { const int kt = t / 8, nt = t % 8;
                    transpose_tile(p.mla_w_ukv + (size_t)l * 128 * 512, 128, 512, p.WukvT + (size_t)l * 512 * 128, kt * 64, nt * 64, p.mla_kv_norm_w + l * 128, 1, wl, lane);
                } else if ((t -= T_UKV) < T_W1) { const int e = t / 512, r = t % 512, kt = r / 32, nt = r % 32;
                    transpose_tile(p.w1 + ((size_t)l * NE + e) * DM * 2048, DM, 2048, p.W1T + ((size_t)l * NE + e) * 2048 * DM, kt * 64, nt * 64, nullptr, 0, wl, lane);
                } else { t -= T_W1; const int e = t / 256, r = t % 256, kt = r / 16, nt = r % 16;
                    transpose_tile(p.w2 + ((size_t)l * NE + e) * DM * DM, DM, DM, p.W2T + ((size_t)l * NE + e) * DM * DM, kt * 64, nt * 64, nullptr, 0, wl, lane);
                }
            }
        } else {
            if (tid < 512) {
                const int j = tid;
                const float a0 = p.hgrn_lb[j], a1 = p.hgrn_lb[512 + j];
                const float m = fmaxf(a0, a1), e0 = expf(a0 - m), e1 = expf(a1 - m);
                p.lball[j] = 0.f;
                p.lball[512 + j] = e1 / (e0 + e1);
            }
            if (tid < 2) {
                const float* lp = p.diff_lambda + tid * 4 * 32;
                float s01 = 0.f, s23 = 0.f;
                for (int i = 0; i < 32; ++i) { s01 += lp[i] * lp[32 + i]; s23 += lp[64 + i] * lp[96 + i]; }
                const float lam_init = tid == 0 ? 0.2f : 0.3555090676f;
                p.lam[tid] = expf(s01) - expf(s23) + lam_init;
            }
            {
                const int pos = tid >> 3, i = tid & 7;
                const float inv = powf(10000.0f, -(float)(2 * i) / 16.0f);
                float sn, cs; sincosf((float)pos * inv, &sn, &cs);
                p.ropec[tid] = cs; p.ropes[tid] = sn;
            }
        }
    }
}

DI void phase_ln1(CParams& p, char* lds) {
    const int tid = otid(), wid = tid >> 6, lane = tid & 63;
    for (int row = blockIdx.x * 8 + wid; row < MR; row += gridDim.x * 8) {
        const float* xr = in_row(p, row);
        f32x4 v[4]; float s = 0.f;
#pragma unroll
        for (int j = 0; j < 4; ++j) { v[j] = *(const f32x4*)(xr + j * 256 + lane * 4); s += (v[j][0] + v[j][1]) + (v[j][2] + v[j][3]); }
        const float mean = wave_sum(s) * (1.f / DM);
        float q = 0.f;
#pragma unroll
        for (int j = 0; j < 4; ++j) { v[j] = v[j] - mean; q += (v[j][0] * v[j][0] + v[j][1] * v[j][1]) + (v[j][2] * v[j][2] + v[j][3] * v[j][3]); }
        const float rstd = rsqrtf(wave_sum(q) * (1.f / DM) + LN_EPS);
        const float* sh = mod_vec(p, 0, row, 0); const float* sc = mod_vec(p, 0, row, 1);
#pragma unroll
        for (int j = 0; j < 4; ++j) {
            const int c = j * 256 + lane * 4;
            const f32x4 a = *(const f32x4*)(sh + c), b = *(const f32x4*)(sc + c);
            const f32x4 h = v[j] * rstd * (b + 1.0f) + a;
            u32x2 w; w.x = pk2(h[0], h[1]); w.y = pk2(h[2], h[3]);
            *(u32x2*)(p.H + (size_t)row * DM + c) = w;
        }
    }
}

template <int ORI>
DI void gemm_core(const bf16_t* const (&pa)[4], const bf16_t* const (&pb)[2], int K, char* lds, f32x4 (&acc)[4][4]) {
    const int tid = otid(), wid = tid >> 6, lane = tid & 63, wr = wid >> 1, wc = wid & 1, fr = lane & 15, fq = lane >> 4;
    const int sw = ((tid & 7) ^ ((tid >> 4) & 7)) << 4;
    const int offA = (tid >> 3) * 128 + sw, offB = 32768 + (tid >> 3) * 128 + sw;
    const int rdA = (wr * 64 + fr) * 128 + ((fq ^ (fr >> 1)) << 4), rdB = 32768 + (wc * 64 + fr) * 128 + ((fq ^ (fr >> 1)) << 4);
#pragma unroll
    for (int mi = 0; mi < 4; ++mi)
#pragma unroll
        for (int ni = 0; ni < 4; ++ni) acc[mi][ni] = zero4();
    u32x4 ra[4], rb[2];
#pragma unroll
    for (int i = 0; i < 4; ++i) ra[i] = *(const u32x4*)(pa[i]);
#pragma unroll
    for (int j = 0; j < 2; ++j) rb[j] = *(const u32x4*)(pb[j]);
#pragma unroll
    for (int i = 0; i < 4; ++i) *(u32x4*)(lds + offA + i * 8192) = ra[i];
#pragma unroll
    for (int j = 0; j < 2; ++j) *(u32x4*)(lds + offB + j * 8192) = rb[j];
    __syncthreads();
    const int nk = K >> 6;
    for (int kt = 0; kt < nk; ++kt) {
        const char* cur = lds + (kt & 1) * 49152;
        const bool more = kt + 1 < nk;
        if (more) {
#pragma unroll
            for (int i = 0; i < 4; ++i) ra[i] = *(const u32x4*)(pa[i] + (kt + 1) * 64);
#pragma unroll
            for (int j = 0; j < 2; ++j) rb[j] = *(const u32x4*)(pb[j] + (kt + 1) * 64);
        }
#pragma unroll
        for (int kk = 0; kk < 2; ++kk) {
            bf16x8 af[4], bfr[4];
#pragma unroll
            for (int mi = 0; mi < 4; ++mi) af[mi] = *(const bf16x8*)(cur + ((rdA + mi * 2048) ^ (kk * 64)));
#pragma unroll
            for (int ni = 0; ni < 4; ++ni) bfr[ni] = *(const bf16x8*)(cur + ((rdB + ni * 2048) ^ (kk * 64)));
#pragma unroll
            for (int mi = 0; mi < 4; ++mi)
#pragma unroll
                for (int ni = 0; ni < 4; ++ni) {
                    if (ORI == 0) acc[mi][ni] = MFMA16(bfr[ni], af[mi], acc[mi][ni]);
                    else          acc[mi][ni] = MFMA16(af[mi], bfr[ni], acc[mi][ni]);
                }
        }
        if (more) {
            char* nxt = lds + ((kt + 1) & 1) * 49152;
#pragma unroll
            for (int i = 0; i < 4; ++i) *(u32x4*)(nxt + offA + i * 8192) = ra[i];
#pragma unroll
            for (int j = 0; j < 2; ++j) *(u32x4*)(nxt + offB + j * 8192) = rb[j];
        }
        __syncthreads();
    }
}

DI void gemm_ptrs(const bf16_t* A, int lda, int row0, const bf16_t* Bt, int ldb, int n0, const bf16_t* (&pa)[4], const bf16_t* (&pb)[2]) {
    const int tid = otid(), r = tid >> 3, c = (tid & 7) * 8;
#pragma unroll
    for (int i = 0; i < 4; ++i) pa[i] = A + (size_t)(row0 + r + 64 * i) * lda + c;
#pragma unroll
    for (int j = 0; j < 2; ++j) pb[j] = Bt + (size_t)(n0 + r + 64 * j) * ldb + c;
}

DI void store4_bf16(bf16_t* dst, const f32x4& v) { u32x2 w; w.x = pk2(v[0], v[1]); w.y = pk2(v[2], v[3]); *(u32x2*)dst = w; }

DI f32x4 rope_tile(CParams& p, f32x4 v, int row, int axis_is_col, int fq) {
    f32x4 o;
    const int b = row / TP, t = row - b * TP;
    const int pos = t - CTX;
    const int ax = axis_is_col ? (pos & 63) : (pos >> 6);
#pragma unroll
    for (int r = 0; r < 4; ++r) {
        const float pr = shx<32>(v[r]);
        float cs = 1.f, sn = 0.f;
        if (t >= CTX) { const int i = (fq & 1) * 4 + r; cs = p.ropec[ax * 8 + i]; sn = p.ropes[ax * 8 + i]; }
        o[r] = fq < 2 ? v[r] * cs - pr * sn : v[r] * cs + pr * sn;
    }
    return o;
}


namespace g8 {
constexpr int BK = 64, HALF = 128, HTB = HALF * BK * 2, STAGE_BYTES = 8 * HTB;
DI int lds_byte(int r, int c) { const int st = (r >> 4) * 2 + (c >> 5), rr = r & 15, cc = c & 31, ob = rr * 64 + cc * 2; return st * 1024 + (ob ^ (((ob >> 9) & 1) << 5)); }
DI void stage_rc(int b, int& R, int& C) { const int st = b / 1024, sb = b % 1024, swz = sb ^ (((sb >> 9) & 1) << 5); R = (st >> 1) * 16 + swz / 64; C = (st & 1) * 32 + (swz % 64) / 2; }
struct GU { const char* a; const char* b; int pm, pn, e, j0; };
DI bool order_next(int i, int nM, int nN, int& pm, int& pn) {
    const int nwg = nM * nN; const long L = (long)i * gridDim.x + blockIdx.x; if (L >= nwg) return false;
    int wgid = (int)L; { const int q = nwg / 8, r = nwg % 8, xcd = wgid % 8, off = wgid / 8; wgid = (xcd < r ? xcd * (q + 1) : r * (q + 1) + (xcd - r) * q) + off; }
    const int nig = 8 * nN, gid = wgid / nig, fm = gid * 8, gsz = (nM - fm) < 8 ? (nM - fm) : 8;
    pm = fm + ((wgid % nig) % gsz); pn = (wgid % nig) / gsz; return true;
}

template <class Epi, class Sched, bool GATHER>
DI void gemm8(char* lds_generic, const int K, const char* Abase, const Sched& S, const Epi& E) {
    LAS unsigned char* lds = (LAS unsigned char*)lds_generic;
    const int tid = otid(), wid = __builtin_amdgcn_readfirstlane(tid >> 6), lane = tid & 63, wr = wid >> 2, wc = wid & 3, fr = lane & 15, fq = lane >> 4;
    const int nt = K / BK;
    int R[2], C[2];
#pragma unroll
    for (int i = 0; i < 2; ++i) stage_rc(tid * 16 + i * 8192, R[i], C[i]);
    unsigned voff[2];
#pragma unroll
    for (int i = 0; i < 2; ++i) voff[i] = (unsigned)(R[i] * K + C[i]) * 2u;
    const size_t kstep = (size_t)(BK * 2), hstep = (size_t)HALF * K * 2;
    const unsigned ldsw = (unsigned)wid * 1024u;
    const int aoff = lds_byte(wr * 64 + fr, fq * 8), boff = lds_byte(wc * 32 + fr, fq * 8);
    unsigned cg[2][2], ng[2][2];
#define G8_SA(b, h) (((b) * 2 + (h)) * HTB)
#define G8_SB(b, h) ((4 + (b) * 2 + (h)) * HTB)
#define G8_LDS(gp, bufoff, i) __builtin_amdgcn_global_load_lds((const unsigned*)(gp), (LAS unsigned*)(lds + (bufoff) + ldsw + (i) * 8192), 16, 0, 0)
#define G8_STAGE_B(bufoff, gbase) do { _Pragma("unroll") for (int _i = 0; _i < 2; ++_i) G8_LDS((const char*)(gbase) + voff[_i], bufoff, _i); } while (0)
#define G8_STAGE_A(bufoff, h, nx, ko) do { _Pragma("unroll") for (int _i = 0; _i < 2; ++_i) { \
        const char* _gp = GATHER ? Abase + (size_t)((nx) ? ng[h][_i] : cg[h][_i]) + (ko) : ((nx) ? nA : cA) + (size_t)(h) * hstep + (ko) + voff[_i]; G8_LDS(_gp, bufoff, _i); } } while (0)
#define G8_LDA(dst, b, h) do { _Pragma("unroll") for (int m = 0; m < 4; ++m) _Pragma("unroll") for (int k = 0; k < 2; ++k) dst[m][k] = *(const LAS bf16x8*)(lds + G8_SA(b, h) + aoff + m * 2048 + k * 1024); } while (0)
#define G8_LDB(dst, b, h) do { _Pragma("unroll") for (int n = 0; n < 2; ++n) _Pragma("unroll") for (int k = 0; k < 2; ++k) dst[n][k] = *(const LAS bf16x8*)(lds + G8_SB(b, h) + boff + n * 2048 + k * 1024); } while (0)
#define G8_MMA(ai, bj, At, Bt) do { __builtin_amdgcn_s_setprio(1); _Pragma("unroll") for (int m = 0; m < 4; ++m) _Pragma("unroll") for (int n = 0; n < 2; ++n) _Pragma("unroll") for (int k = 0; k < 2; ++k) \
        acc[ai][bj][m][n] = __builtin_amdgcn_mfma_f32_16x16x32_bf16(Bt[n][k], At[m][k], acc[ai][bj][m][n], 0, 0, 0); __builtin_amdgcn_s_setprio(0); } while (0)
#define G8_WAIT_V(n) asm volatile("s_waitcnt vmcnt(" #n ")" ::: "memory")
#define G8_WAIT_L(n) asm volatile("s_waitcnt lgkmcnt(" #n ")" ::: "memory")
#define G8_BAR __builtin_amdgcn_s_barrier()
#define G8_SCHED __builtin_amdgcn_sched_barrier(0)
#define G8_GOFF(dst, u) do { if (GATHER) { int _tz = tid; asm volatile("" : "+v"(_tz)); _Pragma("unroll") for (int _i = 0; _i < 2; ++_i) { int _R, _C; stage_rc(_tz * 16 + _i * 8192, _R, _C); \
        _Pragma("unroll") for (int _h = 0; _h < 2; ++_h) dst[_h][_i] = S.arow(u, _h * HALF + _R) * (unsigned)(K * 2) + (unsigned)(_C * 2); } } } while (0)
    GU cur, nxt; int ui = 0;
    __syncthreads();
    if (!S.next(0, cur)) return;
    f32x4 acc[2][2][4][2];
    { const f32x4 z4 = zero4();
#pragma unroll
    for (int a = 0; a < 2; ++a)
#pragma unroll
        for (int b = 0; b < 2; ++b)
#pragma unroll
            for (int m = 0; m < 4; ++m)
#pragma unroll
                for (int n = 0; n < 2; ++n) acc[a][b][m][n] = z4; }
    bf16x8 At[4][2], B0[2][2], B1[2][2];
    const char* cA = cur.a; const char* cB = cur.b; const char* nA = cA; const char* nB = cB;
    G8_GOFF(cg, cur);
#pragma unroll
    for (int _h = 0; _h < 2; ++_h)
#pragma unroll
        for (int _i = 0; _i < 2; ++_i) ng[_h][_i] = cg[_h][_i];
    G8_STAGE_B(G8_SB(0, 0), cB); G8_STAGE_B(G8_SB(0, 1), cB + hstep); G8_STAGE_A(G8_SA(0, 0), 0, false, (size_t)0); G8_STAGE_A(G8_SA(0, 1), 1, false, (size_t)0);
    if (wr == 1) G8_BAR;
    G8_WAIT_V(2); G8_BAR;
    G8_STAGE_B(G8_SB(1, 0), cB + kstep); G8_STAGE_A(G8_SA(1, 0), 0, false, kstep); G8_STAGE_B(G8_SB(1, 1), cB + hstep + kstep);
    G8_WAIT_V(6); G8_BAR;
    for (;;) {
        const bool has_next = S.next(ui + 1, nxt);
        nA = has_next ? nxt.a : cA; nB = has_next ? nxt.b : cB;
        if (has_next) { G8_GOFF(ng, nxt); } else {
#pragma unroll
            for (int _h = 0; _h < 2; ++_h)
#pragma unroll
                for (int _i = 0; _i < 2; ++_i) ng[_h][_i] = cg[_h][_i]; }
        for (int t = 0; t < nt; t += 2) {
            const bool last = (t == nt - 2);
            const size_t k1 = (size_t)(t + 1) * kstep, k2 = last ? (size_t)0 : (size_t)(t + 2) * kstep, k3 = k2 + kstep;
            const char* b2 = last ? nB : cB + (size_t)(t + 2) * kstep; const char* b3 = b2 + kstep;
            G8_LDB(B0, 0, 0); G8_LDB(B1, 0, 1); G8_SCHED; G8_LDA(At, 0, 0); G8_STAGE_A(G8_SA(1, 1), 1, false, k1);
            G8_WAIT_V(8); G8_WAIT_L(0); G8_BAR; G8_MMA(0, 0, At, B0); G8_MMA(0, 1, At, B1); G8_BAR; G8_SCHED;
            G8_LDA(At, 0, 1); G8_STAGE_B(G8_SB(0, 0), b2); G8_STAGE_B(G8_SB(0, 1), b2 + hstep); G8_STAGE_A(G8_SA(0, 0), 0, last, k2);
            G8_WAIT_V(8); G8_WAIT_L(0); G8_BAR; G8_MMA(1, 0, At, B0); G8_MMA(1, 1, At, B1); G8_BAR; G8_SCHED;
            G8_LDB(B0, 1, 0); G8_LDB(B1, 1, 1); G8_SCHED; G8_LDA(At, 1, 0); G8_STAGE_A(G8_SA(0, 1), 1, last, k2);
            G8_WAIT_V(8); G8_WAIT_L(0); G8_BAR; G8_MMA(0, 0, At, B0); G8_MMA(0, 1, At, B1); G8_BAR; G8_SCHED;
            G8_LDA(At, 1, 1); G8_STAGE_B(G8_SB(1, 0), b3); G8_STAGE_B(G8_SB(1, 1), b3 + hstep); G8_STAGE_A(G8_SA(1, 0), 0, last, k3);
            G8_WAIT_V(8); G8_WAIT_L(0); G8_BAR; G8_MMA(1, 0, At, B0); G8_MMA(1, 1, At, B1); G8_BAR; G8_SCHED;
        }
        if (wr == 0) G8_BAR;
        E(acc, cur, wr, wc, fr, fq);
        if (!has_next) break;
        const f32x4 z4 = zero4();
#pragma unroll
        for (int a = 0; a < 2; ++a)
#pragma unroll
            for (int b = 0; b < 2; ++b)
#pragma unroll
                for (int m = 0; m < 4; ++m)
#pragma unroll
                    for (int n = 0; n < 2; ++n) acc[a][b][m][n] = z4;
        cur = nxt; cA = nA; cB = nB; ++ui;
#pragma unroll
        for (int _h = 0; _h < 2; ++_h)
#pragma unroll
            for (int _i = 0; _i < 2; ++_i) cg[_h][_i] = ng[_h][_i];
        if (wr == 1) G8_BAR;
    }
    G8_WAIT_V(0);
    G8_BAR;
#undef G8_SA
#undef G8_SB
#undef G8_LDS
#undef G8_STAGE_A
#undef G8_STAGE_B
#undef G8_LDA
#undef G8_LDB
#undef G8_MMA
#undef G8_WAIT_V
#undef G8_WAIT_L
#undef G8_BAR
#undef G8_SCHED
#undef G8_GOFF
}
}

#define INPROJ_LOOP(BODY) _Pragma("unroll") for (int ai = 0; ai < 2; ++ai) _Pragma("unroll") for (int m = 0; m < 4; ++m) _Pragma("unroll") for (int n = 0; n < 2; ++n) { \
        const int row = row0 + 128 * ai + 16 * m, col = col0 + 16 * n; f32x4 v = acc[ai][bj][m][n]; BODY }
template <int bj>
DI void inproj_half(CParams& p, int l, int nt, const f32x4 (&acc)[2][2][4][2], int row0  , int col0  , int fq) {
    if (nt < 4) {
        INPROJ_LOOP({
            _Pragma("unroll") for (int r = 0; r < 4; ++r) v[r] = geluf_(v[r]);
            store4_bf16(p.Puv + (size_t)row * 512 + col, v); })
    } else if (nt < 6) {
        INPROJ_LOOP({ v = rope_tile(p, v, row, n, fq) * (0.17677669529663687f * LOG2E); store4_bf16(p.Qd + (size_t)row * 256 + (col - 512), v); })
    } else if (nt < 8) {
        INPROJ_LOOP({ v = rope_tile(p, v, row, n, fq); store4_bf16(p.Kd + (size_t)row * 256 + (col - 768), v); })
    } else if (nt < 12) {
        INPROJ_LOOP({
            _Pragma("unroll") for (int r = 0; r < 4; ++r) v[r] = siluf_(v[r]);
            store4_bf16(p.Hq + (size_t)row * 256 + (col - 1280), v); })
    } else if (nt < 18) {
        const int dir = nt >= 16, cb = dir ? 2048 : 1792;
        INPROJ_LOOP({
            const int cc = col - cb;
            const f32x4 lb = *(const f32x4*)(p.lball + (l * 2 + dir) * 256 + cc);
            _Pragma("unroll") for (int r = 0; r < 4; ++r) v[r] = 0.69314718056f * __builtin_amdgcn_logf(lb[r] + (1.0f - lb[r]) * sigmoidf_(v[r]));
            store4_bf16(p.Lf + ((size_t)dir * MR + row) * 256 + cc, v); })
    } else if (nt < 20) {
        INPROJ_LOOP({
            _Pragma("unroll") for (int r = 0; r < 4; ++r) v[r] = siluf_(v[r]);
            store4_bf16(p.Hg + (size_t)row * 256 + (col - 2304), v); })
    } else if (nt < 22) {
        INPROJ_LOOP({ store4_bf16(p.Cq + (size_t)row * 256 + (col - 2560), v); })
    } else if (nt == 22) {
        INPROJ_LOOP({ store4_bf16(p.Ckv + (size_t)row * 128 + (col - 2816), v); })
    } else {
        INPROJ_LOOP({ v = rope_tile(p, v, row, n, fq); if (col < 2976) store4_bf16(p.Kr + (size_t)row * 32 + (col - 2944), v); })
    }
}
struct SchedIn {
    const char* H; const char* W;
    DI bool next(int i, g8::GU& u) const {
        int pm, pn; if (!g8::order_next(i, MR / 256, 12, pm, pn)) return false;
        const bool sw = (pn == 4 || pn == 6);
        u.pm = pm; u.pn = pn; u.e = sw ? 1 : 0; u.j0 = 0;
        const char* ht = H + (size_t)pm * 256 * 2048; const char* wt = W + (size_t)pn * 256 * 2048;
        u.a = sw ? wt : ht; u.b = sw ? ht : wt; return true;
    }
    DI unsigned arow(const g8::GU&, int) const { return 0u; }
};
struct EpiIn {
    CParams* pp; int l;
    DI void operator()(const f32x4 (&acc)[2][2][4][2], const g8::GU& u, int wr, int wc, int fr, int fq) const {
        CParams& p = *pp;
        if (u.e) {
            bf16_t* dst = (u.pn == 4) ? p.Vdt : p.Vht;
            const int m0 = u.pm * 256, b = m0 / TP, t0 = m0 - b * TP;
#pragma unroll
            for (int ai = 0; ai < 2; ++ai)
#pragma unroll
                for (int bj = 0; bj < 2; ++bj)
#pragma unroll
                    for (int m = 0; m < 4; ++m)
#pragma unroll
                        for (int n = 0; n < 2; ++n) {
                            const int f = 128 * ai + 64 * wr + 16 * m + fr, t = t0 + 128 * bj + 32 * wc + 16 * n + 4 * fq;
                            store4_bf16(dst + ((size_t)(b * 256 + f)) * TP + t, acc[ai][bj][m][n]);
                        }
        } else {
            inproj_half<0>(p, l, 2 * u.pn, acc, u.pm * 256 + 64 * wr + fr, u.pn * 256 + 32 * wc + 4 * fq, fq);
            inproj_half<1>(p, l, 2 * u.pn + 1, acc, u.pm * 256 + 64 * wr + fr, u.pn * 256 + 128 + 32 * wc + 4 * fq, fq);
        }
    }
};
DI void phase_inproj(CParams& p, int l, char* lds) {
    SchedIn S; S.H = (const char*)p.H; S.W = (const char*)(p.WinT + (size_t)l * NINP * DM);
    EpiIn E; E.pp = &p; E.l = l;
    g8::gemm8<EpiIn, SchedIn, false>(lds, DM, nullptr, S, E);
}

DI void phase_sgu_prep(CParams& p, int l, char* lds) {
    const int tid = otid(), wid = tid >> 6, lane = tid & 63, fr = lane & 15, fq = lane >> 4;
    constexpr int U_SGU = (MR / 128) * 4, U_PREP = MR / 64;
    float* stats = (float*)(lds + 16384);
    for (int u = blockIdx.x; u < U_SGU + U_PREP; u += gridDim.x) {
        if (u < U_SGU) {
            const int ch = u >> 2, g = u & 3, row0 = ch * 128;
            __syncthreads();
#pragma unroll 1
            for (int i = 0; i < 16; ++i) {
                const int r = wid * 16 + i;
                const u32x2 w = *(const u32x2*)(p.Puv + (size_t)(row0 + r) * 512 + 256 + lane * 4);
                const float a0 = lo2f(w.x), a1 = hi2f(w.x), a2 = lo2f(w.y), a3 = hi2f(w.y);
                const float mean = wave_sum((a0 + a1) + (a2 + a3)) * (1.f / 256.f);
                const float d0 = a0 - mean, d1 = a1 - mean, d2 = a2 - mean, d3 = a3 - mean;
                const float var = wave_sum((d0 * d0 + d1 * d1) + (d2 * d2 + d3 * d3)) * (1.f / 256.f);
                if (lane == 0) { stats[r * 2] = mean; stats[r * 2 + 1] = rsqrtf(var + LN_EPS); }
            }
            __syncthreads();
            {
                const int s = tid >> 2, c0 = (tid & 3) * 16;
                const float mean = stats[s * 2], rstd = stats[s * 2 + 1];
                const bf16_t* src = p.Puv + (size_t)(row0 + s) * 512 + 256 + g * 64 + c0;
                const u32x4 w0 = *(const u32x4*)src, w1 = *(const u32x4*)(src + 8);
                const unsigned ww[8] = {w0.x, w0.y, w0.z, w0.w, w1.x, w1.y, w1.z, w1.w};
                const float* lw = p.sgu_ln_w + l * 256 + g * 64 + c0; const float* lb = p.sgu_ln_b + l * 256 + g * 64 + c0;
#pragma unroll
                for (int j = 0; j < 16; ++j) {
                    const float xv = (j & 1) ? hi2f(ww[j >> 1]) : lo2f(ww[j >> 1]);
                    const float y = (xv - mean) * rstd * lw[j] + lb[j];
                    const int c = c0 + j;
                    const unsigned pk = pk2(y, 0.f);
                    *(bf16_t*)(lds + c * 256 + ((((s >> 3) ^ (c & 15)) << 4) | ((s & 7) * 2))) = (bf16_t)(pk & 0xffffu);
                }
            }
            __syncthreads();
            f32x4 acc[4];
#pragma unroll
            for (int ni = 0; ni < 4; ++ni) acc[ni] = zero4();
            const float* Wg = p.sgu_w + ((size_t)(l * 4 + g) * 128 + wid * 16 + fr) * 128;
#pragma unroll
            for (int ks = 0; ks < 4; ++ks) {
                const f32x4 a0 = *(const f32x4*)(Wg + ks * 32 + fq * 8), a1 = *(const f32x4*)(Wg + ks * 32 + fq * 8 + 4);
                const float av[8] = {a0[0], a0[1], a0[2], a0[3], a1[0], a1[1], a1[2], a1[3]};
                const bf16x8 af = pack8(av);
#pragma unroll
                for (int ni = 0; ni < 4; ++ni) {
                    const int c = ni * 16 + fr;
                    const bf16x8 bfr = *(const bf16x8*)(lds + c * 256 + (((ks * 4 + fq) ^ (c & 15)) << 4));
                    acc[ni] = MFMA16(bfr, af, acc[ni]);
                }
            }
            const int t = wid * 16 + fr, row = row0 + t;
            const float bs = p.sgu_b[(l * 4 + g) * 128 + t];
#pragma unroll
            for (int ni = 0; ni < 4; ++ni) {
                const int c = g * 64 + ni * 16 + fq * 4;
                const u32x2 w = *(const u32x2*)(p.Puv + (size_t)row * 512 + c);
                f32x4 o;
                o[0] = (acc[ni][0] + bs) * lo2f(w.x); o[1] = (acc[ni][1] + bs) * hi2f(w.x);
                o[2] = (acc[ni][2] + bs) * lo2f(w.y); o[3] = (acc[ni][3] + bs) * hi2f(w.y);
                store4_bf16(p.O + (size_t)row * DM + c, o);
            }
        } else {
            const int rbase = (u - U_SGU) * 64 + wid * 8;
#pragma unroll 1
            for (int i = 0; i < 8; ++i) {
                const int row = rbase + i;
                const u32x2 wq = *(const u32x2*)(p.Cq + (size_t)row * 256 + lane * 4);
                const unsigned wk = *(const unsigned*)(p.Ckv + (size_t)row * 128 + lane * 2);
                const float q0 = lo2f(wq.x), q1 = hi2f(wq.x), q2 = lo2f(wq.y), q3 = hi2f(wq.y), k0 = lo2f(wk), k1 = hi2f(wk);
                const float sq = wave_sum((q0 * q0 + q1 * q1) + (q2 * q2 + q3 * q3));
                const float sk = wave_sum(k0 * k0 + k1 * k1);
                if (lane == 0) { p.RS[row * 2] = rsqrtf(sq * (1.f / 256.f) + LN_EPS); p.RS[row * 2 + 1] = rsqrtf(sk * (1.f / 128.f) + LN_EPS); }
            }
        }
    }
}

DI void hgrn_h1_unit(CParams& p, int wu, int lane) {
    const int c = wu % NCH; int t = wu / NCH; const int dir = t & 1, h = (t >> 1) & 3, b = t >> 3;
    const int row0 = b * TP + c * 32, hh = lane >> 5, l31 = lane & 31;
    const bf16_t* Lf = p.Lf + ((size_t)dir * MR + row0) * 256 + h * 64;
    bf16x8 Bf[2][2];
    float* decp = p.DEC + (size_t)wu * 64;
#pragma unroll
    for (int kt = 0; kt < 2; ++kt) {
        const int k = kt * 32 + l31;
        float lf[32], kd[32];
#pragma unroll
        for (int j = 0; j < 32; ++j) lf[j] = bf2f(Lf[(size_t)j * 256 + k]);
        float tot = 0.f;
#pragma unroll
        for (int j = 0; j < 32; ++j) tot += lf[j];
        float run = 0.f;
        if (dir == 0) {
#pragma unroll
            for (int j = 0; j < 32; ++j) { run += lf[j]; kd[j] = (1.0f - __expf(lf[j])) * __expf(tot - run); }
        } else {
#pragma unroll
            for (int j = 31; j >= 0; --j) { run += lf[j]; kd[j] = (1.0f - __expf(lf[j])) * __expf(tot - run); }
        }
        if (hh == 0) decp[k] = __expf(tot);
#pragma unroll
        for (int s = 0; s < 2; ++s) {
            float v8[8];
#pragma unroll
            for (int jj = 0; jj < 8; ++jj) v8[jj] = hh ? kd[16 * s + 8 + jj] : kd[16 * s + jj];
            Bf[kt][s] = pack8(v8);
        }
    }
    const bf16_t* Vt = p.Vht + ((size_t)(b * 4 + h) * 64) * TP + c * 32;
    float* dst = p.DST + (size_t)wu * 4096;
#pragma unroll
    for (int vt = 0; vt < 2; ++vt) {
        bf16x8 Af[2];
#pragma unroll
        for (int s = 0; s < 2; ++s) Af[s] = *(const bf16x8*)(Vt + (size_t)(vt * 32 + l31) * TP + 16 * s + 8 * hh);
#pragma unroll
        for (int kt = 0; kt < 2; ++kt) {
            f32x16 d;
#pragma unroll
            for (int i = 0; i < 16; ++i) d[i] = zf();
            d = MFMA32(Af[0], Bf[kt][0], d);
            d = MFMA32(Af[1], Bf[kt][1], d);
#pragma unroll
            for (int r = 0; r < 16; ++r) dst[(vt * 32 + crow(r, hh)) * 64 + kt * 32 + l31] = d[r];
        }
    }
}

DI void phase_upproj_h1(CParams& p, int l, char* lds) {
    const int tid = otid(), wid = tid >> 6, lane = tid & 63, wr = wid >> 1, wc = wid & 1, fr = lane & 15, fq = lane >> 4;
    constexpr int U_Q = (MR / 256) * 3, U_KV = (MR / 256) * 4, U_H1 = NB * 4 * 2 * NCH / 8;
    for (int u = blockIdx.x; u < U_Q + U_KV + U_H1; u += gridDim.x) {
        if (u < U_Q) {
            const int mt = u / 3, nt = u % 3, m0 = mt * 256, n0 = nt * 128;
            const bf16_t* pa[4]; const bf16_t* pb[2];
            gemm_ptrs(p.Cq, 256, m0, p.WuqT + (size_t)l * 384 * 256, 256, n0, pa, pb);
            f32x4 acc[4][4];
            gemm_core<0>(pa, pb, 256, lds, acc);
#pragma unroll
            for (int mi = 0; mi < 4; ++mi)
#pragma unroll
                for (int ni = 0; ni < 4; ++ni) {
                    const int row = m0 + wr * 64 + mi * 16 + fr, col = n0 + wc * 64 + ni * 16 + fq * 4;
                    f32x4 v = acc[mi][ni] * (p.RS[row * 2] * (0.10206207261596577f * LOG2E));
                    const int cm = col % 96;
                    const f32x4 vr = rope_tile(p, v, row, (cm >> 4) & 1, fq);
                    if (cm >= 64) v = vr;
                    store4_bf16(p.Qm + (size_t)row * 384 + col, v);
                }
        } else if (u < U_Q + U_KV) {
            const int uu = u - U_Q, mt = uu >> 2, nt = uu & 3, m0 = mt * 256, n0 = nt * 128;
            const bf16_t* pa[4]; const bf16_t* pb[2];
            gemm_ptrs(p.Ckv, 128, m0, p.WukvT + (size_t)l * 512 * 128, 128, n0, pa, pb);
            f32x4 acc[4][4];
            if (nt < 2) {
                gemm_core<0>(pa, pb, 128, lds, acc);
#pragma unroll
                for (int mi = 0; mi < 4; ++mi)
#pragma unroll
                    for (int ni = 0; ni < 4; ++ni) {
                        const int row = m0 + wr * 64 + mi * 16 + fr, col = n0 + wc * 64 + ni * 16 + fq * 4;
                        store4_bf16(p.Kn + (size_t)row * 256 + col, acc[mi][ni] * p.RS[row * 2 + 1]);
                    }
            } else {
                gemm_core<1>(pa, pb, 128, lds, acc);
                const int b = m0 / TP, t0 = m0 - b * TP;
#pragma unroll
                for (int mi = 0; mi < 4; ++mi)
#pragma unroll
                    for (int ni = 0; ni < 4; ++ni) {
                        const int f = n0 - 256 + wc * 64 + ni * 16 + fr;
                        const int rl = wr * 64 + mi * 16 + fq * 4;
                        const f32x4 rs = {p.RS[(m0 + rl) * 2 + 1], p.RS[(m0 + rl + 1) * 2 + 1], p.RS[(m0 + rl + 2) * 2 + 1], p.RS[(m0 + rl + 3) * 2 + 1]};
                        store4_bf16(p.Vmt + ((size_t)(b * 256 + f)) * TP + t0 + rl, acc[mi][ni] * rs);
                    }
            }
        } else {
            hgrn_h1_unit(p, (u - U_Q - U_KV) * 8 + wid, lane);
        }
    }
}

DI void hgrn_h2_unit(CParams& p, int cu  ) {
    const int tid = otid();
    if (tid >= 256) return;
    const int gid = cu * 256 + tid;
    const int seq = gid >> 10, e4 = gid & 1023;
    const int dir = seq & 1, k4 = (e4 & 15) * 4;
    f32x4 st = zero4();
    for (int t0 = 0; t0 < NCH; t0 += 8) {
        f32x4 ds[8], dc[8]; float* ptr[8];
#pragma unroll
        for (int j = 0; j < 8; ++j) {
            const int t = t0 + j, pc = dir == 0 ? t : (t < 8 ? 7 - t : 143 - t);
            ptr[j] = p.DST + ((size_t)(seq * NCH + pc)) * 4096 + e4 * 4;
            ds[j] = *(const f32x4*)ptr[j];
            dc[j] = *(const f32x4*)(p.DEC + (size_t)(seq * NCH + pc) * 64 + k4);
        }
#pragma unroll
        for (int j = 0; j < 8; ++j) { *(f32x4*)ptr[j] = st; st = dc[j] * st + ds[j]; }
    }
}

DI void hgrn_h3_unit(CParams& p, int l, int wu, int lane, char* wl) {
    const int pc = wu % NCH; const int t_ = wu / NCH; const int h = t_ & 3, b = t_ >> 2;
    const int row0 = b * TP + pc * 32, hh = lane >> 5, i = lane & 31;
    float* Bl = (float*)wl;
    f32x16 Y[2];
    { const float z = zf();
#pragma unroll
    for (int r = 0; r < 16; ++r) { Y[0][r] = z; Y[1][r] = z; } }
#pragma unroll 1
    for (int dir = 0; dir < 2; ++dir) {
        const bf16_t* Lf = p.Lf + ((size_t)dir * MR + row0) * 256 + h * 64;
        {
            float lf[32];
#pragma unroll
            for (int j = 0; j < 32; ++j) lf[j] = bf2f(Lf[(size_t)j * 256 + lane]);
            float run = 0.f;
            if (dir == 0) {
#pragma unroll
                for (int j = 0; j < 32; ++j) { run += lf[j]; Bl[j * 68 + lane] = run; }
            } else {
#pragma unroll
                for (int j = 31; j >= 0; --j) { run += lf[j]; Bl[j * 68 + lane] = run; }
            }
        }
        __syncthreads();
        bf16x8 Qf[4], Kf[4];
#pragma unroll
        for (int s = 0; s < 4; ++s) {
            const int kb = 16 * s + 8 * hh;
            const u32x4 qw = *(const u32x4*)(p.Hq + (size_t)(row0 + i) * 256 + h * 64 + kb);
            const u32x4 fw = *(const u32x4*)(Lf + (size_t)i * 256 + kb);
            const f32x4 b0 = *(const f32x4*)(Bl + i * 68 + kb), b1 = *(const f32x4*)(Bl + i * 68 + kb + 4);
            const float bb[8] = {b0[0], b0[1], b0[2], b0[3], b1[0], b1[1], b1[2], b1[3]};
            const unsigned qq[4] = {qw.x, qw.y, qw.z, qw.w}, ff[4] = {fw.x, fw.y, fw.z, fw.w};
            float qd[8], kd[8];
#pragma unroll
            for (int j = 0; j < 8; ++j) {
                const float qv = (j & 1) ? hi2f(qq[j >> 1]) : lo2f(qq[j >> 1]);
                const float fv = (j & 1) ? hi2f(ff[j >> 1]) : lo2f(ff[j >> 1]);
                qd[j] = qv * __expf(bb[j]);
                kd[j] = (1.0f - __expf(fv)) * __expf(-bb[j]);
            }
            Qf[s] = pack8(qd); Kf[s] = pack8(kd);
        }
        f32x16 X;
#pragma unroll
        for (int r = 0; r < 16; ++r) X[r] = zf();
#pragma unroll
        for (int s = 0; s < 4; ++s) X = MFMA32(Kf[s], Qf[s], X);
#pragma unroll
        for (int r = 0; r < 16; ++r) { const int j = crow(r, hh); const bool keep = dir == 0 ? (j <= i) : (j >= i); X[r] = keep ? X[r] : 0.f; }
        bf16x8 Xs[2];
#pragma unroll
        for (int s = 0; s < 2; ++s) { const float v8[8] = {X[8 * s], X[8 * s + 1], X[8 * s + 2], X[8 * s + 3], X[8 * s + 4], X[8 * s + 5], X[8 * s + 6], X[8 * s + 7]}; Xs[s] = pack8(v8); }
        const bf16_t* Vt = p.Vht + ((size_t)(b * 4 + h) * 64) * TP + pc * 32;
        const float* ST = p.DST + ((size_t)(((b * 4 + h) * 2 + dir) * NCH + pc)) * 4096;
#pragma unroll
        for (int vt = 0; vt < 2; ++vt) {
            const bf16_t* vrow = Vt + (size_t)(vt * 32 + i) * TP;
#pragma unroll
            for (int s = 0; s < 2; ++s) {
                const u32x2 lo = *(const u32x2*)(vrow + 16 * s + 4 * hh), hi = *(const u32x2*)(vrow + 16 * s + 8 + 4 * hh);
                u32x4 w; w.x = lo.x; w.y = lo.y; w.z = hi.x; w.w = hi.y;
                Y[vt] = MFMA32(__builtin_bit_cast(bf16x8, w), Xs[s], Y[vt]);
            }
            const float* srow = ST + (vt * 32 + i) * 64;
#pragma unroll
            for (int s = 0; s < 4; ++s) {
                const f32x4 a0 = *(const f32x4*)(srow + 16 * s + 8 * hh), a1 = *(const f32x4*)(srow + 16 * s + 8 * hh + 4);
                const float v8[8] = {a0[0], a0[1], a0[2], a0[3], a1[0], a1[1], a1[2], a1[3]};
                Y[vt] = MFMA32(pack8(v8), Qf[s], Y[vt]);
            }
        }
        __syncthreads();
    }
    float ss = 0.f;
#pragma unroll
    for (int r = 0; r < 16; ++r) ss += Y[0][r] * Y[0][r] + Y[1][r] * Y[1][r];
    ss += shx<32>(ss);
    const float rs = rsqrtf(ss * (1.f / 64.f) + LN_EPS);
    const int row = row0 + i;
#pragma unroll
    for (int vt = 0; vt < 2; ++vt)
#pragma unroll
        for (int g4 = 0; g4 < 4; ++g4) {
            const int v0 = vt * 32 + 8 * g4 + 4 * hh;
            const f32x4 nw = *(const f32x4*)(p.hgrn_norm_w + l * 64 + v0);
            const u32x2 gw = *(const u32x2*)(p.Hg + (size_t)row * 256 + h * 64 + v0);
            f32x4 o;
            o[0] = Y[vt][g4 * 4 + 0] * rs * nw[0] * lo2f(gw.x); o[1] = Y[vt][g4 * 4 + 1] * rs * nw[1] * hi2f(gw.x);
            o[2] = Y[vt][g4 * 4 + 2] * rs * nw[2] * lo2f(gw.y); o[3] = Y[vt][g4 * 4 + 3] * rs * nw[3] * hi2f(gw.y);
            store4_bf16(p.O + (size_t)row * DM + 512 + h * 64 + v0, o);
        }
}

template <bool DIFF>
DI void attn_unit(CParams& p, int l, int b, int h, int qrow0  , int nkt  , char* lds) {
    const int tid = otid(), wid = tid >> 6, lane = tid & 63, hh = lane >> 5, q31 = lane & 31;
    constexpr int NS = DIFF ? 2 : 1;
    constexpr int NQF = DIFF ? 4 : 6;
    constexpr int BUF = 8192 + 8192 + (DIFF ? 0 : 4096);
    const int qrow = qrow0 + wid * 32 + q31;
    bf16x8 Qf[NQF];
    {
        const bf16_t* qp = DIFF ? p.Qd + (size_t)qrow * 256 + h * 64 : p.Qm + (size_t)qrow * 384 + h * 96;
#pragma unroll
        for (int s = 0; s < NQF; ++s) Qf[s] = *(const bf16x8*)(qp + 16 * s + 8 * hh);
    }
    const size_t krow0 = (size_t)b * TP;
    const bf16_t* kptr = (DIFF ? p.Kd : p.Kn) + (krow0 + (tid >> 3)) * 256 + h * 64 + (tid & 7) * 8;
    const bf16_t* vptr = (DIFF ? p.Vdt : p.Vmt) + ((size_t)(b * 4 + h) * 64 + (tid >> 3)) * TP + (tid & 7) * 8;
    const bf16_t* rptr = p.Kr + (krow0 + ((tid & 255) >> 2)) * 32 + (tid & 3) * 8;
    const int key_w = tid >> 3, c_w = tid & 7;
    const int kwoff = key_w * 128 + ((c_w ^ ((key_w >> 1) & 7)) << 4);
    const int d_w = tid >> 3;
    const int vwoff0 = 8192 + d_w * 128 + (((2 * c_w) ^ ((d_w >> 1) & 15)) << 3), vwoff1 = 8192 + d_w * 128 + (((2 * c_w + 1) ^ ((d_w >> 1) & 15)) << 3);
    const int rkey = (tid & 255) >> 2, rc = tid & 3;
    const int rwoff = 16384 + rkey * 64 + ((rc ^ ((rkey >> 2) & 3)) << 4);
    const int krd = q31 * 128, ksw = (q31 >> 1) & 7;
    const int rrd = 16384 + q31 * 64, rsw = (q31 >> 2) & 3;
    const int vrd = 8192 + q31 * 128, vsw = (q31 >> 1) & 15;
    f32x16 ot[NS][2];
    float m[NS], lsum[NS];
#pragma unroll
    for (int a = 0; a < NS; ++a) { m[a] = 0.f; lsum[a] = 0.f;
#pragma unroll
        for (int r = 0; r < 16; ++r) { ot[a][0][r] = zf(); ot[a][1][r] = zf(); } }
    u32x4 rk, rv, rr;
    rk = *(const u32x4*)kptr; rv = *(const u32x4*)vptr;
    if (!DIFF) { if (tid < 256) rr = *(const u32x4*)rptr; }
    __syncthreads();
    *(u32x4*)(lds + kwoff) = rk;
    *(u32x2*)(lds + vwoff0) = (u32x2){rv.x, rv.y}; *(u32x2*)(lds + vwoff1) = (u32x2){rv.z, rv.w};
    if (!DIFF) { if (tid < 256) *(u32x4*)(lds + rwoff) = rr; }
    __syncthreads();
    for (int kt = 0; kt < nkt; ++kt) {
        const char* cur = lds + (kt & 1) * BUF;
        const bool more = kt + 1 < nkt;
        if (more) {
            rk = *(const u32x4*)(kptr + (size_t)(kt + 1) * 64 * 256);
            rv = *(const u32x4*)(vptr + (kt + 1) * 64);
            if (!DIFF) { if (tid < 256) rr = *(const u32x4*)(rptr + (size_t)(kt + 1) * 64 * 32); }
        }
        bf16x8 Pf[NS][2][2];
#pragma unroll
        for (int a = 0; a < NS; ++a) {
            f32x16 st[2];
            const float negm = -m[a];
            constexpr int NKF = DIFF ? 2 : 6;
            bf16x8 kf[2][NKF];
#pragma unroll
            for (int t = 0; t < 2; ++t) {
                if (DIFF) {
#pragma unroll
                    for (int s = 0; s < 2; ++s) kf[t][s] = *(const bf16x8*)(cur + t * 4096 + krd + (((4 * a + 2 * s + hh) ^ ksw) << 4));
                } else {
#pragma unroll
                    for (int s = 0; s < 4; ++s) kf[t][s] = *(const bf16x8*)(cur + t * 4096 + krd + (((2 * s + hh) ^ ksw) << 4));
#pragma unroll
                    for (int s = 0; s < 2; ++s) kf[t][4 + s] = *(const bf16x8*)(cur + t * 2048 + rrd + (((2 * s + hh) ^ rsw) << 4));
                }
            }
            __builtin_amdgcn_sched_barrier(0);
#pragma unroll
            for (int t = 0; t < 2; ++t) {
                f32x16 acc;
#pragma unroll
                for (int r = 0; r < 16; ++r) acc[r] = negm;
#pragma unroll
                for (int s = 0; s < NKF; ++s) acc = MFMA32(kf[t][s], Qf[DIFF ? 2 * a + s : s], acc);
                st[t] = acc;
            }
            float tm = fmaxf(fmaxf(st[0][0], st[0][1]), st[0][2]);
#pragma unroll
            for (int r = 3; r < 15; r += 2) tm = fmaxf(fmaxf(tm, st[0][r]), st[0][r + 1]);
            tm = fmaxf(tm, st[0][15]);
#pragma unroll
            for (int r = 0; r < 16; r += 2) tm = fmaxf(fmaxf(tm, st[1][r]), st[1][r + 1]);
            { const auto sw = __builtin_amdgcn_permlane32_swap(__float_as_uint(tm), __float_as_uint(tm), false, false); tm = fmaxf(__uint_as_float(sw[0]), __uint_as_float(sw[1])); }
            if (kt == 0 || __any(tm > 8.0f)) {
                const float delta = kt == 0 ? tm : fmaxf(tm, 0.f);
                const float alpha = __builtin_amdgcn_exp2f(-delta);
                m[a] += delta; lsum[a] *= alpha;
#pragma unroll
                for (int r = 0; r < 16; ++r) { st[0][r] -= delta; st[1][r] -= delta; ot[a][0][r] *= alpha; ot[a][1][r] *= alpha; }
            }
            float ps = 0.f;
#pragma unroll
            for (int t = 0; t < 2; ++t) {
#pragma unroll
                for (int r = 0; r < 16; ++r) { const float e = __builtin_amdgcn_exp2f(st[t][r]); st[t][r] = e; ps += e; }
#pragma unroll
                for (int s = 0; s < 2; ++s) {
                    const float v8[8] = {st[t][8 * s], st[t][8 * s + 1], st[t][8 * s + 2], st[t][8 * s + 3], st[t][8 * s + 4], st[t][8 * s + 5], st[t][8 * s + 6], st[t][8 * s + 7]};
                    Pf[a][t][s] = pack8(v8);
                }
            }
            lsum[a] += ps;
            if (DIFF) __builtin_amdgcn_sched_barrier(0);
        }
#pragma unroll
        for (int dt = 0; dt < 2; ++dt) {
            bf16x8 vf[2][2];
#pragma unroll
            for (int t = 0; t < 2; ++t)
#pragma unroll
                for (int s = 0; s < 2; ++s) {
                    const int c8 = 8 * t + 4 * s + hh;
                    const u32x2 lo = *(const u32x2*)(cur + dt * 4096 + vrd + ((c8 ^ vsw) << 3));
                    const u32x2 hi = *(const u32x2*)(cur + dt * 4096 + vrd + (((c8 + 2) ^ vsw) << 3));
                    u32x4 w; w.x = lo.x; w.y = lo.y; w.z = hi.x; w.w = hi.y;
                    vf[t][s] = __builtin_bit_cast(bf16x8, w);
                }
            __builtin_amdgcn_sched_barrier(0);
#pragma unroll
            for (int t = 0; t < 2; ++t)
#pragma unroll
                for (int s = 0; s < 2; ++s)
#pragma unroll
                    for (int a = 0; a < NS; ++a) ot[a][dt] = MFMA32(vf[t][s], Pf[a][t][s], ot[a][dt]);
        }
        if (more) {
            char* nxt = lds + ((kt + 1) & 1) * BUF;
            *(u32x4*)(nxt + kwoff) = rk;
            *(u32x2*)(nxt + vwoff0) = (u32x2){rv.x, rv.y}; *(u32x2*)(nxt + vwoff1) = (u32x2){rv.z, rv.w};
            if (!DIFF) { if (tid < 256) *(u32x4*)(nxt + rwoff) = rr; }
        }
        __syncthreads();
    }
    float linv[NS];
#pragma unroll
    for (int a = 0; a < NS; ++a) { const float lt = lsum[a] + shx<32>(lsum[a]); linv[a] = 1.0f / lt; }
    f32x16 o[2];
    if (DIFF) {
        const float lam = p.lam[l];
#pragma unroll
        for (int dt = 0; dt < 2; ++dt)
#pragma unroll
            for (int r = 0; r < 16; ++r) o[dt][r] = ot[0][dt][r] * linv[0] - lam * (ot[NS - 1][dt][r] * linv[NS - 1]);
        float ss = 0.f;
#pragma unroll
        for (int r = 0; r < 16; ++r) ss += o[0][r] * o[0][r] + o[1][r] * o[1][r];
        ss += shx<32>(ss);
        int lz = l; asm volatile("" : "+s"(lz));
        const float lam_init = lz == 0 ? 0.2f : 0.3555090676f;
        const float rs = rsqrtf(ss * (1.f / 64.f) + LN_EPS) * (1.0f - lam_init);
#pragma unroll
        for (int dt = 0; dt < 2; ++dt)
#pragma unroll
            for (int r = 0; r < 16; ++r) o[dt][r] *= rs;
    } else {
#pragma unroll
        for (int dt = 0; dt < 2; ++dt)
#pragma unroll
            for (int r = 0; r < 16; ++r) o[dt][r] = ot[0][dt][r] * linv[0];
    }
    bf16_t* orow = p.O + (size_t)qrow * DM + (DIFF ? 256 : 768) + h * 64;
#pragma unroll
    for (int dt = 0; dt < 2; ++dt)
#pragma unroll
        for (int g4 = 0; g4 < 4; ++g4) {
            const int d0 = dt * 32 + 8 * g4 + 4 * hh;
            f32x4 v = {o[dt][g4 * 4], o[dt][g4 * 4 + 1], o[dt][g4 * 4 + 2], o[dt][g4 * 4 + 3]};
            if (DIFF) { const f32x4 sw = *(const f32x4*)(p.diff_subln_w + l * 64 + d0); v = v * sw; }
            store4_bf16(orow + d0, v);
        }
}

DI void phase_attn_diff_h2(CParams& p, int l, char* lds, bool h2skip) {
    const int G = gridDim.x;
    const int U_H2 = 256, U_LAT = NB * 4 * 16, U_CTX = (l == 0) ? NB * 4 : 0;
    const int total = U_H2 + 2 * U_LAT + 2 * U_CTX;
    for (int u = blockIdx.x; u < total; u += G) {
        if (u < U_H2) { if (!h2skip) hgrn_h2_unit(p, u); continue; }
        int v = u - U_H2; bool diff; int b, h, q0, nkt;
        if (v < 2 * U_LAT) { diff = v < U_LAT; if (!diff) v -= U_LAT; b = v >> 6; h = (v >> 4) & 3; q0 = b * TP + CTX + (v & 15) * 256; nkt = TP / 64; }
        else { v -= 2 * U_LAT; diff = v < U_CTX; if (!diff) v -= U_CTX; b = v >> 2; h = v & 3; q0 = b * TP; nkt = CTX / 64; }
        if (diff) attn_unit<true>(p, l, b, h, q0, nkt, lds); else attn_unit<false>(p, l, b, h, q0, nkt, lds);
    }
}
DI void phase_attn_mla_h3(CParams& p, int l, char* lds) {
    const int tid_ = otid(); const int wid = tid_ >> 6, lane = tid_ & 63;
    const int U_H3 = NB * 4 * NCH / 8;
    for (int u = blockIdx.x; u < U_H3; u += gridDim.x) { __syncthreads(); hgrn_h3_unit(p, l, u * 8 + wid, lane, lds + 65536 + wid * 8704); }
}

struct SchedOut {
    const char* O; const char* W; int l;
    DI bool next(int i, g8::GU& u) const {
        int pm, pn;
        if (l == 0) { if (!g8::order_next(i, MR / 256, 4, pm, pn)) return false; }
        else { if (!g8::order_next(i, NB * 16, 4, pm, pn)) return false; pm = (pm >> 4) * 17 + 1 + (pm & 15); }
        u.pm = pm; u.pn = pn; u.e = 0; u.j0 = 0; u.a = O + (size_t)pm * 256 * 2048; u.b = W + (size_t)pn * 256 * 2048; return true;
    }
    DI unsigned arow(const g8::GU&, int) const { return 0u; }
};
struct EpiOut {
    float* Y;
    DI void operator()(const f32x4 (&acc)[2][2][4][2], const g8::GU& u, int wr, int wc, int fr, int fq) const {
#pragma unroll
        for (int ai = 0; ai < 2; ++ai)
#pragma unroll
            for (int bj = 0; bj < 2; ++bj)
#pragma unroll
                for (int m = 0; m < 4; ++m)
#pragma unroll
                    for (int n = 0; n < 2; ++n) {
                        const int row = u.pm * 256 + 128 * ai + 64 * wr + 16 * m + fr, col = u.pn * 256 + 128 * bj + 32 * wc + 16 * n + 4 * fq;
                        *(f32x4*)(Y + (size_t)row * DM + col) = acc[ai][bj][m][n];
                    }
    }
};
DI void phase_outproj(CParams& p, int l, char* lds) {
    SchedOut S; S.O = (const char*)p.O; S.W = (const char*)(p.WoutT + (size_t)l * DM * DM); S.l = l;
    EpiOut E; E.Y = p.Y;
    g8::gemm8<EpiOut, SchedOut, false>(lds, DM, nullptr, S, E);
}

DI void phase_postmix(CParams& p, int l, char* lds) {
    const int tid = otid(), wid = tid >> 6, lane = tid & 63;
    float* WrT = (float*)lds;
    int* lcnt = (int*)(lds + 131072);
    int* lbase = lcnt + 32;
    unsigned* ent = (unsigned*)(lds + 131072 + 256);
    const int G = gridDim.x, nrb = (MR + G - 1) / G;
    const float* rw = p.router_w + (size_t)l * DM * NE;
    __syncthreads();
    for (int i = tid; i < DM * NE / 4; i += NTHREADS) {
        const f32x4 v = *(const f32x4*)(rw + i * 4);
        const int d = i >> 3, e0 = (i & 7) * 4;
#pragma unroll
        for (int j = 0; j < 4; ++j) WrT[(e0 + j) * DM + d] = v[j];
    }
    if (tid < 32) lcnt[tid] = 0;
    __syncthreads();
    const int rbeg = blockIdx.x * nrb;
    const float* lw = p.ln_mix_w + l * DM; const float* lb = p.ln_mix_b + l * DM;
    for (int i0 = wid * 2; i0 < nrb; i0 += 16) {
        f32x4 v[2][4]; bool act[2];
#pragma unroll
        for (int rr = 0; rr < 2; ++rr) {
            const int i = i0 + rr; int row = rbeg + i;
            act[rr] = (i < nrb) && (row < MR);
            if (!act[rr]) row = rbeg;
            const int t = row % TP;
            if (l == 1 && t < CTX) { if (act[rr] && lane < 4) ent[(i * 4 + lane) * 2] = 0xffffffffu; act[rr] = false; }
            const float* xr = l == 0 ? in_row(p, row) : p.X + (size_t)row * DM;
            const float* yr = p.Y + (size_t)row * DM;
            const float* g1 = mod_vec(p, l, row, 2); const float* sh2 = mod_vec(p, l, row, 3); const float* sc2 = mod_vec(p, l, row, 4);
            float s = 0.f;
#pragma unroll
            for (int j = 0; j < 4; ++j) { const int c = j * 256 + lane * 4; v[rr][j] = *(const f32x4*)(xr + c) * DN_ALPHA + *(const f32x4*)(g1 + c) * *(const f32x4*)(yr + c); s += (v[rr][j][0] + v[rr][j][1]) + (v[rr][j][2] + v[rr][j][3]); }
            float mean = wave_sum(s) * (1.f / DM); float q = 0.f;
#pragma unroll
            for (int j = 0; j < 4; ++j) { v[rr][j] = v[rr][j] - mean; q += (v[rr][j][0] * v[rr][j][0] + v[rr][j][1] * v[rr][j][1]) + (v[rr][j][2] * v[rr][j][2] + v[rr][j][3] * v[rr][j][3]); }
            float rstd = rsqrtf(wave_sum(q) * (1.f / DM) + LN_EPS);
            s = 0.f;
#pragma unroll
            for (int j = 0; j < 4; ++j) { const int c = j * 256 + lane * 4; v[rr][j] = v[rr][j] * rstd * *(const f32x4*)(lw + c) + *(const f32x4*)(lb + c);
                if (act[rr]) *(f32x4*)(p.X + (size_t)row * DM + c) = v[rr][j];
                s += (v[rr][j][0] + v[rr][j][1]) + (v[rr][j][2] + v[rr][j][3]); }
            mean = wave_sum(s) * (1.f / DM); q = 0.f;
#pragma unroll
            for (int j = 0; j < 4; ++j) { v[rr][j] = v[rr][j] - mean; q += (v[rr][j][0] * v[rr][j][0] + v[rr][j][1] * v[rr][j][1]) + (v[rr][j][2] * v[rr][j][2] + v[rr][j][3] * v[rr][j][3]); }
            rstd = rsqrtf(wave_sum(q) * (1.f / DM) + LN_EPS);
#pragma unroll
            for (int j = 0; j < 4; ++j) { const int c = j * 256 + lane * 4; v[rr][j] = v[rr][j] * rstd * (*(const f32x4*)(sc2 + c) + 1.0f) + *(const f32x4*)(sh2 + c);
                if (act[rr]) store4_bf16(p.H + (size_t)row * DM + c, v[rr][j]); }
            __builtin_amdgcn_sched_barrier(0);
        }
        float lq[2][4];
#pragma unroll
        for (int qt = 0; qt < 4; ++qt) {
            float pl[2][8];
#pragma unroll
            for (int e = 0; e < 8; ++e) {
                float a0 = 0.f, a1 = 0.f;
#pragma unroll
                for (int j = 0; j < 4; ++j) {
                    const f32x4 w = *(const f32x4*)(WrT + (qt * 8 + e) * DM + j * 256 + lane * 4);
                    a0 += (v[0][j][0] * w[0] + v[0][j][1] * w[1]) + (v[0][j][2] * w[2] + v[0][j][3] * w[3]);
                    a1 += (v[1][j][0] * w[0] + v[1][j][1] * w[1]) + (v[1][j][2] * w[2] + v[1][j][3] * w[3]);
                }
                pl[0][e] = a0; pl[1][e] = a1;
                if ((e & 3) == 3) __builtin_amdgcn_sched_barrier(0);
            }
#pragma unroll
            for (int rr = 0; rr < 2; ++rr) {
                float r4[4], r2[2];
#pragma unroll
                for (int e = 0; e < 4; ++e) { const bool up = (lane & 4) != 0; const float keep = up ? pl[rr][e + 4] : pl[rr][e]; const float send = up ? pl[rr][e] : pl[rr][e + 4]; r4[e] = keep + dpp<DPP_HM>(send); }
#pragma unroll
                for (int e = 0; e < 2; ++e) { const bool up = (lane & 2) != 0; const float keep = up ? r4[e + 2] : r4[e]; const float send = up ? r4[e] : r4[e + 2]; r2[e] = keep + dpp<DPP_X2>(send); }
                float x1; { const bool up = (lane & 1) != 0; const float keep = up ? r2[1] : r2[0]; const float send = up ? r2[0] : r2[1]; x1 = keep + dpp<DPP_X1>(send); }
                x1 += shx<8>(x1); x1 += shx<16>(x1); x1 += shx<32>(x1);
                lq[rr][qt] = x1;
            }
            __builtin_amdgcn_sched_barrier(0);
        }
#pragma unroll
        for (int rr = 0; rr < 2; ++rr) {
            const int i = i0 + rr;
            const int e_me = lane & 31;
            const int qsel = (lane >> 3) & 3;
            float logit = (qsel == 0 ? lq[rr][0] : qsel == 1 ? lq[rr][1] : qsel == 2 ? lq[rr][2] : lq[rr][3]) + p.router_b[l * NE + e_me];
            logit = (logit == logit) ? fminf(fmaxf(logit, -1e30f), 1e30f) : -1e30f;
            int rank = 0;
#pragma unroll
            for (int e = 0; e < 32; ++e) { const float o = rdlane(logit, e); rank += (o > logit || (o == logit && e < e_me)) ? 1 : 0; }
            const float vmax = rdlane(logit, __builtin_amdgcn_readfirstlane(__ffsll((long long)__ballot(rank == 0 && lane < 32)) - 1));
            const float ex = (rank < 4) ? __expf(logit - vmax) : 0.f;
            const float den = wave_sum((lane < 32) ? ex : 0.f);
            if (act[rr] && lane < 32 && rank < 4) {
                const int lp = atomicAdd(&lcnt[e_me], 1);
                ent[(i * 4 + rank) * 2] = (unsigned)e_me | ((unsigned)lp << 8);
                ent[(i * 4 + rank) * 2 + 1] = __float_as_uint(ex / den);
            }
        }
    }
    __syncthreads();
    if (tid < 32) lbase[tid] = (int)atomicAdd(&p.gcnt[l * NE + tid], (unsigned)lcnt[tid]);
    __syncthreads();
    for (int j = tid; j < nrb * 4; j += NTHREADS) {
        const int row = rbeg + (j >> 2);
        if (row >= MR) break;
        const unsigned w = ent[j * 2];
        if (w == 0xffffffffu) continue;
        const int e = w & 255, pos = lbase[e] + (int)(w >> 8);
        p.ltok[(size_t)e * MR + pos] = row;
        p.lgate[(size_t)e * MR + pos] = __uint_as_float(ent[j * 2 + 1]);
        p.rslot[(size_t)row * 4 + (j & 3)] = (e << 24) | pos;
    }
}

DI int moe_prefix(CParams& p, int l, int* tpre  ) {
    __syncthreads();
    if (otid() == 0) {
        int acc = 0;
        for (int e = 0; e < NE; ++e) { tpre[e] = acc; acc += ((int)p.gcnt[l * NE + e] + 255) >> 8; }
        tpre[NE] = acc;
    }
    __syncthreads();
    return tpre[NE];
}
DI int moe_find(const int* tpre, int mt) { int e = 0;
#pragma unroll 1
    for (int j = 0; j < NE; ++j) if (tpre[j + 1] <= mt) e = j + 1;
    return e; }

constexpr int TPRE_OFF = 135168;
struct SchedMoe {
    const int* tpre; const unsigned* cnt; const int* ltok; const char* A; const char* W; int nN; size_t wstride;
    DI bool next(int i, g8::GU& u) const {
        int pm, pn; if (!g8::order_next(i, __builtin_amdgcn_readfirstlane(tpre[NE]), nN, pm, pn)) return false;
        const int e = __builtin_amdgcn_readfirstlane(moe_find(tpre, pm));
        u.pm = pm; u.pn = pn; u.e = e; u.j0 = __builtin_amdgcn_readfirstlane((pm - tpre[e]) * 256);
        u.a = A + (size_t)pm * 256 * 2048; u.b = W + (size_t)e * wstride + (size_t)pn * 256 * 2048; return true;
    }
    DI unsigned arow(const g8::GU& u, int r) const { const int pos = u.j0 + r; return pos < (int)cnt[u.e] ? (unsigned)ltok[(size_t)u.e * MR + pos] : 0u; }
};
struct EpiMoe1 {
    const float* b1; bf16_t* ACT;
    DI void operator()(const f32x4 (&acc)[2][2][4][2], const g8::GU& u, int wr, int wc, int fr, int fq) const {
        const float* bb1 = b1 + (size_t)u.e * 2048;
#pragma unroll
        for (int ai = 0; ai < 2; ++ai)
#pragma unroll
            for (int bj = 0; bj < 2; ++bj)
#pragma unroll
                for (int m = 0; m < 4; ++m)
#pragma unroll
                    for (int n = 0; n < 2; ++n) {
                        const int rl = 128 * ai + 64 * wr + 16 * m + fr, col = u.pn * 256 + 128 * bj + 32 * wc + 16 * n + 4 * fq;
                        const f32x4 hv = acc[ai][bj][m][n] + *(const f32x4*)(bb1 + col);
                        float o[2];
#pragma unroll
                        for (int q = 0; q < 2; ++q) {
                            const float glu = fminf(hv[2 * q], 7.0f), lin = fminf(fmaxf(hv[2 * q + 1], -7.0f), 7.0f);
                            o[q] = glu * sigmoidf_(1.702f * glu) * (lin + 1.0f);
                        }
                        *(unsigned*)(ACT + ((size_t)u.pm * 256 + rl) * 1024 + (col >> 1)) = pk2(o[0], o[1]);
                    }
    }
};
struct EpiMoe2 {
    const float* b2; const float* lgate; const unsigned* cnt; bf16_t* YS;
    DI void operator()(const f32x4 (&acc)[2][2][4][2], const g8::GU& u, int wr, int wc, int fr, int fq) const {
        const float* bb2 = b2 + (size_t)u.e * DM;
        const int cn = (int)cnt[u.e];
#pragma unroll
        for (int ai = 0; ai < 2; ++ai)
#pragma unroll
            for (int m = 0; m < 4; ++m) {
                const int rl = 128 * ai + 64 * wr + 16 * m + fr, pos = u.j0 + rl;
                const float gate = pos < cn ? lgate[(size_t)u.e * MR + pos] : 0.f;
#pragma unroll
                for (int bj = 0; bj < 2; ++bj)
#pragma unroll
                    for (int n = 0; n < 2; ++n) {
                        const int col = u.pn * 256 + 128 * bj + 32 * wc + 16 * n + 4 * fq;
                        store4_bf16(YS + ((size_t)u.pm * 256 + rl) * 1024 + col, (acc[ai][bj][m][n] + *(const f32x4*)(bb2 + col)) * gate);
                    }
                __builtin_amdgcn_sched_barrier(0);
            }
    }
};
DI void phase_moe1(CParams& p, int l, char* lds) {
    int* tpre = (int*)(lds + TPRE_OFF);
    moe_prefix(p, l, tpre);
    SchedMoe S; S.tpre = tpre; S.cnt = p.gcnt + l * NE; S.ltok = p.ltok; S.A = nullptr; S.W = (const char*)(p.W1T + (size_t)l * NE * 2048 * DM); S.nN = 8; S.wstride = (size_t)2048 * DM * 2;
    EpiMoe1 E; E.b1 = p.b1 + (size_t)l * NE * 2048; E.ACT = p.ACT;
    g8::gemm8<EpiMoe1, SchedMoe, true>(lds, DM, (const char*)p.H, S, E);
}
DI void phase_moe2(CParams& p, int l, char* lds) {
    int* tpre = (int*)(lds + TPRE_OFF);
    moe_prefix(p, l, tpre);
    SchedMoe S; S.tpre = tpre; S.cnt = p.gcnt + l * NE; S.ltok = p.ltok; S.A = (const char*)p.ACT; S.W = (const char*)(p.W2T + (size_t)l * NE * DM * DM); S.nN = 4; S.wstride = (size_t)DM * DM * 2;
    EpiMoe2 E; E.b2 = p.b2 + (size_t)l * NE * DM; E.lgate = p.lgate; E.cnt = p.gcnt + l * NE; E.YS = p.YS;
    g8::gemm8<EpiMoe2, SchedMoe, false>(lds, DM, nullptr, S, E);
}

DI void phase_final(CParams& p, int l, char* lds) {
    const int tid = otid(), wid = tid >> 6, lane = tid & 63;
    int* tpre = (int*)(lds + TPRE_OFF);
    moe_prefix(p, l, tpre);
    const float* lw = p.ln_ffn_w + l * DM; const float* lb = p.ln_ffn_b + l * DM;
    for (int row = blockIdx.x * 8 + wid; row < MR; row += gridDim.x * 8) {
        const int b = row / TP, t = row - b * TP;
        if (l == 1 && t < CTX) continue;
        const float* g2 = mod_vec(p, l, row, 5);
        const bf16_t* ys[4];
#pragma unroll
        for (int k = 0; k < 4; ++k) { const int rs = p.rslot[(size_t)row * 4 + k]; const int e = rs >> 24, pos = rs & 0xffffff; ys[k] = p.YS + ((size_t)tpre[e] * 256 + pos) * 1024; }
        f32x4 v[4]; float s = 0.f;
#pragma unroll
        for (int j = 0; j < 4; ++j) {
            const int c = j * 256 + lane * 4;
            f32x4 y = zero4();
#pragma unroll
            for (int k = 0; k < 4; ++k) { const u32x2 w = *(const u32x2*)(ys[k] + c); y[0] += lo2f(w.x); y[1] += hi2f(w.x); y[2] += lo2f(w.y); y[3] += hi2f(w.y); }
            const f32x4 xv = *(const f32x4*)(p.X + (size_t)row * DM + c), gg = *(const f32x4*)(g2 + c);
            v[j] = xv * DN_ALPHA + gg * y;
            s += (v[j][0] + v[j][1]) + (v[j][2] + v[j][3]);
        }
        float mean = wave_sum(s) * (1.f / DM); float q = 0.f;
#pragma unroll
        for (int j = 0; j < 4; ++j) { v[j] = v[j] - mean; q += (v[j][0] * v[j][0] + v[j][1] * v[j][1]) + (v[j][2] * v[j][2] + v[j][3] * v[j][3]); }
        float rstd = rsqrtf(wave_sum(q) * (1.f / DM) + LN_EPS);
        s = 0.f;
#pragma unroll
        for (int j = 0; j < 4; ++j) {
            const int c = j * 256 + lane * 4;
            v[j] = v[j] * rstd * *(const f32x4*)(lw + c) + *(const f32x4*)(lb + c);
            s += (v[j][0] + v[j][1]) + (v[j][2] + v[j][3]);
        }
        if (l == 1) {
            float* o = p.out + ((size_t)b * SEQ + (t - CTX)) * DM;
#pragma unroll
            for (int j = 0; j < 4; ++j) *(f32x4*)(o + j * 256 + lane * 4) = v[j];
        } else {
#pragma unroll
            for (int j = 0; j < 4; ++j) *(f32x4*)(p.X + (size_t)row * DM + j * 256 + lane * 4) = v[j];
            mean = wave_sum(s) * (1.f / DM); q = 0.f;
#pragma unroll
            for (int j = 0; j < 4; ++j) { v[j] = v[j] - mean; q += (v[j][0] * v[j][0] + v[j][1] * v[j][1]) + (v[j][2] * v[j][2] + v[j][3] * v[j][3]); }
            rstd = rsqrtf(wave_sum(q) * (1.f / DM) + LN_EPS);
            const float* sh = mod_vec(p, 1, row, 0); const float* sc = mod_vec(p, 1, row, 1);
#pragma unroll
            for (int j = 0; j < 4; ++j) {
                const int c = j * 256 + lane * 4;
                const f32x4 h = v[j] * rstd * (*(const f32x4*)(sc + c) + 1.0f) + *(const f32x4*)(sh + c);
                store4_bf16(p.H + (size_t)row * DM + c, h);
            }
        }
    }
}

constexpr int PH_PER_LAYER = 11, N_PHASES = 1 + 2 * PH_PER_LAYER;

__global__ void __launch_bounds__(NTHREADS, 2) mega(Params p_unused, int ph_lo, int ph_hi) {
    extern __shared__ __attribute__((aligned(16))) char smem[];
    CParams* kp0 = (CParams*)__builtin_amdgcn_kernarg_segment_ptr();
    CParams& p = *kp0;
    ((volatile int*)(smem + WVTAB_OFF))[hw_slot()] = (int)(threadIdx.x >> 6);
    __syncthreads();
    const bool fused = (ph_hi - ph_lo) > 1;
    XcdBarrier bar; bar.bar = p.bar; bar.x = 0; bar.st = (volatile LAS unsigned*)(smem + LDS_BYTES - 16);
    if (fused) {
        if (otid() == 0) *(uint4*)(smem + LDS_BYTES - 16) = make_uint4(0u, 0u, 0u, 0u);
        __syncthreads();
        bar = xcd_barrier_post(p.bar, (volatile LAS unsigned*)(smem + LDS_BYTES - 16));
    }
#if MK_DEBUG == 2
#define PH_STAMP(i) if (blockIdx.x == 0 && threadIdx.x == 0) ((unsigned long long*)(p.gcnt + 1024))[(i) + 1] = wall_clock64();
#else
#define PH_STAMP(i)
#endif
#ifndef MK_REP
#define MK_REP 0u
#endif
#define PH(idx, call) do { const int _i = (idx); if (ph_lo <= _i && _i < ph_hi) { CParams* _kp = kp0; asm volatile("" : "+s"(_kp)); CParams& p = *_kp; call; if ((MK_REP >> (_i == 0 ? 0 : 1 + (_i - 1) % 11)) & 1u) { xcd_barrier(bar); h2skip = true; call; h2skip = false; } if (_i + 1 < ph_hi) xcd_barrier(bar); PH_STAMP(_i) } } while (0)
    bool h2skip = false;
    PH_STAMP(-1)
    PH(0, phase_prologue(p, smem));
#pragma unroll 1
    for (int l = 0; l < 2; ++l) {
        const int base = 1 + l * PH_PER_LAYER;
        PH(base + 0, if (l == 0) phase_ln1(p, smem));
        PH(base + 1, phase_inproj(p, l, smem));
        PH(base + 2, phase_sgu_prep(p, l, smem));
        PH(base + 3, phase_upproj_h1(p, l, smem));
        PH(base + 4, phase_attn_diff_h2(p, l, smem, h2skip));
        PH(base + 5, phase_attn_mla_h3(p, l, smem));
        PH(base + 6, phase_outproj(p, l, smem));
        PH(base + 7, phase_postmix(p, l, smem));
        PH(base + 8, phase_moe1(p, l, smem));
        PH(base + 9, phase_moe2(p, l, smem));
        PH(base + 10, phase_final(p, l, smem));
    }
#undef PH
}


#ifndef MK_DEBUG
#define MK_DEBUG 0
#define MK_REP 0u
#endif
#if MK_DEBUG
struct DbgItem { const void* ptr; unsigned long long n; int f32; int ld; int c0; int c1; int mode; int pad; };
struct DbgList { DbgItem it[40]; int count; int pad; };
__global__ void dbg_scan(DbgList L, unsigned* flag) {
    for (int i = 0; i < L.count; ++i) {
        const DbgItem d = L.it[i];
        bool bad = false;
        for (unsigned long long e = (unsigned long long)blockIdx.x * blockDim.x + threadIdx.x; e < d.n; e += (unsigned long long)gridDim.x * blockDim.x) {
            if (d.ld > 0) { const int c = (int)(e % d.ld); if (c < d.c0 || c >= d.c1) continue; }
            if (d.f32) { const unsigned u = ((const unsigned*)d.ptr)[e]; if (((d.mode & 1) && (u & 0x7f800000u) == 0x7f800000u) || ((d.mode & 2) && u == 0xAAAAAAAAu) || ((d.mode & 4) && (u & 0x7f800000u) >= 0x46800000u)) bad = true; }
            else { const unsigned short u = ((const unsigned short*)d.ptr)[e]; if (((d.mode & 1) && (u & 0x7f80u) == 0x7f80u) || ((d.mode & 2) && u == 0xAAAAu) || ((d.mode & 4) && (u & 0x7f80u) >= 0x4680u)) bad = true; }
        }
        if (bad) atomicMin(flag, (unsigned)i);
    }
}
__global__ void dbg_time(float* out, unsigned long long n, const unsigned long long* ts, unsigned maskA, unsigned maskB) {
    float ta = 0.f, tb = 0.f;
    for (int i = 0; i < 23; ++i) { const float d = (float)(ts[i + 1] - ts[i]) * 0.01f; const int cls = i == 0 ? 0 : 1 + (i - 1) % 11; if (maskA >> cls & 1) ta += d; if (maskB >> cls & 1) tb += d; }
    for (unsigned long long e = (unsigned long long)blockIdx.x * blockDim.x + threadIdx.x; e < n; e += (unsigned long long)gridDim.x * blockDim.x) out[e] = e == 0 ? ta : tb;
}
__global__ void dbg_fill(float* out, unsigned long long n, const unsigned* flag, float hostcode) {
    const unsigned f = *flag;
    float v = f < 1000u ? 100.0f * (float)(f + 1u) : 0.0f;
    if (hostcode != 0.f) v = hostcode;
    for (unsigned long long e = (unsigned long long)blockIdx.x * blockDim.x + threadIdx.x; e < n; e += (unsigned long long)gridDim.x * blockDim.x) out[e] = v;
}
#endif

#ifndef MK_MULTI
#define MK_MULTI 0
#endif

extern "C" void kernel_launch(void* const* d_in, const int* in_sizes, int n_in, void* d_out, int out_size, void* d_ws, size_t ws_size, hipStream_t stream) {
    (void)in_sizes; (void)n_in; (void)out_size; (void)ws_size;
    Params p;
    memset(&p, 0, sizeof(p));
    const float* const* in = (const float* const*)d_in;
    p.x = in[0]; p.c = in[1]; p.ctx = in[2]; p.c_ctx = in[3]; p.ada_w = in[4]; p.ada_b = in[5]; p.w_in = in[6]; p.w_out = in[7];
    p.sgu_ln_w = in[8]; p.sgu_ln_b = in[9]; p.sgu_w = in[10]; p.sgu_b = in[11]; p.diff_lambda = in[12]; p.diff_subln_w = in[13];
    p.hgrn_lb = in[14]; p.hgrn_norm_w = in[15]; p.mla_q_norm_w = in[16]; p.mla_w_uq = in[17]; p.mla_kv_norm_w = in[18]; p.mla_w_ukv = in[19];
    p.ln_mix_w = in[20]; p.ln_mix_b = in[21]; p.ln_ffn_w = in[22]; p.ln_ffn_b = in[23]; p.router_w = in[24]; p.router_b = in[25];
    p.w1 = in[26]; p.b1 = in[27]; p.w2 = in[28]; p.b2 = in[29];
    p.out = (float*)d_out;
    char* ws = (char*)d_ws; size_t off = 0;
    auto take = [&](size_t bytes) { char* r = ws + off; off += (bytes + 255) & ~(size_t)255; return r; };
    constexpr size_t CTRL_BYTES = 65536;
    char* ctrl = take(CTRL_BYTES);
    p.bar = (unsigned*)ctrl; p.gcnt = (unsigned*)(ctrl + 16384);
    p.mod = (float*)take((size_t)2 * 9 * 6144 * 4); p.lball = (float*)take(2 * 512 * 4); p.lam = (float*)take(256); p.ropec = (float*)take(512 * 4); p.ropes = (float*)take(512 * 4);
    p.WinT = (bf16_t*)take((size_t)2 * NINP * DM * 2); p.WoutT = (bf16_t*)take((size_t)2 * DM * DM * 2);
    p.WuqT = (bf16_t*)take((size_t)2 * 384 * 256 * 2); p.WukvT = (bf16_t*)take((size_t)2 * 512 * 128 * 2);
    p.W1T = (bf16_t*)take((size_t)2 * NE * 2048 * DM * 2); p.W2T = (bf16_t*)take((size_t)2 * NE * DM * DM * 2);
    p.X = (float*)take((size_t)MR * DM * 4); p.H = (bf16_t*)take((size_t)MR * DM * 2);
    p.Puv = (bf16_t*)take((size_t)MR * 512 * 2); p.Qd = (bf16_t*)take((size_t)MR * 256 * 2); p.Kd = (bf16_t*)take((size_t)MR * 256 * 2); p.Vdt = (bf16_t*)take((size_t)MR * 256 * 2);
    p.Hq = (bf16_t*)take((size_t)MR * 256 * 2); p.Vht = (bf16_t*)take((size_t)MR * 256 * 2); p.Lf = (bf16_t*)take((size_t)2 * MR * 256 * 2); p.Hg = (bf16_t*)take((size_t)MR * 256 * 2);
    p.Cq = (bf16_t*)take((size_t)MR * 256 * 2); p.Ckv = (bf16_t*)take((size_t)MR * 128 * 2); p.Kr = (bf16_t*)take((size_t)MR * 32 * 2);
    p.Qm = (bf16_t*)take((size_t)MR * 384 * 2); p.Kn = (bf16_t*)take((size_t)MR * 256 * 2); p.Vmt = (bf16_t*)take((size_t)MR * 256 * 2);
    p.O = (bf16_t*)take((size_t)MR * DM * 2);
    p.RS = (float*)take((size_t)MR * 2 * 4); p.DST = (float*)take((size_t)NB * 4 * 2 * NCH * 4096 * 4); p.DEC = (float*)take((size_t)NB * 4 * 2 * NCH * 64 * 4);
    p.Y = (float*)take((size_t)MR * DM * 4);
    p.ltok = (int*)take((size_t)NE * MR * 4); p.lgate = (float*)take((size_t)NE * MR * 4); p.rslot = (int*)take((size_t)MR * 4 * 4);
    p.ACT = (bf16_t*)take((size_t)NSLOT * 1024 * 2); p.YS = (bf16_t*)take((size_t)NSLOT * 1024 * 2);

    static int grid = 0;
    if (!grid) {
        int dev = 0, cus = 0, per_cu = 0;
        hipGetDevice(&dev);
        hipDeviceGetAttribute(&cus, hipDeviceAttributeMultiprocessorCount, dev);
        hipFuncSetAttribute((const void*)mega, hipFuncAttributeMaxDynamicSharedMemorySize, LDS_BYTES);
        hipOccupancyMaxActiveBlocksPerMultiprocessor(&per_cu, mega, NTHREADS, LDS_BYTES);
        if (cus <= 0) cus = 256;
        grid = cus * (per_cu < 1 ? 1 : 1);
    }
    hipMemsetAsync(ctrl, 0, CTRL_BYTES, stream);
#if MK_MULTI
#ifndef MK_NPH
#define MK_NPH N_PHASES
#endif
    for (int ph = 0; ph < MK_NPH; ++ph) {
        if (ph == 1 + PH_PER_LAYER) continue;
        hipLaunchKernelGGL(mega, dim3(grid), dim3(NTHREADS), LDS_BYTES, stream, p, ph, ph + 1);
    }
#else
    hipLaunchKernelGGL(mega, dim3(grid), dim3(NTHREADS), LDS_BYTES, stream, p, 0, N_PHASES);
#endif

#if MK_DEBUG == 2
    hipLaunchKernelGGL(dbg_time, dim3(2048), dim3(256), 0, stream, (float*)d_out, (unsigned long long)NB * SEQ * DM, (const unsigned long long*)(p.gcnt + 1024), (unsigned)MK_TMASK_A, (unsigned)MK_TMASK_B);
#elif MK_DEBUG
    {
        DbgList L; memset(&L, 0, sizeof(L));
        int n = 0;
        auto add = [&](const void* ptr, unsigned long long cnt, int f32, int ld = 0, int c0 = 0, int c1 = 0, int mode = 3) { L.it[n].ptr = ptr; L.it[n].n = cnt; L.it[n].f32 = f32; L.it[n].ld = ld; L.it[n].c0 = c0; L.it[n].c1 = c1; L.it[n].mode = mode; ++n; };
        MK_DEBUG_LIST
        L.count = n;
        unsigned* flag = (unsigned*)(ctrl + 32768);
        hipMemsetAsync(flag, 0x7f, 4, stream);
        hipLaunchKernelGGL(dbg_scan, dim3(2048), dim3(256), 0, stream, L, flag);
        hipLaunchKernelGGL(dbg_fill, dim3(2048), dim3(256), 0, stream, (float*)d_out, (unsigned long long)NB * SEQ * DM, (const unsigned*)flag, 0.0f);
    }
#endif
}
```

```cpp
#include <hip/hip_runtime.h>
#include <stdint.h>
#include <string.h>

#define MK_MULTI 0
#define MK_NPH N_PHASES
#define MK_DEBUG 0
#define MK_REP 0u
#define MK_DEBUG_LIST \
  add(p.mod, 2*9*6144, 1,0,0,0,7); add(p.WinT, 2ull*NINP*DM, 0,0,0,0,7); add(p.H, (unsigned long long)MR*DM, 0,0,0,0,7); add(p.Puv, (unsigned long long)MR*512, 0,0,0,0,7); \
  add(p.Cq, (unsigned long long)MR*256, 0,0,0,0,7); add(p.Ckv, (unsigned long long)MR*128, 0,0,0,0,7); add(p.RS, (unsigned long long)MR*2, 1,0,0,0,7); \
  add(p.Kn, (unsigned long long)MR*256, 0,0,0,0,7); add(p.Vmt, (unsigned long long)MR*256, 0,0,0,0,7); \
  add(p.O, (unsigned long long)MR*DM, 0, DM, 0, 256, 1); \
  add(p.Y, (unsigned long long)MR*DM, 1);

#define DI __device__ __forceinline__
typedef unsigned short bf16_t;
typedef short bf16x8 __attribute__((ext_vector_type(8)));
typedef float f32x4 __attribute__((ext_vector_type(4)));
typedef float f32x2 __attribute__((ext_vector_type(2)));
typedef float f32x16 __attribute__((ext_vector_type(16)));
typedef unsigned u32x4 __attribute__((ext_vector_type(4)));
typedef unsigned u32x2 __attribute__((ext_vector_type(2)));

constexpr int DM = 1024, NB = 8, SEQ = 4096, CTX = 256, TP = 4352, MR = NB * TP;
constexpr int NIN = 2976, NINP = 3072;
constexpr int NE = 32;
constexpr int NCH = TP / 32;
constexpr int NSLOT = 147456;
constexpr float LN_EPS = 1e-6f;
constexpr float DN_ALPHA = 1.4142135623730951f;
constexpr float LOG2E = 1.4426950408889634f;
constexpr int NTHREADS = 512;
constexpr int LDS_BYTES = 147456;

#define XB_TMO      128
#define XB_XCNT(j)  (256  + 64 * (j))
#define XB_XSUB(j)  (1280 + 64 * (j))
#define XB_XGEN(j)  (2304 + 64 * (j))
#define XB_TOP      3328
#define XB_TOPGEN   3392
#define XCD_BAR_WORDS 3456
#define XB_SPIN_CAP (1u << 22)
#define LAS __attribute__((address_space(3)))
__device__ __forceinline__ int otid();

DI unsigned xb_ld(unsigned* p)              { return __hip_atomic_load(p, __ATOMIC_RELAXED, __HIP_MEMORY_SCOPE_AGENT); }
DI unsigned xb_add(unsigned* p, unsigned v) { return __hip_atomic_fetch_add(p, v, __ATOMIC_RELAXED, __HIP_MEMORY_SCOPE_AGENT); }
DI unsigned xb_xcc_id() { return (unsigned)__builtin_amdgcn_s_getreg((3 << 11) | 20) & 0xFu; }
#define XB_SPIN(cond, bar) do { unsigned _sp = 0; while (cond) { __builtin_amdgcn_s_sleep(1); \
    if ((++_sp & 255u) == 0u) { if (xb_ld(&(bar)[XB_TMO])) break; if (_sp > XB_SPIN_CAP) { atomicAdd(&(bar)[XB_TMO], 1u); break; } } } } while (0)

struct XcdBarrier { unsigned* bar; unsigned x; volatile LAS unsigned* st; };

DI XcdBarrier xcd_barrier_post(unsigned* bar, volatile LAS unsigned* st) {
    XcdBarrier b; b.bar = bar; b.x = xb_xcc_id(); b.st = st;
    if (otid() == 0) (void)xb_add(&bar[XB_XCNT(b.x)], 1u);
    return b;
}
DI void xcd_barrier_complete(unsigned* bar, unsigned x, unsigned& nloc, unsigned& nx) {
    const unsigned G = gridDim.x * gridDim.y * gridDim.z;
    unsigned sum, cnt, mine, sp = 0u;
    for (;;) {
        sum = 0u; cnt = 0u; mine = 0u;
#pragma unroll
        for (unsigned j = 0; j < 16; ++j) { const unsigned c = xb_ld(&bar[XB_XCNT(j)]); sum += c; cnt += (c > 0u) ? 1u : 0u; mine = (j == x) ? c : mine; }
        if (sum == G) break;
        __builtin_amdgcn_s_sleep(1);
        if ((++sp & 255u) == 0u) { if (xb_ld(&bar[XB_TMO])) break; if (sp > XB_SPIN_CAP) { atomicAdd(&bar[XB_TMO], 1u); break; } }
    }
    nloc = mine > 0u ? mine : 1u; nx = cnt > 0u ? cnt : 1u;
}
DI void xcd_barrier(const XcdBarrier& b) {
    asm volatile("s_waitcnt vmcnt(0)" ::: "memory");
    __syncthreads();
    if (otid() == 0) {
        unsigned* bar = b.bar;
        __builtin_amdgcn_s_waitcnt(0);
        unsigned nloc = b.st[0], nx = b.st[1];
        if (nloc == 0u) { xcd_barrier_complete(bar, b.x, nloc, nx); b.st[0] = nloc; b.st[1] = nx; }
        const unsigned old = xb_add(&bar[XB_XSUB(b.x)], 1u);
        const unsigned gen = old / nloc;
        if (old + 1u == (gen + 1u) * nloc) {
            __builtin_amdgcn_fence(__ATOMIC_RELEASE, "agent");
            asm volatile("s_waitcnt vmcnt(0)" ::: "memory");
            const unsigned og = xb_add(&bar[XB_TOP], 1u);
            const unsigned tg = og / nx;
            if (og + 1u == (tg + 1u) * nx) xb_add(&bar[XB_TOPGEN], 1u);
            else XB_SPIN(xb_ld(&bar[XB_TOPGEN]) == tg, bar);
            __builtin_amdgcn_fence(__ATOMIC_ACQUIRE, "agent");
            xb_add(&bar[XB_XGEN(b.x)], 1u);
            asm volatile("s_waitcnt vmcnt(0)" ::: "memory");
        } else {
            XB_SPIN(xb_ld(&bar[XB_XGEN(b.x)]) == gen, bar);
            __builtin_amdgcn_fence(__ATOMIC_ACQUIRE, "agent");
            asm volatile("s_waitcnt vmcnt(0)" ::: "memory");
        }
    }
    __syncthreads();
}

struct Params {
    const float *x, *c, *ctx, *c_ctx, *ada_w, *ada_b, *w_in, *w_out, *sgu_ln_w, *sgu_ln_b, *sgu_w, *sgu_b,
                *diff_lambda, *diff_subln_w, *hgrn_lb, *hgrn_norm_w, *mla_q_norm_w, *mla_w_uq, *mla_kv_norm_w, *mla_w_ukv,
                *ln_mix_w, *ln_mix_b, *ln_ffn_w, *ln_ffn_b, *router_w, *router_b, *w1, *b1, *w2, *b2;
    float* out;
    unsigned* bar; unsigned* gcnt;
    float *mod, *lball, *lam, *ropec, *ropes;
    bf16_t *WinT, *WoutT, *WuqT, *WukvT, *W1T, *W2T;
    float* X; bf16_t* H; unsigned char* H8;
    bf16_t *Puv, *Qd, *Kd, *Vdt, *Hq, *Vht, *Lf, *Hg, *Cq, *Ckv, *Kr, *Qm, *Kn, *Vmt, *O;
    float *RS, *DST, *DEC, *Y;
    int* ltok; float* lgate; int* rslot; bf16_t *ACT, *YS;
};

typedef const __attribute__((address_space(4))) Params CParams;
extern __shared__ __attribute__((aligned(16))) char smem_all[];
constexpr int WVTAB_OFF = 147456 - 16 - 256;
DI int hw_slot() { return (int)(__builtin_amdgcn_s_getreg((6 << 11) | 4) & 63u); }
DI int otid() {
    int l = (int)__builtin_amdgcn_mbcnt_hi(~0u, __builtin_amdgcn_mbcnt_lo(~0u, 0u));
    const int w = __builtin_amdgcn_readfirstlane(((volatile int*)(smem_all + WVTAB_OFF))[hw_slot()]);
    int t = w * 64 + l; asm volatile("" : "+v"(t)); return t;
}
DI float bf2f(bf16_t v) { return __uint_as_float(((unsigned)v) << 16); }
typedef __bf16 bf16x2_t __attribute__((ext_vector_type(2)));
DI unsigned pk2(float lo, float hi) { const bf16x2_t v = {(__bf16)lo, (__bf16)hi}; return __builtin_bit_cast(unsigned, v); }
DI unsigned pk4_fp8(float a, float b, float c, float d) { int w = 0; w = __builtin_amdgcn_cvt_pk_fp8_f32(a, b, w, false); w = __builtin_amdgcn_cvt_pk_fp8_f32(c, d, w, true); return (unsigned)w; }
DI float lo2f(unsigned w) { return __uint_as_float(w << 16); }
DI float hi2f(unsigned w) { return __uint_as_float(w & 0xffff0000u); }
DI bf16x8 pack8(const float (&v)[8]) { u32x4 w; w.x = pk2(v[0], v[1]); w.y = pk2(v[2], v[3]); w.z = pk2(v[4], v[5]); w.w = pk2(v[6], v[7]); return __builtin_bit_cast(bf16x8, w); }
template <int MASK> DI float shx(float v) {
    if (MASK < 32) return __int_as_float(__builtin_amdgcn_ds_swizzle(__float_as_int(v), (MASK << 10) | 0x1f));
    int l = (int)__builtin_amdgcn_mbcnt_hi(~0u, __builtin_amdgcn_mbcnt_lo(~0u, 0u)); asm volatile("" : "+v"(l));
    return __int_as_float(__builtin_amdgcn_ds_bpermute((l ^ 32) << 2, __float_as_int(v)));
}
DI float zf() { float z = 0.f; asm volatile("" : "+v"(z)); return z; }
DI f32x4 zero4() { const float z = zf(); return (f32x4){z, z, z, z}; }
DI float rdlane(float v, int l) { return __int_as_float(__builtin_amdgcn_readlane(__float_as_int(v), l)); }
template <int CTRL> DI float dpp(float v) { return __int_as_float(__builtin_amdgcn_update_dpp(0, __float_as_int(v), CTRL, 0xf, 0xf, false)); }
constexpr int DPP_X1 = 0xB1, DPP_X2 = 0x4E, DPP_HM = 0x141, DPP_RM = 0x140;
DI float wave_sum(float v) { v += dpp<DPP_X1>(v); v += dpp<DPP_X2>(v); v += dpp<DPP_HM>(v); v += dpp<DPP_RM>(v); v += shx<16>(v); v += shx<32>(v); return v; }
DI float sigmoidf_(float x) { return __builtin_amdgcn_rcpf(1.0f + __builtin_amdgcn_exp2f(-LOG2E * x)); }
DI float geluf_(float v) {
    const float av = fabsf(v), t = __builtin_amdgcn_rcpf(av * 0.2316418882f + 1.0f);
    float q = t * 0.5307027145f + (-0.7265760135f); q = q * t + 0.7107068705f; q = q * t + (-0.142248368f); q = q * t + 0.127414796f; q = q * t;
    const float e = __builtin_amdgcn_exp2f((v * v) * (-0.72134752044f));
    const float m = v * (q * e);
    return v < 0.f ? m : v - m;
}
DI float siluf_(float x) { return x * sigmoidf_(x); }
DI int crow(int r, int hh) { return (r & 3) + 8 * (r >> 2) + 4 * hh; }
#define MFMA16(a, b, c) __builtin_amdgcn_mfma_f32_16x16x32_bf16((a), (b), (c), 0, 0, 0)
#define MFMA32(a, b, c) __builtin_amdgcn_mfma_f32_32x32x16_bf16((a), (b), (c), 0, 0, 0)

DI const float* in_row(CParams& p, int row) {
    const int b = row / TP, t = row - b * TP;
    return t < CTX ? p.ctx + ((size_t)b * CTX + t) * DM : p.x + ((size_t)b * SEQ + (t - CTX)) * DM;
}
DI const float* mod_vec(CParams& p, int l, int row, int j) {
    const int b = row / TP, t = row - b * TP;
    const int r = t < CTX ? 8 : b;
    return p.mod + ((size_t)(l * 9 + r) * 6 + j) * DM;
}

DI void transpose_tile(const float* __restrict__ src, int K, int N, bf16_t* __restrict__ dst, int k0, int n0, const float* __restrict__ kscale, int perm_ukv, char* wl, int lane, float f8scale = 0.f) {
    bf16_t* S = (bf16_t*)wl;
#pragma unroll 4
    for (int it = 0; it < 16; ++it) {
        const int kk = it * 4 + (lane >> 4), nn = (lane & 15) * 4;
        f32x4 v = {0.f, 0.f, 0.f, 0.f};
        if (n0 + nn < N) v = *(const f32x4*)(src + (size_t)(k0 + kk) * N + n0 + nn);
        if (kscale) { const float s = kscale[k0 + kk]; v = v * s; }
        if (f8scale != 0.f) v = v * f8scale;
        unsigned* d = (unsigned*)(S + kk * 66 + nn);
        d[0] = pk2(v[0], v[1]); d[1] = pk2(v[2], v[3]);
    }
    __builtin_amdgcn_fence(__ATOMIC_RELEASE, "workgroup");
    __builtin_amdgcn_wave_barrier();
    __builtin_amdgcn_fence(__ATOMIC_ACQUIRE, "workgroup");
#pragma unroll 2
    for (int it = 0; it < 8; ++it) {
        const int nn = it * 8 + (lane >> 3), kc = lane & 7;
        unsigned short e[8];
#pragma unroll
        for (int j = 0; j < 8; ++j) e[j] = S[(kc * 8 + j) * 66 + nn];
        u32x4 w; w.x = e[0] | ((unsigned)e[1] << 16); w.y = e[2] | ((unsigned)e[3] << 16); w.z = e[4] | ((unsigned)e[5] << 16); w.w = e[6] | ((unsigned)e[7] << 16);
        int n = n0 + nn;
        if (perm_ukv) { const int hh = n >> 7, t = n & 127; n = t < 64 ? hh * 64 + t : 256 + hh * 64 + (t - 64); }
        if (f8scale != 0.f) {
            u32x2 w8; w8.x = pk4_fp8(bf2f(e[0]), bf2f(e[1]), bf2f(e[2]), bf2f(e[3])); w8.y = pk4_fp8(bf2f(e[4]), bf2f(e[5]), bf2f(e[6]), bf2f(e[7]));
            *(u32x2*)((unsigned char*)dst + (size_t)n * K + k0 + kc * 8) = w8;
        } else *(u32x4*)(dst + (size_t)n * K + k0 + kc * 8) = w;
    }
    __builtin_amdgcn_fence(__ATOMIC_RELEASE, "workgroup");
    __builtin_amdgcn_wave_barrier();
}

DI void phase_prologue(CParams& p, char* lds) {
    const int tid = otid(), wid = tid >> 6, lane = tid & 63;
    char* wl = lds + wid * 8704;
    constexpr int T_IN = 16 * 48, T_OUT = 16 * 16, T_UQ = 4 * 6, T_UKV = 2 * 8, T_W1 = 32 * 16 * 32, T_W2 = 32 * 16 * 16;
    constexpr int T_LAYER = T_IN + T_OUT + T_UQ + T_UKV + T_W1 + T_W2;
    constexpr int T_ALL = 2 * T_LAYER;
    constexpr int U_TR = (T_ALL + 7) / 8;
    constexpr int U_GEMV = 2 * 6144 / 64;
    const int nunits = U_GEMV + U_TR + 1;
    for (int u = blockIdx.x; u < nunits; u += gridDim.x) {
        if (u < U_GEMV) {
            const int l = u / 96, n = (u % 96) * 64 + lane;
            const float* W = p.ada_w + (size_t)l * DM * 6144 + (size_t)(wid * 128) * 6144 + n;
            float* sc = (float*)(lds + 73728);
            float* part = (float*)lds;
            __syncthreads();
            for (int i = tid; i < 9 * DM; i += NTHREADS) { const float cv = i < 8 * DM ? p.c[i] : p.c_ctx[i - 8 * DM]; sc[i] = siluf_(cv); }
            __syncthreads();
            float acc[9];
#pragma unroll
            for (int r = 0; r < 9; ++r) acc[r] = 0.f;
#pragma unroll 2
            for (int k = 0; k < 128; k += 4) {
                float w[4];
#pragma unroll
                for (int j = 0; j < 4; ++j) w[j] = W[(size_t)(k + j) * 6144];
#pragma unroll
                for (int r = 0; r < 9; ++r) {
                    const f32x4 cc = *(const f32x4*)(sc + r * DM + wid * 128 + k);
#pragma unroll
                    for (int j = 0; j < 4; ++j) acc[r] += cc[j] * w[j];
                }
            }
#pragma unroll
            for (int r = 0; r < 9; ++r) part[(wid * 9 + r) * 64 + lane] = acc[r];
            __syncthreads();
            for (int i = tid; i < 9 * 64; i += NTHREADS) {
                const int r = i >> 6, c = i & 63;
                float sum = p.ada_b[l * 6144 + (u % 96) * 64 + c];
#pragma unroll
                for (int w8 = 0; w8 < 8; ++w8) sum += part[(w8 * 9 + r) * 64 + c];
                p.mod[(size_t)(l * 9 + r) * 6144 + (u % 96) * 64 + c] = sum;
            }
            __syncthreads();
        } else if (u < U_GEMV + U_TR) {
            int t = (u - U_GEMV) * 8 + wid;
            if (t < T_ALL) {
                const int l = t / T_LAYER; t -= l * T_LAYER;
                if (t < T_IN) { const int kt = t / 48, nt = t % 48;
                    transpose_tile(p.w_in + (size_t)l * DM * NIN, DM, NIN, p.WinT + (size_t)l * NINP * DM, kt * 64, nt * 64, nullptr, 0, wl, lane);
                } else if ((t -= T_IN) < T_OUT) { const int kt = t / 16, nt = t % 16;
                    transpose_tile(p.w_out + (size_t)l * DM * DM, DM, DM, p.WoutT + (size_t)l * DM * DM, kt * 64, nt * 64, nullptr, 0, wl, lane);
                } else if ((t -= T_OUT) < T_UQ) { const int kt = t / 6, nt = t % 6;
                    transpose_tile(p.mla_w_uq + (size_t)l * 256 * 384, 256, 384, p.WuqT + (size_t)l * 384 * 256, kt * 64, nt * 64, p.mla_q_norm_w + l * 256, 0, wl, lane);
                } else if ((t -= T_UQ) < T_UKV) { const int kt = t / 8, nt = t % 8;
                    transpose_tile(p.mla_w_ukv + (size_t)l * 128 * 512, 128, 512, p.WukvT + (size_t)l * 512 * 128, kt * 64, nt * 64, p.mla_kv_norm_w + l * 128, 1, wl, lane);
                } else if ((t -= T_UKV) < T_W1) { const int e = t / 512, r = t % 512, kt = r / 32, nt = r % 32;
                    transpose_tile(p.w1 + ((size_t)l * NE + e) * DM * 2048, DM, 2048, (bf16_t*)((unsigned char*)p.W1T + ((size_t)l * NE + e) * 2048 * DM), kt * 64, nt * 64, nullptr, 0, wl, lane, 32.0f);
                } else { t -= T_W1; const int e = t / 256, r = t % 256, kt = r / 16, nt = r % 16;
                    transpose_tile(p.w2 + ((size_t)l * NE + e) * DM * DM, DM, DM, (bf16_t*)((unsigned char*)p.W2T + ((size_t)l * NE + e) * DM * DM), kt * 64, nt * 64, nullptr, 0, wl, lane, 64.0f);
                }
            }
        } else {
            if (tid < 512) {
                const int j = tid;
                const float a0 = p.hgrn_lb[j], a1 = p.hgrn_lb[512 + j];
                const float m = fmaxf(a0, a1), e0 = expf(a0 - m), e1 = expf(a1 - m);
                p.lball[j] = 0.f;
                p.lball[512 + j] = e1 / (e0 + e1);
            }
            if (tid < 2) {
                const float* lp = p.diff_lambda + tid * 4 * 32;
                float s01 = 0.f, s23 = 0.f;
                for (int i = 0; i < 32; ++i) { s01 += lp[i] * lp[32 + i]; s23 += lp[64 + i] * lp[96 + i]; }
                const float lam_init = tid == 0 ? 0.2f : 0.3555090676f;
                p.lam[tid] = expf(s01) - expf(s23) + lam_init;
            }
            {
                const int pos = tid >> 3, i = tid & 7;
                const float inv = powf(10000.0f, -(float)(2 * i) / 16.0f);
                float sn, cs; sincosf((float)pos * inv, &sn, &cs);
                p.ropec[tid] = cs; p.ropes[tid] = sn;
            }
        }
    }
}

DI void phase_ln1(CParams& p, char* lds) {
    const int tid = otid(), wid = tid >> 6, lane = tid & 63;
    for (int row = blockIdx.x * 8 + wid; row < MR; row += gridDim.x * 8) {
        const float* xr = in_row(p, row);
        f32x4 v[4]; float s = 0.f;
#pragma unroll
        for (int j = 0; j < 4; ++j) { v[j] = *(const f32x4*)(xr + j * 256 + lane * 4); s += (v[j][0] + v[j][1]) + (v[j][2] + v[j][3]); }
        const float mean = wave_sum(s) * (1.f / DM);
        float q = 0.f;
#pragma unroll
        for (int j = 0; j < 4; ++j) { v[j] = v[j] - mean; q += (v[j][0] * v[j][0] + v[j][1] * v[j][1]) + (v[j][2] * v[j][2] + v[j][3] * v[j][3]); }
        const float rstd = rsqrtf(wave_sum(q) * (1.f / DM) + LN_EPS);
        const float* sh = mod_vec(p, 0, row, 0); const float* sc = mod_vec(p, 0, row, 1);
#pragma unroll
        for (int j = 0; j < 4; ++j) {
            const int c = j * 256 + lane * 4;
            const f32x4 a = *(const f32x4*)(sh + c), b = *(const f32x4*)(sc + c);
            const f32x4 h = v[j] * rstd * (b + 1.0f) + a;
            u32x2 w; w.x = pk2(h[0], h[1]); w.y = pk2(h[2], h[3]);
            *(u32x2*)(p.H + (size_t)row * DM + c) = w;
        }
    }
}

template <int ORI>
DI void gemm_core(const bf16_t* const (&pa)[4], const bf16_t* const (&pb)[2], int K, char* lds, f32x4 (&acc)[4][4]) {
    const int tid = otid(), wid = tid >> 6, lane = tid & 63, wr = wid >> 1, wc = wid & 1, fr = lane & 15, fq = lane >> 4;
    const int sw = ((tid & 7) ^ ((tid >> 4) & 7)) << 4;
    const int offA = (tid >> 3) * 128 + sw, offB = 32768 + (tid >> 3) * 128 + sw;
    const int rdA = (wr * 64 + fr) * 128 + ((fq ^ (fr >> 1)) << 4), rdB = 32768 + (wc * 64 + fr) * 128 + ((fq ^ (fr >> 1)) << 4);
#pragma unroll
    for (int mi = 0; mi < 4; ++mi)
#pragma unroll
        for (int ni = 0; ni < 4; ++ni) acc[mi][ni] = zero4();
    u32x4 ra[4], rb[2];
#pragma unroll
    for (int i = 0; i < 4; ++i) ra[i] = *(const u32x4*)(pa[i]);
#pragma unroll
    for (int j = 0; j < 2; ++j) rb[j] = *(const u32x4*)(pb[j]);
#pragma unroll
    for (int i = 0; i < 4; ++i) *(u32x4*)(lds + offA + i * 8192) = ra[i];
#pragma unroll
    for (int j = 0; j < 2; ++j) *(u32x4*)(lds + offB + j * 8192) = rb[j];
    __syncthreads();
    const int nk = K >> 6;
    for (int kt = 0; kt < nk; ++kt) {
        const char* cur = lds + (kt & 1) * 49152;
        const bool more = kt + 1 < nk;
        if (more) {
#pragma unroll
            for (int i = 0; i < 4; ++i) ra[i] = *(const u32x4*)(pa[i] + (kt + 1) * 64);
#pragma unroll
            for (int j = 0; j < 2; ++j) rb[j] = *(const u32x4*)(pb[j] + (kt + 1) * 64);
        }
#pragma unroll
        for (int kk = 0; kk < 2; ++kk) {
            bf16x8 af[4], bfr[4];
#pragma unroll
            for (int mi = 0; mi < 4; ++mi) af[mi] = *(const bf16x8*)(cur + ((rdA + mi * 2048) ^ (kk * 64)));
#pragma unroll
            for (int ni = 0; ni < 4; ++ni) bfr[ni] = *(const bf16x8*)(cur + ((rdB + ni * 2048) ^ (kk * 64)));
#pragma unroll
            for (int mi = 0; mi < 4; ++mi)
#pragma unroll
                for (int ni = 0; ni < 4; ++ni) {
                    if (ORI == 0) acc[mi][ni] = MFMA16(bfr[ni], af[mi], acc[mi][ni]);
                    else          acc[mi][ni] = MFMA16(af[mi], bfr[ni], acc[mi][ni]);
                }
        }
        if (more) {
            char* nxt = lds + ((kt + 1) & 1) * 49152;
#pragma unroll
            for (int i = 0; i < 4; ++i) *(u32x4*)(nxt + offA + i * 8192) = ra[i];
#pragma unroll
            for (int j = 0; j < 2; ++j) *(u32x4*)(nxt + offB + j * 8192) = rb[j];
        }
        __syncthreads();
    }
}

DI void gemm_ptrs(const bf16_t* A, int lda, int row0, const bf16_t* Bt, int ldb, int n0, const bf16_t* (&pa)[4], const bf16_t* (&pb)[2]) {
    const int tid = otid(), r = tid >> 3, c = (tid & 7) * 8;
#pragma unroll
    for (int i = 0; i < 4; ++i) pa[i] = A + (size_t)(row0 + r + 64 * i) * lda + c;
#pragma unroll
    for (int j = 0; j < 2; ++j) pb[j] = Bt + (size_t)(n0 + r + 64 * j) * ldb + c;
}

DI void store4_bf16(bf16_t* dst, const f32x4& v) { u32x2 w; w.x = pk2(v[0], v[1]); w.y = pk2(v[2], v[3]); *(u32x2*)dst = w; }

DI f32x4 rope_tile(CParams& p, f32x4 v, int row, int axis_is_col, int fq) {
    f32x4 o;
    const int b = row / TP, t = row - b * TP;
    const int pos = t - CTX;
    const int ax = axis_is_col ? (pos & 63) : (pos >> 6);
#pragma unroll
    for (int r = 0; r < 4; ++r) {
        const float pr = shx<32>(v[r]);
        float cs = 1.f, sn = 0.f;
        if (t >= CTX) { const int i = (fq & 1) * 4 + r; cs = p.ropec[ax * 8 + i]; sn = p.ropes[ax * 8 + i]; }
        o[r] = fq < 2 ? v[r] * cs - pr * sn : v[r] * cs + pr * sn;
    }
    return o;
}


namespace g8 {
constexpr int BK = 64, HALF = 128, HTB = HALF * BK * 2, STAGE_BYTES = 8 * HTB;
DI int lds_byte(int r, int c) { const int st = (r >> 4) * 2 + (c >> 5), rr = r & 15, cc = c & 31, ob = rr * 64 + cc * 2; return st * 1024 + (ob ^ (((ob >> 9) & 1) << 5)); }
DI void stage_rc(int b, int& R, int& C) { const int st = b / 1024, sb = b % 1024, swz = sb ^ (((sb >> 9) & 1) << 5); R = (st >> 1) * 16 + swz / 64; C = (st & 1) * 32 + (swz % 64) / 2; }
struct GU { const char* a; const char* b; int pm, pn, e, j0; };
DI bool order_next(int i, int nM, int nN, int& pm, int& pn) {
    const int nwg = nM * nN; const long L = (long)i * gridDim.x + blockIdx.x; if (L >= nwg) return false;
    int wgid = (int)L; { const int q = nwg / 8, r = nwg % 8, xcd = wgid % 8, off = wgid / 8; wgid = (xcd < r ? xcd * (q + 1) : r * (q + 1) + (xcd - r) * q) + off; }
    const int nig = 8 * nN, gid = wgid / nig, fm = gid * 8, gsz = (nM - fm) < 8 ? (nM - fm) : 8;
    pm = fm + ((wgid % nig) % gsz); pn = (wgid % nig) / gsz; return true;
}

typedef int v4i_t __attribute__((ext_vector_type(4)));
typedef int v8i_t __attribute__((ext_vector_type(8)));
template <class Epi, class Sched, bool GATHER, bool FP8 = false>
DI void gemm8(char* lds_generic, const int KB, const char* Abase, const Sched& S, const Epi& E, const unsigned sclB = 0x7f7f7f7fu) {
    LAS unsigned char* lds = (LAS unsigned char*)lds_generic;
    const int tid = otid(), wid = __builtin_amdgcn_readfirstlane(tid >> 6), lane = tid & 63, wr = wid >> 2, wc = wid & 3, fr = lane & 15, fq = lane >> 4;
    const int nt = KB / 128;
    int R[2], C[2];
#pragma unroll
    for (int i = 0; i < 2; ++i) stage_rc(tid * 16 + i * 8192, R[i], C[i]);
    unsigned voff[2];
#pragma unroll
    for (int i = 0; i < 2; ++i) voff[i] = (unsigned)(R[i] * KB + C[i] * 2);
    const size_t kstep = (size_t)(BK * 2), hstep = (size_t)HALF * KB;
    const unsigned ldsw = (unsigned)wid * 1024u;
    const int aoff = lds_byte(wr * 64 + fr, fq * 8), boff = lds_byte(wc * 32 + fr, fq * 8);
    LAS unsigned* gtab = (LAS unsigned*)(lds + STAGE_BYTES);
#define G8_SA(b, h) (((b) * 2 + (h)) * HTB)
#define G8_SB(b, h) ((4 + (b) * 2 + (h)) * HTB)
#define G8_LDS(gp, bufoff, i) __builtin_amdgcn_global_load_lds((const unsigned*)(gp), (LAS unsigned*)(lds + (bufoff) + ldsw + (i) * 8192), 16, 0, 0)
#define G8_STAGE_B(bufoff, gbase) do { _Pragma("unroll") for (int _i = 0; _i < 2; ++_i) G8_LDS((const char*)(gbase) + voff[_i], bufoff, _i); } while (0)
#define G8_STAGE_A(bufoff, h, nx, ko) do { _Pragma("unroll") for (int _i = 0; _i < 2; ++_i) { \
        const char* _gp = GATHER ? Abase + (size_t)(gtab[((((nx) ? ui + 1 : ui) & 1) << 8) + (h) * HALF + R[_i]] + (unsigned)(C[_i] * 2)) + (ko) : ((nx) ? nA : cA) + (size_t)(h) * hstep + (ko) + voff[_i]; G8_LDS(_gp, bufoff, _i); } } while (0)
#define G8_LDA(dst, b, h) do { _Pragma("unroll") for (int m = 0; m < 4; ++m) _Pragma("unroll") for (int k = 0; k < 2; ++k) dst[m][k] = *(const LAS bf16x8*)(lds + G8_SA(b, h) + aoff + m * 2048 + k * 1024); } while (0)
#define G8_LDB(dst, b, h) do { _Pragma("unroll") for (int n = 0; n < 2; ++n) _Pragma("unroll") for (int k = 0; k < 2; ++k) dst[n][k] = *(const LAS bf16x8*)(lds + G8_SB(b, h) + boff + n * 2048 + k * 1024); } while (0)
#define G8_MMA(ai, bj, At, Bt) do { __builtin_amdgcn_s_setprio(1); _Pragma("unroll") for (int m = 0; m < 4; ++m) _Pragma("unroll") for (int n = 0; n < 2; ++n) { \
        if constexpr (FP8) { const v8i_t _a = __builtin_shufflevector(__builtin_bit_cast(v4i_t, At[m][0]), __builtin_bit_cast(v4i_t, At[m][1]), 0, 1, 2, 3, 4, 5, 6, 7); \
                   const v8i_t _b = __builtin_shufflevector(__builtin_bit_cast(v4i_t, Bt[n][0]), __builtin_bit_cast(v4i_t, Bt[n][1]), 0, 1, 2, 3, 4, 5, 6, 7); \
                   acc[ai][bj][m][n] = __builtin_amdgcn_mfma_scale_f32_16x16x128_f8f6f4(_b, _a, acc[ai][bj][m][n], 0, 0, 0, (int)sclB, 0, 0x7f7f7f7f); } \
        else { _Pragma("unroll") for (int k = 0; k < 2; ++k) acc[ai][bj][m][n] = __builtin_amdgcn_mfma_f32_16x16x32_bf16(Bt[n][k], At[m][k], acc[ai][bj][m][n], 0, 0, 0); } } \
        if constexpr (FP8) asm volatile("" : "+v"(acc[ai][bj][0][0]), "+v"(acc[ai][bj][0][1]), "+v"(acc[ai][bj][1][0]), "+v"(acc[ai][bj][1][1]), "+v"(acc[ai][bj][2][0]), "+v"(acc[ai][bj][2][1]), "+v"(acc[ai][bj][3][0]), "+v"(acc[ai][bj][3][1]));   \
        __builtin_amdgcn_s_setprio(0); } while (0)
#define G8_WAIT_V(n) asm volatile("s_waitcnt vmcnt(" #n ")" ::: "memory")
#define G8_WAIT_L(n) asm volatile("s_waitcnt lgkmcnt(" #n ")" ::: "memory")
#define G8_BAR __builtin_amdgcn_s_barrier()
#define G8_SCHED __builtin_amdgcn_sched_barrier(0)
#define G8_GOFF(slot, u) do { if (GATHER) { int _tz = tid; asm volatile("" : "+v"(_tz)); if (_tz < 256) gtab[((slot) << 8) + _tz] = S.arow(u, _tz) * (unsigned)KB; } } while (0)
    GU cur, nxt; int ui = 0;
    __syncthreads();
    if (!S.next(0, cur)) return;
    f32x4 acc[2][2][4][2];
    { const f32x4 z4 = zero4();
#pragma unroll
    for (int a = 0; a < 2; ++a)
#pragma unroll
        for (int b = 0; b < 2; ++b)
#pragma unroll
            for (int m = 0; m < 4; ++m)
#pragma unroll
                for (int n = 0; n < 2; ++n) acc[a][b][m][n] = z4; }
    bf16x8 At[4][2], B0[2][2], B1[2][2];
    const char* cA = cur.a; const char* cB = cur.b; const char* nA = cA; const char* nB = cB;
    G8_GOFF(0, cur);
    if (GATHER) __syncthreads();
    G8_STAGE_B(G8_SB(0, 0), cB); G8_STAGE_B(G8_SB(0, 1), cB + hstep); G8_STAGE_A(G8_SA(0, 0), 0, false, (size_t)0); G8_STAGE_A(G8_SA(0, 1), 1, false, (size_t)0);
    if (wr == 1) G8_BAR;
    G8_WAIT_V(2); G8_BAR;
    G8_STAGE_B(G8_SB(1, 0), cB + kstep); G8_STAGE_A(G8_SA(1, 0), 0, false, kstep); G8_STAGE_B(G8_SB(1, 1), cB + hstep + kstep);
    G8_WAIT_V(6); G8_BAR;
    for (;;) {
        const bool has_next = S.next(ui + 1, nxt);
        nA = has_next ? nxt.a : cA; nB = has_next ? nxt.b : cB;
        G8_GOFF((ui + 1) & 1, has_next ? nxt : cur);
        for (int t = 0; t < nt; t += 2) {
            const bool last = (t == nt - 2);
            const size_t k1 = (size_t)(t + 1) * kstep, k2 = last ? (size_t)0 : (size_t)(t + 2) * kstep, k3 = k2 + kstep;
            const char* b2 = last ? nB : cB + (size_t)(t + 2) * kstep; const char* b3 = b2 + kstep;
            G8_LDB(B0, 0, 0); G8_LDB(B1, 0, 1); G8_SCHED; G8_LDA(At, 0, 0); G8_STAGE_A(G8_SA(1, 1), 1, false, k1);
            G8_WAIT_V(8); G8_WAIT_L(0); G8_BAR; G8_MMA(0, 0, At, B0); G8_MMA(0, 1, At, B1); G8_BAR; G8_SCHED;
            G8_LDA(At, 0, 1); G8_STAGE_B(G8_SB(0, 0), b2); G8_STAGE_B(G8_SB(0, 1), b2 + hstep); G8_STAGE_A(G8_SA(0, 0), 0, last, k2);
            G8_WAIT_V(8); G8_WAIT_L(0); G8_BAR; G8_MMA(1, 0, At, B0); G8_MMA(1, 1, At, B1); G8_BAR; G8_SCHED;
            G8_LDB(B0, 1, 0); G8_LDB(B1, 1, 1); G8_SCHED; G8_LDA(At, 1, 0); G8_STAGE_A(G8_SA(0, 1), 1, last, k2);
            G8_WAIT_V(8); G8_WAIT_L(0); G8_BAR; G8_MMA(0, 0, At, B0); G8_MMA(0, 1, At, B1); G8_BAR; G8_SCHED;
            G8_LDA(At, 1, 1); G8_STAGE_B(G8_SB(1, 0), b3); G8_STAGE_B(G8_SB(1, 1), b3 + hstep); G8_STAGE_A(G8_SA(1, 0), 0, last, k3);
            G8_WAIT_V(8); G8_WAIT_L(0); G8_BAR; G8_MMA(1, 0, At, B0); G8_MMA(1, 1, At, B1); G8_BAR; G8_SCHED;
        }
        if (wr == 0) G8_BAR;
        E(acc, cur, wr, wc, fr, fq);
        if (!has_next) break;
        const f32x4 z4 = zero4();
#pragma unroll
        for (int a = 0; a < 2; ++a)
#pragma unroll
            for (int b = 0; b < 2; ++b)
#pragma unroll
                for (int m = 0; m < 4; ++m)
#pragma unroll
                    for (int n = 0; n < 2; ++n) acc[a][b][m][n] = z4;
        cur = nxt; cA = nA; cB = nB; ++ui;
        if (wr == 1) G8_BAR;
    }
    G8_WAIT_V(0);
    G8_BAR;
#undef G8_SA
#undef G8_SB
#undef G8_LDS
#undef G8_STAGE_A
#undef G8_STAGE_B
#undef G8_LDA
#undef G8_LDB
#undef G8_MMA
#undef G8_WAIT_V
#undef G8_WAIT_L
#undef G8_BAR
#undef G8_SCHED
#undef G8_GOFF
}
}

#define INPROJ_LOOP(BODY) _Pragma("unroll") for (int ai = 0; ai < 2; ++ai) _Pragma("unroll") for (int m = 0; m < 4; ++m) _Pragma("unroll") for (int n = 0; n < 2; ++n) { \
        const int row = row0 + 128 * ai + 16 * m, col = col0 + 16 * n; f32x4 v = acc[ai][bj][m][n]; BODY }
template <int bj>
DI void inproj_half(CParams& p, int l, int nt, const f32x4 (&acc)[2][2][4][2], int row0  , int col0  , int fq) {
    if (nt < 4) {
        INPROJ_LOOP({
            _Pragma("unroll") for (int r = 0; r < 4; ++r) v[r] = geluf_(v[r]);
            store4_bf16(p.Puv + (size_t)row * 512 + col, v); })
    } else if (nt < 6) {
        INPROJ_LOOP({ v = rope_tile(p, v, row, n, fq) * (0.17677669529663687f * LOG2E); store4_bf16(p.Qd + (size_t)row * 256 + (col - 512), v); })
    } else if (nt < 8) {
        INPROJ_LOOP({ v = rope_tile(p, v, row, n, fq); store4_bf16(p.Kd + (size_t)row * 256 + (col - 768), v); })
    } else if (nt < 12) {
        INPROJ_LOOP({
            _Pragma("unroll") for (int r = 0; r < 4; ++r) v[r] = siluf_(v[r]);
            store4_bf16(p.Hq + (size_t)row * 256 + (col - 1280), v); })
    } else if (nt < 18) {
        const int dir = nt >= 16, cb = dir ? 2048 : 1792;
        INPROJ_LOOP({
            const int cc = col - cb;
            const f32x4 lb = *(const f32x4*)(p.lball + (l * 2 + dir) * 256 + cc);
            _Pragma("unroll") for (int r = 0; r < 4; ++r) v[r] = 0.69314718056f * __builtin_amdgcn_logf(lb[r] + (1.0f - lb[r]) * sigmoidf_(v[r]));
            store4_bf16(p.Lf + ((size_t)dir * MR + row) * 256 + cc, v); })
    } else if (nt < 20) {
        INPROJ_LOOP({
            _Pragma("unroll") for (int r = 0; r < 4; ++r) v[r] = siluf_(v[r]);
            store4_bf16(p.Hg + (size_t)row * 256 + (col - 2304), v); })
    } else if (nt < 22) {
        INPROJ_LOOP({ store4_bf16(p.Cq + (size_t)row * 256 + (col - 2560), v); })
    } else if (nt == 22) {
        INPROJ_LOOP({ store4_bf16(p.Ckv + (size_t)row * 128 + (col - 2816), v); })
    } else {
        INPROJ_LOOP({ v = rope_tile(p, v, row, n, fq); if (col < 2976) store4_bf16(p.Kr + (size_t)row * 32 + (col - 2944), v); })
    }
}
struct SchedIn {
    const char* H; const char* W;
    DI bool next(int i, g8::GU& u) const {
        int pm, pn; if (!g8::order_next(i, MR / 256, 12, pm, pn)) return false;
        const bool sw = (pn == 4 || pn == 6);
        u.pm = pm; u.pn = pn; u.e = sw ? 1 : 0; u.j0 = 0;
        const char* ht = H + (size_t)pm * 256 * 2048; const char* wt = W + (size_t)pn * 256 * 2048;
        u.a = sw ? wt : ht; u.b = sw ? ht : wt; return true;
    }
    DI unsigned arow(const g8::GU&, int) const { return 0u; }
};
struct EpiIn {
    CParams* pp; int l;
    DI void operator()(const f32x4 (&acc)[2][2][4][2], const g8::GU& u, int wr, int wc, int fr, int fq) const {
        CParams& p = *pp;
        if (u.e) {
            bf16_t* dst = (u.pn == 4) ? p.Vdt : p.Vht;
            const int m0 = u.pm * 256, b = m0 / TP, t0 = m0 - b * TP;
#pragma unroll
            for (int ai = 0; ai < 2; ++ai)
#pragma unroll
                for (int bj = 0; bj < 2; ++bj)
#pragma unroll
                    for (int m = 0; m < 4; ++m)
#pragma unroll
                        for (int n = 0; n < 2; ++n) {
                            const int f = 128 * ai + 64 * wr + 16 * m + fr, t = t0 + 128 * bj + 32 * wc + 16 * n + 4 * fq;
                            store4_bf16(dst + ((size_t)(b * 256 + f)) * TP + t, acc[ai][bj][m][n]);
                        }
        } else {
            inproj_half<0>(p, l, 2 * u.pn, acc, u.pm * 256 + 64 * wr + fr, u.pn * 256 + 32 * wc + 4 * fq, fq);
            inproj_half<1>(p, l, 2 * u.pn + 1, acc, u.pm * 256 + 64 * wr + fr, u.pn * 256 + 128 + 32 * wc + 4 * fq, fq);
        }
    }
};
DI void phase_inproj(CParams& p, int l, char* lds) {
    SchedIn S; S.H = (const char*)p.H; S.W = (const char*)(p.WinT + (size_t)l * NINP * DM);
    EpiIn E; E.pp = &p; E.l = l;
    g8::gemm8<EpiIn, SchedIn, false>(lds, DM * 2, nullptr, S, E);
}

DI void phase_sgu_prep(CParams& p, int l, char* lds) {
    const int tid = otid(), wid = tid >> 6, lane = tid & 63, fr = lane & 15, fq = lane >> 4;
    constexpr int U_SGU = (MR / 128) * 4, U_PREP = MR / 64;
    float* stats = (float*)(lds + 16384);
    for (int u = blockIdx.x; u < U_SGU + U_PREP; u += gridDim.x) {
        if (u < U_SGU) {
            const int ch = u >> 2, g = u & 3, row0 = ch * 128;
            __syncthreads();
#pragma unroll 1
            for (int i = 0; i < 16; ++i) {
                const int r = wid * 16 + i;
                const u32x2 w = *(const u32x2*)(p.Puv + (size_t)(row0 + r) * 512 + 256 + lane * 4);
                const float a0 = lo2f(w.x), a1 = hi2f(w.x), a2 = lo2f(w.y), a3 = hi2f(w.y);
                const float mean = wave_sum((a0 + a1) + (a2 + a3)) * (1.f / 256.f);
                const float d0 = a0 - mean, d1 = a1 - mean, d2 = a2 - mean, d3 = a3 - mean;
                const float var = wave_sum((d0 * d0 + d1 * d1) + (d2 * d2 + d3 * d3)) * (1.f / 256.f);
                if (lane == 0) { stats[r * 2] = mean; stats[r * 2 + 1] = rsqrtf(var + LN_EPS); }
            }
            __syncthreads();
            {
                const int s = tid >> 2, c0 = (tid & 3) * 16;
                const float mean = stats[s * 2], rstd = stats[s * 2 + 1];
                const bf16_t* src = p.Puv + (size_t)(row0 + s) * 512 + 256 + g * 64 + c0;
                const u32x4 w0 = *(const u32x4*)src, w1 = *(const u32x4*)(src + 8);
                const unsigned ww[8] = {w0.x, w0.y, w0.z, w0.w, w1.x, w1.y, w1.z, w1.w};
                const float* lw = p.sgu_ln_w + l * 256 + g * 64 + c0; const float* lb = p.sgu_ln_b + l * 256 + g * 64 + c0;
#pragma unroll
                for (int j = 0; j < 16; ++j) {
                    const float xv = (j & 1) ? hi2f(ww[j >> 1]) : lo2f(ww[j >> 1]);
                    const float y = (xv - mean) * rstd * lw[j] + lb[j];
                    const int c = c0 + j;
                    const unsigned pk = pk2(y, 0.f);
                    *(bf16_t*)(lds + c * 256 + ((((s >> 3) ^ (c & 15)) << 4) | ((s & 7) * 2))) = (bf16_t)(pk & 0xffffu);
                }
            }
            __syncthreads();
            f32x4 acc[4];
#pragma unroll
            for (int ni = 0; ni < 4; ++ni) acc[ni] = zero4();
            const float* Wg = p.sgu_w + ((size_t)(l * 4 + g) * 128 + wid * 16 + fr) * 128;
#pragma unroll
            for (int ks = 0; ks < 4; ++ks) {
                const f32x4 a0 = *(const f32x4*)(Wg + ks * 32 + fq * 8), a1 = *(const f32x4*)(Wg + ks * 32 + fq * 8 + 4);
                const float av[8] = {a0[0], a0[1], a0[2], a0[3], a1[0], a1[1], a1[2], a1[3]};
                const bf16x8 af = pack8(av);
#pragma unroll
                for (int ni = 0; ni < 4; ++ni) {
                    const int c = ni * 16 + fr;
                    const bf16x8 bfr = *(const bf16x8*)(lds + c * 256 + (((ks * 4 + fq) ^ (c & 15)) << 4));
                    acc[ni] = MFMA16(bfr, af, acc[ni]);
                }
            }
            const int t = wid * 16 + fr, row = row0 + t;
            const float bs = p.sgu_b[(l * 4 + g) * 128 + t];
#pragma unroll
            for (int ni = 0; ni < 4; ++ni) {
                const int c = g * 64 + ni * 16 + fq * 4;
                const u32x2 w = *(const u32x2*)(p.Puv + (size_t)row * 512 + c);
                f32x4 o;
                o[0] = (acc[ni][0] + bs) * lo2f(w.x); o[1] = (acc[ni][1] + bs) * hi2f(w.x);
                o[2] = (acc[ni][2] + bs) * lo2f(w.y); o[3] = (acc[ni][3] + bs) * hi2f(w.y);
                store4_bf16(p.O + (size_t)row * DM + c, o);
            }
        } else {
            const int rbase = (u - U_SGU) * 64 + wid * 8;
#pragma unroll 1
            for (int i = 0; i < 8; ++i) {
                const int row = rbase + i;
                const u32x2 wq = *(const u32x2*)(p.Cq + (size_t)row * 256 + lane * 4);
                const unsigned wk = *(const unsigned*)(p.Ckv + (size_t)row * 128 + lane * 2);
                const float q0 = lo2f(wq.x), q1 = hi2f(wq.x), q2 = lo2f(wq.y), q3 = hi2f(wq.y), k0 = lo2f(wk), k1 = hi2f(wk);
                const float sq = wave_sum((q0 * q0 + q1 * q1) + (q2 * q2 + q3 * q3));
                const float sk = wave_sum(k0 * k0 + k1 * k1);
                if (lane == 0) { p.RS[row * 2] = rsqrtf(sq * (1.f / 256.f) + LN_EPS); p.RS[row * 2 + 1] = rsqrtf(sk * (1.f / 128.f) + LN_EPS); }
            }
        }
    }
}

DI void hgrn_h1_unit(CParams& p, int wu, int lane) {
    const int c = wu % NCH; int t = wu / NCH; const int dir = t & 1, h = (t >> 1) & 3, b = t >> 3;
    const int row0 = b * TP + c * 32, hh = lane >> 5, l31 = lane & 31;
    const bf16_t* Lf = p.Lf + ((size_t)dir * MR + row0) * 256 + h * 64;
    bf16x8 Bf[2][2];
    float* decp = p.DEC + (size_t)wu * 64;
#pragma unroll
    for (int kt = 0; kt < 2; ++kt) {
        const int k = kt * 32 + l31;
        float lf[32], kd[32];
#pragma unroll
        for (int j = 0; j < 32; ++j) lf[j] = bf2f(Lf[(size_t)j * 256 + k]);
        float tot = 0.f;
#pragma unroll
        for (int j = 0; j < 32; ++j) tot += lf[j];
        float run = 0.f;
        if (dir == 0) {
#pragma unroll
            for (int j = 0; j < 32; ++j) { run += lf[j]; kd[j] = (1.0f - __expf(lf[j])) * __expf(tot - run); }
        } else {
#pragma unroll
            for (int j = 31; j >= 0; --j) { run += lf[j]; kd[j] = (1.0f - __expf(lf[j])) * __expf(tot - run); }
        }
        if (hh == 0) decp[k] = __expf(tot);
#pragma unroll
        for (int s = 0; s < 2; ++s) {
            float v8[8];
#pragma unroll
            for (int jj = 0; jj < 8; ++jj) v8[jj] = hh ? kd[16 * s + 8 + jj] : kd[16 * s + jj];
            Bf[kt][s] = pack8(v8);
        }
    }
    const bf16_t* Vt = p.Vht + ((size_t)(b * 4 + h) * 64) * TP + c * 32;
    float* dst = p.DST + (size_t)wu * 4096;
#pragma unroll
    for (int vt = 0; vt < 2; ++vt) {
        bf16x8 Af[2];
#pragma unroll
        for (int s = 0; s < 2; ++s) Af[s] = *(const bf16x8*)(Vt + (size_t)(vt * 32 + l31) * TP + 16 * s + 8 * hh);
#pragma unroll
        for (int kt = 0; kt < 2; ++kt) {
            f32x16 d;
#pragma unroll
            for (int i = 0; i < 16; ++i) d[i] = zf();
            d = MFMA32(Af[0], Bf[kt][0], d);
            d = MFMA32(Af[1], Bf[kt][1], d);
#pragma unroll
            for (int r = 0; r < 16; ++r) dst[(vt * 32 + crow(r, hh)) * 64 + kt * 32 + l31] = d[r];
        }
    }
}

DI void phase_upproj_h1(CParams& p, int l, char* lds) {
    const int tid = otid(), wid = tid >> 6, lane = tid & 63, wr = wid >> 1, wc = wid & 1, fr = lane & 15, fq = lane >> 4;
    constexpr int U_Q = (MR / 256) * 3, U_KV = (MR / 256) * 4, U_H1 = NB * 4 * 2 * NCH / 8;
    for (int u = blockIdx.x; u < U_Q + U_KV + U_H1; u += gridDim.x) {
        if (u < U_Q) {
            const int mt = u / 3, nt = u % 3, m0 = mt * 256, n0 = nt * 128;
            const bf16_t* pa[4]; const bf16_t* pb[2];
            gemm_ptrs(p.Cq, 256, m0, p.WuqT + (size_t)l * 384 * 256, 256, n0, pa, pb);
            f32x4 acc[4][4];
            gemm_core<0>(pa, pb, 256, lds, acc);
#pragma unroll
            for (int mi = 0; mi < 4; ++mi)
#pragma unroll
                for (int ni = 0; ni < 4; ++ni) {
                    const int row = m0 + wr * 64 + mi * 16 + fr, col = n0 + wc * 64 + ni * 16 + fq * 4;
                    f32x4 v = acc[mi][ni] * (p.RS[row * 2] * (0.10206207261596577f * LOG2E));
                    const int cm = col % 96;
                    const f32x4 vr = rope_tile(p, v, row, (cm >> 4) & 1, fq);
                    if (cm >= 64) v = vr;
                    store4_bf16(p.Qm + (size_t)row * 384 + col, v);
                }
        } else if (u < U_Q + U_KV) {
            const int uu = u - U_Q, mt = uu >> 2, nt = uu & 3, m0 = mt * 256, n0 = nt * 128;
            const bf16_t* pa[4]; const bf16_t* pb[2];
            gemm_ptrs(p.Ckv, 128, m0, p.WukvT + (size_t)l * 512 * 128, 128, n0, pa, pb);
            f32x4 acc[4][4];
            if (nt < 2) {
                gemm_core<0>(pa, pb, 128, lds, acc);
#pragma unroll
                for (int mi = 0; mi < 4; ++mi)
#pragma unroll
                    for (int ni = 0; ni < 4; ++ni) {
                        const int row = m0 + wr * 64 + mi * 16 + fr, col = n0 + wc * 64 + ni * 16 + fq * 4;
                        store4_bf16(p.Kn + (size_t)row * 256 + col, acc[mi][ni] * p.RS[row * 2 + 1]);
                    }
            } else {
                gemm_core<1>(pa, pb, 128, lds, acc);
                const int b = m0 / TP, t0 = m0 - b * TP;
#pragma unroll
                for (int mi = 0; mi < 4; ++mi)
#pragma unroll
                    for (int ni = 0; ni < 4; ++ni) {
                        const int f = n0 - 256 + wc * 64 + ni * 16 + fr;
                        const int rl = wr * 64 + mi * 16 + fq * 4;
                        const f32x4 rs = {p.RS[(m0 + rl) * 2 + 1], p.RS[(m0 + rl + 1) * 2 + 1], p.RS[(m0 + rl + 2) * 2 + 1], p.RS[(m0 + rl + 3) * 2 + 1]};
                        store4_bf16(p.Vmt + ((size_t)(b * 256 + f)) * TP + t0 + rl, acc[mi][ni] * rs);
                    }
            }
        } else {
            hgrn_h1_unit(p, (u - U_Q - U_KV) * 8 + wid, lane);
        }
    }
}

DI void hgrn_h2_unit(CParams& p, int cu  ) {
    const int tid = otid();
    if (tid >= 256) return;
    const int gid = cu * 256 + tid;
    const int seq = gid >> 10, e4 = gid & 1023;
    const int dir = seq & 1, k4 = (e4 & 15) * 4;
    f32x4 st = zero4();
    for (int t0 = 0; t0 < NCH; t0 += 8) {
        f32x4 ds[8], dc[8]; float* ptr[8];
#pragma unroll
        for (int j = 0; j < 8; ++j) {
            const int t = t0 + j, pc = dir == 0 ? t : (t < 8 ? 7 - t : 143 - t);
            ptr[j] = p.DST + ((size_t)(seq * NCH + pc)) * 4096 + e4 * 4;
            ds[j] = *(const f32x4*)ptr[j];
            dc[j] = *(const f32x4*)(p.DEC + (size_t)(seq * NCH + pc) * 64 + k4);
        }
#pragma unroll
        for (int j = 0; j < 8; ++j) { *(f32x4*)ptr[j] = st; st = dc[j] * st + ds[j]; }
    }
}

DI void hgrn_h3_unit(CParams& p, int l, int wu, int lane, char* wl) {
    const int pc = wu % NCH; const int t_ = wu / NCH; const int h = t_ & 3, b = t_ >> 2;
    const int row0 = b * TP + pc * 32, hh = lane >> 5, i = lane & 31;
    float* Bl = (float*)wl;
    f32x16 Y[2];
    { const float z = zf();
#pragma unroll
    for (int r = 0; r < 16; ++r) { Y[0][r] = z; Y[1][r] = z; } }
#pragma unroll 1
    for (int dir = 0; dir < 2; ++dir) {
        const bf16_t* Lf = p.Lf + ((size_t)dir * MR + row0) * 256 + h * 64;
        {
            float lf[32];
#pragma unroll
            for (int j = 0; j < 32; ++j) lf[j] = bf2f(Lf[(size_t)j * 256 + lane]);
            float run = 0.f;
            if (dir == 0) {
#pragma unroll
                for (int j = 0; j < 32; ++j) { run += lf[j]; Bl[j * 68 + lane] = run; }
            } else {
#pragma unroll
                for (int j = 31; j >= 0; --j) { run += lf[j]; Bl[j * 68 + lane] = run; }
            }
        }
        __syncthreads();
        bf16x8 Qf[4], Kf[4];
#pragma unroll
        for (int s = 0; s < 4; ++s) {
            const int kb = 16 * s + 8 * hh;
            const u32x4 qw = *(const u32x4*)(p.Hq + (size_t)(row0 + i) * 256 + h * 64 + kb);
            const u32x4 fw = *(const u32x4*)(Lf + (size_t)i * 256 + kb);
            const f32x4 b0 = *(const f32x4*)(Bl + i * 68 + kb), b1 = *(const f32x4*)(Bl + i * 68 + kb + 4);
            const float bb[8] = {b0[0], b0[1], b0[2], b0[3], b1[0], b1[1], b1[2], b1[3]};
            const unsigned qq[4] = {qw.x, qw.y, qw.z, qw.w}, ff[4] = {fw.x, fw.y, fw.z, fw.w};
            float qd[8], kd[8];
#pragma unroll
            for (int j = 0; j < 8; ++j) {
                const float qv = (j & 1) ? hi2f(qq[j >> 1]) : lo2f(qq[j >> 1]);
                const float fv = (j & 1) ? hi2f(ff[j >> 1]) : lo2f(ff[j >> 1]);
                qd[j] = qv * __expf(bb[j]);
                kd[j] = (1.0f - __expf(fv)) * __expf(-bb[j]);
            }
            Qf[s] = pack8(qd); Kf[s] = pack8(kd);
        }
        f32x16 X;
#pragma unroll
        for (int r = 0; r < 16; ++r) X[r] = zf();
#pragma unroll
        for (int s = 0; s < 4; ++s) X = MFMA32(Kf[s], Qf[s], X);
#pragma unroll
        for (int r = 0; r < 16; ++r) { const int j = crow(r, hh); const bool keep = dir == 0 ? (j <= i) : (j >= i); X[r] = keep ? X[r] : 0.f; }
        bf16x8 Xs[2];
#pragma unroll
        for (int s = 0; s < 2; ++s) { const float v8[8] = {X[8 * s], X[8 * s + 1], X[8 * s + 2], X[8 * s + 3], X[8 * s + 4], X[8 * s + 5], X[8 * s + 6], X[8 * s + 7]}; Xs[s] = pack8(v8); }
        const bf16_t* Vt = p.Vht + ((size_t)(b * 4 + h) * 64) * TP + pc * 32;
        const float* ST = p.DST + ((size_t)(((b * 4 + h) * 2 + dir) * NCH + pc)) * 4096;
#pragma unroll
        for (int vt = 0; vt < 2; ++vt) {
            const bf16_t* vrow = Vt + (size_t)(vt * 32 + i) * TP;
#pragma unroll
            for (int s = 0; s < 2; ++s) {
                const u32x2 lo = *(const u32x2*)(vrow + 16 * s + 4 * hh), hi = *(const u32x2*)(vrow + 16 * s + 8 + 4 * hh);
                u32x4 w; w.x = lo.x; w.y = lo.y; w.z = hi.x; w.w = hi.y;
                Y[vt] = MFMA32(__builtin_bit_cast(bf16x8, w), Xs[s], Y[vt]);
            }
            const float* srow = ST + (vt * 32 + i) * 64;
#pragma unroll
            for (int s = 0; s < 4; ++s) {
                const f32x4 a0 = *(const f32x4*)(srow + 16 * s + 8 * hh), a1 = *(const f32x4*)(srow + 16 * s + 8 * hh + 4);
                const float v8[8] = {a0[0], a0[1], a0[2], a0[3], a1[0], a1[1], a1[2], a1[3]};
                Y[vt] = MFMA32(pack8(v8), Qf[s], Y[vt]);
            }
        }
        __syncthreads();
    }
    float ss = 0.f;
#pragma unroll
    for (int r = 0; r < 16; ++r) ss += Y[0][r] * Y[0][r] + Y[1][r] * Y[1][r];
    ss += shx<32>(ss);
    const float rs = rsqrtf(ss * (1.f / 64.f) + LN_EPS);
    const int row = row0 + i;
#pragma unroll
    for (int vt = 0; vt < 2; ++vt)
#pragma unroll
        for (int g4 = 0; g4 < 4; ++g4) {
            const int v0 = vt * 32 + 8 * g4 + 4 * hh;
            const f32x4 nw = *(const f32x4*)(p.hgrn_norm_w + l * 64 + v0);
            const u32x2 gw = *(const u32x2*)(p.Hg + (size_t)row * 256 + h * 64 + v0);
            f32x4 o;
            o[0] = Y[vt][g4 * 4 + 0] * rs * nw[0] * lo2f(gw.x); o[1] = Y[vt][g4 * 4 + 1] * rs * nw[1] * hi2f(gw.x);
            o[2] = Y[vt][g4 * 4 + 2] * rs * nw[2] * lo2f(gw.y); o[3] = Y[vt][g4 * 4 + 3] * rs * nw[3] * hi2f(gw.y);
            store4_bf16(p.O + (size_t)row * DM + 512 + h * 64 + v0, o);
        }
}

template <bool DIFF>
DI void attn_unit(CParams& p, int l, int b, int h, int qrow0  , int nkt  , char* lds) {
    const int tid = otid(), wid = tid >> 6, lane = tid & 63, hh = lane >> 5, q31 = lane & 31;
    constexpr int NS = DIFF ? 2 : 1;
    constexpr int NQF = DIFF ? 4 : 6;
    constexpr int BUF = 8192 + 8192 + (DIFF ? 0 : 4096);
    const int qrow = qrow0 + wid * 32 + q31;
    bf16x8 Qf[NQF];
    {
        const bf16_t* qp = DIFF ? p.Qd + (size_t)qrow * 256 + h * 64 : p.Qm + (size_t)qrow * 384 + h * 96;
#pragma unroll
        for (int s = 0; s < NQF; ++s) Qf[s] = *(const bf16x8*)(qp + 16 * s + 8 * hh);
    }
    const size_t krow0 = (size_t)b * TP;
    const bf16_t* kptr = (DIFF ? p.Kd : p.Kn) + (krow0 + (tid >> 3)) * 256 + h * 64 + (tid & 7) * 8;
    const bf16_t* vptr = (DIFF ? p.Vdt : p.Vmt) + ((size_t)(b * 4 + h) * 64 + (tid >> 3)) * TP + (tid & 7) * 8;
    const bf16_t* rptr = p.Kr + (krow0 + ((tid & 255) >> 2)) * 32 + (tid & 3) * 8;
    const int key_w = tid >> 3, c_w = tid & 7;
    const int kwoff = key_w * 128 + ((c_w ^ ((key_w >> 1) & 7)) << 4);
    const int d_w = tid >> 3;
    const int vwoff0 = 8192 + d_w * 128 + (((2 * c_w) ^ ((d_w >> 1) & 15)) << 3), vwoff1 = 8192 + d_w * 128 + (((2 * c_w + 1) ^ ((d_w >> 1) & 15)) << 3);
    const int rkey = (tid & 255) >> 2, rc = tid & 3;
    const int rwoff = 16384 + rkey * 64 + ((rc ^ ((rkey >> 2) & 3)) << 4);
    const int krd = q31 * 128, ksw = (q31 >> 1) & 7;
    const int rrd = 16384 + q31 * 64, rsw = (q31 >> 2) & 3;
    const int vrd = 8192 + q31 * 128, vsw = (q31 >> 1) & 15;
    f32x16 ot[NS][2];
    float m[NS], lsum[NS];
#pragma unroll
    for (int a = 0; a < NS; ++a) { m[a] = 0.f; lsum[a] = 0.f;
#pragma unroll
        for (int r = 0; r < 16; ++r) { ot[a][0][r] = zf(); ot[a][1][r] = zf(); } }
    u32x4 rk, rv, rr;
    rk = *(const u32x4*)kptr; rv = *(const u32x4*)vptr;
    if (!DIFF) { if (tid < 256) rr = *(const u32x4*)rptr; }
    __syncthreads();
    *(u32x4*)(lds + kwoff) = rk;
    *(u32x2*)(lds + vwoff0) = (u32x2){rv.x, rv.y}; *(u32x2*)(lds + vwoff1) = (u32x2){rv.z, rv.w};
    if (!DIFF) { if (tid < 256) *(u32x4*)(lds + rwoff) = rr; }
    __syncthreads();
    for (int kt = 0; kt < nkt; ++kt) {
        const char* cur = lds + (kt & 1) * BUF;
        const bool more = kt + 1 < nkt;
        if (more) {
            rk = *(const u32x4*)(kptr + (size_t)(kt + 1) * 64 * 256);
            rv = *(const u32x4*)(vptr + (kt + 1) * 64);
            if (!DIFF) { if (tid < 256) rr = *(const u32x4*)(rptr + (size_t)(kt + 1) * 64 * 32); }
        }
        bf16x8 Pf[NS][2][2];
#pragma unroll
        for (int a = 0; a < NS; ++a) {
            f32x16 st[2];
            const float negm = -m[a];
            constexpr int NKF = DIFF ? 2 : 6;
            bf16x8 kf[2][NKF];
#pragma unroll
            for (int t = 0; t < 2; ++t) {
                if (DIFF) {
#pragma unroll
                    for (int s = 0; s < 2; ++s) kf[t][s] = *(const bf16x8*)(cur + t * 4096 + krd + (((4 * a + 2 * s + hh) ^ ksw) << 4));
                } else {
#pragma unroll
                    for (int s = 0; s < 4; ++s) kf[t][s] = *(const bf16x8*)(cur + t * 4096 + krd + (((2 * s + hh) ^ ksw) << 4));
#pragma unroll
                    for (int s = 0; s < 2; ++s) kf[t][4 + s] = *(const bf16x8*)(cur + t * 2048 + rrd + (((2 * s + hh) ^ rsw) << 4));
                }
            }
            __builtin_amdgcn_sched_barrier(0);
#pragma unroll
            for (int t = 0; t < 2; ++t) {
                f32x16 acc;
#pragma unroll
                for (int r = 0; r < 16; ++r) acc[r] = negm;
#pragma unroll
                for (int s = 0; s < NKF; ++s) acc = MFMA32(kf[t][s], Qf[DIFF ? 2 * a + s : s], acc);
                st[t] = acc;
            }
            float tm = fmaxf(fmaxf(st[0][0], st[0][1]), st[0][2]);
#pragma unroll
            for (int r = 3; r < 15; r += 2) tm = fmaxf(fmaxf(tm, st[0][r]), st[0][r + 1]);
            tm = fmaxf(tm, st[0][15]);
#pragma unroll
            for (int r = 0; r < 16; r += 2) tm = fmaxf(fmaxf(tm, st[1][r]), st[1][r + 1]);
            { const auto sw = __builtin_amdgcn_permlane32_swap(__float_as_uint(tm), __float_as_uint(tm), false, false); tm = fmaxf(__uint_as_float(sw[0]), __uint_as_float(sw[1])); }
            if (kt == 0 || __any(tm > 8.0f)) {
                const float delta = kt == 0 ? tm : fmaxf(tm, 0.f);
                const float alpha = __builtin_amdgcn_exp2f(-delta);
                m[a] += delta; lsum[a] *= alpha;
#pragma unroll
                for (int r = 0; r < 16; ++r) { st[0][r] -= delta; st[1][r] -= delta; ot[a][0][r] *= alpha; ot[a][1][r] *= alpha; }
            }
            float ps = 0.f;
#pragma unroll
            for (int t = 0; t < 2; ++t) {
#pragma unroll
                for (int r = 0; r < 16; ++r) { const float e = __builtin_amdgcn_exp2f(st[t][r]); st[t][r] = e; ps += e; }
#pragma unroll
                for (int s = 0; s < 2; ++s) {
                    const float v8[8] = {st[t][8 * s], st[t][8 * s + 1], st[t][8 * s + 2], st[t][8 * s + 3], st[t][8 * s + 4], st[t][8 * s + 5], st[t][8 * s + 6], st[t][8 * s + 7]};
                    Pf[a][t][s] = pack8(v8);
                }
            }
            lsum[a] += ps;
            if (DIFF) __builtin_amdgcn_sched_barrier(0);
        }
#pragma unroll
        for (int dt = 0; dt < 2; ++dt) {
            bf16x8 vf[2][2];
#pragma unroll
            for (int t = 0; t < 2; ++t)
#pragma unroll
                for (int s = 0; s < 2; ++s) {
                    const int c8 = 8 * t + 4 * s + hh;
                    const u32x2 lo = *(const u32x2*)(cur + dt * 4096 + vrd + ((c8 ^ vsw) << 3));
                    const u32x2 hi = *(const u32x2*)(cur + dt * 4096 + vrd + (((c8 + 2) ^ vsw) << 3));
                    u32x4 w; w.x = lo.x; w.y = lo.y; w.z = hi.x; w.w = hi.y;
                    vf[t][s] = __builtin_bit_cast(bf16x8, w);
                }
            __builtin_amdgcn_sched_barrier(0);
#pragma unroll
            for (int t = 0; t < 2; ++t)
#pragma unroll
                for (int s = 0; s < 2; ++s)
#pragma unroll
                    for (int a = 0; a < NS; ++a) ot[a][dt] = MFMA32(vf[t][s], Pf[a][t][s], ot[a][dt]);
        }
        if (more) {
            char* nxt = lds + ((kt + 1) & 1) * BUF;
            *(u32x4*)(nxt + kwoff) = rk;
            *(u32x2*)(nxt + vwoff0) = (u32x2){rv.x, rv.y}; *(u32x2*)(nxt + vwoff1) = (u32x2){rv.z, rv.w};
            if (!DIFF) { if (tid < 256) *(u32x4*)(nxt + rwoff) = rr; }
        }
        __syncthreads();
    }
    float linv[NS];
#pragma unroll
    for (int a = 0; a < NS; ++a) { const float lt = lsum[a] + shx<32>(lsum[a]); linv[a] = 1.0f / lt; }
    f32x16 o[2];
    if (DIFF) {
        const float lam = p.lam[l];
#pragma unroll
        for (int dt = 0; dt < 2; ++dt)
#pragma unroll
            for (int r = 0; r < 16; ++r) o[dt][r] = ot[0][dt][r] * linv[0] - lam * (ot[NS - 1][dt][r] * linv[NS - 1]);
        float ss = 0.f;
#pragma unroll
        for (int r = 0; r < 16; ++r) ss += o[0][r] * o[0][r] + o[1][r] * o[1][r];
        ss += shx<32>(ss);
        int lz = l; asm volatile("" : "+s"(lz));
        const float lam_init = lz == 0 ? 0.2f : 0.3555090676f;
        const float rs = rsqrtf(ss * (1.f / 64.f) + LN_EPS) * (1.0f - lam_init);
#pragma unroll
        for (int dt = 0; dt < 2; ++dt)
#pragma unroll
            for (int r = 0; r < 16; ++r) o[dt][r] *= rs;
    } else {
#pragma unroll
        for (int dt = 0; dt < 2; ++dt)
#pragma unroll
            for (int r = 0; r < 16; ++r) o[dt][r] = ot[0][dt][r] * linv[0];
    }
    bf16_t* orow = p.O + (size_t)qrow * DM + (DIFF ? 256 : 768) + h * 64;
#pragma unroll
    for (int dt = 0; dt < 2; ++dt)
#pragma unroll
        for (int g4 = 0; g4 < 4; ++g4) {
            const int d0 = dt * 32 + 8 * g4 + 4 * hh;
            f32x4 v = {o[dt][g4 * 4], o[dt][g4 * 4 + 1], o[dt][g4 * 4 + 2], o[dt][g4 * 4 + 3]};
            if (DIFF) { const f32x4 sw = *(const f32x4*)(p.diff_subln_w + l * 64 + d0); v = v * sw; }
            store4_bf16(orow + d0, v);
        }
}

DI void phase_attn_diff_h2(CParams& p, int l, char* lds, bool h2skip) {
    const int G = gridDim.x;
    const int U_H2 = 256, U_LAT = NB * 4 * 16, U_CTX = (l == 0) ? NB * 4 : 0;
    const int total = U_H2 + 2 * U_LAT + 2 * U_CTX;
    for (int u = blockIdx.x; u < total; u += G) {
        if (u < U_H2) { if (!h2skip) hgrn_h2_unit(p, u); continue; }
        int v = u - U_H2; bool diff; int b, h, q0, nkt;
        if (v < 2 * U_LAT) { diff = v < U_LAT; if (!diff) v -= U_LAT; b = v >> 6; h = (v >> 4) & 3; q0 = b * TP + CTX + (v & 15) * 256; nkt = TP / 64; }
        else { v -= 2 * U_LAT; diff = v < U_CTX; if (!diff) v -= U_CTX; b = v >> 2; h = v & 3; q0 = b * TP; nkt = CTX / 64; }
        if (diff) attn_unit<true>(p, l, b, h, q0, nkt, lds); else attn_unit<false>(p, l, b, h, q0, nkt, lds);
    }
}
DI void phase_attn_mla_h3(CParams& p, int l, char* lds) {
    const int tid_ = otid(); const int wid = tid_ >> 6, lane = tid_ & 63;
    const int U_H3 = NB * 4 * NCH / 8;
    for (int u = blockIdx.x; u < U_H3; u += gridDim.x) { __syncthreads(); hgrn_h3_unit(p, l, u * 8 + wid, lane, lds + 65536 + wid * 8704); }
}

struct SchedOut {
    const char* O; const char* W; int l;
    DI bool next(int i, g8::GU& u) const {
        int pm, pn;
        if (l == 0) { if (!g8::order_next(i, MR / 256, 4, pm, pn)) return false; }
        else { if (!g8::order_next(i, NB * 16, 4, pm, pn)) return false; pm = (pm >> 4) * 17 + 1 + (pm & 15); }
        u.pm = pm; u.pn = pn; u.e = 0; u.j0 = 0; u.a = O + (size_t)pm * 256 * 2048; u.b = W + (size_t)pn * 256 * 2048; return true;
    }
    DI unsigned arow(const g8::GU&, int) const { return 0u; }
};
struct EpiOut {
    float* Y;
    DI void operator()(const f32x4 (&acc)[2][2][4][2], const g8::GU& u, int wr, int wc, int fr, int fq) const {
#pragma unroll
        for (int ai = 0; ai < 2; ++ai)
#pragma unroll
            for (int bj = 0; bj < 2; ++bj)
#pragma unroll
                for (int m = 0; m < 4; ++m)
#pragma unroll
                    for (int n = 0; n < 2; ++n) {
                        const int row = u.pm * 256 + 128 * ai + 64 * wr + 16 * m + fr, col = u.pn * 256 + 128 * bj + 32 * wc + 16 * n + 4 * fq;
                        *(f32x4*)(Y + (size_t)row * DM + col) = acc[ai][bj][m][n];
                    }
    }
};
DI void phase_outproj(CParams& p, int l, char* lds) {
    SchedOut S; S.O = (const char*)p.O; S.W = (const char*)(p.WoutT + (size_t)l * DM * DM); S.l = l;
    EpiOut E; E.Y = p.Y;
    g8::gemm8<EpiOut, SchedOut, false>(lds, DM * 2, nullptr, S, E);
}

DI void phase_postmix(CParams& p, int l, char* lds) {
    const int tid = otid(), wid = tid >> 6, lane = tid & 63;
    float* WrT = (float*)lds;
    int* lcnt = (int*)(lds + 131072);
    int* lbase = lcnt + 32;
    unsigned* ent = (unsigned*)(lds + 131072 + 256);
    const int G = gridDim.x, nrb = (MR + G - 1) / G;
    const float* rw = p.router_w + (size_t)l * DM * NE;
    __syncthreads();
    for (int i = tid; i < DM * NE / 4; i += NTHREADS) {
        const f32x4 v = *(const f32x4*)(rw + i * 4);
        const int d = i >> 3, e0 = (i & 7) * 4;
#pragma unroll
        for (int j = 0; j < 4; ++j) WrT[(e0 + j) * DM + d] = v[j];
    }
    if (tid < 32) lcnt[tid] = 0;
    __syncthreads();
    const int rbeg = blockIdx.x * nrb;
    const float* lw = p.ln_mix_w + l * DM; const float* lb = p.ln_mix_b + l * DM;
    for (int i0 = wid * 2; i0 < nrb; i0 += 16) {
        f32x4 v[2][4]; bool act[2];
#pragma unroll
        for (int rr = 0; rr < 2; ++rr) {
            const int i = i0 + rr; int row = rbeg + i;
            act[rr] = (i < nrb) && (row < MR);
            if (!act[rr]) row = rbeg;
            const int t = row % TP;
            if (l == 1 && t < CTX) { if (act[rr] && lane < 4) ent[(i * 4 + lane) * 2] = 0xffffffffu; act[rr] = false; }
            const float* xr = l == 0 ? in_row(p, row) : p.X + (size_t)row * DM;
            const float* yr = p.Y + (size_t)row * DM;
            const float* g1 = mod_vec(p, l, row, 2); const float* sh2 = mod_vec(p, l, row, 3); const float* sc2 = mod_vec(p, l, row, 4);
            float s = 0.f;
#pragma unroll
            for (int j = 0; j < 4; ++j) { const int c = j * 256 + lane * 4; v[rr][j] = *(const f32x4*)(xr + c) * DN_ALPHA + *(const f32x4*)(g1 + c) * *(const f32x4*)(yr + c); s += (v[rr][j][0] + v[rr][j][1]) + (v[rr][j][2] + v[rr][j][3]); }
            float mean = wave_sum(s) * (1.f / DM); float q = 0.f;
#pragma unroll
            for (int j = 0; j < 4; ++j) { v[rr][j] = v[rr][j] - mean; q += (v[rr][j][0] * v[rr][j][0] + v[rr][j][1] * v[rr][j][1]) + (v[rr][j][2] * v[rr][j][2] + v[rr][j][3] * v[rr][j][3]); }
            float rstd = rsqrtf(wave_sum(q) * (1.f / DM) + LN_EPS);
            s = 0.f;
#pragma unroll
            for (int j = 0; j < 4; ++j) { const int c = j * 256 + lane * 4; v[rr][j] = v[rr][j] * rstd * *(const f32x4*)(lw + c) + *(const f32x4*)(lb + c);
                if (act[rr]) *(f32x4*)(p.X + (size_t)row * DM + c) = v[rr][j];
                s += (v[rr][j][0] + v[rr][j][1]) + (v[rr][j][2] + v[rr][j][3]); }
            mean = wave_sum(s) * (1.f / DM); q = 0.f;
#pragma unroll
            for (int j = 0; j < 4; ++j) { v[rr][j] = v[rr][j] - mean; q += (v[rr][j][0] * v[rr][j][0] + v[rr][j][1] * v[rr][j][1]) + (v[rr][j][2] * v[rr][j][2] + v[rr][j][3] * v[rr][j][3]); }
            rstd = rsqrtf(wave_sum(q) * (1.f / DM) + LN_EPS);
#pragma unroll
            for (int j = 0; j < 4; ++j) { const int c = j * 256 + lane * 4; v[rr][j] = v[rr][j] * rstd * (*(const f32x4*)(sc2 + c) + 1.0f) + *(const f32x4*)(sh2 + c);
                if (act[rr]) *(unsigned*)(p.H8 + (size_t)row * DM + c) = pk4_fp8(v[rr][j][0], v[rr][j][1], v[rr][j][2], v[rr][j][3]); }
            __builtin_amdgcn_sched_barrier(0);
        }
        float lq[2][4];
#pragma unroll
        for (int qt = 0; qt < 4; ++qt) {
            float pl[2][8];
#pragma unroll
            for (int e = 0; e < 8; ++e) {
                float a0 = 0.f, a1 = 0.f;
#pragma unroll
                for (int j = 0; j < 4; ++j) {
                    const f32x4 w = *(const f32x4*)(WrT + (qt * 8 + e) * DM + j * 256 + lane * 4);
                    a0 += (v[0][j][0] * w[0] + v[0][j][1] * w[1]) + (v[0][j][2] * w[2] + v[0][j][3] * w[3]);
                    a1 += (v[1][j][0] * w[0] + v[1][j][1] * w[1]) + (v[1][j][2] * w[2] + v[1][j][3] * w[3]);
                }
                pl[0][e] = a0; pl[1][e] = a1;
                if ((e & 3) == 3) __builtin_amdgcn_sched_barrier(0);
            }
#pragma unroll
            for (int rr = 0; rr < 2; ++rr) {
                float r4[4], r2[2];
#pragma unroll
                for (int e = 0; e < 4; ++e) { const bool up = (lane & 4) != 0; const float keep = up ? pl[rr][e + 4] : pl[rr][e]; const float send = up ? pl[rr][e] : pl[rr][e + 4]; r4[e] = keep + dpp<DPP_HM>(send); }
#pragma unroll
                for (int e = 0; e < 2; ++e) { const bool up = (lane & 2) != 0; const float keep = up ? r4[e + 2] : r4[e]; const float send = up ? r4[e] : r4[e + 2]; r2[e] = keep + dpp<DPP_X2>(send); }
                float x1; { const bool up = (lane & 1) != 0; const float keep = up ? r2[1] : r2[0]; const float send = up ? r2[0] : r2[1]; x1 = keep + dpp<DPP_X1>(send); }
                x1 += shx<8>(x1); x1 += shx<16>(x1); x1 += shx<32>(x1);
                lq[rr][qt] = x1;
            }
            __builtin_amdgcn_sched_barrier(0);
        }
#pragma unroll
        for (int rr = 0; rr < 2; ++rr) {
            const int i = i0 + rr;
            const int e_me = lane & 31;
            const int qsel = (lane >> 3) & 3;
            float logit = (qsel == 0 ? lq[rr][0] : qsel == 1 ? lq[rr][1] : qsel == 2 ? lq[rr][2] : lq[rr][3]) + p.router_b[l * NE + e_me];
            logit = (logit == logit) ? fminf(fmaxf(logit, -1e30f), 1e30f) : -1e30f;
            int rank = 0;
#pragma unroll
            for (int e = 0; e < 32; ++e) { const float o = rdlane(logit, e); rank += (o > logit || (o == logit && e < e_me)) ? 1 : 0; }
            const float vmax = rdlane(logit, __builtin_amdgcn_readfirstlane(__ffsll((long long)__ballot(rank == 0 && lane < 32)) - 1));
            const float ex = (rank < 4) ? __expf(logit - vmax) : 0.f;
            const float den = wave_sum((lane < 32) ? ex : 0.f);
            if (act[rr] && lane < 32 && rank < 4) {
                const int lp = atomicAdd(&lcnt[e_me], 1);
                ent[(i * 4 + rank) * 2] = (unsigned)e_me | ((unsigned)lp << 8);
                ent[(i * 4 + rank) * 2 + 1] = __float_as_uint(ex / den);
            }
        }
    }
    __syncthreads();
    if (tid < 32) lbase[tid] = (int)atomicAdd(&p.gcnt[l * NE + tid], (unsigned)lcnt[tid]);
    __syncthreads();
    for (int j = tid; j < nrb * 4; j += NTHREADS) {
        const int row = rbeg + (j >> 2);
        if (row >= MR) break;
        const unsigned w = ent[j * 2];
        if (w == 0xffffffffu) continue;
        const int e = w & 255, pos = lbase[e] + (int)(w >> 8);
        p.ltok[(size_t)e * MR + pos] = row;
        p.lgate[(size_t)e * MR + pos] = __uint_as_float(ent[j * 2 + 1]);
        p.rslot[(size_t)row * 4 + (j & 3)] = (e << 24) | pos;
    }
}

DI int moe_prefix(CParams& p, int l, int* tpre  ) {
    __syncthreads();
    if (otid() == 0) {
        int acc = 0;
        for (int e = 0; e < NE; ++e) { tpre[e] = acc; acc += ((int)p.gcnt[l * NE + e] + 255) >> 8; }
        tpre[NE] = acc;
    }
    __syncthreads();
    return tpre[NE];
}
DI int moe_find(const int* tpre, int mt) { int e = 0;
#pragma unroll 1
    for (int j = 0; j < NE; ++j) if (tpre[j + 1] <= mt) e = j + 1;
    return e; }

constexpr int TPRE_OFF = 135168;
struct SchedMoe {
    const int* tpre; const unsigned* cnt; const int* ltok; const char* A; const char* W; int nN; size_t wstride;
    DI bool next(int i, g8::GU& u) const {
        int pm, pn; if (!g8::order_next(i, __builtin_amdgcn_readfirstlane(tpre[NE]), nN, pm, pn)) return false;
        const int e = __builtin_amdgcn_readfirstlane(moe_find(tpre, pm));
        u.pm = pm; u.pn = pn; u.e = e; u.j0 = __builtin_amdgcn_readfirstlane((pm - tpre[e]) * 256);
        u.a = A + (size_t)pm * 256 * 1024; u.b = W + (size_t)e * wstride + (size_t)pn * 256 * 1024; return true;
    }
    DI unsigned arow(const g8::GU& u, int r) const { const int pos = u.j0 + r; return pos < (int)cnt[u.e] ? (unsigned)ltok[(size_t)u.e * MR + pos] : 0u; }
};
struct EpiMoe1 {
    const float* b1; unsigned char* ACT;
    DI void operator()(const f32x4 (&acc)[2][2][4][2], const g8::GU& u, int wr, int wc, int fr, int fq) const {
        const float* bb1 = b1 + (size_t)u.e * 2048;
#pragma unroll
        for (int ai = 0; ai < 2; ++ai)
#pragma unroll
            for (int bj = 0; bj < 2; ++bj)
#pragma unroll
                for (int m = 0; m < 4; ++m)
#pragma unroll
                    for (int n = 0; n < 2; ++n) {
                        const int rl = 128 * ai + 64 * wr + 16 * m + fr, col = u.pn * 256 + 128 * bj + 32 * wc + 16 * n + 4 * fq;
                        const f32x4 hv = acc[ai][bj][m][n] + *(const f32x4*)(bb1 + col);
                        float o[2];
#pragma unroll
                        for (int q = 0; q < 2; ++q) {
                            const float glu = fminf(hv[2 * q], 7.0f), lin = fminf(fmaxf(hv[2 * q + 1], -7.0f), 7.0f);
                            o[q] = glu * sigmoidf_(1.702f * glu) * (lin + 1.0f);
                        }
                        *(unsigned short*)(ACT + ((size_t)u.pm * 256 + rl) * 1024 + (col >> 1)) = (unsigned short)(__builtin_amdgcn_cvt_pk_fp8_f32(o[0], o[1], 0, false) & 0xffff);
                    }
    }
};
struct EpiMoe2 {
    const float* b2; const float* lgate; const unsigned* cnt; bf16_t* YS;
    DI void operator()(const f32x4 (&acc)[2][2][4][2], const g8::GU& u, int wr, int wc, int fr, int fq) const {
        const float* bb2 = b2 + (size_t)u.e * DM;
        const int cn = (int)cnt[u.e];
        int frz = fr; asm volatile("" : "+v"(frz));
#pragma unroll
        for (int ai = 0; ai < 2; ++ai)
#pragma unroll
            for (int m = 0; m < 4; ++m) {
                const int rl = 128 * ai + 64 * wr + 16 * m + frz, pos = u.j0 + rl;
                const float gate = pos < cn ? lgate[(size_t)u.e * MR + pos] : 0.f;
#pragma unroll
                for (int bj = 0; bj < 2; ++bj)
#pragma unroll
                    for (int n = 0; n < 2; ++n) {
                        const int col = u.pn * 256 + 128 * bj + 32 * wc + 16 * n + 4 * fq;
                        store4_bf16(YS + ((size_t)u.pm * 256 + rl) * 1024 + col, (acc[ai][bj][m][n] + *(const f32x4*)(bb2 + col)) * gate);
                    }
                __builtin_amdgcn_sched_barrier(0);
            }
    }
};
DI void phase_moe1(CParams& p, int l, char* lds) {
    int* tpre = (int*)(lds + TPRE_OFF);
    moe_prefix(p, l, tpre);
    SchedMoe S; S.tpre = tpre; S.cnt = p.gcnt + l * NE; S.ltok = p.ltok; S.A = nullptr; S.W = (const char*)p.W1T + (size_t)l * NE * 2048 * DM; S.nN = 8; S.wstride = (size_t)2048 * DM;
    EpiMoe1 E; E.b1 = p.b1 + (size_t)l * NE * 2048; E.ACT = (unsigned char*)p.ACT;
    g8::gemm8<EpiMoe1, SchedMoe, true, true>(lds, DM, (const char*)p.H8, S, E, 0x7a7a7a7au);
}
DI void phase_moe2(CParams& p, int l, char* lds) {
    int* tpre = (int*)(lds + TPRE_OFF);
    moe_prefix(p, l, tpre);
    SchedMoe S; S.tpre = tpre; S.cnt = p.gcnt + l * NE; S.ltok = p.ltok; S.A = (const char*)p.ACT; S.W = (const char*)p.W2T + (size_t)l * NE * DM * DM; S.nN = 4; S.wstride = (size_t)DM * DM;
    EpiMoe2 E; E.b2 = p.b2 + (size_t)l * NE * DM; E.lgate = p.lgate; E.cnt = p.gcnt + l * NE; E.YS = p.YS;
    g8::gemm8<EpiMoe2, SchedMoe, false, true>(lds, DM, nullptr, S, E, 0x79797979u);
}

DI void phase_final(CParams& p, int l, char* lds) {
    const int tid = otid(), wid = tid >> 6, lane = tid & 63;
    int* tpre = (int*)(lds + TPRE_OFF);
    moe_prefix(p, l, tpre);
    const float* lw = p.ln_ffn_w + l * DM; const float* lb = p.ln_ffn_b + l * DM;
    for (int row = blockIdx.x * 8 + wid; row < MR; row += gridDim.x * 8) {
        const int b = row / TP, t = row - b * TP;
        if (l == 1 && t < CTX) continue;
        const float* g2 = mod_vec(p, l, row, 5);
        const bf16_t* ys[4];
#pragma unroll
        for (int k = 0; k < 4; ++k) { const int rs = p.rslot[(size_t)row * 4 + k]; const int e = rs >> 24, pos = rs & 0xffffff; ys[k] = p.YS + ((size_t)tpre[e] * 256 + pos) * 1024; }
        f32x4 v[4]; float s = 0.f;
#pragma unroll
        for (int j = 0; j < 4; ++j) {
            const int c = j * 256 + lane * 4;
            f32x4 y = zero4();
#pragma unroll
            for (int k = 0; k < 4; ++k) { const u32x2 w = *(const u32x2*)(ys[k] + c); y[0] += lo2f(w.x); y[1] += hi2f(w.x); y[2] += lo2f(w.y); y[3] += hi2f(w.y); }
            const f32x4 xv = *(const f32x4*)(p.X + (size_t)row * DM + c), gg = *(const f32x4*)(g2 + c);
            v[j] = xv * DN_ALPHA + gg * y;
            s += (v[j][0] + v[j][1]) + (v[j][2] + v[j][3]);
        }
        float mean = wave_sum(s) * (1.f / DM); float q = 0.f;
#pragma unroll
        for (int j = 0; j < 4; ++j) { v[j] = v[j] - mean; q += (v[j][0] * v[j][0] + v[j][1] * v[j][1]) + (v[j][2] * v[j][2] + v[j][3] * v[j][3]); }
        float rstd = rsqrtf(wave_sum(q) * (1.f / DM) + LN_EPS);
        s = 0.f;
#pragma unroll
        for (int j = 0; j < 4; ++j) {
            const int c = j * 256 + lane * 4;
            v[j] = v[j] * rstd * *(const f32x4*)(lw + c) + *(const f32x4*)(lb + c);
            s += (v[j][0] + v[j][1]) + (v[j][2] + v[j][3]);
        }
        if (l == 1) {
            float* o = p.out + ((size_t)b * SEQ + (t - CTX)) * DM;
#pragma unroll
            for (int j = 0; j < 4; ++j) *(f32x4*)(o + j * 256 + lane * 4) = v[j];
        } else {
#pragma unroll
            for (int j = 0; j < 4; ++j) *(f32x4*)(p.X + (size_t)row * DM + j * 256 + lane * 4) = v[j];
            mean = wave_sum(s) * (1.f / DM); q = 0.f;
#pragma unroll
            for (int j = 0; j < 4; ++j) { v[j] = v[j] - mean; q += (v[j][0] * v[j][0] + v[j][1] * v[j][1]) + (v[j][2] * v[j][2] + v[j][3] * v[j][3]); }
            rstd = rsqrtf(wave_sum(q) * (1.f / DM) + LN_EPS);
            const float* sh = mod_vec(p, 1, row, 0); const float* sc = mod_vec(p, 1, row, 1);
#pragma unroll
            for (int j = 0; j < 4; ++j) {
                const int c = j * 256 + lane * 4;
                const f32x4 h = v[j] * rstd * (*(const f32x4*)(sc + c) + 1.0f) + *(const f32x4*)(sh + c);
                store4_bf16(p.H + (size_t)row * DM + c, h);
            }
        }
    }
}

constexpr int PH_PER_LAYER = 11, N_PHASES = 1 + 2 * PH_PER_LAYER;

__global__ void __launch_bounds__(NTHREADS, 2) mega(Params p_unused, int ph_lo, int ph_hi) {
    extern __shared__ __attribute__((aligned(16))) char smem[];
    CParams* kp0 = (CParams*)__builtin_amdgcn_kernarg_segment_ptr();
    CParams& p = *kp0;
    ((volatile int*)(smem + WVTAB_OFF))[hw_slot()] = (int)(threadIdx.x >> 6);
    __syncthreads();
    const bool fused = (ph_hi - ph_lo) > 1;
    XcdBarrier bar; bar.bar = p.bar; bar.x = 0; bar.st = (volatile LAS unsigned*)(smem + LDS_BYTES - 16);
    if (fused) {
        if (otid() == 0) *(uint4*)(smem + LDS_BYTES - 16) = make_uint4(0u, 0u, 0u, 0u);
        __syncthreads();
        bar = xcd_barrier_post(p.bar, (volatile LAS unsigned*)(smem + LDS_BYTES - 16));
    }
#if MK_DEBUG == 2
#define PH_STAMP(i) if (blockIdx.x == 0 && threadIdx.x == 0) ((unsigned long long*)(p.gcnt + 1024))[(i) + 1] = wall_clock64();
#else
#define PH_STAMP(i)
#endif
#ifndef MK_REP
#define MK_REP 0u
#endif
#define PH(idx, call) do { const int _i = (idx); if (ph_lo <= _i && _i < ph_hi) { CParams* _kp = kp0; asm volatile("" : "+s"(_kp)); CParams& p = *_kp; call; if ((MK_REP >> (_i == 0 ? 0 : 1 + (_i - 1) % 11)) & 1u) { xcd_barrier(bar); h2skip = true; call; h2skip = false; } if (_i + 1 < ph_hi) xcd_barrier(bar); PH_STAMP(_i) } } while (0)
    bool h2skip = false;
    PH_STAMP(-1)
    PH(0, phase_prologue(p, smem));
#pragma unroll 1
    for (int l = 0; l < 2; ++l) {
        const int base = 1 + l * PH_PER_LAYER;
        PH(base + 0, if (l == 0) phase_ln1(p, smem));
        PH(base + 1, phase_inproj(p, l, smem));
        PH(base + 2, phase_sgu_prep(p, l, smem));
        PH(base + 3, phase_upproj_h1(p, l, smem));
        PH(base + 4, phase_attn_diff_h2(p, l, smem, h2skip));
        PH(base + 5, phase_attn_mla_h3(p, l, smem));
        PH(base + 6, phase_outproj(p, l, smem));
        PH(base + 7, phase_postmix(p, l, smem));
        PH(base + 8, phase_moe1(p, l, smem));
        PH(base + 9, phase_moe2(p, l, smem));
        PH(base + 10, phase_final(p, l, smem));
    }
#undef PH
}


#ifndef MK_DEBUG
#define MK_DEBUG 0
#define MK_REP 0u
#endif
#if MK_DEBUG
struct DbgItem { const void* ptr; unsigned long long n; int f32; int ld; int c0; int c1; int mode; int pad; };
struct DbgList { DbgItem it[40]; int count; int pad; };
__global__ void dbg_scan(DbgList L, unsigned* flag) {
    for (int i = 0; i < L.count; ++i) {
        const DbgItem d = L.it[i];
        bool bad = false;
        for (unsigned long long e = (unsigned long long)blockIdx.x * blockDim.x + threadIdx.x; e < d.n; e += (unsigned long long)gridDim.x * blockDim.x) {
            if (d.ld > 0) { const int c = (int)(e % d.ld); if (c < d.c0 || c >= d.c1) continue; }
            if (d.f32) { const unsigned u = ((const unsigned*)d.ptr)[e]; if (((d.mode & 1) && (u & 0x7f800000u) == 0x7f800000u) || ((d.mode & 2) && u == 0xAAAAAAAAu) || ((d.mode & 4) && (u & 0x7f800000u) >= 0x46800000u)) bad = true; }
            else { const unsigned short u = ((const unsigned short*)d.ptr)[e]; if (((d.mode & 1) && (u & 0x7f80u) == 0x7f80u) || ((d.mode & 2) && u == 0xAAAAu) || ((d.mode & 4) && (u & 0x7f80u) >= 0x4680u)) bad = true; }
        }
        if (bad) atomicMin(flag, (unsigned)i);
    }
}
__global__ void dbg_time(float* out, unsigned long long n, const unsigned long long* ts, unsigned maskA, unsigned maskB) {
    float ta = 0.f, tb = 0.f;
    for (int i = 0; i < 23; ++i) { const float d = (float)(ts[i + 1] - ts[i]) * 0.01f; const int cls = i == 0 ? 0 : 1 + (i - 1) % 11; if (maskA >> cls & 1) ta += d; if (maskB >> cls & 1) tb += d; }
    for (unsigned long long e = (unsigned long long)blockIdx.x * blockDim.x + threadIdx.x; e < n; e += (unsigned long long)gridDim.x * blockDim.x) out[e] = e == 0 ? ta : tb;
}
__global__ void dbg_fill(float* out, unsigned long long n, const unsigned* flag, float hostcode) {
    const unsigned f = *flag;
    float v = f < 1000u ? 100.0f * (float)(f + 1u) : 0.0f;
    if (hostcode != 0.f) v = hostcode;
    for (unsigned long long e = (unsigned long long)blockIdx.x * blockDim.x + threadIdx.x; e < n; e += (unsigned long long)gridDim.x * blockDim.x) out[e] = v;
}
#endif

#ifndef MK_MULTI
#define MK_MULTI 0
#endif

extern "C" void kernel_launch(void* const* d_in, const int* in_sizes, int n_in, void* d_out, int out_size, void* d_ws, size_t ws_size, hipStream_t stream) {
    (void)in_sizes; (void)n_in; (void)out_size; (void)ws_size;
    Params p;
    memset(&p, 0, sizeof(p));
    const float* const* in = (const float* const*)d_in;
    p.x = in[0]; p.c = in[1]; p.ctx = in[2]; p.c_ctx = in[3]; p.ada_w = in[4]; p.ada_b = in[5]; p.w_in = in[6]; p.w_out = in[7];
    p.sgu_ln_w = in[8]; p.sgu_ln_b = in[9]; p.sgu_w = in[10]; p.sgu_b = in[11]; p.diff_lambda = in[12]; p.diff_subln_w = in[13];
    p.hgrn_lb = in[14]; p.hgrn_norm_w = in[15]; p.mla_q_norm_w = in[16]; p.mla_w_uq = in[17]; p.mla_kv_norm_w = in[18]; p.mla_w_ukv = in[19];
    p.ln_mix_w = in[20]; p.ln_mix_b = in[21]; p.ln_ffn_w = in[22]; p.ln_ffn_b = in[23]; p.router_w = in[24]; p.router_b = in[25];
    p.w1 = in[26]; p.b1 = in[27]; p.w2 = in[28]; p.b2 = in[29];
    p.out = (float*)d_out;
    char* ws = (char*)d_ws; size_t off = 0;
    auto take = [&](size_t bytes) { char* r = ws + off; off += (bytes + 255) & ~(size_t)255; return r; };
    constexpr size_t CTRL_BYTES = 65536;
    char* ctrl = take(CTRL_BYTES);
    p.bar = (unsigned*)ctrl; p.gcnt = (unsigned*)(ctrl + 16384);
    p.mod = (float*)take((size_t)2 * 9 * 6144 * 4); p.lball = (float*)take(2 * 512 * 4); p.lam = (float*)take(256); p.ropec = (float*)take(512 * 4); p.ropes = (float*)take(512 * 4);
    p.WinT = (bf16_t*)take((size_t)2 * NINP * DM * 2); p.WoutT = (bf16_t*)take((size_t)2 * DM * DM * 2);
    p.WuqT = (bf16_t*)take((size_t)2 * 384 * 256 * 2); p.WukvT = (bf16_t*)take((size_t)2 * 512 * 128 * 2);
    p.W1T = (bf16_t*)take((size_t)2 * NE * 2048 * DM * 2); p.W2T = (bf16_t*)take((size_t)2 * NE * DM * DM * 2);
    p.X = (float*)take((size_t)MR * DM * 4); p.H = (bf16_t*)take((size_t)MR * DM * 2); p.H8 = (unsigned char*)take((size_t)MR * DM);
    p.Puv = (bf16_t*)take((size_t)MR * 512 * 2); p.Qd = (bf16_t*)take((size_t)MR * 256 * 2); p.Kd = (bf16_t*)take((size_t)MR * 256 * 2); p.Vdt = (bf16_t*)take((size_t)MR * 256 * 2);
    p.Hq = (bf16_t*)take((size_t)MR * 256 * 2); p.Vht = (bf16_t*)take((size_t)MR * 256 * 2); p.Lf = (bf16_t*)take((size_t)2 * MR * 256 * 2); p.Hg = (bf16_t*)take((size_t)MR * 256 * 2);
    p.Cq = (bf16_t*)take((size_t)MR * 256 * 2); p.Ckv = (bf16_t*)take((size_t)MR * 128 * 2); p.Kr = (bf16_t*)take((size_t)MR * 32 * 2);
    p.Qm = (bf16_t*)take((size_t)MR * 384 * 2); p.Kn = (bf16_t*)take((size_t)MR * 256 * 2); p.Vmt = (bf16_t*)take((size_t)MR * 256 * 2);
    p.O = (bf16_t*)take((size_t)MR * DM * 2);
    p.RS = (float*)take((size_t)MR * 2 * 4); p.DST = (float*)take((size_t)NB * 4 * 2 * NCH * 4096 * 4); p.DEC = (float*)take((size_t)NB * 4 * 2 * NCH * 64 * 4);
    p.Y = (float*)take((size_t)MR * DM * 4);
    p.ltok = (int*)take((size_t)NE * MR * 4); p.lgate = (float*)take((size_t)NE * MR * 4); p.rslot = (int*)take((size_t)MR * 4 * 4);
    p.ACT = (bf16_t*)take((size_t)NSLOT * 1024 * 2); p.YS = (bf16_t*)take((size_t)NSLOT * 1024 * 2);

    static int grid = 0;
    if (!grid) {
        int dev = 0, cus = 0, per_cu = 0;
        hipGetDevice(&dev);
        hipDeviceGetAttribute(&cus, hipDeviceAttributeMultiprocessorCount, dev);
        hipFuncSetAttribute((const void*)mega, hipFuncAttributeMaxDynamicSharedMemorySize, LDS_BYTES);
        hipOccupancyMaxActiveBlocksPerMultiprocessor(&per_cu, mega, NTHREADS, LDS_BYTES);
        if (cus <= 0) cus = 256;
        grid = cus * (per_cu < 1 ? 1 : 1);
    }
    hipMemsetAsync(ctrl, 0, CTRL_BYTES, stream);
#if MK_MULTI
#ifndef MK_NPH
#define MK_NPH N_PHASES
#endif
    for (int ph = 0; ph < MK_NPH; ++ph) {
        if (ph == 1 + PH_PER_LAYER) continue;
        hipLaunchKernelGGL(mega, dim3(grid), dim3(NTHREADS), LDS_BYTES, stream, p, ph, ph + 1);
    }
#else
    hipLaunchKernelGGL(mega, dim3(grid), dim3(NTHREADS), LDS_BYTES, stream, p, 0, N_PHASES);
#endif

#if MK_DEBUG == 2
    hipLaunchKernelGGL(dbg_time, dim3(2048), dim3(256), 0, stream, (float*)d_out, (unsigned long long)NB * SEQ * DM, (const unsigned long long*)(p.gcnt + 1024), (unsigned)MK_TMASK_A, (unsigned)MK_TMASK_B);
#elif MK_DEBUG
    {
        DbgList L; memset(&L, 0, sizeof(L));
        int n = 0;
        auto add = [&](const void* ptr, unsigned long long cnt, int f32, int ld = 0, int c0 = 0, int c1 = 0, int mode = 3) { L.it[n].ptr = ptr; L.it[n].n = cnt; L.it[n].f32 = f32; L.it[n].ld = ld; L.it[n].c0 = c0; L.it[n].c1 = c1; L.it[n].mode = mode; ++n; };
        MK_DEBUG_LIST
        L.count = n;
        unsigned* flag = (unsigned*)(ctrl + 32768);
        hipMemsetAsync(flag, 0x7f, 4, stream);
        hipLaunchKernelGGL(dbg_scan, dim3(2048), dim3(256), 0, stream, L, flag);
        hipLaunchKernelGGL(dbg_fill, dim3(2048), dim3(256), 0, stream, (float*)d_out, (unsigned long long)NB * SEQ * DM, (const unsigned*)flag, 0.0f);
    }
#endif
}
```

```cpp
#include <hip/hip_runtime.h>
#include <stdint.h>
#include <string.h>

#define MK_MULTI 0
#define MK_NPH N_PHASES
#define MK_DEBUG 0
#define MK_REP 0u
#define MK_DEBUG_LIST \
  add(p.mod, 2*9*6144, 1,0,0,0,7); add(p.WinT, 2ull*NINP*DM, 0,0,0,0,7); add(p.H, (unsigned long long)MR*DM, 0,0,0,0,7); add(p.Puv, (unsigned long long)MR*512, 0,0,0,0,7); \
  add(p.Cq, (unsigned long long)MR*256, 0,0,0,0,7); add(p.Ckv, (unsigned long long)MR*128, 0,0,0,0,7); add(p.RS, (unsigned long long)MR*2, 1,0,0,0,7); \
  add(p.Kn, (unsigned long long)MR*256, 0,0,0,0,7); add(p.Vmt, (unsigned long long)MR*256, 0,0,0,0,7); \
  add(p.O, (unsigned long long)MR*DM, 0, DM, 0, 256, 1); \
  add(p.Y, (unsigned long long)MR*DM, 1);

#define DI __device__ __forceinline__
typedef unsigned short bf16_t;
typedef short bf16x8 __attribute__((ext_vector_type(8)));
typedef float f32x4 __attribute__((ext_vector_type(4)));
typedef float f32x2 __attribute__((ext_vector_type(2)));
typedef float f32x16 __attribute__((ext_vector_type(16)));
typedef unsigned u32x4 __attribute__((ext_vector_type(4)));
typedef unsigned u32x2 __attribute__((ext_vector_type(2)));

constexpr int DM = 1024, NB = 8, SEQ = 4096, CTX = 256, TP = 4352, MR = NB * TP;
constexpr int NIN = 2976, NINP = 3072;
constexpr int NE = 32;
constexpr int NCH = TP / 32;
constexpr int NSLOT = 147456;
constexpr float LN_EPS = 1e-6f;
constexpr float DN_ALPHA = 1.4142135623730951f;
constexpr float LOG2E = 1.4426950408889634f;
constexpr int NTHREADS = 512;
constexpr int LDS_BYTES = 147456;

#define XB_TMO      128
#define XB_XCNT(j)  (256  + 64 * (j))
#define XB_XSUB(j)  (1280 + 64 * (j))
#define XB_XGEN(j)  (2304 + 64 * (j))
#define XB_TOP      3328
#define XB_TOPGEN   3392
#define XCD_BAR_WORDS 3456
#define XB_SPIN_CAP (1u << 22)
#define LAS __attribute__((address_space(3)))
__device__ __forceinline__ int otid();

DI unsigned xb_ld(unsigned* p)              { return __hip_atomic_load(p, __ATOMIC_RELAXED, __HIP_MEMORY_SCOPE_AGENT); }
DI unsigned xb_add(unsigned* p, unsigned v) { return __hip_atomic_fetch_add(p, v, __ATOMIC_RELAXED, __HIP_MEMORY_SCOPE_AGENT); }
DI unsigned xb_xcc_id() { return (unsigned)__builtin_amdgcn_s_getreg((3 << 11) | 20) & 0xFu; }
#define XB_SPIN(cond, bar) do { unsigned _sp = 0; while (cond) { __builtin_amdgcn_s_sleep(1); \
    if ((++_sp & 255u) == 0u) { if (xb_ld(&(bar)[XB_TMO])) break; if (_sp > XB_SPIN_CAP) { atomicAdd(&(bar)[XB_TMO], 1u); break; } } } } while (0)

struct XcdBarrier { unsigned* bar; unsigned x; volatile LAS unsigned* st; };

DI XcdBarrier xcd_barrier_post(unsigned* bar, volatile LAS unsigned* st) {
    XcdBarrier b; b.bar = bar; b.x = xb_xcc_id(); b.st = st;
    if (otid() == 0) (void)xb_add(&bar[XB_XCNT(b.x)], 1u);
    return b;
}
DI void xcd_barrier_complete(unsigned* bar, unsigned x, unsigned& nloc, unsigned& nx) {
    const unsigned G = gridDim.x * gridDim.y * gridDim.z;
    unsigned sum, cnt, mine, sp = 0u;
    for (;;) {
        sum = 0u; cnt = 0u; mine = 0u;
#pragma unroll
        for (unsigned j = 0; j < 16; ++j) { const unsigned c = xb_ld(&bar[XB_XCNT(j)]); sum += c; cnt += (c > 0u) ? 1u : 0u; mine = (j == x) ? c : mine; }
        if (sum == G) break;
        __builtin_amdgcn_s_sleep(1);
        if ((++sp & 255u) == 0u) { if (xb_ld(&bar[XB_TMO])) break; if (sp > XB_SPIN_CAP) { atomicAdd(&bar[XB_TMO], 1u); break; } }
    }
    nloc = mine > 0u ? mine : 1u; nx = cnt > 0u ? cnt : 1u;
}
DI void xcd_barrier(const XcdBarrier& b) {
    asm volatile("s_waitcnt vmcnt(0)" ::: "memory");
    __syncthreads();
    if (otid() == 0) {
        unsigned* bar = b.bar;
        __builtin_amdgcn_s_waitcnt(0);
        unsigned nloc = b.st[0], nx = b.st[1];
        if (nloc == 0u) { xcd_barrier_complete(bar, b.x, nloc, nx); b.st[0] = nloc; b.st[1] = nx; }
        const unsigned old = xb_add(&bar[XB_XSUB(b.x)], 1u);
        const unsigned gen = old / nloc;
        if (old + 1u == (gen + 1u) * nloc) {
            __builtin_amdgcn_fence(__ATOMIC_RELEASE, "agent");
            asm volatile("s_waitcnt vmcnt(0)" ::: "memory");
            const unsigned og = xb_add(&bar[XB_TOP], 1u);
            const unsigned tg = og / nx;
            if (og + 1u == (tg + 1u) * nx) xb_add(&bar[XB_TOPGEN], 1u);
            else XB_SPIN(xb_ld(&bar[XB_TOPGEN]) == tg, bar);
            __builtin_amdgcn_fence(__ATOMIC_ACQUIRE, "agent");
            xb_add(&bar[XB_XGEN(b.x)], 1u);
            asm volatile("s_waitcnt vmcnt(0)" ::: "memory");
        } else {
            XB_SPIN(xb_ld(&bar[XB_XGEN(b.x)]) == gen, bar);
            __builtin_amdgcn_fence(__ATOMIC_ACQUIRE, "agent");
            asm volatile("s_waitcnt vmcnt(0)" ::: "memory");
        }
    }
    __syncthreads();
}

struct Params {
    const float *x, *c, *ctx, *c_ctx, *ada_w, *ada_b, *w_in, *w_out, *sgu_ln_w, *sgu_ln_b, *sgu_w, *sgu_b,
                *diff_lambda, *diff_subln_w, *hgrn_lb, *hgrn_norm_w, *mla_q_norm_w, *mla_w_uq, *mla_kv_norm_w, *mla_w_ukv,
                *ln_mix_w, *ln_mix_b, *ln_ffn_w, *ln_ffn_b, *router_w, *router_b, *w1, *b1, *w2, *b2;
    float* out;
    unsigned* bar; unsigned* gcnt;
    float *mod, *lball, *lam, *ropec, *ropes;
    bf16_t *WinT, *WoutT, *WuqT, *WukvT, *W1T, *W2T;
    float* X; bf16_t* H; unsigned char* H8;
    bf16_t *Puv, *Qd, *Kd, *Vdt, *Hq, *Vht, *Lf, *Hg, *Cq, *Ckv, *Kr, *Qm, *Kn, *Vmt, *O;
    float *RS, *DEC, *Y; bf16_t* DST;
    int* ltok; float* lgate; int* rslot; bf16_t *ACT, *YS;
};

typedef const __attribute__((address_space(4))) Params CParams;
extern __shared__ __attribute__((aligned(16))) char smem_all[];
constexpr int WVTAB_OFF = 147456 - 16 - 256;
DI int hw_slot() { return (int)(__builtin_amdgcn_s_getreg((6 << 11) | 4) & 63u); }
DI int otid() {
    int l = (int)__builtin_amdgcn_mbcnt_hi(~0u, __builtin_amdgcn_mbcnt_lo(~0u, 0u));
    const int w = __builtin_amdgcn_readfirstlane(((volatile int*)(smem_all + WVTAB_OFF))[hw_slot()]);
    int t = w * 64 + l; asm volatile("" : "+v"(t)); return t;
}
DI float bf2f(bf16_t v) { return __uint_as_float(((unsigned)v) << 16); }
typedef __bf16 bf16x2_t __attribute__((ext_vector_type(2)));
DI unsigned pk2(float lo, float hi) { const bf16x2_t v = {(__bf16)lo, (__bf16)hi}; return __builtin_bit_cast(unsigned, v); }
DI unsigned pk4_fp8(float a, float b, float c, float d) { int w = 0; w = __builtin_amdgcn_cvt_pk_fp8_f32(a, b, w, false); w = __builtin_amdgcn_cvt_pk_fp8_f32(c, d, w, true); return (unsigned)w; }
DI float lo2f(unsigned w) { return __uint_as_float(w << 16); }
DI float hi2f(unsigned w) { return __uint_as_float(w & 0xffff0000u); }
DI bf16x8 pack8(const float (&v)[8]) { u32x4 w; w.x = pk2(v[0], v[1]); w.y = pk2(v[2], v[3]); w.z = pk2(v[4], v[5]); w.w = pk2(v[6], v[7]); return __builtin_bit_cast(bf16x8, w); }
template <int MASK> DI float shx(float v) {
    if (MASK < 32) return __int_as_float(__builtin_amdgcn_ds_swizzle(__float_as_int(v), (MASK << 10) | 0x1f));
    int l = (int)__builtin_amdgcn_mbcnt_hi(~0u, __builtin_amdgcn_mbcnt_lo(~0u, 0u)); asm volatile("" : "+v"(l));
    return __int_as_float(__builtin_amdgcn_ds_bpermute((l ^ 32) << 2, __float_as_int(v)));
}
DI float zf() { float z = 0.f; asm volatile("" : "+v"(z)); return z; }
DI f32x4 zero4() { const float z = zf(); return (f32x4){z, z, z, z}; }
DI float rdlane(float v, int l) { return __int_as_float(__builtin_amdgcn_readlane(__float_as_int(v), l)); }
template <int CTRL> DI float dpp(float v) { return __int_as_float(__builtin_amdgcn_update_dpp(0, __float_as_int(v), CTRL, 0xf, 0xf, false)); }
constexpr int DPP_X1 = 0xB1, DPP_X2 = 0x4E, DPP_HM = 0x141, DPP_RM = 0x140;
DI float wave_sum(float v) { v += dpp<DPP_X1>(v); v += dpp<DPP_X2>(v); v += dpp<DPP_HM>(v); v += dpp<DPP_RM>(v); v += shx<16>(v); v += shx<32>(v); return v; }
DI float sigmoidf_(float x) { return __builtin_amdgcn_rcpf(1.0f + __builtin_amdgcn_exp2f(-LOG2E * x)); }
DI float geluf_(float v) {
    const float av = fabsf(v), t = __builtin_amdgcn_rcpf(av * 0.2316418882f + 1.0f);
    float q = t * 0.5307027145f + (-0.7265760135f); q = q * t + 0.7107068705f; q = q * t + (-0.142248368f); q = q * t + 0.127414796f; q = q * t;
    const float e = __builtin_amdgcn_exp2f((v * v) * (-0.72134752044f));
    const float m = v * (q * e);
    return v < 0.f ? m : v - m;
}
DI float siluf_(float x) { return x * sigmoidf_(x); }
DI int crow(int r, int hh) { return (r & 3) + 8 * (r >> 2) + 4 * hh; }
#define MFMA16(a, b, c) __builtin_amdgcn_mfma_f32_16x16x32_bf16((a), (b), (c), 0, 0, 0)
#define MFMA32(a, b, c) __builtin_amdgcn_mfma_f32_32x32x16_bf16((a), (b), (c), 0, 0, 0)

DI const float* in_row(CParams& p, int row) {
    const int b = row / TP, t = row - b * TP;
    return t < CTX ? p.ctx + ((size_t)b * CTX + t) * DM : p.x + ((size_t)b * SEQ + (t - CTX)) * DM;
}
DI const float* mod_vec(CParams& p, int l, int row, int j) {
    const int b = row / TP, t = row - b * TP;
    const int r = t < CTX ? 8 : b;
    return p.mod + ((size_t)(l * 9 + r) * 6 + j) * DM;
}

DI void transpose_tile(const float* __restrict__ src, int K, int N, bf16_t* __restrict__ dst, int k0, int n0, const float* __restrict__ kscale, int perm_ukv, char* wl, int lane, float f8scale = 0.f) {
    bf16_t* S = (bf16_t*)wl;
#pragma unroll 4
    for (int it = 0; it < 16; ++it) {
        const int kk = it * 4 + (lane >> 4), nn = (lane & 15) * 4;
        f32x4 v = {0.f, 0.f, 0.f, 0.f};
        if (n0 + nn < N) v = *(const f32x4*)(src + (size_t)(k0 + kk) * N + n0 + nn);
        if (kscale) { const float s = kscale[k0 + kk]; v = v * s; }
        if (f8scale != 0.f) v = v * f8scale;
        unsigned* d = (unsigned*)(S + kk * 66 + nn);
        d[0] = pk2(v[0], v[1]); d[1] = pk2(v[2], v[3]);
    }
    __builtin_amdgcn_fence(__ATOMIC_RELEASE, "workgroup");
    __builtin_amdgcn_wave_barrier();
    __builtin_amdgcn_fence(__ATOMIC_ACQUIRE, "workgroup");
#pragma unroll 2
    for (int it = 0; it < 8; ++it) {
        const int nn = it * 8 + (lane >> 3), kc = lane & 7;
        unsigned short e[8];
#pragma unroll
        for (int j = 0; j < 8; ++j) e[j] = S[(kc * 8 + j) * 66 + nn];
        u32x4 w; w.x = e[0] | ((unsigned)e[1] << 16); w.y = e[2] | ((unsigned)e[3] << 16); w.z = e[4] | ((unsigned)e[5] << 16); w.w = e[6] | ((unsigned)e[7] << 16);
        int n = n0 + nn;
        if (perm_ukv) { const int hh = n >> 7, t = n & 127; n = t < 64 ? hh * 64 + t : 256 + hh * 64 + (t - 64); }
        if (f8scale != 0.f) {
            u32x2 w8; w8.x = pk4_fp8(bf2f(e[0]), bf2f(e[1]), bf2f(e[2]), bf2f(e[3])); w8.y = pk4_fp8(bf2f(e[4]), bf2f(e[5]), bf2f(e[6]), bf2f(e[7]));
            *(u32x2*)((unsigned char*)dst + (size_t)n * K + k0 + kc * 8) = w8;
        } else *(u32x4*)(dst + (size_t)n * K + k0 + kc * 8) = w;
    }
    __builtin_amdgcn_fence(__ATOMIC_RELEASE, "workgroup");
    __builtin_amdgcn_wave_barrier();
}

DI void phase_prologue(CParams& p, char* lds) {
    const int tid = otid(), wid = tid >> 6, lane = tid & 63;
    char* wl = lds + wid * 8704;
    constexpr int T_IN = 16 * 48, T_OUT = 16 * 16, T_UQ = 4 * 6, T_UKV = 2 * 8, T_W1 = 32 * 16 * 32, T_W2 = 32 * 16 * 16;
    constexpr int T_LAYER = T_IN + T_OUT + T_UQ + T_UKV + T_W1 + T_W2;
    constexpr int T_ALL = 2 * T_LAYER;
    constexpr int U_TR = (T_ALL + 7) / 8;
    constexpr int U_GEMV = 2 * 6144 / 64;
    const int nunits = U_GEMV + U_TR + 1;
    for (int u = blockIdx.x; u < nunits; u += gridDim.x) {
        if (u < U_GEMV) {
            const int l = u / 96, n = (u % 96) * 64 + lane;
            const float* W = p.ada_w + (size_t)l * DM * 6144 + (size_t)(wid * 128) * 6144 + n;
            float* sc = (float*)(lds + 73728);
            float* part = (float*)lds;
            __syncthreads();
            for (int i = tid; i < 9 * DM; i += NTHREADS) { const float cv = i < 8 * DM ? p.c[i] : p.c_ctx[i - 8 * DM]; sc[i] = siluf_(cv); }
            __syncthreads();
            float acc[9];
#pragma unroll
            for (int r = 0; r < 9; ++r) acc[r] = 0.f;
#pragma unroll 2
            for (int k = 0; k < 128; k += 4) {
                float w[4];
#pragma unroll
                for (int j = 0; j < 4; ++j) w[j] = W[(size_t)(k + j) * 6144];
#pragma unroll
                for (int r = 0; r < 9; ++r) {
                    const f32x4 cc = *(const f32x4*)(sc + r * DM + wid * 128 + k);
#pragma unroll
                    for (int j = 0; j < 4; ++j) acc[r] += cc[j] * w[j];
                }
            }
#pragma unroll
            for (int r = 0; r < 9; ++r) part[(wid * 9 + r) * 64 + lane] = acc[r];
            __syncthreads();
            for (int i = tid; i < 9 * 64; i += NTHREADS) {
                const int r = i >> 6, c = i & 63;
                float sum = p.ada_b[l * 6144 + (u % 96) * 64 + c];
#pragma unroll
                for (int w8 = 0; w8 < 8; ++w8) sum += part[(w8 * 9 + r) * 64 + c];
                p.mod[(size_t)(l * 9 + r) * 6144 + (u % 96) * 64 + c] = sum;
            }
            __syncthreads();
        } else if (u < U_GEMV + U_TR) {
            int t = (u - U_GEMV) * 8 + wid;
            if (t < T_ALL) {
                const int l = t / T_LAYER; t -= l * T_LAYER;
                if (t < T_IN) { const int kt = t / 48, nt = t % 48;
                    transpose_tile(p.w_in + (size_t)l * DM * NIN, DM, NIN, (bf16_t*)((unsigned char*)p.WinT + (size_t)l * NINP * DM), kt * 64, nt * 64, nullptr, 0, wl, lane, 32.0f);
                } else if ((t -= T_IN) < T_OUT) { const int kt = t / 16, nt = t % 16;
                    transpose_tile(p.w_out + (size_t)l * DM * DM, DM, DM, p.WoutT + (size_t)l * DM * DM, kt * 64, nt * 64, nullptr, 0, wl, lane);
                } else if ((t -= T_OUT) < T_UQ) { const int kt = t / 6, nt = t % 6;
                    transpose_tile(p.mla_w_uq + (size_t)l * 256 * 384, 256, 384, p.WuqT + (size_t)l * 384 * 256, kt * 64, nt * 64, p.mla_q_norm_w + l * 256, 0, wl, lane);
                } else if ((t -= T_UQ) < T_UKV) { const int kt = t / 8, nt = t % 8;
                    transpose_tile(p.mla_w_ukv + (size_t)l * 128 * 512, 128, 512, p.WukvT + (size_t)l * 512 * 128, kt * 64, nt * 64, p.mla_kv_norm_w + l * 128, 1, wl, lane);
                } else if ((t -= T_UKV) < T_W1) { const int e = t / 512, r = t % 512, kt = r / 32, nt = r % 32;
                    transpose_tile(p.w1 + ((size_t)l * NE + e) * DM * 2048, DM, 2048, (bf16_t*)((unsigned char*)p.W1T + ((size_t)l * NE + e) * 2048 * DM), kt * 64, nt * 64, nullptr, 0, wl, lane, 32.0f);
                } else { t -= T_W1; const int e = t / 256, r = t % 256, kt = r / 16, nt = r % 16;
                    transpose_tile(p.w2 + ((size_t)l * NE + e) * DM * DM, DM, DM, (bf16_t*)((unsigned char*)p.W2T + ((size_t)l * NE + e) * DM * DM), kt * 64, nt * 64, nullptr, 0, wl, lane, 64.0f);
                }
            }
        } else {
            if (tid < 512) {
                const int j = tid;
                const float a0 = p.hgrn_lb[j], a1 = p.hgrn_lb[512 + j];
                const float m = fmaxf(a0, a1), e0 = expf(a0 - m), e1 = expf(a1 - m);
                p.lball[j] = 0.f;
                p.lball[512 + j] = e1 / (e0 + e1);
            }
            if (tid < 2) {
                const float* lp = p.diff_lambda + tid * 4 * 32;
                float s01 = 0.f, s23 = 0.f;
                for (int i = 0; i < 32; ++i) { s01 += lp[i] * lp[32 + i]; s23 += lp[64 + i] * lp[96 + i]; }
                const float lam_init = tid == 0 ? 0.2f : 0.3555090676f;
                p.lam[tid] = expf(s01) - expf(s23) + lam_init;
            }
            {
                const int pos = tid >> 3, i = tid & 7;
                const float inv = powf(10000.0f, -(float)(2 * i) / 16.0f);
                float sn, cs; sincosf((float)pos * inv, &sn, &cs);
                p.ropec[tid] = cs; p.ropes[tid] = sn;
            }
        }
    }
}

DI void phase_ln1(CParams& p, char* lds) {
    const int tid = otid(), wid = tid >> 6, lane = tid & 63;
    for (int row = blockIdx.x * 8 + wid; row < MR; row += gridDim.x * 8) {
        const float* xr = in_row(p, row);
        f32x4 v[4]; float s = 0.f;
#pragma unroll
        for (int j = 0; j < 4; ++j) { v[j] = *(const f32x4*)(xr + j * 256 + lane * 4); s += (v[j][0] + v[j][1]) + (v[j][2] + v[j][3]); }
        const float mean = wave_sum(s) * (1.f / DM);
        float q = 0.f;
#pragma unroll
        for (int j = 0; j < 4; ++j) { v[j] = v[j] - mean; q += (v[j][0] * v[j][0] + v[j][1] * v[j][1]) + (v[j][2] * v[j][2] + v[j][3] * v[j][3]); }
        const float rstd = rsqrtf(wave_sum(q) * (1.f / DM) + LN_EPS);
        const float* sh = mod_vec(p, 0, row, 0); const float* sc = mod_vec(p, 0, row, 1);
#pragma unroll
        for (int j = 0; j < 4; ++j) {
            const int c = j * 256 + lane * 4;
            const f32x4 a = *(const f32x4*)(sh + c), b = *(const f32x4*)(sc + c);
            const f32x4 h = v[j] * rstd * (b + 1.0f) + a;
            *(unsigned*)(p.H8 + (size_t)row * DM + c) = pk4_fp8(h[0], h[1], h[2], h[3]);
        }
    }
}

template <int ORI>
DI void gemm_core(const bf16_t* const (&pa)[4], const bf16_t* const (&pb)[2], int K, char* lds, f32x4 (&acc)[4][4]) {
    const int tid = otid(), wid = tid >> 6, lane = tid & 63, wr = wid >> 1, wc = wid & 1, fr = lane & 15, fq = lane >> 4;
    const int sw = ((tid & 7) ^ ((tid >> 4) & 7)) << 4;
    const int offA = (tid >> 3) * 128 + sw, offB = 32768 + (tid >> 3) * 128 + sw;
    const int rdA = (wr * 64 + fr) * 128 + ((fq ^ (fr >> 1)) << 4), rdB = 32768 + (wc * 64 + fr) * 128 + ((fq ^ (fr >> 1)) << 4);
#pragma unroll
    for (int mi = 0; mi < 4; ++mi)
#pragma unroll
        for (int ni = 0; ni < 4; ++ni) acc[mi][ni] = zero4();
    u32x4 ra[4], rb[2];
#pragma unroll
    for (int i = 0; i < 4; ++i) ra[i] = *(const u32x4*)(pa[i]);
#pragma unroll
    for (int j = 0; j < 2; ++j) rb[j] = *(const u32x4*)(pb[j]);
#pragma unroll
    for (int i = 0; i < 4; ++i) *(u32x4*)(lds + offA + i * 8192) = ra[i];
#pragma unroll
    for (int j = 0; j < 2; ++j) *(u32x4*)(lds + offB + j * 8192) = rb[j];
    __syncthreads();
    const int nk = K >> 6;
    for (int kt = 0; kt < nk; ++kt) {
        const char* cur = lds + (kt & 1) * 49152;
        const bool more = kt + 1 < nk;
        if (more) {
#pragma unroll
            for (int i = 0; i < 4; ++i) ra[i] = *(const u32x4*)(pa[i] + (kt + 1) * 64);
#pragma unroll
            for (int j = 0; j < 2; ++j) rb[j] = *(const u32x4*)(pb[j] + (kt + 1) * 64);
        }
#pragma unroll
        for (int kk = 0; kk < 2; ++kk) {
            bf16x8 af[4], bfr[4];
#pragma unroll
            for (int mi = 0; mi < 4; ++mi) af[mi] = *(const bf16x8*)(cur + ((rdA + mi * 2048) ^ (kk * 64)));
#pragma unroll
            for (int ni = 0; ni < 4; ++ni) bfr[ni] = *(const bf16x8*)(cur + ((rdB + ni * 2048) ^ (kk * 64)));
#pragma unroll
            for (int mi = 0; mi < 4; ++mi)
#pragma unroll
                for (int ni = 0; ni < 4; ++ni) {
                    if (ORI == 0) acc[mi][ni] = MFMA16(bfr[ni], af[mi], acc[mi][ni]);
                    else          acc[mi][ni] = MFMA16(af[mi], bfr[ni], acc[mi][ni]);
                }
        }
        if (more) {
            char* nxt = lds + ((kt + 1) & 1) * 49152;
#pragma unroll
            for (int i = 0; i < 4; ++i) *(u32x4*)(nxt + offA + i * 8192) = ra[i];
#pragma unroll
            for (int j = 0; j < 2; ++j) *(u32x4*)(nxt + offB + j * 8192) = rb[j];
        }
        __syncthreads();
    }
}

DI void gemm_ptrs(const bf16_t* A, int lda, int row0, const bf16_t* Bt, int ldb, int n0, const bf16_t* (&pa)[4], const bf16_t* (&pb)[2]) {
    const int tid = otid(), r = tid >> 3, c = (tid & 7) * 8;
#pragma unroll
    for (int i = 0; i < 4; ++i) pa[i] = A + (size_t)(row0 + r + 64 * i) * lda + c;
#pragma unroll
    for (int j = 0; j < 2; ++j) pb[j] = Bt + (size_t)(n0 + r + 64 * j) * ldb + c;
}

DI void store4_bf16(bf16_t* dst, const f32x4& v) { u32x2 w; w.x = pk2(v[0], v[1]); w.y = pk2(v[2], v[3]); *(u32x2*)dst = w; }

DI f32x4 rope_tile(CParams& p, f32x4 v, int row, int axis_is_col, int fq) {
    f32x4 o;
    const int b = row / TP, t = row - b * TP;
    const int pos = t - CTX;
    const int ax = axis_is_col ? (pos & 63) : (pos >> 6);
#pragma unroll
    for (int r = 0; r < 4; ++r) {
        const float pr = shx<32>(v[r]);
        float cs = 1.f, sn = 0.f;
        if (t >= CTX) { const int i = (fq & 1) * 4 + r; cs = p.ropec[ax * 8 + i]; sn = p.ropes[ax * 8 + i]; }
        o[r] = fq < 2 ? v[r] * cs - pr * sn : v[r] * cs + pr * sn;
    }
    return o;
}


namespace g8 {
constexpr int BK = 64, HALF = 128, HTB = HALF * BK * 2, STAGE_BYTES = 8 * HTB;
DI int lds_byte(int r, int c) { const int st = (r >> 4) * 2 + (c >> 5), rr = r & 15, cc = c & 31, ob = rr * 64 + cc * 2; return st * 1024 + (ob ^ (((ob >> 9) & 1) << 5)); }
DI void stage_rc(int b, int& R, int& C) { const int st = b / 1024, sb = b % 1024, swz = sb ^ (((sb >> 9) & 1) << 5); R = (st >> 1) * 16 + swz / 64; C = (st & 1) * 32 + (swz % 64) / 2; }
struct GU { const char* a; const char* b; int pm, pn, e, j0; };
DI bool order_next(int i, int nM, int nN, int& pm, int& pn) {
    const int nwg = nM * nN; const long L = (long)i * gridDim.x + blockIdx.x; if (L >= nwg) return false;
    int wgid = (int)L; { const int q = nwg / 8, r = nwg % 8, xcd = wgid % 8, off = wgid / 8; wgid = (xcd < r ? xcd * (q + 1) : r * (q + 1) + (xcd - r) * q) + off; }
    const int nig = 8 * nN, gid = wgid / nig, fm = gid * 8, gsz = (nM - fm) < 8 ? (nM - fm) : 8;
    pm = fm + ((wgid % nig) % gsz); pn = (wgid % nig) / gsz; return true;
}

typedef int v4i_t __attribute__((ext_vector_type(4)));
typedef int v8i_t __attribute__((ext_vector_type(8)));
template <class Epi, class Sched, bool GATHER, bool FP8 = false, bool SWAPSC = false>
DI void gemm8(char* lds_generic, const int KB, const char* Abase, const Sched& S, const Epi& E, const unsigned sclB = 0x7f7f7f7fu) {
    LAS unsigned char* lds = (LAS unsigned char*)lds_generic;
    const int tid = otid(), wid = __builtin_amdgcn_readfirstlane(tid >> 6), lane = tid & 63, wr = wid >> 2, wc = wid & 3, fr = lane & 15, fq = lane >> 4;
    const int nt = KB / 128;
    int R[2], C[2];
#pragma unroll
    for (int i = 0; i < 2; ++i) stage_rc(tid * 16 + i * 8192, R[i], C[i]);
    unsigned voff[2];
#pragma unroll
    for (int i = 0; i < 2; ++i) voff[i] = (unsigned)(R[i] * KB + C[i] * 2);
    const size_t kstep = (size_t)(BK * 2), hstep = (size_t)HALF * KB;
    const unsigned ldsw = (unsigned)wid * 1024u;
    const int aoff = lds_byte(wr * 64 + fr, fq * 8), boff = lds_byte(wc * 32 + fr, fq * 8);
    LAS unsigned* gtab = (LAS unsigned*)(lds + STAGE_BYTES);
#define G8_SA(b, h) (((b) * 2 + (h)) * HTB)
#define G8_SB(b, h) ((4 + (b) * 2 + (h)) * HTB)
#define G8_LDS(gp, bufoff, i) __builtin_amdgcn_global_load_lds((const unsigned*)(gp), (LAS unsigned*)(lds + (bufoff) + ldsw + (i) * 8192), 16, 0, 0)
#define G8_STAGE_B(bufoff, gbase) do { _Pragma("unroll") for (int _i = 0; _i < 2; ++_i) G8_LDS((const char*)(gbase) + voff[_i], bufoff, _i); } while (0)
#define G8_STAGE_A(bufoff, h, nx, ko) do { _Pragma("unroll") for (int _i = 0; _i < 2; ++_i) { \
        const char* _gp = GATHER ? Abase + (size_t)(gtab[((((nx) ? ui + 1 : ui) & 1) << 8) + (h) * HALF + R[_i]] + (unsigned)(C[_i] * 2)) + (ko) : ((nx) ? nA : cA) + (size_t)(h) * hstep + (ko) + voff[_i]; G8_LDS(_gp, bufoff, _i); } } while (0)
#define G8_LDA(dst, b, h) do { _Pragma("unroll") for (int m = 0; m < 4; ++m) _Pragma("unroll") for (int k = 0; k < 2; ++k) dst[m][k] = *(const LAS bf16x8*)(lds + G8_SA(b, h) + aoff + m * 2048 + k * 1024); } while (0)
#define G8_LDB(dst, b, h) do { _Pragma("unroll") for (int n = 0; n < 2; ++n) _Pragma("unroll") for (int k = 0; k < 2; ++k) dst[n][k] = *(const LAS bf16x8*)(lds + G8_SB(b, h) + boff + n * 2048 + k * 1024); } while (0)
#define G8_MMA(ai, bj, At, Bt) do { __builtin_amdgcn_s_setprio(1); _Pragma("unroll") for (int m = 0; m < 4; ++m) _Pragma("unroll") for (int n = 0; n < 2; ++n) { \
        if constexpr (FP8) { const v8i_t _a = __builtin_shufflevector(__builtin_bit_cast(v4i_t, At[m][0]), __builtin_bit_cast(v4i_t, At[m][1]), 0, 1, 2, 3, 4, 5, 6, 7); \
                   const v8i_t _b = __builtin_shufflevector(__builtin_bit_cast(v4i_t, Bt[n][0]), __builtin_bit_cast(v4i_t, Bt[n][1]), 0, 1, 2, 3, 4, 5, 6, 7); \
                   acc[ai][bj][m][n] = __builtin_amdgcn_mfma_scale_f32_16x16x128_f8f6f4(_b, _a, acc[ai][bj][m][n], 0, 0, 0, (int)(SWAPSC && cur.e ? 0x7f7f7f7fu : sclB), 0, (int)(SWAPSC && cur.e ? sclB : 0x7f7f7f7fu)); } \
        else { _Pragma("unroll") for (int k = 0; k < 2; ++k) acc[ai][bj][m][n] = __builtin_amdgcn_mfma_f32_16x16x32_bf16(Bt[n][k], At[m][k], acc[ai][bj][m][n], 0, 0, 0); } } \
        if constexpr (FP8) asm volatile("" : "+v"(acc[ai][bj][0][0]), "+v"(acc[ai][bj][0][1]), "+v"(acc[ai][bj][1][0]), "+v"(acc[ai][bj][1][1]), "+v"(acc[ai][bj][2][0]), "+v"(acc[ai][bj][2][1]), "+v"(acc[ai][bj][3][0]), "+v"(acc[ai][bj][3][1]));   \
        __builtin_amdgcn_s_setprio(0); } while (0)
#define G8_WAIT_V(n) asm volatile("s_waitcnt vmcnt(" #n ")" ::: "memory")
#define G8_WAIT_L(n) asm volatile("s_waitcnt lgkmcnt(" #n ")" ::: "memory")
#define G8_BAR __builtin_amdgcn_s_barrier()
#define G8_SCHED __builtin_amdgcn_sched_barrier(0)
#define G8_GOFF(slot, u) do { if (GATHER) { int _tz = tid; asm volatile("" : "+v"(_tz)); if (_tz < 256) gtab[((slot) << 8) + _tz] = S.arow(u, _tz) * (unsigned)KB; } } while (0)
    GU cur, nxt; int ui = 0;
    __syncthreads();
    if (!S.next(0, cur)) return;
    f32x4 acc[2][2][4][2];
    { const f32x4 z4 = zero4();
#pragma unroll
    for (int a = 0; a < 2; ++a)
#pragma unroll
        for (int b = 0; b < 2; ++b)
#pragma unroll
            for (int m = 0; m < 4; ++m)
#pragma unroll
                for (int n = 0; n < 2; ++n) acc[a][b][m][n] = z4; }
    bf16x8 At[4][2], B0[2][2], B1[2][2];
    const char* cA = cur.a; const char* cB = cur.b; const char* nA = cA; const char* nB = cB;
    G8_GOFF(0, cur);
    if (GATHER) __syncthreads();
    G8_STAGE_B(G8_SB(0, 0), cB); G8_STAGE_B(G8_SB(0, 1), cB + hstep); G8_STAGE_A(G8_SA(0, 0), 0, false, (size_t)0); G8_STAGE_A(G8_SA(0, 1), 1, false, (size_t)0);
    if (wr == 1) G8_BAR;
    G8_WAIT_V(2); G8_BAR;
    G8_STAGE_B(G8_SB(1, 0), cB + kstep); G8_STAGE_A(G8_SA(1, 0), 0, false, kstep); G8_STAGE_B(G8_SB(1, 1), cB + hstep + kstep);
    G8_WAIT_V(6); G8_BAR;
    for (;;) {
        const bool has_next = S.next(ui + 1, nxt);
        nA = has_next ? nxt.a : cA; nB = has_next ? nxt.b : cB;
        G8_GOFF((ui + 1) & 1, has_next ? nxt : cur);
        for (int t = 0; t < nt; t += 2) {
            const bool last = (t == nt - 2);
            const size_t k1 = (size_t)(t + 1) * kstep, k2 = last ? (size_t)0 : (size_t)(t + 2) * kstep, k3 = k2 + kstep;
            const char* b2 = last ? nB : cB + (size_t)(t + 2) * kstep; const char* b3 = b2 + kstep;
            G8_LDB(B0, 0, 0); G8_LDB(B1, 0, 1); G8_SCHED; G8_LDA(At, 0, 0); G8_STAGE_A(G8_SA(1, 1), 1, false, k1);
            G8_WAIT_V(8); G8_WAIT_L(0); G8_BAR; G8_MMA(0, 0, At, B0); G8_MMA(0, 1, At, B1); G8_BAR; G8_SCHED;
            G8_LDA(At, 0, 1); G8_STAGE_B(G8_SB(0, 0), b2); G8_STAGE_B(G8_SB(0, 1), b2 + hstep); G8_STAGE_A(G8_SA(0, 0), 0, last, k2);
            G8_WAIT_V(8); G8_WAIT_L(0); G8_BAR; G8_MMA(1, 0, At, B0); G8_MMA(1, 1, At, B1); G8_BAR; G8_SCHED;
            G8_LDB(B0, 1, 0); G8_LDB(B1, 1, 1); G8_SCHED; G8_LDA(At, 1, 0); G8_STAGE_A(G8_SA(0, 1), 1, last, k2);
            G8_WAIT_V(8); G8_WAIT_L(0); G8_BAR; G8_MMA(0, 0, At, B0); G8_MMA(0, 1, At, B1); G8_BAR; G8_SCHED;
            G8_LDA(At, 1, 1); G8_STAGE_B(G8_SB(1, 0), b3); G8_STAGE_B(G8_SB(1, 1), b3 + hstep); G8_STAGE_A(G8_SA(1, 0), 0, last, k3);
            G8_WAIT_V(8); G8_WAIT_L(0); G8_BAR; G8_MMA(1, 0, At, B0); G8_MMA(1, 1, At, B1); G8_BAR; G8_SCHED;
        }
        if (wr == 0) G8_BAR;
        E(acc, cur, wr, wc, fr, fq);
        if (!has_next) break;
        const f32x4 z4 = zero4();
#pragma unroll
        for (int a = 0; a < 2; ++a)
#pragma unroll
            for (int b = 0; b < 2; ++b)
#pragma unroll
                for (int m = 0; m < 4; ++m)
#pragma unroll
                    for (int n = 0; n < 2; ++n) acc[a][b][m][n] = z4;
        cur = nxt; cA = nA; cB = nB; ++ui;
        if (wr == 1) G8_BAR;
    }
    G8_WAIT_V(0);
    G8_BAR;
#undef G8_SA
#undef G8_SB
#undef G8_LDS
#undef G8_STAGE_A
#undef G8_STAGE_B
#undef G8_LDA
#undef G8_LDB
#undef G8_MMA
#undef G8_WAIT_V
#undef G8_WAIT_L
#undef G8_BAR
#undef G8_SCHED
#undef G8_GOFF
}
}

#define INPROJ_LOOP(BODY) _Pragma("unroll") for (int ai = 0; ai < 2; ++ai) _Pragma("unroll") for (int m = 0; m < 4; ++m) _Pragma("unroll") for (int n = 0; n < 2; ++n) { \
        const int row = row0 + 128 * ai + 16 * m, col = col0 + 16 * n; f32x4 v = acc[ai][bj][m][n]; BODY }
template <int bj>
DI void inproj_half(CParams& p, int l, int nt, const f32x4 (&acc)[2][2][4][2], int row0  , int col0  , int fq) {
    if (nt < 4) {
        INPROJ_LOOP({
            _Pragma("unroll") for (int r = 0; r < 4; ++r) v[r] = geluf_(v[r]);
            store4_bf16(p.Puv + (size_t)row * 512 + col, v); })
    } else if (nt < 6) {
        INPROJ_LOOP({ v = rope_tile(p, v, row, n, fq) * (0.17677669529663687f * LOG2E); store4_bf16(p.Qd + (size_t)row * 256 + (col - 512), v); })
    } else if (nt < 8) {
        INPROJ_LOOP({ v = rope_tile(p, v, row, n, fq); store4_bf16(p.Kd + (size_t)row * 256 + (col - 768), v); })
    } else if (nt < 12) {
        INPROJ_LOOP({
            _Pragma("unroll") for (int r = 0; r < 4; ++r) v[r] = siluf_(v[r]);
            store4_bf16(p.Hq + (size_t)row * 256 + (col - 1280), v); })
    } else if (nt < 18) {
        const int dir = nt >= 16, cb = dir ? 2048 : 1792;
        INPROJ_LOOP({
            const int cc = col - cb;
            const f32x4 lb = *(const f32x4*)(p.lball + (l * 2 + dir) * 256 + cc);
            _Pragma("unroll") for (int r = 0; r < 4; ++r) v[r] = 0.69314718056f * __builtin_amdgcn_logf(lb[r] + (1.0f - lb[r]) * sigmoidf_(v[r]));
            store4_bf16(p.Lf + ((size_t)dir * MR + row) * 256 + cc, v); })
    } else if (nt < 20) {
        INPROJ_LOOP({
            _Pragma("unroll") for (int r = 0; r < 4; ++r) v[r] = siluf_(v[r]);
            store4_bf16(p.Hg + (size_t)row * 256 + (col - 2304), v); })
    } else if (nt < 22) {
        INPROJ_LOOP({ store4_bf16(p.Cq + (size_t)row * 256 + (col - 2560), v); })
    } else if (nt == 22) {
        INPROJ_LOOP({ store4_bf16(p.Ckv + (size_t)row * 128 + (col - 2816), v); })
    } else {
        INPROJ_LOOP({ v = rope_tile(p, v, row, n, fq); if (col < 2976) store4_bf16(p.Kr + (size_t)row * 32 + (col - 2944), v); })
    }
}
struct SchedIn {
    const char* H; const char* W;
    DI bool next(int i, g8::GU& u) const {
        int pm, pn; if (!g8::order_next(i, MR / 256, 12, pm, pn)) return false;
        const bool sw = (pn == 4 || pn == 6);
        u.pm = pm; u.pn = pn; u.e = sw ? 1 : 0; u.j0 = 0;
        const char* ht = H + (size_t)pm * 256 * 1024; const char* wt = W + (size_t)pn * 256 * 1024;
        u.a = sw ? wt : ht; u.b = sw ? ht : wt; return true;
    }
    DI unsigned arow(const g8::GU&, int) const { return 0u; }
};
struct EpiIn {
    CParams* pp; int l;
    DI void operator()(const f32x4 (&acc)[2][2][4][2], const g8::GU& u, int wr, int wc, int fr, int fq) const {
        CParams& p = *pp;
        if (u.e) {
            bf16_t* dst = (u.pn == 4) ? p.Vdt : p.Vht;
            const int m0 = u.pm * 256, b = m0 / TP, t0 = m0 - b * TP;
#pragma unroll
            for (int ai = 0; ai < 2; ++ai)
#pragma unroll
                for (int bj = 0; bj < 2; ++bj)
#pragma unroll
                    for (int m = 0; m < 4; ++m)
#pragma unroll
                        for (int n = 0; n < 2; ++n) {
                            const int f = 128 * ai + 64 * wr + 16 * m + fr, t = t0 + 128 * bj + 32 * wc + 16 * n + 4 * fq;
                            store4_bf16(dst + ((size_t)(b * 256 + f)) * TP + t, acc[ai][bj][m][n]);
                        }
        } else {
            inproj_half<0>(p, l, 2 * u.pn, acc, u.pm * 256 + 64 * wr + fr, u.pn * 256 + 32 * wc + 4 * fq, fq);
            inproj_half<1>(p, l, 2 * u.pn + 1, acc, u.pm * 256 + 64 * wr + fr, u.pn * 256 + 128 + 32 * wc + 4 * fq, fq);
        }
    }
};
DI void phase_inproj(CParams& p, int l, char* lds) {
    SchedIn S; S.H = (const char*)p.H8; S.W = (const char*)p.WinT + (size_t)l * NINP * DM;
    EpiIn E; E.pp = &p; E.l = l;
    g8::gemm8<EpiIn, SchedIn, false, true, true>(lds, DM, nullptr, S, E, 0x7a7a7a7au);
}

DI void phase_sgu_prep(CParams& p, int l, char* lds) {
    const int tid = otid(), wid = tid >> 6, lane = tid & 63, fr = lane & 15, fq = lane >> 4;
    constexpr int U_SGU = (MR / 128) * 4, U_PREP = MR / 64;
    float* stats = (float*)(lds + 16384);
    for (int u = blockIdx.x; u < U_SGU + U_PREP; u += gridDim.x) {
        if (u < U_SGU) {
            const int ch = u >> 2, g = u & 3, row0 = ch * 128;
            __syncthreads();
#pragma unroll 1
            for (int i = 0; i < 16; ++i) {
                const int r = wid * 16 + i;
                const u32x2 w = *(const u32x2*)(p.Puv + (size_t)(row0 + r) * 512 + 256 + lane * 4);
                const float a0 = lo2f(w.x), a1 = hi2f(w.x), a2 = lo2f(w.y), a3 = hi2f(w.y);
                const float mean = wave_sum((a0 + a1) + (a2 + a3)) * (1.f / 256.f);
                const float d0 = a0 - mean, d1 = a1 - mean, d2 = a2 - mean, d3 = a3 - mean;
                const float var = wave_sum((d0 * d0 + d1 * d1) + (d2 * d2 + d3 * d3)) * (1.f / 256.f);
                if (lane == 0) { stats[r * 2] = mean; stats[r * 2 + 1] = rsqrtf(var + LN_EPS); }
            }
            __syncthreads();
            {
                const int s = tid >> 2, c0 = (tid & 3) * 16;
                const float mean = stats[s * 2], rstd = stats[s * 2 + 1];
                const bf16_t* src = p.Puv + (size_t)(row0 + s) * 512 + 256 + g * 64 + c0;
                const u32x4 w0 = *(const u32x4*)src, w1 = *(const u32x4*)(src + 8);
                const unsigned ww[8] = {w0.x, w0.y, w0.z, w0.w, w1.x, w1.y, w1.z, w1.w};
                const float* lw = p.sgu_ln_w + l * 256 + g * 64 + c0; const float* lb = p.sgu_ln_b + l * 256 + g * 64 + c0;
#pragma unroll
                for (int j = 0; j < 16; ++j) {
                    const float xv = (j & 1) ? hi2f(ww[j >> 1]) : lo2f(ww[j >> 1]);
                    const float y = (xv - mean) * rstd * lw[j] + lb[j];
                    const int c = c0 + j;
                    const unsigned pk = pk2(y, 0.f);
                    *(bf16_t*)(lds + c * 256 + ((((s >> 3) ^ (c & 15)) << 4) | ((s & 7) * 2))) = (bf16_t)(pk & 0xffffu);
                }
            }
            __syncthreads();
            f32x4 acc[4];
#pragma unroll
            for (int ni = 0; ni < 4; ++ni) acc[ni] = zero4();
            const float* Wg = p.sgu_w + ((size_t)(l * 4 + g) * 128 + wid * 16 + fr) * 128;
#pragma unroll
            for (int ks = 0; ks < 4; ++ks) {
                const f32x4 a0 = *(const f32x4*)(Wg + ks * 32 + fq * 8), a1 = *(const f32x4*)(Wg + ks * 32 + fq * 8 + 4);
                const float av[8] = {a0[0], a0[1], a0[2], a0[3], a1[0], a1[1], a1[2], a1[3]};
                const bf16x8 af = pack8(av);
#pragma unroll
                for (int ni = 0; ni < 4; ++ni) {
                    const int c = ni * 16 + fr;
                    const bf16x8 bfr = *(const bf16x8*)(lds + c * 256 + (((ks * 4 + fq) ^ (c & 15)) << 4));
                    acc[ni] = MFMA16(bfr, af, acc[ni]);
                }
            }
            const int t = wid * 16 + fr, row = row0 + t;
            const float bs = p.sgu_b[(l * 4 + g) * 128 + t];
#pragma unroll
            for (int ni = 0; ni < 4; ++ni) {
                const int c = g * 64 + ni * 16 + fq * 4;
                const u32x2 w = *(const u32x2*)(p.Puv + (size_t)row * 512 + c);
                f32x4 o;
                o[0] = (acc[ni][0] + bs) * lo2f(w.x); o[1] = (acc[ni][1] + bs) * hi2f(w.x);
                o[2] = (acc[ni][2] + bs) * lo2f(w.y); o[3] = (acc[ni][3] + bs) * hi2f(w.y);
                store4_bf16(p.O + (size_t)row * DM + c, o);
            }
        } else {
            const int rbase = (u - U_SGU) * 64 + wid * 8;
#pragma unroll 1
            for (int i = 0; i < 8; ++i) {
                const int row = rbase + i;
                const u32x2 wq = *(const u32x2*)(p.Cq + (size_t)row * 256 + lane * 4);
                const unsigned wk = *(const unsigned*)(p.Ckv + (size_t)row * 128 + lane * 2);
                const float q0 = lo2f(wq.x), q1 = hi2f(wq.x), q2 = lo2f(wq.y), q3 = hi2f(wq.y), k0 = lo2f(wk), k1 = hi2f(wk);
                const float sq = wave_sum((q0 * q0 + q1 * q1) + (q2 * q2 + q3 * q3));
                const float sk = wave_sum(k0 * k0 + k1 * k1);
                if (lane == 0) { p.RS[row * 2] = rsqrtf(sq * (1.f / 256.f) + LN_EPS); p.RS[row * 2 + 1] = rsqrtf(sk * (1.f / 128.f) + LN_EPS); }
            }
        }
    }
}

DI void hgrn_h1_unit(CParams& p, int wu, int lane) {
    const int c = wu % NCH; int t = wu / NCH; const int dir = t & 1, h = (t >> 1) & 3, b = t >> 3;
    const int row0 = b * TP + c * 32, hh = lane >> 5, l31 = lane & 31;
    const bf16_t* Lf = p.Lf + ((size_t)dir * MR + row0) * 256 + h * 64;
    bf16x8 Bf[2][2];
    float* decp = p.DEC + (size_t)wu * 64;
#pragma unroll
    for (int kt = 0; kt < 2; ++kt) {
        const int k = kt * 32 + l31;
        float lf[32], kd[32];
#pragma unroll
        for (int j = 0; j < 32; ++j) lf[j] = bf2f(Lf[(size_t)j * 256 + k]);
        float tot = 0.f;
#pragma unroll
        for (int j = 0; j < 32; ++j) tot += lf[j];
        float run = 0.f;
        if (dir == 0) {
#pragma unroll
            for (int j = 0; j < 32; ++j) { run += lf[j]; kd[j] = (1.0f - __expf(lf[j])) * __expf(tot - run); }
        } else {
#pragma unroll
            for (int j = 31; j >= 0; --j) { run += lf[j]; kd[j] = (1.0f - __expf(lf[j])) * __expf(tot - run); }
        }
        if (hh == 0) decp[k] = __expf(tot);
#pragma unroll
        for (int s = 0; s < 2; ++s) {
            float v8[8];
#pragma unroll
            for (int jj = 0; jj < 8; ++jj) v8[jj] = hh ? kd[16 * s + 8 + jj] : kd[16 * s + jj];
            Bf[kt][s] = pack8(v8);
        }
    }
    const bf16_t* Vt = p.Vht + ((size_t)(b * 4 + h) * 64) * TP + c * 32;
    bf16_t* dst = p.DST + (size_t)wu * 4096;
#pragma unroll
    for (int vt = 0; vt < 2; ++vt) {
        bf16x8 Af[2];
#pragma unroll
        for (int s = 0; s < 2; ++s) Af[s] = *(const bf16x8*)(Vt + (size_t)(vt * 32 + l31) * TP + 16 * s + 8 * hh);
#pragma unroll
        for (int kt = 0; kt < 2; ++kt) {
            f32x16 d;
#pragma unroll
            for (int i = 0; i < 16; ++i) d[i] = zf();
            d = MFMA32(Af[0], Bf[kt][0], d);
            d = MFMA32(Af[1], Bf[kt][1], d);
#pragma unroll
            for (int r = 0; r < 16; ++r) dst[(vt * 32 + crow(r, hh)) * 64 + kt * 32 + l31] = (bf16_t)(pk2(d[r], 0.f) & 0xffffu);
        }
    }
}

DI void phase_upproj_h1(CParams& p, int l, char* lds) {
    const int tid = otid(), wid = tid >> 6, lane = tid & 63, wr = wid >> 1, wc = wid & 1, fr = lane & 15, fq = lane >> 4;
    constexpr int U_Q = (MR / 256) * 3, U_KV = (MR / 256) * 4, U_H1 = NB * 4 * 2 * NCH / 8;
    for (int u = blockIdx.x; u < U_Q + U_KV + U_H1; u += gridDim.x) {
        if (u < U_Q) {
            const int mt = u / 3, nt = u % 3, m0 = mt * 256, n0 = nt * 128;
            const bf16_t* pa[4]; const bf16_t* pb[2];
            gemm_ptrs(p.Cq, 256, m0, p.WuqT + (size_t)l * 384 * 256, 256, n0, pa, pb);
            f32x4 acc[4][4];
            gemm_core<0>(pa, pb, 256, lds, acc);
#pragma unroll
            for (int mi = 0; mi < 4; ++mi)
#pragma unroll
                for (int ni = 0; ni < 4; ++ni) {
                    const int row = m0 + wr * 64 + mi * 16 + fr, col = n0 + wc * 64 + ni * 16 + fq * 4;
                    f32x4 v = acc[mi][ni] * (p.RS[row * 2] * (0.10206207261596577f * LOG2E));
                    const int cm = col % 96;
                    const f32x4 vr = rope_tile(p, v, row, (cm >> 4) & 1, fq);
                    if (cm >= 64) v = vr;
                    store4_bf16(p.Qm + (size_t)row * 384 + col, v);
                }
        } else if (u < U_Q + U_KV) {
            const int uu = u - U_Q, mt = uu >> 2, nt = uu & 3, m0 = mt * 256, n0 = nt * 128;
            const bf16_t* pa[4]; const bf16_t* pb[2];
            gemm_ptrs(p.Ckv, 128, m0, p.WukvT + (size_t)l * 512 * 128, 128, n0, pa, pb);
            f32x4 acc[4][4];
            if (nt < 2) {
                gemm_core<0>(pa, pb, 128, lds, acc);
#pragma unroll
                for (int mi = 0; mi < 4; ++mi)
#pragma unroll
                    for (int ni = 0; ni < 4; ++ni) {
                        const int row = m0 + wr * 64 + mi * 16 + fr, col = n0 + wc * 64 + ni * 16 + fq * 4;
                        store4_bf16(p.Kn + (size_t)row * 256 + col, acc[mi][ni] * p.RS[row * 2 + 1]);
                    }
            } else {
                gemm_core<1>(pa, pb, 128, lds, acc);
                const int b = m0 / TP, t0 = m0 - b * TP;
#pragma unroll
                for (int mi = 0; mi < 4; ++mi)
#pragma unroll
                    for (int ni = 0; ni < 4; ++ni) {
                        const int f = n0 - 256 + wc * 64 + ni * 16 + fr;
                        const int rl = wr * 64 + mi * 16 + fq * 4;
                        const f32x4 rs = {p.RS[(m0 + rl) * 2 + 1], p.RS[(m0 + rl + 1) * 2 + 1], p.RS[(m0 + rl + 2) * 2 + 1], p.RS[(m0 + rl + 3) * 2 + 1]};
                        store4_bf16(p.Vmt + ((size_t)(b * 256 + f)) * TP + t0 + rl, acc[mi][ni] * rs);
                    }
            }
        } else {
            hgrn_h1_unit(p, (u - U_Q - U_KV) * 8 + wid, lane);
        }
    }
}

DI void hgrn_h2_unit(CParams& p, int cu  ) {
    const int tid = otid();
    if (tid >= 256) return;
    const int gid = cu * 256 + tid;
    const int seq = gid >> 10, e4 = gid & 1023;
    const int dir = seq & 1, k4 = (e4 & 15) * 4;
    f32x4 st = zero4();
    for (int t0 = 0; t0 < NCH; t0 += 8) {
        f32x4 ds[8], dc[8]; bf16_t* ptr[8];
#pragma unroll
        for (int j = 0; j < 8; ++j) {
            const int t = t0 + j, pc = dir == 0 ? t : (t < 8 ? 7 - t : 143 - t);
            ptr[j] = p.DST + ((size_t)(seq * NCH + pc)) * 4096 + e4 * 4;
            const u32x2 w = *(const u32x2*)ptr[j];
            ds[j] = (f32x4){lo2f(w.x), hi2f(w.x), lo2f(w.y), hi2f(w.y)};
            dc[j] = *(const f32x4*)(p.DEC + (size_t)(seq * NCH + pc) * 64 + k4);
        }
#pragma unroll
        for (int j = 0; j < 8; ++j) { store4_bf16(ptr[j], st); st = dc[j] * st + ds[j]; }
    }
}

DI void hgrn_h3_unit(CParams& p, int l, int wu, int lane, char* wl) {
    const int pc = wu % NCH; const int t_ = wu / NCH; const int h = t_ & 3, b = t_ >> 2;
    const int row0 = b * TP + pc * 32, hh = lane >> 5, i = lane & 31;
    float* Bl = (float*)wl;
    f32x16 Y[2];
    { const float z = zf();
#pragma unroll
    for (int r = 0; r < 16; ++r) { Y[0][r] = z; Y[1][r] = z; } }
#pragma unroll 1
    for (int dir = 0; dir < 2; ++dir) {
        const bf16_t* Lf = p.Lf + ((size_t)dir * MR + row0) * 256 + h * 64;
        {
            float lf[32];
#pragma unroll
            for (int j = 0; j < 32; ++j) lf[j] = bf2f(Lf[(size_t)j * 256 + lane]);
            float run = 0.f;
            if (dir == 0) {
#pragma unroll
                for (int j = 0; j < 32; ++j) { run += lf[j]; Bl[j * 68 + lane] = run; }
            } else {
#pragma unroll
                for (int j = 31; j >= 0; --j) { run += lf[j]; Bl[j * 68 + lane] = run; }
            }
        }
        __syncthreads();
        bf16x8 Qf[4], Kf[4];
#pragma unroll
        for (int s = 0; s < 4; ++s) {
            const int kb = 16 * s + 8 * hh;
            const u32x4 qw = *(const u32x4*)(p.Hq + (size_t)(row0 + i) * 256 + h * 64 + kb);
            const u32x4 fw = *(const u32x4*)(Lf + (size_t)i * 256 + kb);
            const f32x4 b0 = *(const f32x4*)(Bl + i * 68 + kb), b1 = *(const f32x4*)(Bl + i * 68 + kb + 4);
            const float bb[8] = {b0[0], b0[1], b0[2], b0[3], b1[0], b1[1], b1[2], b1[3]};
            const unsigned qq[4] = {qw.x, qw.y, qw.z, qw.w}, ff[4] = {fw.x, fw.y, fw.z, fw.w};
            float qd[8], kd[8];
#pragma unroll
            for (int j = 0; j < 8; ++j) {
                const float qv = (j & 1) ? hi2f(qq[j >> 1]) : lo2f(qq[j >> 1]);
                const float fv = (j & 1) ? hi2f(ff[j >> 1]) : lo2f(ff[j >> 1]);
                qd[j] = qv * __expf(bb[j]);
                kd[j] = (1.0f - __expf(fv)) * __expf(-bb[j]);
            }
            Qf[s] = pack8(qd); Kf[s] = pack8(kd);
        }
        f32x16 X;
#pragma unroll
        for (int r = 0; r < 16; ++r) X[r] = zf();
#pragma unroll
        for (int s = 0; s < 4; ++s) X = MFMA32(Kf[s], Qf[s], X);
#pragma unroll
        for (int r = 0; r < 16; ++r) { const int j = crow(r, hh); const bool keep = dir == 0 ? (j <= i) : (j >= i); X[r] = keep ? X[r] : 0.f; }
        bf16x8 Xs[2];
#pragma unroll
        for (int s = 0; s < 2; ++s) { const float v8[8] = {X[8 * s], X[8 * s + 1], X[8 * s + 2], X[8 * s + 3], X[8 * s + 4], X[8 * s + 5], X[8 * s + 6], X[8 * s + 7]}; Xs[s] = pack8(v8); }
        const bf16_t* Vt = p.Vht + ((size_t)(b * 4 + h) * 64) * TP + pc * 32;
        const bf16_t* ST = p.DST + ((size_t)(((b * 4 + h) * 2 + dir) * NCH + pc)) * 4096;
#pragma unroll
        for (int vt = 0; vt < 2; ++vt) {
            const bf16_t* vrow = Vt + (size_t)(vt * 32 + i) * TP;
#pragma unroll
            for (int s = 0; s < 2; ++s) {
                const u32x2 lo = *(const u32x2*)(vrow + 16 * s + 4 * hh), hi = *(const u32x2*)(vrow + 16 * s + 8 + 4 * hh);
                u32x4 w; w.x = lo.x; w.y = lo.y; w.z = hi.x; w.w = hi.y;
                Y[vt] = MFMA32(__builtin_bit_cast(bf16x8, w), Xs[s], Y[vt]);
            }
            const bf16_t* srow = ST + (vt * 32 + i) * 64;
#pragma unroll
            for (int s = 0; s < 4; ++s) {
                Y[vt] = MFMA32(*(const bf16x8*)(srow + 16 * s + 8 * hh), Qf[s], Y[vt]);
            }
        }
        __syncthreads();
    }
    float ss = 0.f;
#pragma unroll
    for (int r = 0; r < 16; ++r) ss += Y[0][r] * Y[0][r] + Y[1][r] * Y[1][r];
    ss += shx<32>(ss);
    const float rs = rsqrtf(ss * (1.f / 64.f) + LN_EPS);
    const int row = row0 + i;
#pragma unroll
    for (int vt = 0; vt < 2; ++vt)
#pragma unroll
        for (int g4 = 0; g4 < 4; ++g4) {
            const int v0 = vt * 32 + 8 * g4 + 4 * hh;
            const f32x4 nw = *(const f32x4*)(p.hgrn_norm_w + l * 64 + v0);
            const u32x2 gw = *(const u32x2*)(p.Hg + (size_t)row * 256 + h * 64 + v0);
            f32x4 o;
            o[0] = Y[vt][g4 * 4 + 0] * rs * nw[0] * lo2f(gw.x); o[1] = Y[vt][g4 * 4 + 1] * rs * nw[1] * hi2f(gw.x);
            o[2] = Y[vt][g4 * 4 + 2] * rs * nw[2] * lo2f(gw.y); o[3] = Y[vt][g4 * 4 + 3] * rs * nw[3] * hi2f(gw.y);
            store4_bf16(p.O + (size_t)row * DM + 512 + h * 64 + v0, o);
        }
}

template <bool DIFF>
DI void attn_unit(CParams& p, int l, int b, int h, int qrow0  , int nkt  , char* lds) {
    const int tid = otid(), wid = tid >> 6, lane = tid & 63, hh = lane >> 5, q31 = lane & 31;
    constexpr int NS = DIFF ? 2 : 1;
    constexpr int NQF = DIFF ? 4 : 6;
    constexpr int BUF = 8192 + 8192 + (DIFF ? 0 : 4096);
    const int qrow = qrow0 + wid * 32 + q31;
    bf16x8 Qf[NQF];
    {
        const bf16_t* qp = DIFF ? p.Qd + (size_t)qrow * 256 + h * 64 : p.Qm + (size_t)qrow * 384 + h * 96;
#pragma unroll
        for (int s = 0; s < NQF; ++s) Qf[s] = *(const bf16x8*)(qp + 16 * s + 8 * hh);
    }
    const size_t krow0 = (size_t)b * TP;
    const bf16_t* kptr = (DIFF ? p.Kd : p.Kn) + (krow0 + (tid >> 3)) * 256 + h * 64 + (tid & 7) * 8;
    const bf16_t* vptr = (DIFF ? p.Vdt : p.Vmt) + ((size_t)(b * 4 + h) * 64 + (tid >> 3)) * TP + (tid & 7) * 8;
    const bf16_t* rptr = p.Kr + (krow0 + ((tid & 255) >> 2)) * 32 + (tid & 3) * 8;
    const int key_w = tid >> 3, c_w = tid & 7;
    const int kwoff = key_w * 128 + ((c_w ^ ((key_w >> 1) & 7)) << 4);
    const int d_w = tid >> 3;
    const int vwoff0 = 8192 + d_w * 128 + (((2 * c_w) ^ ((d_w >> 1) & 15)) << 3), vwoff1 = 8192 + d_w * 128 + (((2 * c_w + 1) ^ ((d_w >> 1) & 15)) << 3);
    const int rkey = (tid & 255) >> 2, rc = tid & 3;
    const int rwoff = 16384 + rkey * 64 + ((rc ^ ((rkey >> 2) & 3)) << 4);
    const int krd = q31 * 128, ksw = (q31 >> 1) & 7;
    const int rrd = 16384 + q31 * 64, rsw = (q31 >> 2) & 3;
    const int vrd = 8192 + q31 * 128, vsw = (q31 >> 1) & 15;
    f32x16 ot[NS][2];
    float m[NS], lsum[NS];
#pragma unroll
    for (int a = 0; a < NS; ++a) { m[a] = 0.f; lsum[a] = 0.f;
#pragma unroll
        for (int r = 0; r < 16; ++r) { ot[a][0][r] = zf(); ot[a][1][r] = zf(); } }
    u32x4 rk, rv, rr;
    rk = *(const u32x4*)kptr; rv = *(const u32x4*)vptr;
    if (!DIFF) { if (tid < 256) rr = *(const u32x4*)rptr; }
    __syncthreads();
    *(u32x4*)(lds + kwoff) = rk;
    *(u32x2*)(lds + vwoff0) = (u32x2){rv.x, rv.y}; *(u32x2*)(lds + vwoff1) = (u32x2){rv.z, rv.w};
    if (!DIFF) { if (tid < 256) *(u32x4*)(lds + rwoff) = rr; }
    __syncthreads();
    for (int kt = 0; kt < nkt; ++kt) {
        const char* cur = lds + (kt & 1) * BUF;
        const bool more = kt + 1 < nkt;
        if (more) {
            rk = *(const u32x4*)(kptr + (size_t)(kt + 1) * 64 * 256);
            rv = *(const u32x4*)(vptr + (kt + 1) * 64);
            if (!DIFF) { if (tid < 256) rr = *(const u32x4*)(rptr + (size_t)(kt + 1) * 64 * 32); }
        }
        bf16x8 Pf[NS][2][2];
#pragma unroll
        for (int a = 0; a < NS; ++a) {
            f32x16 st[2];
            const float negm = -m[a];
            constexpr int NKF = DIFF ? 2 : 6;
            bf16x8 kf[2][NKF];
#pragma unroll
            for (int t = 0; t < 2; ++t) {
                if (DIFF) {
#pragma unroll
                    for (int s = 0; s < 2; ++s) kf[t][s] = *(const bf16x8*)(cur + t * 4096 + krd + (((4 * a + 2 * s + hh) ^ ksw) << 4));
                } else {
#pragma unroll
                    for (int s = 0; s < 4; ++s) kf[t][s] = *(const bf16x8*)(cur + t * 4096 + krd + (((2 * s + hh) ^ ksw) << 4));
#pragma unroll
                    for (int s = 0; s < 2; ++s) kf[t][4 + s] = *(const bf16x8*)(cur + t * 2048 + rrd + (((2 * s + hh) ^ rsw) << 4));
                }
            }
            __builtin_amdgcn_sched_barrier(0);
#pragma unroll
            for (int t = 0; t < 2; ++t) {
                f32x16 acc;
#pragma unroll
                for (int r = 0; r < 16; ++r) acc[r] = negm;
#pragma unroll
                for (int s = 0; s < NKF; ++s) acc = MFMA32(kf[t][s], Qf[DIFF ? 2 * a + s : s], acc);
                st[t] = acc;
            }
            float tm = fmaxf(fmaxf(st[0][0], st[0][1]), st[0][2]);
#pragma unroll
            for (int r = 3; r < 15; r += 2) tm = fmaxf(fmaxf(tm, st[0][r]), st[0][r + 1]);
            tm = fmaxf(tm, st[0][15]);
#pragma unroll
            for (int r = 0; r < 16; r += 2) tm = fmaxf(fmaxf(tm, st[1][r]), st[1][r + 1]);
            { const auto sw = __builtin_amdgcn_permlane32_swap(__float_as_uint(tm), __float_as_uint(tm), false, false); tm = fmaxf(__uint_as_float(sw[0]), __uint_as_float(sw[1])); }
            if (kt == 0 || __any(tm > 8.0f)) {
                const float delta = kt == 0 ? tm : fmaxf(tm, 0.f);
                const float alpha = __builtin_amdgcn_exp2f(-delta);
                m[a] += delta; lsum[a] *= alpha;
#pragma unroll
                for (int r = 0; r < 16; ++r) { st[0][r] -= delta; st[1][r] -= delta; ot[a][0][r] *= alpha; ot[a][1][r] *= alpha; }
            }
            float ps = 0.f;
#pragma unroll
            for (int t = 0; t < 2; ++t) {
#pragma unroll
                for (int r = 0; r < 16; ++r) { const float e = __builtin_amdgcn_exp2f(st[t][r]); st[t][r] = e; ps += e; }
#pragma unroll
                for (int s = 0; s < 2; ++s) {
                    const float v8[8] = {st[t][8 * s], st[t][8 * s + 1], st[t][8 * s + 2], st[t][8 * s + 3], st[t][8 * s + 4], st[t][8 * s + 5], st[t][8 * s + 6], st[t][8 * s + 7]};
                    Pf[a][t][s] = pack8(v8);
                }
            }
            lsum[a] += ps;
            if (DIFF) __builtin_amdgcn_sched_barrier(0);
        }
#pragma unroll
        for (int dt = 0; dt < 2; ++dt) {
            bf16x8 vf[2][2];
#pragma unroll
            for (int t = 0; t < 2; ++t)
#pragma unroll
                for (int s = 0; s < 2; ++s) {
                    const int c8 = 8 * t + 4 * s + hh;
                    const u32x2 lo = *(const u32x2*)(cur + dt * 4096 + vrd + ((c8 ^ vsw) << 3));
                    const u32x2 hi = *(const u32x2*)(cur + dt * 4096 + vrd + (((c8 + 2) ^ vsw) << 3));
                    u32x4 w; w.x = lo.x; w.y = lo.y; w.z = hi.x; w.w = hi.y;
                    vf[t][s] = __builtin_bit_cast(bf16x8, w);
                }
            __builtin_amdgcn_sched_barrier(0);
#pragma unroll
            for (int t = 0; t < 2; ++t)
#pragma unroll
                for (int s = 0; s < 2; ++s)
#pragma unroll
                    for (int a = 0; a < NS; ++a) ot[a][dt] = MFMA32(vf[t][s], Pf[a][t][s], ot[a][dt]);
        }
        if (more) {
            char* nxt = lds + ((kt + 1) & 1) * BUF;
            *(u32x4*)(nxt + kwoff) = rk;
            *(u32x2*)(nxt + vwoff0) = (u32x2){rv.x, rv.y}; *(u32x2*)(nxt + vwoff1) = (u32x2){rv.z, rv.w};
            if (!DIFF) { if (tid < 256) *(u32x4*)(nxt + rwoff) = rr; }
        }
        __syncthreads();
    }
    float linv[NS];
#pragma unroll
    for (int a = 0; a < NS; ++a) { const float lt = lsum[a] + shx<32>(lsum[a]); linv[a] = 1.0f / lt; }
    f32x16 o[2];
    if (DIFF) {
        const float lam = p.lam[l];
#pragma unroll
        for (int dt = 0; dt < 2; ++dt)
#pragma unroll
            for (int r = 0; r < 16; ++r) o[dt][r] = ot[0][dt][r] * linv[0] - lam * (ot[NS - 1][dt][r] * linv[NS - 1]);
        float ss = 0.f;
#pragma unroll
        for (int r = 0; r < 16; ++r) ss += o[0][r] * o[0][r] + o[1][r] * o[1][r];
        ss += shx<32>(ss);
        int lz = l; asm volatile("" : "+s"(lz));
        const float lam_init = lz == 0 ? 0.2f : 0.3555090676f;
        const float rs = rsqrtf(ss * (1.f / 64.f) + LN_EPS) * (1.0f - lam_init);
#pragma unroll
        for (int dt = 0; dt < 2; ++dt)
#pragma unroll
            for (int r = 0; r < 16; ++r) o[dt][r] *= rs;
    } else {
#pragma unroll
        for (int dt = 0; dt < 2; ++dt)
#pragma unroll
            for (int r = 0; r < 16; ++r) o[dt][r] = ot[0][dt][r] * linv[0];
    }
    bf16_t* orow = p.O + (size_t)qrow * DM + (DIFF ? 256 : 768) + h * 64;
#pragma unroll
    for (int dt = 0; dt < 2; ++dt)
#pragma unroll
        for (int g4 = 0; g4 < 4; ++g4) {
            const int d0 = dt * 32 + 8 * g4 + 4 * hh;
            f32x4 v = {o[dt][g4 * 4], o[dt][g4 * 4 + 1], o[dt][g4 * 4 + 2], o[dt][g4 * 4 + 3]};
            if (DIFF) { const f32x4 sw = *(const f32x4*)(p.diff_subln_w + l * 64 + d0); v = v * sw; }
            store4_bf16(orow + d0, v);
        }
}

DI void phase_attn_diff_h2(CParams& p, int l, char* lds, bool h2skip) {
    const int G = gridDim.x;
    const int U_H2 = 256, U_LAT = NB * 4 * 16, U_CTX = (l == 0) ? NB * 4 : 0;
    const int total = U_H2 + 2 * U_LAT + 2 * U_CTX;
    for (int u = blockIdx.x; u < total; u += G) {
        if (u < U_H2) { if (!h2skip) hgrn_h2_unit(p, u); continue; }
        int v = u - U_H2; bool diff; int b, h, q0, nkt;
        if (v < 2 * U_LAT) { diff = v < U_LAT; if (!diff) v -= U_LAT; b = v >> 6; h = (v >> 4) & 3; q0 = b * TP + CTX + (v & 15) * 256; nkt = TP / 64; }
        else { v -= 2 * U_LAT; diff = v < U_CTX; if (!diff) v -= U_CTX; b = v >> 2; h = v & 3; q0 = b * TP; nkt = CTX / 64; }
        if (diff) attn_unit<true>(p, l, b, h, q0, nkt, lds); else attn_unit<false>(p, l, b, h, q0, nkt, lds);
    }
}
DI void phase_attn_mla_h3(CParams& p, int l, char* lds) {
    const int tid_ = otid(); const int wid = tid_ >> 6, lane = tid_ & 63;
    const int U_H3 = NB * 4 * NCH / 8;
    for (int u = blockIdx.x; u < U_H3; u += gridDim.x) { __syncthreads(); hgrn_h3_unit(p, l, u * 8 + wid, lane, lds + 65536 + wid * 8704); }
}

struct SchedOut {
    const char* O; const char* W; int l;
    DI bool next(int i, g8::GU& u) const {
        int pm, pn;
        if (l == 0) { if (!g8::order_next(i, MR / 256, 4, pm, pn)) return false; }
        else { if (!g8::order_next(i, NB * 16, 4, pm, pn)) return false; pm = (pm >> 4) * 17 + 1 + (pm & 15); }
        u.pm = pm; u.pn = pn; u.e = 0; u.j0 = 0; u.a = O + (size_t)pm * 256 * 2048; u.b = W + (size_t)pn * 256 * 2048; return true;
    }
    DI unsigned arow(const g8::GU&, int) const { return 0u; }
};
struct EpiOut {
    float* Y;
    DI void operator()(const f32x4 (&acc)[2][2][4][2], const g8::GU& u, int wr, int wc, int fr, int fq) const {
#pragma unroll
        for (int ai = 0; ai < 2; ++ai)
#pragma unroll
            for (int bj = 0; bj < 2; ++bj)
#pragma unroll
                for (int m = 0; m < 4; ++m)
#pragma unroll
                    for (int n = 0; n < 2; ++n) {
                        const int row = u.pm * 256 + 128 * ai + 64 * wr + 16 * m + fr, col = u.pn * 256 + 128 * bj + 32 * wc + 16 * n + 4 * fq;
                        *(f32x4*)(Y + (size_t)row * DM + col) = acc[ai][bj][m][n];
                    }
    }
};
DI void phase_outproj(CParams& p, int l, char* lds) {
    SchedOut S; S.O = (const char*)p.O; S.W = (const char*)(p.WoutT + (size_t)l * DM * DM); S.l = l;
    EpiOut E; E.Y = p.Y;
    g8::gemm8<EpiOut, SchedOut, false>(lds, DM * 2, nullptr, S, E);
}

DI void phase_postmix(CParams& p, int l, char* lds) {
    const int tid = otid(), wid = tid >> 6, lane = tid & 63;
    float* WrT = (float*)lds;
    int* lcnt = (int*)(lds + 131072);
    int* lbase = lcnt + 32;
    unsigned* ent = (unsigned*)(lds + 131072 + 256);
    const int G = gridDim.x, nrb = (MR + G - 1) / G;
    const float* rw = p.router_w + (size_t)l * DM * NE;
    __syncthreads();
    for (int i = tid; i < DM * NE / 4; i += NTHREADS) {
        const f32x4 v = *(const f32x4*)(rw + i * 4);
        const int d = i >> 3, e0 = (i & 7) * 4;
#pragma unroll
        for (int j = 0; j < 4; ++j) WrT[(e0 + j) * DM + d] = v[j];
    }
    if (tid < 32) lcnt[tid] = 0;
    __syncthreads();
    const int rbeg = blockIdx.x * nrb;
    const float* lw = p.ln_mix_w + l * DM; const float* lb = p.ln_mix_b + l * DM;
    for (int i0 = wid * 2; i0 < nrb; i0 += 16) {
        f32x4 v[2][4]; bool act[2];
#pragma unroll
        for (int rr = 0; rr < 2; ++rr) {
            const int i = i0 + rr; int row = rbeg + i;
            act[rr] = (i < nrb) && (row < MR);
            if (!act[rr]) row = rbeg;
            const int t = row % TP;
            if (l == 1 && t < CTX) { if (act[rr] && lane < 4) ent[(i * 4 + lane) * 2] = 0xffffffffu; act[rr] = false; }
            const float* xr = l == 0 ? in_row(p, row) : p.X + (size_t)row * DM;
            const float* yr = p.Y + (size_t)row * DM;
            const float* g1 = mod_vec(p, l, row, 2); const float* sh2 = mod_vec(p, l, row, 3); const float* sc2 = mod_vec(p, l, row, 4);
            float s = 0.f;
#pragma unroll
            for (int j = 0; j < 4; ++j) { const int c = j * 256 + lane * 4; v[rr][j] = *(const f32x4*)(xr + c) * DN_ALPHA + *(const f32x4*)(g1 + c) * *(const f32x4*)(yr + c); s += (v[rr][j][0] + v[rr][j][1]) + (v[rr][j][2] + v[rr][j][3]); }
            float mean = wave_sum(s) * (1.f / DM); float q = 0.f;
#pragma unroll
            for (int j = 0; j < 4; ++j) { v[rr][j] = v[rr][j] - mean; q += (v[rr][j][0] * v[rr][j][0] + v[rr][j][1] * v[rr][j][1]) + (v[rr][j][2] * v[rr][j][2] + v[rr][j][3] * v[rr][j][3]); }
            float rstd = rsqrtf(wave_sum(q) * (1.f / DM) + LN_EPS);
            s = 0.f;
#pragma unroll
            for (int j = 0; j < 4; ++j) { const int c = j * 256 + lane * 4; v[rr][j] = v[rr][j] * rstd * *(const f32x4*)(lw + c) + *(const f32x4*)(lb + c);
                if (act[rr]) *(f32x4*)(p.X + (size_t)row * DM + c) = v[rr][j];
                s += (v[rr][j][0] + v[rr][j][1]) + (v[rr][j][2] + v[rr][j][3]); }
            mean = wave_sum(s) * (1.f / DM); q = 0.f;
#pragma unroll
            for (int j = 0; j < 4; ++j) { v[rr][j] = v[rr][j] - mean; q += (v[rr][j][0] * v[rr][j][0] + v[rr][j][1] * v[rr][j][1]) + (v[rr][j][2] * v[rr][j][2] + v[rr][j][3] * v[rr][j][3]); }
            rstd = rsqrtf(wave_sum(q) * (1.f / DM) + LN_EPS);
#pragma unroll
            for (int j = 0; j < 4; ++j) { const int c = j * 256 + lane * 4; v[rr][j] = v[rr][j] * rstd * (*(const f32x4*)(sc2 + c) + 1.0f) + *(const f32x4*)(sh2 + c);
                if (act[rr]) *(unsigned*)(p.H8 + (size_t)row * DM + c) = pk4_fp8(v[rr][j][0], v[rr][j][1], v[rr][j][2], v[rr][j][3]); }
            __builtin_amdgcn_sched_barrier(0);
        }
        float lq[2][4];
#pragma unroll
        for (int qt = 0; qt < 4; ++qt) {
            float pl[2][8];
#pragma unroll
            for (int e = 0; e < 8; ++e) {
                float a0 = 0.f, a1 = 0.f;
#pragma unroll
                for (int j = 0; j < 4; ++j) {
                    const f32x4 w = *(const f32x4*)(WrT + (qt * 8 + e) * DM + j * 256 + lane * 4);
                    a0 += (v[0][j][0] * w[0] + v[0][j][1] * w[1]) + (v[0][j][2] * w[2] + v[0][j][3] * w[3]);
                    a1 += (v[1][j][0] * w[0] + v[1][j][1] * w[1]) + (v[1][j][2] * w[2] + v[1][j][3] * w[3]);
                }
                pl[0][e] = a0; pl[1][e] = a1;
                if ((e & 3) == 3) __builtin_amdgcn_sched_barrier(0);
            }
#pragma unroll
            for (int rr = 0; rr < 2; ++rr) {
                float r4[4], r2[2];
#pragma unroll
                for (int e = 0; e < 4; ++e) { const bool up = (lane & 4) != 0; const float keep = up ? pl[rr][e + 4] : pl[rr][e]; const float send = up ? pl[rr][e] : pl[rr][e + 4]; r4[e] = keep + dpp<DPP_HM>(send); }
#pragma unroll
                for (int e = 0; e < 2; ++e) { const bool up = (lane & 2) != 0; const float keep = up ? r4[e + 2] : r4[e]; const float send = up ? r4[e] : r4[e + 2]; r2[e] = keep + dpp<DPP_X2>(send); }
                float x1; { const bool up = (lane & 1) != 0; const float keep = up ? r2[1] : r2[0]; const float send = up ? r2[0] : r2[1]; x1 = keep + dpp<DPP_X1>(send); }
                x1 += shx<8>(x1); x1 += shx<16>(x1); x1 += shx<32>(x1);
                lq[rr][qt] = x1;
            }
            __builtin_amdgcn_sched_barrier(0);
        }
#pragma unroll
        for (int rr = 0; rr < 2; ++rr) {
            const int i = i0 + rr;
            const int e_me = lane & 31;
            const int qsel = (lane >> 3) & 3;
            float logit = (qsel == 0 ? lq[rr][0] : qsel == 1 ? lq[rr][1] : qsel == 2 ? lq[rr][2] : lq[rr][3]) + p.router_b[l * NE + e_me];
            logit = (logit == logit) ? fminf(fmaxf(logit, -1e30f), 1e30f) : -1e30f;
            int rank = 0;
#pragma unroll
            for (int e = 0; e < 32; ++e) { const float o = rdlane(logit, e); rank += (o > logit || (o == logit && e < e_me)) ? 1 : 0; }
            const float vmax = rdlane(logit, __builtin_amdgcn_readfirstlane(__ffsll((long long)__ballot(rank == 0 && lane < 32)) - 1));
            const float ex = (rank < 4) ? __expf(logit - vmax) : 0.f;
            const float den = wave_sum((lane < 32) ? ex : 0.f);
            if (act[rr] && lane < 32 && rank < 4) {
                const int lp = atomicAdd(&lcnt[e_me], 1);
                ent[(i * 4 + rank) * 2] = (unsigned)e_me | ((unsigned)lp << 8);
                ent[(i * 4 + rank) * 2 + 1] = __float_as_uint(ex / den);
            }
        }
    }
    __syncthreads();
    if (tid < 32) lbase[tid] = (int)atomicAdd(&p.gcnt[l * NE + tid], (unsigned)lcnt[tid]);
    __syncthreads();
    for (int j = tid; j < nrb * 4; j += NTHREADS) {
        const int row = rbeg + (j >> 2);
        if (row >= MR) break;
        const unsigned w = ent[j * 2];
        if (w == 0xffffffffu) continue;
        const int e = w & 255, pos = lbase[e] + (int)(w >> 8);
        p.ltok[(size_t)e * MR + pos] = row;
        p.lgate[(size_t)e * MR + pos] = __uint_as_float(ent[j * 2 + 1]);
        p.rslot[(size_t)row * 4 + (j & 3)] = (e << 24) | pos;
    }
}

DI int moe_prefix(CParams& p, int l, int* tpre  ) {
    __syncthreads();
    if (otid() == 0) {
        int acc = 0;
        for (int e = 0; e < NE; ++e) { tpre[e] = acc; acc += ((int)p.gcnt[l * NE + e] + 255) >> 8; }
        tpre[NE] = acc;
    }
    __syncthreads();
    return tpre[NE];
}
DI int moe_find(const int* tpre, int mt) { int e = 0;
#pragma unroll 1
    for (int j = 0; j < NE; ++j) if (tpre[j + 1] <= mt) e = j + 1;
    return e; }

constexpr int TPRE_OFF = 135168;
struct SchedMoe {
    const int* tpre; const unsigned* cnt; const int* ltok; const char* A; const char* W; int nN; size_t wstride;
    DI bool next(int i, g8::GU& u) const {
        int pm, pn; if (!g8::order_next(i, __builtin_amdgcn_readfirstlane(tpre[NE]), nN, pm, pn)) return false;
        const int e = __builtin_amdgcn_readfirstlane(moe_find(tpre, pm));
        u.pm = pm; u.pn = pn; u.e = e; u.j0 = __builtin_amdgcn_readfirstlane((pm - tpre[e]) * 256);
        u.a = A + (size_t)pm * 256 * 1024; u.b = W + (size_t)e * wstride + (size_t)pn * 256 * 1024; return true;
    }
    DI unsigned arow(const g8::GU& u, int r) const { const int pos = u.j0 + r; return pos < (int)cnt[u.e] ? (unsigned)ltok[(size_t)u.e * MR + pos] : 0u; }
};
struct EpiMoe1 {
    const float* b1; unsigned char* ACT;
    DI void operator()(const f32x4 (&acc)[2][2][4][2], const g8::GU& u, int wr, int wc, int fr, int fq) const {
        const float* bb1 = b1 + (size_t)u.e * 2048;
#pragma unroll
        for (int ai = 0; ai < 2; ++ai)
#pragma unroll
            for (int bj = 0; bj < 2; ++bj)
#pragma unroll
                for (int m = 0; m < 4; ++m)
#pragma unroll
                    for (int n = 0; n < 2; ++n) {
                        const int rl = 128 * ai + 64 * wr + 16 * m + fr, col = u.pn * 256 + 128 * bj + 32 * wc + 16 * n + 4 * fq;
                        const f32x4 hv = acc[ai][bj][m][n] + *(const f32x4*)(bb1 + col);
                        float o[2];
#pragma unroll
                        for (int q = 0; q < 2; ++q) {
                            const float glu = fminf(hv[2 * q], 7.0f), lin = fminf(fmaxf(hv[2 * q + 1], -7.0f), 7.0f);
                            o[q] = glu * sigmoidf_(1.702f * glu) * (lin + 1.0f);
                        }
                        *(unsigned short*)(ACT + ((size_t)u.pm * 256 + rl) * 1024 + (col >> 1)) = (unsigned short)(__builtin_amdgcn_cvt_pk_fp8_f32(o[0], o[1], 0, false) & 0xffff);
                    }
    }
};
struct EpiMoe2 {
    const float* b2; const float* lgate; const unsigned* cnt; bf16_t* YS;
    DI void operator()(const f32x4 (&acc)[2][2][4][2], const g8::GU& u, int wr, int wc, int fr, int fq) const {
        const float* bb2 = b2 + (size_t)u.e * DM;
        const int cn = (int)cnt[u.e];
        int frz = fr; asm volatile("" : "+v"(frz));
#pragma unroll
        for (int ai = 0; ai < 2; ++ai)
#pragma unroll
            for (int m = 0; m < 4; ++m) {
                const int rl = 128 * ai + 64 * wr + 16 * m + frz, pos = u.j0 + rl;
                const float gate = pos < cn ? lgate[(size_t)u.e * MR + pos] : 0.f;
#pragma unroll
                for (int bj = 0; bj < 2; ++bj)
#pragma unroll
                    for (int n = 0; n < 2; ++n) {
                        const int col = u.pn * 256 + 128 * bj + 32 * wc + 16 * n + 4 * fq;
                        store4_bf16(YS + ((size_t)u.pm * 256 + rl) * 1024 + col, (acc[ai][bj][m][n] + *(const f32x4*)(bb2 + col)) * gate);
                    }
                __builtin_amdgcn_sched_barrier(0);
            }
    }
};
DI void phase_moe1(CParams& p, int l, char* lds) {
    int* tpre = (int*)(lds + TPRE_OFF);
    moe_prefix(p, l, tpre);
    SchedMoe S; S.tpre = tpre; S.cnt = p.gcnt + l * NE; S.ltok = p.ltok; S.A = nullptr; S.W = (const char*)p.W1T + (size_t)l * NE * 2048 * DM; S.nN = 8; S.wstride = (size_t)2048 * DM;
    EpiMoe1 E; E.b1 = p.b1 + (size_t)l * NE * 2048; E.ACT = (unsigned char*)p.ACT;
    g8::gemm8<EpiMoe1, SchedMoe, true, true>(lds, DM, (const char*)p.H8, S, E, 0x7a7a7a7au);
}
DI void phase_moe2(CParams& p, int l, char* lds) {
    int* tpre = (int*)(lds + TPRE_OFF);
    moe_prefix(p, l, tpre);
    SchedMoe S; S.tpre = tpre; S.cnt = p.gcnt + l * NE; S.ltok = p.ltok; S.A = (const char*)p.ACT; S.W = (const char*)p.W2T + (size_t)l * NE * DM * DM; S.nN = 4; S.wstride = (size_t)DM * DM;
    EpiMoe2 E; E.b2 = p.b2 + (size_t)l * NE * DM; E.lgate = p.lgate; E.cnt = p.gcnt + l * NE; E.YS = p.YS;
    g8::gemm8<EpiMoe2, SchedMoe, false, true>(lds, DM, nullptr, S, E, 0x79797979u);
}

DI void phase_final(CParams& p, int l, char* lds) {
    const int tid = otid(), wid = tid >> 6, lane = tid & 63;
    int* tpre = (int*)(lds + TPRE_OFF);
    moe_prefix(p, l, tpre);
    const float* lw = p.ln_ffn_w + l * DM; const float* lb = p.ln_ffn_b + l * DM;
    for (int row = blockIdx.x * 8 + wid; row < MR; row += gridDim.x * 8) {
        const int b = row / TP, t = row - b * TP;
        if (l == 1 && t < CTX) continue;
        const float* g2 = mod_vec(p, l, row, 5);
        const bf16_t* ys[4];
#pragma unroll
        for (int k = 0; k < 4; ++k) { const int rs = p.rslot[(size_t)row * 4 + k]; const int e = rs >> 24, pos = rs & 0xffffff; ys[k] = p.YS + ((size_t)tpre[e] * 256 + pos) * 1024; }
        f32x4 v[4]; float s = 0.f;
#pragma unroll
        for (int j = 0; j < 4; ++j) {
            const int c = j * 256 + lane * 4;
            f32x4 y = zero4();
#pragma unroll
            for (int k = 0; k < 4; ++k) { const u32x2 w = *(const u32x2*)(ys[k] + c); y[0] += lo2f(w.x); y[1] += hi2f(w.x); y[2] += lo2f(w.y); y[3] += hi2f(w.y); }
            const f32x4 xv = *(const f32x4*)(p.X + (size_t)row * DM + c), gg = *(const f32x4*)(g2 + c);
            v[j] = xv * DN_ALPHA + gg * y;
            s += (v[j][0] + v[j][1]) + (v[j][2] + v[j][3]);
        }
        float mean = wave_sum(s) * (1.f / DM); float q = 0.f;
#pragma unroll
        for (int j = 0; j < 4; ++j) { v[j] = v[j] - mean; q += (v[j][0] * v[j][0] + v[j][1] * v[j][1]) + (v[j][2] * v[j][2] + v[j][3] * v[j][3]); }
        float rstd = rsqrtf(wave_sum(q) * (1.f / DM) + LN_EPS);
        s = 0.f;
#pragma unroll
        for (int j = 0; j < 4; ++j) {
            const int c = j * 256 + lane * 4;
            v[j] = v[j] * rstd * *(const f32x4*)(lw + c) + *(const f32x4*)(lb + c);
            s += (v[j][0] + v[j][1]) + (v[j][2] + v[j][3]);
        }
        if (l == 1) {
            float* o = p.out + ((size_t)b * SEQ + (t - CTX)) * DM;
#pragma unroll
            for (int j = 0; j < 4; ++j) *(f32x4*)(o + j * 256 + lane * 4) = v[j];
        } else {
#pragma unroll
            for (int j = 0; j < 4; ++j) *(f32x4*)(p.X + (size_t)row * DM + j * 256 + lane * 4) = v[j];
            mean = wave_sum(s) * (1.f / DM); q = 0.f;
#pragma unroll
            for (int j = 0; j < 4; ++j) { v[j] = v[j] - mean; q += (v[j][0] * v[j][0] + v[j][1] * v[j][1]) + (v[j][2] * v[j][2] + v[j][3] * v[j][3]); }
            rstd = rsqrtf(wave_sum(q) * (1.f / DM) + LN_EPS);
            const float* sh = mod_vec(p, 1, row, 0); const float* sc = mod_vec(p, 1, row, 1);
#pragma unroll
            for (int j = 0; j < 4; ++j) {
                const int c = j * 256 + lane * 4;
                const f32x4 h = v[j] * rstd * (*(const f32x4*)(sc + c) + 1.0f) + *(const f32x4*)(sh + c);
                *(unsigned*)(p.H8 + (size_t)row * DM + c) = pk4_fp8(h[0], h[1], h[2], h[3]);
            }
        }
    }
}

constexpr int PH_PER_LAYER = 11, N_PHASES = 1 + 2 * PH_PER_LAYER;

__global__ void __launch_bounds__(NTHREADS, 2) mega(Params p_unused, int ph_lo, int ph_hi) {
    extern __shared__ __attribute__((aligned(16))) char smem[];
    CParams* kp0 = (CParams*)__builtin_amdgcn_kernarg_segment_ptr();
    CParams& p = *kp0;
    ((volatile int*)(smem + WVTAB_OFF))[hw_slot()] = (int)(threadIdx.x >> 6);
    __syncthreads();
    const bool fused = (ph_hi - ph_lo) > 1;
    XcdBarrier bar; bar.bar = p.bar; bar.x = 0; bar.st = (volatile LAS unsigned*)(smem + LDS_BYTES - 16);
    if (fused) {
        if (otid() == 0) *(uint4*)(smem + LDS_BYTES - 16) = make_uint4(0u, 0u, 0u, 0u);
        __syncthreads();
        bar = xcd_barrier_post(p.bar, (volatile LAS unsigned*)(smem + LDS_BYTES - 16));
    }
#if MK_DEBUG == 2
#define PH_STAMP(i) if (blockIdx.x == 0 && threadIdx.x == 0) ((unsigned long long*)(p.gcnt + 1024))[(i) + 1] = wall_clock64();
#else
#define PH_STAMP(i)
#endif
#ifndef MK_REP
#define MK_REP 0u
#endif
#define PH(idx, call) do { const int _i = (idx); if (ph_lo <= _i && _i < ph_hi) { CParams* _kp = kp0; asm volatile("" : "+s"(_kp)); CParams& p = *_kp; call; if ((MK_REP >> (_i == 0 ? 0 : 1 + (_i - 1) % 11)) & 1u) { xcd_barrier(bar); h2skip = true; call; h2skip = false; } if (_i + 1 < ph_hi) xcd_barrier(bar); PH_STAMP(_i) } } while (0)
    bool h2skip = false;
    PH_STAMP(-1)
    PH(0, phase_prologue(p, smem));
#pragma unroll 1
    for (int l = 0; l < 2; ++l) {
        const int base = 1 + l * PH_PER_LAYER;
        PH(base + 0, if (l == 0) phase_ln1(p, smem));
        PH(base + 1, phase_inproj(p, l, smem));
        PH(base + 2, phase_sgu_prep(p, l, smem));
        PH(base + 3, phase_upproj_h1(p, l, smem));
        PH(base + 4, phase_attn_diff_h2(p, l, smem, h2skip));
        PH(base + 5, phase_attn_mla_h3(p, l, smem));
        PH(base + 6, phase_outproj(p, l, smem));
        PH(base + 7, phase_postmix(p, l, smem));
        PH(base + 8, phase_moe1(p, l, smem));
        PH(base + 9, phase_moe2(p, l, smem));
        PH(base + 10, phase_final(p, l, smem));
    }
#undef PH
}


#ifndef MK_DEBUG
#define MK_DEBUG 0
#define MK_REP 0u
#endif
#if MK_DEBUG
struct DbgItem { const void* ptr; unsigned long long n; int f32; int ld; int c0; int c1; int mode; int pad; };
struct DbgList { DbgItem it[40]; int count; int pad; };
__global__ void dbg_scan(DbgList L, unsigned* flag) {
    for (int i = 0; i < L.count; ++i) {
        const DbgItem d = L.it[i];
        bool bad = false;
        for (unsigned long long e = (unsigned long long)blockIdx.x * blockDim.x + threadIdx.x; e < d.n; e += (unsigned long long)gridDim.x * blockDim.x) {
            if (d.ld > 0) { const int c = (int)(e % d.ld); if (c < d.c0 || c >= d.c1) continue; }
            if (d.f32) { const unsigned u = ((const unsigned*)d.ptr)[e]; if (((d.mode & 1) && (u & 0x7f800000u) == 0x7f800000u) || ((d.mode & 2) && u == 0xAAAAAAAAu) || ((d.mode & 4) && (u & 0x7f800000u) >= 0x46800000u)) bad = true; }
            else { const unsigned short u = ((const unsigned short*)d.ptr)[e]; if (((d.mode & 1) && (u & 0x7f80u) == 0x7f80u) || ((d.mode & 2) && u == 0xAAAAu) || ((d.mode & 4) && (u & 0x7f80u) >= 0x4680u)) bad = true; }
        }
        if (bad) atomicMin(flag, (unsigned)i);
    }
}
__global__ void dbg_time(float* out, unsigned long long n, const unsigned long long* ts, unsigned maskA, unsigned maskB) {
    float ta = 0.f, tb = 0.f;
    for (int i = 0; i < 23; ++i) { const float d = (float)(ts[i + 1] - ts[i]) * 0.01f; const int cls = i == 0 ? 0 : 1 + (i - 1) % 11; if (maskA >> cls & 1) ta += d; if (maskB >> cls & 1) tb += d; }
    for (unsigned long long e = (unsigned long long)blockIdx.x * blockDim.x + threadIdx.x; e < n; e += (unsigned long long)gridDim.x * blockDim.x) out[e] = e == 0 ? ta : tb;
}
__global__ void dbg_fill(float* out, unsigned long long n, const unsigned* flag, float hostcode) {
    const unsigned f = *flag;
    float v = f < 1000u ? 100.0f * (float)(f + 1u) : 0.0f;
    if (hostcode != 0.f) v = hostcode;
    for (unsigned long long e = (unsigned long long)blockIdx.x * blockDim.x + threadIdx.x; e < n; e += (unsigned long long)gridDim.x * blockDim.x) out[e] = v;
}
#endif

#ifndef MK_MULTI
#define MK_MULTI 0
#endif

extern "C" void kernel_launch(void* const* d_in, const int* in_sizes, int n_in, void* d_out, int out_size, void* d_ws, size_t ws_size, hipStream_t stream) {
    (void)in_sizes; (void)n_in; (void)out_size; (void)ws_size;
    Params p;
    memset(&p, 0, sizeof(p));
    const float* const* in = (const float* const*)d_in;
    p.x = in[0]; p.c = in[1]; p.ctx = in[2]; p.c_ctx = in[3]; p.ada_w = in[4]; p.ada_b = in[5]; p.w_in = in[6]; p.w_out = in[7];
    p.sgu_ln_w = in[8]; p.sgu_ln_b = in[9]; p.sgu_w = in[10]; p.sgu_b = in[11]; p.diff_lambda = in[12]; p.diff_subln_w = in[13];
    p.hgrn_lb = in[14]; p.hgrn_norm_w = in[15]; p.mla_q_norm_w = in[16]; p.mla_w_uq = in[17]; p.mla_kv_norm_w = in[18]; p.mla_w_ukv = in[19];
    p.ln_mix_w = in[20]; p.ln_mix_b = in[21]; p.ln_ffn_w = in[22]; p.ln_ffn_b = in[23]; p.router_w = in[24]; p.router_b = in[25];
    p.w1 = in[26]; p.b1 = in[27]; p.w2 = in[28]; p.b2 = in[29];
    p.out = (float*)d_out;
    char* ws = (char*)d_ws; size_t off = 0;
    auto take = [&](size_t bytes) { char* r = ws + off; off += (bytes + 255) & ~(size_t)255; return r; };
    constexpr size_t CTRL_BYTES = 65536;
    char* ctrl = take(CTRL_BYTES);
    p.bar = (unsigned*)ctrl; p.gcnt = (unsigned*)(ctrl + 16384);
    p.mod = (float*)take((size_t)2 * 9 * 6144 * 4); p.lball = (float*)take(2 * 512 * 4); p.lam = (float*)take(256); p.ropec = (float*)take(512 * 4); p.ropes = (float*)take(512 * 4);
    p.WinT = (bf16_t*)take((size_t)2 * NINP * DM * 2); p.WoutT = (bf16_t*)take((size_t)2 * DM * DM * 2);
    p.WuqT = (bf16_t*)take((size_t)2 * 384 * 256 * 2); p.WukvT = (bf16_t*)take((size_t)2 * 512 * 128 * 2);
    p.W1T = (bf16_t*)take((size_t)2 * NE * 2048 * DM * 2); p.W2T = (bf16_t*)take((size_t)2 * NE * DM * DM * 2);
    p.X = (float*)take((size_t)MR * DM * 4); p.H = (bf16_t*)take((size_t)MR * DM * 2); p.H8 = (unsigned char*)take((size_t)MR * DM);
    p.Puv = (bf16_t*)take((size_t)MR * 512 * 2); p.Qd = (bf16_t*)take((size_t)MR * 256 * 2); p.Kd = (bf16_t*)take((size_t)MR * 256 * 2); p.Vdt = (bf16_t*)take((size_t)MR * 256 * 2);
    p.Hq = (bf16_t*)take((size_t)MR * 256 * 2); p.Vht = (bf16_t*)take((size_t)MR * 256 * 2); p.Lf = (bf16_t*)take((size_t)2 * MR * 256 * 2); p.Hg = (bf16_t*)take((size_t)MR * 256 * 2);
    p.Cq = (bf16_t*)take((size_t)MR * 256 * 2); p.Ckv = (bf16_t*)take((size_t)MR * 128 * 2); p.Kr = (bf16_t*)take((size_t)MR * 32 * 2);
    p.Qm = (bf16_t*)take((size_t)MR * 384 * 2); p.Kn = (bf16_t*)take((size_t)MR * 256 * 2); p.Vmt = (bf16_t*)take((size_t)MR * 256 * 2);
    p.O = (bf16_t*)take((size_t)MR * DM * 2);
    p.RS = (float*)take((size_t)MR * 2 * 4); p.DST = (bf16_t*)take((size_t)NB * 4 * 2 * NCH * 4096 * 2); p.DEC = (float*)take((size_t)NB * 4 * 2 * NCH * 64 * 4);
    p.Y = (float*)take((size_t)MR * DM * 4);
    p.ltok = (int*)take((size_t)NE * MR * 4); p.lgate = (float*)take((size_t)NE * MR * 4); p.rslot = (int*)take((size_t)MR * 4 * 4);
    p.ACT = (bf16_t*)take((size_t)NSLOT * 1024 * 2); p.YS = (bf16_t*)take((size_t)NSLOT * 1024 * 2);

    static int grid = 0;
    if (!grid) {
        int dev = 0, cus = 0, per_cu = 0;
        hipGetDevice(&dev);
        hipDeviceGetAttribute(&cus, hipDeviceAttributeMultiprocessorCount, dev);
        hipFuncSetAttribute((const void*)mega, hipFuncAttributeMaxDynamicSharedMemorySize, LDS_BYTES);
        hipOccupancyMaxActiveBlocksPerMultiprocessor(&per_cu, mega, NTHREADS, LDS_BYTES);
        if (cus <= 0) cus = 256;
        grid = cus * (per_cu < 1 ? 1 : 1);
    }
    hipMemsetAsync(ctrl, 0, CTRL_BYTES, stream);
#if MK_MULTI
#ifndef MK_NPH
#define MK_NPH N_PHASES
#endif
    for (int ph = 0; ph < MK_NPH; ++ph) {
        if (ph == 1 + PH_PER_LAYER) continue;
        hipLaunchKernelGGL(mega, dim3(grid), dim3(NTHREADS), LDS_BYTES, stream, p, ph, ph + 1);
    }
#else
    hipLaunchKernelGGL(mega, dim3(grid), dim3(NTHREADS), LDS_BYTES, stream, p, 0, N_PHASES);
#endif

#if MK_DEBUG == 2
    hipLaunchKernelGGL(dbg_time, dim3(2048), dim3(256), 0, stream, (float*)d_out, (unsigned long long)NB * SEQ * DM, (const unsigned long long*)(p.gcnt + 1024), (unsigned)MK_TMASK_A, (unsigned)MK_TMASK_B);
#elif MK_DEBUG
    {
        DbgList L; memset(&L, 0, sizeof(L));
        int n = 0;
        auto add = [&](const void* ptr, unsigned long long cnt, int f32, int ld = 0, int c0 = 0, int c1 = 0, int mode = 3) { L.it[n].ptr = ptr; L.it[n].n = cnt; L.it[n].f32 = f32; L.it[n].ld = ld; L.it[n].c0 = c0; L.it[n].c1 = c1; L.it[n].mode = mode; ++n; };
        MK_DEBUG_LIST
        L.count = n;
        unsigned* flag = (unsigned*)(ctrl + 32768);
        hipMemsetAsync(flag, 0x7f, 4, stream);
        hipLaunchKernelGGL(dbg_scan, dim3(2048), dim3(256), 0, stream, L, flag);
        hipLaunchKernelGGL(dbg_fill, dim3(2048), dim3(256), 0, stream, (float*)d_out, (unsigned long long)NB * SEQ * DM, (const unsigned*)flag, 0.0f);
    }
#endif
}
```

```cpp
#include <hip/hip_runtime.h>
#include <stdint.h>
#include <string.h>

#define MK_MULTI 0
#define MK_NPH N_PHASES
#define MK_DEBUG 0
#define MK_REP 0u
#define MK_DEBUG_LIST \
  add(p.mod, 2*9*6144, 1,0,0,0,7); add(p.WinT, 2ull*NINP*DM, 0,0,0,0,7); add(p.H, (unsigned long long)MR*DM, 0,0,0,0,7); add(p.Puv, (unsigned long long)MR*512, 0,0,0,0,7); \
  add(p.Cq, (unsigned long long)MR*256, 0,0,0,0,7); add(p.Ckv, (unsigned long long)MR*128, 0,0,0,0,7); add(p.RS, (unsigned long long)MR*2, 1,0,0,0,7); \
  add(p.Kn, (unsigned long long)MR*256, 0,0,0,0,7); add(p.Vmt, (unsigned long long)MR*256, 0,0,0,0,7); \
  add(p.O, (unsigned long long)MR*DM, 0, DM, 0, 256, 1); \
  add(p.Y, (unsigned long long)MR*DM, 1);

#define DI __device__ __forceinline__
typedef unsigned short bf16_t;
typedef short bf16x8 __attribute__((ext_vector_type(8)));
typedef float f32x4 __attribute__((ext_vector_type(4)));
typedef float f32x2 __attribute__((ext_vector_type(2)));
typedef float f32x16 __attribute__((ext_vector_type(16)));
typedef unsigned u32x4 __attribute__((ext_vector_type(4)));
typedef unsigned u32x2 __attribute__((ext_vector_type(2)));

constexpr int DM = 1024, NB = 8, SEQ = 4096, CTX = 256, TP = 4352, MR = NB * TP;
constexpr int NIN = 2976, NINP = 3072;
constexpr int NE = 32;
constexpr int NCH = TP / 32;
constexpr int NSLOT = 147456;
constexpr float LN_EPS = 1e-6f;
constexpr float DN_ALPHA = 1.4142135623730951f;
constexpr float LOG2E = 1.4426950408889634f;
constexpr int NTHREADS = 512;
constexpr int LDS_BYTES = 147456;

#define XB_TMO      128
#define XB_XCNT(j)  (256  + 64 * (j))
#define XB_XSUB(j)  (1280 + 64 * (j))
#define XB_XGEN(j)  (2304 + 64 * (j))
#define XB_TOP      3328
#define XB_TOPGEN   3392
#define XCD_BAR_WORDS 3456
#define XB_SPIN_CAP (1u << 22)
#define LAS __attribute__((address_space(3)))
__device__ __forceinline__ int otid();

DI unsigned xb_ld(unsigned* p)              { return __hip_atomic_load(p, __ATOMIC_RELAXED, __HIP_MEMORY_SCOPE_AGENT); }
DI unsigned xb_add(unsigned* p, unsigned v) { return __hip_atomic_fetch_add(p, v, __ATOMIC_RELAXED, __HIP_MEMORY_SCOPE_AGENT); }
DI unsigned xb_xcc_id() { return (unsigned)__builtin_amdgcn_s_getreg((3 << 11) | 20) & 0xFu; }
#define XB_SPIN(cond, bar) do { unsigned _sp = 0; while (cond) { __builtin_amdgcn_s_sleep(1); \
    if ((++_sp & 255u) == 0u) { if (xb_ld(&(bar)[XB_TMO])) break; if (_sp > XB_SPIN_CAP) { atomicAdd(&(bar)[XB_TMO], 1u); break; } } } } while (0)

struct XcdBarrier { unsigned* bar; unsigned x; volatile LAS unsigned* st; };

DI XcdBarrier xcd_barrier_post(unsigned* bar, volatile LAS unsigned* st) {
    XcdBarrier b; b.bar = bar; b.x = xb_xcc_id(); b.st = st;
    if (otid() == 0) (void)xb_add(&bar[XB_XCNT(b.x)], 1u);
    return b;
}
DI void xcd_barrier_complete(unsigned* bar, unsigned x, unsigned& nloc, unsigned& nx) {
    const unsigned G = gridDim.x * gridDim.y * gridDim.z;
    unsigned sum, cnt, mine, sp = 0u;
    for (;;) {
        sum = 0u; cnt = 0u; mine = 0u;
#pragma unroll
        for (unsigned j = 0; j < 16; ++j) { const unsigned c = xb_ld(&bar[XB_XCNT(j)]); sum += c; cnt += (c > 0u) ? 1u : 0u; mine = (j == x) ? c : mine; }
        if (sum == G) break;
        __builtin_amdgcn_s_sleep(1);
        if ((++sp & 255u) == 0u) { if (xb_ld(&bar[XB_TMO])) break; if (sp > XB_SPIN_CAP) { atomicAdd(&bar[XB_TMO], 1u); break; } }
    }
    nloc = mine > 0u ? mine : 1u; nx = cnt > 0u ? cnt : 1u;
}
DI void xcd_barrier(const XcdBarrier& b) {
    asm volatile("s_waitcnt vmcnt(0)" ::: "memory");
    __syncthreads();
    if (otid() == 0) {
        unsigned* bar = b.bar;
        __builtin_amdgcn_s_waitcnt(0);
        unsigned nloc = b.st[0], nx = b.st[1];
        if (nloc == 0u) { xcd_barrier_complete(bar, b.x, nloc, nx); b.st[0] = nloc; b.st[1] = nx; }
        const unsigned old = xb_add(&bar[XB_XSUB(b.x)], 1u);
        const unsigned gen = old / nloc;
        if (old + 1u == (gen + 1u) * nloc) {
            __builtin_amdgcn_fence(__ATOMIC_RELEASE, "agent");
            asm volatile("s_waitcnt vmcnt(0)" ::: "memory");
            const unsigned og = xb_add(&bar[XB_TOP], 1u);
            const unsigned tg = og / nx;
            if (og + 1u == (tg + 1u) * nx) xb_add(&bar[XB_TOPGEN], 1u);
            else XB_SPIN(xb_ld(&bar[XB_TOPGEN]) == tg, bar);
            __builtin_amdgcn_fence(__ATOMIC_ACQUIRE, "agent");
            xb_add(&bar[XB_XGEN(b.x)], 1u);
            asm volatile("s_waitcnt vmcnt(0)" ::: "memory");
        } else {
            XB_SPIN(xb_ld(&bar[XB_XGEN(b.x)]) == gen, bar);
            __builtin_amdgcn_fence(__ATOMIC_ACQUIRE, "agent");
            asm volatile("s_waitcnt vmcnt(0)" ::: "memory");
        }
    }
    __syncthreads();
}

struct Params {
    const float *x, *c, *ctx, *c_ctx, *ada_w, *ada_b, *w_in, *w_out, *sgu_ln_w, *sgu_ln_b, *sgu_w, *sgu_b,
                *diff_lambda, *diff_subln_w, *hgrn_lb, *hgrn_norm_w, *mla_q_norm_w, *mla_w_uq, *mla_kv_norm_w, *mla_w_ukv,
                *ln_mix_w, *ln_mix_b, *ln_ffn_w, *ln_ffn_b, *router_w, *router_b, *w1, *b1, *w2, *b2;
    float* out;
    unsigned* bar; unsigned* gcnt;
    float *mod, *lball, *lam, *ropec, *ropes;
    bf16_t *WinT, *WoutT, *WuqT, *WukvT, *W1T, *W2T;
    float* X; bf16_t* H; unsigned char* H8;
    bf16_t *Puv, *Qd, *Kd, *Vdt, *Hq, *Vht, *Lf, *Hg, *Cq, *Ckv, *Kr, *Qm, *Kn, *Vmt, *O;
    float *RS, *DEC, *Y; bf16_t* DST;
    int* ltok; float* lgate; int* rslot; bf16_t *ACT, *YS;
};

typedef const __attribute__((address_space(4))) Params CParams;
extern __shared__ __attribute__((aligned(16))) char smem_all[];
constexpr int WVTAB_OFF = 147456 - 16 - 256;
DI int hw_slot() { return (int)(__builtin_amdgcn_s_getreg((6 << 11) | 4) & 63u); }
DI int otid() {
    int l = (int)__builtin_amdgcn_mbcnt_hi(~0u, __builtin_amdgcn_mbcnt_lo(~0u, 0u));
    const int w = __builtin_amdgcn_readfirstlane(((volatile int*)(smem_all + WVTAB_OFF))[hw_slot()]);
    int t = w * 64 + l; asm volatile("" : "+v"(t)); return t;
}
DI float bf2f(bf16_t v) { return __uint_as_float(((unsigned)v) << 16); }
typedef __bf16 bf16x2_t __attribute__((ext_vector_type(2)));
DI unsigned pk2(float lo, float hi) { const bf16x2_t v = {(__bf16)lo, (__bf16)hi}; return __builtin_bit_cast(unsigned, v); }
DI unsigned pk4_fp8(float a, float b, float c, float d) { int w = 0; w = __builtin_amdgcn_cvt_pk_fp8_f32(a, b, w, false); w = __builtin_amdgcn_cvt_pk_fp8_f32(c, d, w, true); return (unsigned)w; }
DI float lo2f(unsigned w) { return __uint_as_float(w << 16); }
DI float hi2f(unsigned w) { return __uint_as_float(w & 0xffff0000u); }
DI bf16x8 pack8(const float (&v)[8]) { u32x4 w; w.x = pk2(v[0], v[1]); w.y = pk2(v[2], v[3]); w.z = pk2(v[4], v[5]); w.w = pk2(v[6], v[7]); return __builtin_bit_cast(bf16x8, w); }
template <int MASK> DI float shx(float v) {
    if (MASK < 32) return __int_as_float(__builtin_amdgcn_ds_swizzle(__float_as_int(v), (MASK << 10) | 0x1f));
    int l = (int)__builtin_amdgcn_mbcnt_hi(~0u, __builtin_amdgcn_mbcnt_lo(~0u, 0u)); asm volatile("" : "+v"(l));
    return __int_as_float(__builtin_amdgcn_ds_bpermute((l ^ 32) << 2, __float_as_int(v)));
}
DI float zf() { float z = 0.f; asm volatile("" : "+v"(z)); return z; }
DI f32x4 zero4() { const float z = zf(); return (f32x4){z, z, z, z}; }
DI float rdlane(float v, int l) { return __int_as_float(__builtin_amdgcn_readlane(__float_as_int(v), l)); }
template <int CTRL> DI float dpp(float v) { return __int_as_float(__builtin_amdgcn_update_dpp(0, __float_as_int(v), CTRL, 0xf, 0xf, false)); }
constexpr int DPP_X1 = 0xB1, DPP_X2 = 0x4E, DPP_HM = 0x141, DPP_RM = 0x140;
DI float xsum32(float v) { const auto sw = __builtin_amdgcn_permlane32_swap(__float_as_uint(v), __float_as_uint(v), false, false); return __uint_as_float(sw[0]) + __uint_as_float(sw[1]); }
DI float xget32(float v, bool lower_half) { const auto sw = __builtin_amdgcn_permlane32_swap(__float_as_uint(v), __float_as_uint(v), false, false); return lower_half ? __uint_as_float(sw[1]) : __uint_as_float(sw[0]); }
DI float wave_sum(float v) { v += dpp<DPP_X1>(v); v += dpp<DPP_X2>(v); v += dpp<DPP_HM>(v); v += dpp<DPP_RM>(v); v += shx<16>(v); return xsum32(v); }
DI float sigmoidf_(float x) { return __builtin_amdgcn_rcpf(1.0f + __builtin_amdgcn_exp2f(-LOG2E * x)); }
DI float geluf_(float v) {
    const float av = fabsf(v), t = __builtin_amdgcn_rcpf(av * 0.2316418882f + 1.0f);
    float q = t * 0.5307027145f + (-0.7265760135f); q = q * t + 0.7107068705f; q = q * t + (-0.142248368f); q = q * t + 0.127414796f; q = q * t;
    const float e = __builtin_amdgcn_exp2f((v * v) * (-0.72134752044f));
    const float m = v * (q * e);
    return v < 0.f ? m : v - m;
}
DI float siluf_(float x) { return x * sigmoidf_(x); }
DI int crow(int r, int hh) { return (r & 3) + 8 * (r >> 2) + 4 * hh; }
#define MFMA16(a, b, c) __builtin_amdgcn_mfma_f32_16x16x32_bf16((a), (b), (c), 0, 0, 0)
#define MFMA32(a, b, c) __builtin_amdgcn_mfma_f32_32x32x16_bf16((a), (b), (c), 0, 0, 0)

DI const float* in_row(CParams& p, int row) {
    const int b = row / TP, t = row - b * TP;
    return t < CTX ? p.ctx + ((size_t)b * CTX + t) * DM : p.x + ((size_t)b * SEQ + (t - CTX)) * DM;
}
DI const float* mod_vec(CParams& p, int l, int row, int j) {
    const int b = row / TP, t = row - b * TP;
    const int r = t < CTX ? 8 : b;
    return p.mod + ((size_t)(l * 9 + r) * 6 + j) * DM;
}

DI void transpose_tile(const float* __restrict__ src, int K, int N, bf16_t* __restrict__ dst, int k0, int n0, const float* __restrict__ kscale, int perm_ukv, char* wl, int lane, float f8scale = 0.f) {
    bf16_t* S = (bf16_t*)wl;
#pragma unroll 4
    for (int it = 0; it < 16; ++it) {
        const int kk = it * 4 + (lane >> 4), nn = (lane & 15) * 4;
        f32x4 v = {0.f, 0.f, 0.f, 0.f};
        if (n0 + nn < N) v = *(const f32x4*)(src + (size_t)(k0 + kk) * N + n0 + nn);
        if (kscale) { const float s = kscale[k0 + kk]; v = v * s; }
        if (f8scale != 0.f) v = v * f8scale;
        unsigned* d = (unsigned*)(S + kk * 66 + nn);
        d[0] = pk2(v[0], v[1]); d[1] = pk2(v[2], v[3]);
    }
    __builtin_amdgcn_fence(__ATOMIC_RELEASE, "workgroup");
    __builtin_amdgcn_wave_barrier();
    __builtin_amdgcn_fence(__ATOMIC_ACQUIRE, "workgroup");
#pragma unroll 2
    for (int it = 0; it < 8; ++it) {
        const int nn = it * 8 + (lane >> 3), kc = lane & 7;
        unsigned short e[8];
#pragma unroll
        for (int j = 0; j < 8; ++j) e[j] = S[(kc * 8 + j) * 66 + nn];
        u32x4 w; w.x = e[0] | ((unsigned)e[1] << 16); w.y = e[2] | ((unsigned)e[3] << 16); w.z = e[4] | ((unsigned)e[5] << 16); w.w = e[6] | ((unsigned)e[7] << 16);
        int n = n0 + nn;
        if (perm_ukv) { const int hh = n >> 7, t = n & 127; n = t < 64 ? hh * 64 + t : 256 + hh * 64 + (t - 64); }
        if (f8scale != 0.f) {
            u32x2 w8; w8.x = pk4_fp8(bf2f(e[0]), bf2f(e[1]), bf2f(e[2]), bf2f(e[3])); w8.y = pk4_fp8(bf2f(e[4]), bf2f(e[5]), bf2f(e[6]), bf2f(e[7]));
            *(u32x2*)((unsigned char*)dst + (size_t)n * K + k0 + kc * 8) = w8;
        } else *(u32x4*)(dst + (size_t)n * K + k0 + kc * 8) = w;
    }
    __builtin_amdgcn_fence(__ATOMIC_RELEASE, "workgroup");
    __builtin_amdgcn_wave_barrier();
}

DI void phase_prologue(CParams& p, char* lds) {
    const int tid = otid(), wid = tid >> 6, lane = tid & 63;
    char* wl = lds + wid * 8704;
    constexpr int T_IN = 16 * 48, T_OUT = 16 * 16, T_UQ = 4 * 6, T_UKV = 2 * 8, T_W1 = 32 * 16 * 32, T_W2 = 32 * 16 * 16;
    constexpr int T_LAYER = T_IN + T_OUT + T_UQ + T_UKV + T_W1 + T_W2;
    constexpr int T_ALL = 2 * T_LAYER;
    constexpr int U_TR = (T_ALL + 7) / 8;
    constexpr int U_GEMV = 2 * 6144 / 64;
    const int nunits = U_GEMV + U_TR + 1;
    for (int u = blockIdx.x; u < nunits; u += gridDim.x) {
        if (u < U_GEMV) {
            const int l = u / 96, n = (u % 96) * 64 + lane;
            const float* W = p.ada_w + (size_t)l * DM * 6144 + (size_t)(wid * 128) * 6144 + n;
            float* sc = (float*)(lds + 73728);
            float* part = (float*)lds;
            __syncthreads();
            for (int i = tid; i < 9 * DM; i += NTHREADS) { const float cv = i < 8 * DM ? p.c[i] : p.c_ctx[i - 8 * DM]; sc[i] = siluf_(cv); }
            __syncthreads();
            float acc[9];
#pragma unroll
            for (int r = 0; r < 9; ++r) acc[r] = 0.f;
#pragma unroll 2
            for (int k = 0; k < 128; k += 4) {
                float w[4];
#pragma unroll
                for (int j = 0; j < 4; ++j) w[j] = W[(size_t)(k + j) * 6144];
#pragma unroll
                for (int r = 0; r < 9; ++r) {
                    const f32x4 cc = *(const f32x4*)(sc + r * DM + wid * 128 + k);
#pragma unroll
                    for (int j = 0; j < 4; ++j) acc[r] += cc[j] * w[j];
                }
            }
#pragma unroll
            for (int r = 0; r < 9; ++r) part[(wid * 9 + r) * 64 + lane] = acc[r];
            __syncthreads();
            for (int i = tid; i < 9 * 64; i += NTHREADS) {
                const int r = i >> 6, c = i & 63;
                float sum = p.ada_b[l * 6144 + (u % 96) * 64 + c];
#pragma unroll
                for (int w8 = 0; w8 < 8; ++w8) sum += part[(w8 * 9 + r) * 64 + c];
                p.mod[(size_t)(l * 9 + r) * 6144 + (u % 96) * 64 + c] = sum;
            }
            __syncthreads();
        } else if (u < U_GEMV + U_TR) {
            int t = (u - U_GEMV) * 8 + wid;
            if (t < T_ALL) {
                const int l = t / T_LAYER; t -= l * T_LAYER;
                if (t < T_IN) { const int kt = t / 48, nt = t % 48;
                    transpose_tile(p.w_in + (size_t)l * DM * NIN, DM, NIN, (bf16_t*)((unsigned char*)p.WinT + (size_t)l * NINP * DM), kt * 64, nt * 64, nullptr, 0, wl, lane, 32.0f);
                } else if ((t -= T_IN) < T_OUT) { const int kt = t / 16, nt = t % 16;
                    transpose_tile(p.w_out + (size_t)l * DM * DM, DM, DM, p.WoutT + (size_t)l * DM * DM, kt * 64, nt * 64, nullptr, 0, wl, lane);
                } else if ((t -= T_OUT) < T_UQ) { const int kt = t / 6, nt = t % 6;
                    transpose_tile(p.mla_w_uq + (size_t)l * 256 * 384, 256, 384, p.WuqT + (size_t)l * 384 * 256, kt * 64, nt * 64, p.mla_q_norm_w + l * 256, 0, wl, lane);
                } else if ((t -= T_UQ) < T_UKV) { const int kt = t / 8, nt = t % 8;
                    transpose_tile(p.mla_w_ukv + (size_t)l * 128 * 512, 128, 512, p.WukvT + (size_t)l * 512 * 128, kt * 64, nt * 64, p.mla_kv_norm_w + l * 128, 1, wl, lane);
                } else if ((t -= T_UKV) < T_W1) { const int e = t / 512, r = t % 512, kt = r / 32, nt = r % 32;
                    transpose_tile(p.w1 + ((size_t)l * NE + e) * DM * 2048, DM, 2048, (bf16_t*)((unsigned char*)p.W1T + ((size_t)l * NE + e) * 2048 * DM), kt * 64, nt * 64, nullptr, 0, wl, lane, 32.0f);
                } else { t -= T_W1; const int e = t / 256, r = t % 256, kt = r / 16, nt = r % 16;
                    transpose_tile(p.w2 + ((size_t)l * NE + e) * DM * DM, DM, DM, (bf16_t*)((unsigned char*)p.W2T + ((size_t)l * NE + e) * DM * DM), kt * 64, nt * 64, nullptr, 0, wl, lane, 64.0f);
                }
            }
        } else {
            if (tid < 512) {
                const int j = tid;
                const float a0 = p.hgrn_lb[j], a1 = p.hgrn_lb[512 + j];
                const float m = fmaxf(a0, a1), e0 = expf(a0 - m), e1 = expf(a1 - m);
                p.lball[j] = 0.f;
                p.lball[512 + j] = e1 / (e0 + e1);
            }
            if (tid < 2) {
                const float* lp = p.diff_lambda + tid * 4 * 32;
                float s01 = 0.f, s23 = 0.f;
                for (int i = 0; i < 32; ++i) { s01 += lp[i] * lp[32 + i]; s23 += lp[64 + i] * lp[96 + i]; }
                const float lam_init = tid == 0 ? 0.2f : 0.3555090676f;
                p.lam[tid] = expf(s01) - expf(s23) + lam_init;
            }
            {
                const int pos = tid >> 3, i = tid & 7;
                const float inv = powf(10000.0f, -(float)(2 * i) / 16.0f);
                float sn, cs; sincosf((float)pos * inv, &sn, &cs);
                p.ropec[tid] = cs; p.ropes[tid] = sn;
            }
        }
    }
}

DI void phase_ln1(CParams& p, char* lds) {
    const int tid = otid(), wid = tid >> 6, lane = tid & 63;
    for (int row = blockIdx.x * 8 + wid; row < MR; row += gridDim.x * 8) {
        const float* xr = in_row(p, row);
        f32x4 v[4]; float s = 0.f;
#pragma unroll
        for (int j = 0; j < 4; ++j) { v[j] = *(const f32x4*)(xr + j * 256 + lane * 4); s += (v[j][0] + v[j][1]) + (v[j][2] + v[j][3]); }
        const float mean = wave_sum(s) * (1.f / DM);
        float q = 0.f;
#pragma unroll
        for (int j = 0; j < 4; ++j) { v[j] = v[j] - mean; q += (v[j][0] * v[j][0] + v[j][1] * v[j][1]) + (v[j][2] * v[j][2] + v[j][3] * v[j][3]); }
        const float rstd = rsqrtf(wave_sum(q) * (1.f / DM) + LN_EPS);
        const float* sh = mod_vec(p, 0, row, 0); const float* sc = mod_vec(p, 0, row, 1);
#pragma unroll
        for (int j = 0; j < 4; ++j) {
            const int c = j * 256 + lane * 4;
            const f32x4 a = *(const f32x4*)(sh + c), b = *(const f32x4*)(sc + c);
            const f32x4 h = v[j] * rstd * (b + 1.0f) + a;
            *(unsigned*)(p.H8 + (size_t)row * DM + c) = pk4_fp8(h[0], h[1], h[2], h[3]);
        }
    }
}

template <int ORI>
DI void gemm_core(const bf16_t* const (&pa)[4], const bf16_t* const (&pb)[2], int K, char* lds, f32x4 (&acc)[4][4]) {
    const int tid = otid(), wid = tid >> 6, lane = tid & 63, wr = wid >> 1, wc = wid & 1, fr = lane & 15, fq = lane >> 4;
    const int sw = ((tid & 7) ^ ((tid >> 4) & 7)) << 4;
    const int offA = (tid >> 3) * 128 + sw, offB = 32768 + (tid >> 3) * 128 + sw;
    const int rdA = (wr * 64 + fr) * 128 + ((fq ^ (fr >> 1)) << 4), rdB = 32768 + (wc * 64 + fr) * 128 + ((fq ^ (fr >> 1)) << 4);
#pragma unroll
    for (int mi = 0; mi < 4; ++mi)
#pragma unroll
        for (int ni = 0; ni < 4; ++ni) acc[mi][ni] = zero4();
    u32x4 ra[4], rb[2];
#pragma unroll
    for (int i = 0; i < 4; ++i) ra[i] = *(const u32x4*)(pa[i]);
#pragma unroll
    for (int j = 0; j < 2; ++j) rb[j] = *(const u32x4*)(pb[j]);
#pragma unroll
    for (int i = 0; i < 4; ++i) *(u32x4*)(lds + offA + i * 8192) = ra[i];
#pragma unroll
    for (int j = 0; j < 2; ++j) *(u32x4*)(lds + offB + j * 8192) = rb[j];
    __syncthreads();
    const int nk = K >> 6;
    for (int kt = 0; kt < nk; ++kt) {
        const char* cur = lds + (kt & 1) * 49152;
        const bool more = kt + 1 < nk;
        if (more) {
#pragma unroll
            for (int i = 0; i < 4; ++i) ra[i] = *(const u32x4*)(pa[i] + (kt + 1) * 64);
#pragma unroll
            for (int j = 0; j < 2; ++j) rb[j] = *(const u32x4*)(pb[j] + (kt + 1) * 64);
        }
#pragma unroll
        for (int kk = 0; kk < 2; ++kk) {
            bf16x8 af[4], bfr[4];
#pragma unroll
            for (int mi = 0; mi < 4; ++mi) af[mi] = *(const bf16x8*)(cur + ((rdA + mi * 2048) ^ (kk * 64)));
#pragma unroll
            for (int ni = 0; ni < 4; ++ni) bfr[ni] = *(const bf16x8*)(cur + ((rdB + ni * 2048) ^ (kk * 64)));
#pragma unroll
            for (int mi = 0; mi < 4; ++mi)
#pragma unroll
                for (int ni = 0; ni < 4; ++ni) {
                    if (ORI == 0) acc[mi][ni] = MFMA16(bfr[ni], af[mi], acc[mi][ni]);
                    else          acc[mi][ni] = MFMA16(af[mi], bfr[ni], acc[mi][ni]);
                }
        }
        if (more) {
            char* nxt = lds + ((kt + 1) & 1) * 49152;
#pragma unroll
            for (int i = 0; i < 4; ++i) *(u32x4*)(nxt + offA + i * 8192) = ra[i];
#pragma unroll
            for (int j = 0; j < 2; ++j) *(u32x4*)(nxt + offB + j * 8192) = rb[j];
        }
        __syncthreads();
    }
}

DI void gemm_ptrs(const bf16_t* A, int lda, int row0, const bf16_t* Bt, int ldb, int n0, const bf16_t* (&pa)[4], const bf16_t* (&pb)[2]) {
    const int tid = otid(), r = tid >> 3, c = (tid & 7) * 8;
#pragma unroll
    for (int i = 0; i < 4; ++i) pa[i] = A + (size_t)(row0 + r + 64 * i) * lda + c;
#pragma unroll
    for (int j = 0; j < 2; ++j) pb[j] = Bt + (size_t)(n0 + r + 64 * j) * ldb + c;
}

DI void store4_bf16(bf16_t* dst, const f32x4& v) { u32x2 w; w.x = pk2(v[0], v[1]); w.y = pk2(v[2], v[3]); *(u32x2*)dst = w; }

DI f32x4 rope_tile(CParams& p, f32x4 v, int row, int axis_is_col, int fq) {
    f32x4 o;
    const int b = row / TP, t = row - b * TP;
    const int pos = t - CTX;
    const int ax = axis_is_col ? (pos & 63) : (pos >> 6);
    f32x4 cs = {1.f, 1.f, 1.f, 1.f}, sn = {0.f, 0.f, 0.f, 0.f};
    if (t >= CTX) { cs = *(const f32x4*)(p.ropec + ax * 8 + (fq & 1) * 4); sn = *(const f32x4*)(p.ropes + ax * 8 + (fq & 1) * 4); }
#pragma unroll
    for (int r = 0; r < 4; ++r) {
        const float pr = xget32(v[r], fq < 2);
        o[r] = fq < 2 ? v[r] * cs[r] - pr * sn[r] : v[r] * cs[r] + pr * sn[r];
    }
    return o;
}

namespace g8 {
constexpr int BK = 64, HALF = 128, HTB = HALF * BK * 2, STAGE_BYTES = 8 * HTB;
DI int lds_byte(int r, int c) { const int st = (r >> 4) * 2 + (c >> 5), rr = r & 15, cc = c & 31, ob = rr * 64 + cc * 2; return st * 1024 + (ob ^ (((ob >> 9) & 1) << 5)); }
DI void stage_rc(int b, int& R, int& C) { const int st = b / 1024, sb = b % 1024, swz = sb ^ (((sb >> 9) & 1) << 5); R = (st >> 1) * 16 + swz / 64; C = (st & 1) * 32 + (swz % 64) / 2; }
struct GU { const char* a; const char* b; int pm, pn, e, j0; };
DI bool order_next(int i, int nM, int nN, int& pm, int& pn) {
    const int nwg = nM * nN; const long L = (long)i * gridDim.x + blockIdx.x; if (L >= nwg) return false;
    int wgid = (int)L; { const int q = nwg / 8, r = nwg % 8, xcd = wgid % 8, off = wgid / 8; wgid = (xcd < r ? xcd * (q + 1) : r * (q + 1) + (xcd - r) * q) + off; }
    const int nig = 8 * nN, gid = wgid / nig, fm = gid * 8, gsz = (nM - fm) < 8 ? (nM - fm) : 8;
    pm = fm + ((wgid % nig) % gsz); pn = (wgid % nig) / gsz; return true;
}

typedef int v4i_t __attribute__((ext_vector_type(4)));
typedef int v8i_t __attribute__((ext_vector_type(8)));
template <class Epi, class Sched, bool GATHER, bool FP8 = false, bool SWAPSC = false>
DI void gemm8(char* lds_generic, const int KB, const char* Abase, const Sched& S, const Epi& E, const unsigned sclB = 0x7f7f7f7fu) {
    LAS unsigned char* lds = (LAS unsigned char*)lds_generic;
    const int tid = otid(), wid = __builtin_amdgcn_readfirstlane(tid >> 6), lane = tid & 63, wr = wid >> 2, wc = wid & 3, fr = lane & 15, fq = lane >> 4;
    const int nt = KB / 128;
    int R[2], C[2];
#pragma unroll
    for (int i = 0; i < 2; ++i) stage_rc(tid * 16 + i * 8192, R[i], C[i]);
    unsigned voff[2];
#pragma unroll
    for (int i = 0; i < 2; ++i) voff[i] = (unsigned)(R[i] * KB + C[i] * 2);
    const size_t kstep = (size_t)(BK * 2), hstep = (size_t)HALF * KB;
    const unsigned ldsw = (unsigned)wid * 1024u;
    const int aoff = lds_byte(wr * 64 + fr, fq * 8), boff = lds_byte(wc * 32 + fr, fq * 8);
    LAS unsigned* gtab = (LAS unsigned*)(lds + STAGE_BYTES);
#define G8_SA(b, h) (((b) * 2 + (h)) * HTB)
#define G8_SB(b, h) ((4 + (b) * 2 + (h)) * HTB)
#define G8_LDS(gp, bufoff, i) __builtin_amdgcn_global_load_lds((const unsigned*)(gp), (LAS unsigned*)(lds + (bufoff) + ldsw + (i) * 8192), 16, 0, 0)
#define G8_STAGE_B(bufoff, gbase) do { _Pragma("unroll") for (int _i = 0; _i < 2; ++_i) G8_LDS((const char*)(gbase) + voff[_i], bufoff, _i); } while (0)
#define G8_STAGE_A(bufoff, h, nx, ko) do { _Pragma("unroll") for (int _i = 0; _i < 2; ++_i) { \
        const char* _gp = GATHER ? Abase + (size_t)(gtab[((((nx) ? ui + 1 : ui) & 1) << 8) + (h) * HALF + R[_i]] + (unsigned)(C[_i] * 2)) + (ko) : ((nx) ? nA : cA) + (size_t)(h) * hstep + (ko) + voff[_i]; G8_LDS(_gp, bufoff, _i); } } while (0)
#define G8_LDA(dst, b, h) do { _Pragma("unroll") for (int m = 0; m < 4; ++m) _Pragma("unroll") for (int k = 0; k < 2; ++k) dst[m][k] = *(const LAS bf16x8*)(lds + G8_SA(b, h) + aoff + m * 2048 + k * 1024); } while (0)
#define G8_LDB(dst, b, h) do { _Pragma("unroll") for (int n = 0; n < 2; ++n) _Pragma("unroll") for (int k = 0; k < 2; ++k) dst[n][k] = *(const LAS bf16x8*)(lds + G8_SB(b, h) + boff + n * 2048 + k * 1024); } while (0)
#define G8_MMA(ai, bj, At, Bt) do { __builtin_amdgcn_s_setprio(1); _Pragma("unroll") for (int m = 0; m < 4; ++m) _Pragma("unroll") for (int n = 0; n < 2; ++n) { \
        if constexpr (FP8) { const v8i_t _a = __builtin_shufflevector(__builtin_bit_cast(v4i_t, At[m][0]), __builtin_bit_cast(v4i_t, At[m][1]), 0, 1, 2, 3, 4, 5, 6, 7); \
                   const v8i_t _b = __builtin_shufflevector(__builtin_bit_cast(v4i_t, Bt[n][0]), __builtin_bit_cast(v4i_t, Bt[n][1]), 0, 1, 2, 3, 4, 5, 6, 7); \
                   acc[ai][bj][m][n] = __builtin_amdgcn_mfma_scale_f32_16x16x128_f8f6f4(_b, _a, acc[ai][bj][m][n], 0, 0, 0, (int)(SWAPSC && cur.e ? 0x7f7f7f7fu : sclB), 0, (int)(SWAPSC && cur.e ? sclB : 0x7f7f7f7fu)); } \
        else { _Pragma("unroll") for (int k = 0; k < 2; ++k) acc[ai][bj][m][n] = __builtin_amdgcn_mfma_f32_16x16x32_bf16(Bt[n][k], At[m][k], acc[ai][bj][m][n], 0, 0, 0); } } \
        if constexpr (FP8) asm volatile("" : "+v"(acc[ai][bj][0][0]), "+v"(acc[ai][bj][0][1]), "+v"(acc[ai][bj][1][0]), "+v"(acc[ai][bj][1][1]), "+v"(acc[ai][bj][2][0]), "+v"(acc[ai][bj][2][1]), "+v"(acc[ai][bj][3][0]), "+v"(acc[ai][bj][3][1]));   \
        __builtin_amdgcn_s_setprio(0); } while (0)
#define G8_WAIT_V(n) asm volatile("s_waitcnt vmcnt(" #n ")" ::: "memory")
#define G8_WAIT_L(n) asm volatile("s_waitcnt lgkmcnt(" #n ")" ::: "memory")
#define G8_BAR __builtin_amdgcn_s_barrier()
#define G8_SCHED __builtin_amdgcn_sched_barrier(0)
#define G8_GOFF(slot, u) do { if (GATHER) { int _tz = tid; asm volatile("" : "+v"(_tz)); if (_tz < 256) gtab[((slot) << 8) + _tz] = S.arow(u, _tz) * (unsigned)KB; } } while (0)
    GU cur, nxt; int ui = 0;
    __syncthreads();
    if (!S.next(0, cur)) return;
    f32x4 acc[2][2][4][2];
    { const f32x4 z4 = zero4();
#pragma unroll
    for (int a = 0; a < 2; ++a)
#pragma unroll
        for (int b = 0; b < 2; ++b)
#pragma unroll
            for (int m = 0; m < 4; ++m)
#pragma unroll
                for (int n = 0; n < 2; ++n) acc[a][b][m][n] = z4; }
    bf16x8 At[4][2], B0[2][2], B1[2][2];
    const char* cA = cur.a; const char* cB = cur.b; const char* nA = cA; const char* nB = cB;
    G8_GOFF(0, cur);
    if (GATHER) __syncthreads();
    G8_STAGE_B(G8_SB(0, 0), cB); G8_STAGE_B(G8_SB(0, 1), cB + hstep); G8_STAGE_A(G8_SA(0, 0), 0, false, (size_t)0); G8_STAGE_A(G8_SA(0, 1), 1, false, (size_t)0);
    if (wr == 1) G8_BAR;
    G8_WAIT_V(2); G8_BAR;
    G8_STAGE_B(G8_SB(1, 0), cB + kstep); G8_STAGE_A(G8_SA(1, 0), 0, false, kstep); G8_STAGE_B(G8_SB(1, 1), cB + hstep + kstep);
    G8_WAIT_V(6); G8_BAR;
    for (;;) {
        const bool has_next = S.next(ui + 1, nxt);
        nA = has_next ? nxt.a : cA; nB = has_next ? nxt.b : cB;
        G8_GOFF((ui + 1) & 1, has_next ? nxt : cur);
        for (int t = 0; t < nt; t += 2) {
            const bool last = (t == nt - 2);
            const size_t k1 = (size_t)(t + 1) * kstep, k2 = last ? (size_t)0 : (size_t)(t + 2) * kstep, k3 = k2 + kstep;
            const char* b2 = last ? nB : cB + (size_t)(t + 2) * kstep; const char* b3 = b2 + kstep;
            G8_LDB(B0, 0, 0); G8_LDB(B1, 0, 1); G8_SCHED; G8_LDA(At, 0, 0); G8_STAGE_A(G8_SA(1, 1), 1, false, k1);
            G8_WAIT_V(8); G8_WAIT_L(0); G8_BAR; G8_MMA(0, 0, At, B0); G8_MMA(0, 1, At, B1); G8_BAR; G8_SCHED;
            G8_LDA(At, 0, 1); G8_STAGE_B(G8_SB(0, 0), b2); G8_STAGE_B(G8_SB(0, 1), b2 + hstep); G8_STAGE_A(G8_SA(0, 0), 0, last, k2);
            G8_WAIT_V(8); G8_WAIT_L(0); G8_BAR; G8_MMA(1, 0, At, B0); G8_MMA(1, 1, At, B1); G8_BAR; G8_SCHED;
            G8_LDB(B0, 1, 0); G8_LDB(B1, 1, 1); G8_SCHED; G8_LDA(At, 1, 0); G8_STAGE_A(G8_SA(0, 1), 1, last, k2);
            G8_WAIT_V(8); G8_WAIT_L(0); G8_BAR; G8_MMA(0, 0, At, B0); G8_MMA(0, 1, At, B1); G8_BAR; G8_SCHED;
            G8_LDA(At, 1, 1); G8_STAGE_B(G8_SB(1, 0), b3); G8_STAGE_B(G8_SB(1, 1), b3 + hstep); G8_STAGE_A(G8_SA(1, 0), 0, last, k3);
            G8_WAIT_V(8); G8_WAIT_L(0); G8_BAR; G8_MMA(1, 0, At, B0); G8_MMA(1, 1, At, B1); G8_BAR; G8_SCHED;
        }
        if (wr == 0) G8_BAR;
        E(acc, cur, wr, wc, fr, fq);
        if (!has_next) break;
        const f32x4 z4 = zero4();
#pragma unroll
        for (int a = 0; a < 2; ++a)
#pragma unroll
            for (int b = 0; b < 2; ++b)
#pragma unroll
                for (int m = 0; m < 4; ++m)
#pragma unroll
                    for (int n = 0; n < 2; ++n) acc[a][b][m][n] = z4;
        cur = nxt; cA = nA; cB = nB; ++ui;
        if (wr == 1) G8_BAR;
    }
    G8_WAIT_V(0);
    G8_BAR;
#undef G8_SA
#undef G8_SB
#undef G8_LDS
#undef G8_STAGE_A
#undef G8_STAGE_B
#undef G8_LDA
#undef G8_LDB
#undef G8_MMA
#undef G8_WAIT_V
#undef G8_WAIT_L
#undef G8_BAR
#undef G8_SCHED
#undef G8_GOFF
}
}

#define INPROJ_LOOP(BODY) _Pragma("unroll") for (int ai = 0; ai < 2; ++ai) _Pragma("unroll") for (int m = 0; m < 4; ++m) _Pragma("unroll") for (int n = 0; n < 2; ++n) { \
        const int row = row0 + 128 * ai + 16 * m, col = col0 + 16 * n; f32x4 v = acc[ai][bj][m][n]; BODY }
template <int bj>
DI void inproj_half(CParams& p, int l, int nt, const f32x4 (&acc)[2][2][4][2], int row0  , int col0  , int fq) {
    if (nt < 4) {
        INPROJ_LOOP({
            _Pragma("unroll") for (int r = 0; r < 4; ++r) v[r] = geluf_(v[r]);
            store4_bf16(p.Puv + (size_t)row * 512 + col, v); })
    } else if (nt < 6) {
        INPROJ_LOOP({ v = rope_tile(p, v, row, n, fq) * (0.17677669529663687f * LOG2E); store4_bf16(p.Qd + (size_t)row * 256 + (col - 512), v); })
    } else if (nt < 8) {
        INPROJ_LOOP({ v = rope_tile(p, v, row, n, fq); store4_bf16(p.Kd + (size_t)row * 256 + (col - 768), v); })
    } else if (nt < 12) {
        INPROJ_LOOP({
            _Pragma("unroll") for (int r = 0; r < 4; ++r) v[r] = siluf_(v[r]);
            store4_bf16(p.Hq + (size_t)row * 256 + (col - 1280), v); })
    } else if (nt < 18) {
        const int dir = nt >= 16, cb = dir ? 2048 : 1792;
        const f32x4 lb2[2] = {*(const f32x4*)(p.lball + (l * 2 + dir) * 256 + col0 - cb), *(const f32x4*)(p.lball + (l * 2 + dir) * 256 + col0 + 16 - cb)};
        INPROJ_LOOP({
            const int cc = col - cb;
            const f32x4 lb = lb2[n];
            _Pragma("unroll") for (int r = 0; r < 4; ++r) v[r] = 0.69314718056f * __builtin_amdgcn_logf(lb[r] + (1.0f - lb[r]) * sigmoidf_(v[r]));
            store4_bf16(p.Lf + ((size_t)dir * MR + row) * 256 + cc, v); })
    } else if (nt < 20) {
        INPROJ_LOOP({
            _Pragma("unroll") for (int r = 0; r < 4; ++r) v[r] = siluf_(v[r]);
            store4_bf16(p.Hg + (size_t)row * 256 + (col - 2304), v); })
    } else if (nt < 22) {
        INPROJ_LOOP({ store4_bf16(p.Cq + (size_t)row * 256 + (col - 2560), v); })
    } else if (nt == 22) {
        INPROJ_LOOP({ store4_bf16(p.Ckv + (size_t)row * 128 + (col - 2816), v); })
    } else {
        INPROJ_LOOP({ v = rope_tile(p, v, row, n, fq); if (col < 2976) store4_bf16(p.Kr + (size_t)row * 32 + (col - 2944), v); })
    }
}
struct SchedIn {
    const char* H; const char* W;
    DI bool next(int i, g8::GU& u) const {
        int pm, pn; if (!g8::order_next(i, MR / 256, 12, pm, pn)) return false;
        const bool sw = (pn == 4 || pn == 6);
        u.pm = pm; u.pn = pn; u.e = sw ? 1 : 0; u.j0 = 0;
        const char* ht = H + (size_t)pm * 256 * 1024; const char* wt = W + (size_t)pn * 256 * 1024;
        u.a = sw ? wt : ht; u.b = sw ? ht : wt; return true;
    }
    DI unsigned arow(const g8::GU&, int) const { return 0u; }
};
struct EpiIn {
    CParams* pp; int l;
    DI void operator()(const f32x4 (&acc)[2][2][4][2], const g8::GU& u, int wr, int wc, int fr, int fq) const {
        CParams& p = *pp;
        if (u.e) {
            bf16_t* dst = (u.pn == 4) ? p.Vdt : p.Vht;
            const int m0 = u.pm * 256, b = m0 / TP, t0 = m0 - b * TP;
#pragma unroll
            for (int ai = 0; ai < 2; ++ai)
#pragma unroll
                for (int bj = 0; bj < 2; ++bj)
#pragma unroll
                    for (int m = 0; m < 4; ++m)
#pragma unroll
                        for (int n = 0; n < 2; ++n) {
                            const int f = 128 * ai + 64 * wr + 16 * m + fr, t = t0 + 128 * bj + 32 * wc + 16 * n + 4 * fq;
                            store4_bf16(dst + ((size_t)(b * 256 + f)) * TP + t, acc[ai][bj][m][n]);
                        }
        } else {
            inproj_half<0>(p, l, 2 * u.pn, acc, u.pm * 256 + 64 * wr + fr, u.pn * 256 + 32 * wc + 4 * fq, fq);
            inproj_half<1>(p, l, 2 * u.pn + 1, acc, u.pm * 256 + 64 * wr + fr, u.pn * 256 + 128 + 32 * wc + 4 * fq, fq);
        }
    }
};
DI void phase_inproj(CParams& p, int l, char* lds) {
    SchedIn S; S.H = (const char*)p.H8; S.W = (const char*)p.WinT + (size_t)l * NINP * DM;
    EpiIn E; E.pp = &p; E.l = l;
    g8::gemm8<EpiIn, SchedIn, false, true, true>(lds, DM, nullptr, S, E, 0x7a7a7a7au);
}

DI void phase_sgu_prep(CParams& p, int l, char* lds) {
    const int tid = otid(), wid = tid >> 6, lane = tid & 63, fr = lane & 15, fq = lane >> 4;
    constexpr int U_SGU = (MR / 128) * 4, U_PREP = MR / 64;
    float* stats = (float*)(lds + 16384);
    for (int u = blockIdx.x; u < U_SGU + U_PREP; u += gridDim.x) {
        if (u < U_SGU) {
            const int ch = u >> 2, g = u & 3, row0 = ch * 128;
            __syncthreads();
#pragma unroll 1
            for (int i = 0; i < 16; ++i) {
                const int r = wid * 16 + i;
                const u32x2 w = *(const u32x2*)(p.Puv + (size_t)(row0 + r) * 512 + 256 + lane * 4);
                const float a0 = lo2f(w.x), a1 = hi2f(w.x), a2 = lo2f(w.y), a3 = hi2f(w.y);
                const float mean = wave_sum((a0 + a1) + (a2 + a3)) * (1.f / 256.f);
                const float d0 = a0 - mean, d1 = a1 - mean, d2 = a2 - mean, d3 = a3 - mean;
                const float var = wave_sum((d0 * d0 + d1 * d1) + (d2 * d2 + d3 * d3)) * (1.f / 256.f);
                if (lane == 0) { stats[r * 2] = mean; stats[r * 2 + 1] = rsqrtf(var + LN_EPS); }
            }
            __syncthreads();
            {
                const int s = tid >> 2, c0 = (tid & 3) * 16;
                const float mean = stats[s * 2], rstd = stats[s * 2 + 1];
                const bf16_t* src = p.Puv + (size_t)(row0 + s) * 512 + 256 + g * 64 + c0;
                const u32x4 w0 = *(const u32x4*)src, w1 = *(const u32x4*)(src + 8);
                const unsigned ww[8] = {w0.x, w0.y, w0.z, w0.w, w1.x, w1.y, w1.z, w1.w};
                const float* lw = p.sgu_ln_w + l * 256 + g * 64 + c0; const float* lb = p.sgu_ln_b + l * 256 + g * 64 + c0;
#pragma unroll
                for (int j = 0; j < 16; ++j) {
                    const float xv = (j & 1) ? hi2f(ww[j >> 1]) : lo2f(ww[j >> 1]);
                    const float y = (xv - mean) * rstd * lw[j] + lb[j];
                    const int c = c0 + j;
                    const unsigned pk = pk2(y, 0.f);
                    *(bf16_t*)(lds + c * 256 + ((((s >> 3) ^ (c & 15)) << 4) | ((s & 7) * 2))) = (bf16_t)(pk & 0xffffu);
                }
            }
            __syncthreads();
            f32x4 acc[4];
#pragma unroll
            for (int ni = 0; ni < 4; ++ni) acc[ni] = zero4();
            const float* Wg = p.sgu_w + ((size_t)(l * 4 + g) * 128 + wid * 16 + fr) * 128;
#pragma unroll
            for (int ks = 0; ks < 4; ++ks) {
                const f32x4 a0 = *(const f32x4*)(Wg + ks * 32 + fq * 8), a1 = *(const f32x4*)(Wg + ks * 32 + fq * 8 + 4);
                const float av[8] = {a0[0], a0[1], a0[2], a0[3], a1[0], a1[1], a1[2], a1[3]};
                const bf16x8 af = pack8(av);
#pragma unroll
                for (int ni = 0; ni < 4; ++ni) {
                    const int c = ni * 16 + fr;
                    const bf16x8 bfr = *(const bf16x8*)(lds + c * 256 + (((ks * 4 + fq) ^ (c & 15)) << 4));
                    acc[ni] = MFMA16(bfr, af, acc[ni]);
                }
            }
            const int t = wid * 16 + fr, row = row0 + t;
            const float bs = p.sgu_b[(l * 4 + g) * 128 + t];
#pragma unroll
            for (int ni = 0; ni < 4; ++ni) {
                const int c = g * 64 + ni * 16 + fq * 4;
                const u32x2 w = *(const u32x2*)(p.Puv + (size_t)row * 512 + c);
                f32x4 o;
                o[0] = (acc[ni][0] + bs) * lo2f(w.x); o[1] = (acc[ni][1] + bs) * hi2f(w.x);
                o[2] = (acc[ni][2] + bs) * lo2f(w.y); o[3] = (acc[ni][3] + bs) * hi2f(w.y);
                store4_bf16(p.O + (size_t)row * DM + c, o);
            }
        } else {
            const int rbase = (u - U_SGU) * 64 + wid * 8;
#pragma unroll 1
            for (int i = 0; i < 8; ++i) {
                const int row = rbase + i;
                const u32x2 wq = *(const u32x2*)(p.Cq + (size_t)row * 256 + lane * 4);
                const unsigned wk = *(const unsigned*)(p.Ckv + (size_t)row * 128 + lane * 2);
                const float q0 = lo2f(wq.x), q1 = hi2f(wq.x), q2 = lo2f(wq.y), q3 = hi2f(wq.y), k0 = lo2f(wk), k1 = hi2f(wk);
                const float sq = wave_sum((q0 * q0 + q1 * q1) + (q2 * q2 + q3 * q3));
                const float sk = wave_sum(k0 * k0 + k1 * k1);
                if (lane == 0) { p.RS[row * 2] = rsqrtf(sq * (1.f / 256.f) + LN_EPS); p.RS[row * 2 + 1] = rsqrtf(sk * (1.f / 128.f) + LN_EPS); }
            }
        }
    }
}

DI void hgrn_h1_unit(CParams& p, int wu, int lane) {
    const int c = wu % NCH; int t = wu / NCH; const int dir = t & 1, h = (t >> 1) & 3, b = t >> 3;
    const int row0 = b * TP + c * 32, hh = lane >> 5, l31 = lane & 31;
    const bf16_t* Lf = p.Lf + ((size_t)dir * MR + row0) * 256 + h * 64;
    bf16x8 Bf[2][2];
    float* decp = p.DEC + (size_t)wu * 64;
#pragma unroll
    for (int kt = 0; kt < 2; ++kt) {
        const int k = kt * 32 + l31;
        float lf[32], kd[32];
#pragma unroll
        for (int j = 0; j < 32; ++j) lf[j] = bf2f(Lf[(size_t)j * 256 + k]);
        float tot = 0.f;
#pragma unroll
        for (int j = 0; j < 32; ++j) tot += lf[j];
        float run = 0.f;
        if (dir == 0) {
#pragma unroll
            for (int j = 0; j < 32; ++j) { run += lf[j]; kd[j] = (1.0f - __expf(lf[j])) * __expf(tot - run); }
        } else {
#pragma unroll
            for (int j = 31; j >= 0; --j) { run += lf[j]; kd[j] = (1.0f - __expf(lf[j])) * __expf(tot - run); }
        }
        if (hh == 0) decp[k] = __expf(tot);
#pragma unroll
        for (int s = 0; s < 2; ++s) {
            float v8[8];
#pragma unroll
            for (int jj = 0; jj < 8; ++jj) v8[jj] = hh ? kd[16 * s + 8 + jj] : kd[16 * s + jj];
            Bf[kt][s] = pack8(v8);
        }
    }
    const bf16_t* Vt = p.Vht + ((size_t)(b * 4 + h) * 64) * TP + c * 32;
    bf16_t* dst = p.DST + (size_t)wu * 4096;
#pragma unroll
    for (int vt = 0; vt < 2; ++vt) {
        bf16x8 Af[2];
#pragma unroll
        for (int s = 0; s < 2; ++s) Af[s] = *(const bf16x8*)(Vt + (size_t)(vt * 32 + l31) * TP + 16 * s + 8 * hh);
#pragma unroll
        for (int kt = 0; kt < 2; ++kt) {
            f32x16 d;
#pragma unroll
            for (int i = 0; i < 16; ++i) d[i] = zf();
            d = MFMA32(Af[0], Bf[kt][0], d);
            d = MFMA32(Af[1], Bf[kt][1], d);
#pragma unroll
            for (int r = 0; r < 16; ++r) dst[(vt * 32 + crow(r, hh)) * 64 + kt * 32 + l31] = (bf16_t)(pk2(d[r], 0.f) & 0xffffu);
        }
    }
}

DI void phase_upproj_h1(CParams& p, int l, char* lds) {
    const int tid = otid(), wid = tid >> 6, lane = tid & 63, wr = wid >> 1, wc = wid & 1, fr = lane & 15, fq = lane >> 4;
    constexpr int U_Q = (MR / 256) * 3, U_KV = (MR / 256) * 4, U_H1 = NB * 4 * 2 * NCH / 8;
    for (int u = blockIdx.x; u < U_Q + U_KV + U_H1; u += gridDim.x) {
        if (u < U_Q) {
            const int mt = u / 3, nt = u % 3, m0 = mt * 256, n0 = nt * 128;
            const bf16_t* pa[4]; const bf16_t* pb[2];
            gemm_ptrs(p.Cq, 256, m0, p.WuqT + (size_t)l * 384 * 256, 256, n0, pa, pb);
            f32x4 acc[4][4];
            gemm_core<0>(pa, pb, 256, lds, acc);
            float rsq[4];
#pragma unroll
            for (int mi = 0; mi < 4; ++mi) rsq[mi] = p.RS[(m0 + wr * 64 + mi * 16 + fr) * 2] * (0.10206207261596577f * LOG2E);
#pragma unroll
            for (int mi = 0; mi < 4; ++mi)
#pragma unroll
                for (int ni = 0; ni < 4; ++ni) {
                    const int row = m0 + wr * 64 + mi * 16 + fr, col = n0 + wc * 64 + ni * 16 + fq * 4;
                    f32x4 v = acc[mi][ni] * rsq[mi];
                    const int cm = col % 96;
                    const f32x4 vr = rope_tile(p, v, row, (cm >> 4) & 1, fq);
                    if (cm >= 64) v = vr;
                    store4_bf16(p.Qm + (size_t)row * 384 + col, v);
                }
        } else if (u < U_Q + U_KV) {
            const int uu = u - U_Q, mt = uu >> 2, nt = uu & 3, m0 = mt * 256, n0 = nt * 128;
            const bf16_t* pa[4]; const bf16_t* pb[2];
            gemm_ptrs(p.Ckv, 128, m0, p.WukvT + (size_t)l * 512 * 128, 128, n0, pa, pb);
            f32x4 acc[4][4];
            if (nt < 2) {
                gemm_core<0>(pa, pb, 128, lds, acc);
                float rsk[4];
#pragma unroll
                for (int mi = 0; mi < 4; ++mi) rsk[mi] = p.RS[(m0 + wr * 64 + mi * 16 + fr) * 2 + 1];
#pragma unroll
                for (int mi = 0; mi < 4; ++mi)
#pragma unroll
                    for (int ni = 0; ni < 4; ++ni) {
                        const int row = m0 + wr * 64 + mi * 16 + fr, col = n0 + wc * 64 + ni * 16 + fq * 4;
                        store4_bf16(p.Kn + (size_t)row * 256 + col, acc[mi][ni] * rsk[mi]);
                    }
            } else {
                gemm_core<1>(pa, pb, 128, lds, acc);
                const int b = m0 / TP, t0 = m0 - b * TP;
                f32x4 rsv[4];
#pragma unroll
                for (int mi = 0; mi < 4; ++mi) { const int rl = m0 + wr * 64 + mi * 16 + fq * 4; rsv[mi] = (f32x4){p.RS[rl * 2 + 1], p.RS[(rl + 1) * 2 + 1], p.RS[(rl + 2) * 2 + 1], p.RS[(rl + 3) * 2 + 1]}; }
#pragma unroll
                for (int mi = 0; mi < 4; ++mi)
#pragma unroll
                    for (int ni = 0; ni < 4; ++ni) {
                        const int f = n0 - 256 + wc * 64 + ni * 16 + fr;
                        const int rl = wr * 64 + mi * 16 + fq * 4;
                        store4_bf16(p.Vmt + ((size_t)(b * 256 + f)) * TP + t0 + rl, acc[mi][ni] * rsv[mi]);
                    }
            }
        } else {
            hgrn_h1_unit(p, (u - U_Q - U_KV) * 8 + wid, lane);
        }
    }
}

DI void hgrn_h2_unit(CParams& p, int cu  ) {
    const int tid = otid();
    if (tid >= 256) return;
    const int gid = cu * 256 + tid;
    const int seq = gid >> 10, e4 = gid & 1023;
    const int dir = seq & 1, k4 = (e4 & 15) * 4;
    f32x4 st = zero4();
    for (int t0 = 0; t0 < NCH; t0 += 8) {
        f32x4 ds[8], dc[8]; bf16_t* ptr[8];
#pragma unroll
        for (int j = 0; j < 8; ++j) {
            const int t = t0 + j, pc = dir == 0 ? t : (t < 8 ? 7 - t : 143 - t);
            ptr[j] = p.DST + ((size_t)(seq * NCH + pc)) * 4096 + e4 * 4;
            const u32x2 w = *(const u32x2*)ptr[j];
            ds[j] = (f32x4){lo2f(w.x), hi2f(w.x), lo2f(w.y), hi2f(w.y)};
            dc[j] = *(const f32x4*)(p.DEC + (size_t)(seq * NCH + pc) * 64 + k4);
        }
#pragma unroll
        for (int j = 0; j < 8; ++j) { store4_bf16(ptr[j], st); st = dc[j] * st + ds[j]; }
    }
}

DI void hgrn_h3_unit(CParams& p, int l, int wu, int lane, char* wl) {
    const int pc = wu % NCH; const int t_ = wu / NCH; const int h = t_ & 3, b = t_ >> 2;
    const int row0 = b * TP + pc * 32, hh = lane >> 5, i = lane & 31;
    float* Bl = (float*)wl;
    f32x16 Y[2];
    { const float z = zf();
#pragma unroll
    for (int r = 0; r < 16; ++r) { Y[0][r] = z; Y[1][r] = z; } }
#pragma unroll 1
    for (int dir = 0; dir < 2; ++dir) {
        const bf16_t* Lf = p.Lf + ((size_t)dir * MR + row0) * 256 + h * 64;
        {
            float lf[32];
#pragma unroll
            for (int j = 0; j < 32; ++j) lf[j] = bf2f(Lf[(size_t)j * 256 + lane]);
            float run = 0.f;
            if (dir == 0) {
#pragma unroll
                for (int j = 0; j < 32; ++j) { run += lf[j]; Bl[j * 68 + lane] = run; }
            } else {
#pragma unroll
                for (int j = 31; j >= 0; --j) { run += lf[j]; Bl[j * 68 + lane] = run; }
            }
        }
        __syncthreads();
        bf16x8 Qf[4], Kf[4];
#pragma unroll
        for (int s = 0; s < 4; ++s) {
            const int kb = 16 * s + 8 * hh;
            const u32x4 qw = *(const u32x4*)(p.Hq + (size_t)(row0 + i) * 256 + h * 64 + kb);
            const u32x4 fw = *(const u32x4*)(Lf + (size_t)i * 256 + kb);
            const f32x4 b0 = *(const f32x4*)(Bl + i * 68 + kb), b1 = *(const f32x4*)(Bl + i * 68 + kb + 4);
            const float bb[8] = {b0[0], b0[1], b0[2], b0[3], b1[0], b1[1], b1[2], b1[3]};
            const unsigned qq[4] = {qw.x, qw.y, qw.z, qw.w}, ff[4] = {fw.x, fw.y, fw.z, fw.w};
            float qd[8], kd[8];
#pragma unroll
            for (int j = 0; j < 8; ++j) {
                const float qv = (j & 1) ? hi2f(qq[j >> 1]) : lo2f(qq[j >> 1]);
                const float fv = (j & 1) ? hi2f(ff[j >> 1]) : lo2f(ff[j >> 1]);
                qd[j] = qv * __expf(bb[j]);
                kd[j] = (1.0f - __expf(fv)) * __expf(-bb[j]);
            }
            Qf[s] = pack8(qd); Kf[s] = pack8(kd);
        }
        f32x16 X;
#pragma unroll
        for (int r = 0; r < 16; ++r) X[r] = zf();
#pragma unroll
        for (int s = 0; s < 4; ++s) X = MFMA32(Kf[s], Qf[s], X);
#pragma unroll
        for (int r = 0; r < 16; ++r) { const int j = crow(r, hh); const bool keep = dir == 0 ? (j <= i) : (j >= i); X[r] = keep ? X[r] : 0.f; }
        bf16x8 Xs[2];
#pragma unroll
        for (int s = 0; s < 2; ++s) { const float v8[8] = {X[8 * s], X[8 * s + 1], X[8 * s + 2], X[8 * s + 3], X[8 * s + 4], X[8 * s + 5], X[8 * s + 6], X[8 * s + 7]}; Xs[s] = pack8(v8); }
        const bf16_t* Vt = p.Vht + ((size_t)(b * 4 + h) * 64) * TP + pc * 32;
        const bf16_t* ST = p.DST + ((size_t)(((b * 4 + h) * 2 + dir) * NCH + pc)) * 4096;
#pragma unroll
        for (int vt = 0; vt < 2; ++vt) {
            const bf16_t* vrow = Vt + (size_t)(vt * 32 + i) * TP;
#pragma unroll
            for (int s = 0; s < 2; ++s) {
                const u32x2 lo = *(const u32x2*)(vrow + 16 * s + 4 * hh), hi = *(const u32x2*)(vrow + 16 * s + 8 + 4 * hh);
                u32x4 w; w.x = lo.x; w.y = lo.y; w.z = hi.x; w.w = hi.y;
                Y[vt] = MFMA32(__builtin_bit_cast(bf16x8, w), Xs[s], Y[vt]);
            }
            const bf16_t* srow = ST + (vt * 32 + i) * 64;
#pragma unroll
            for (int s = 0; s < 4; ++s) {
                Y[vt] = MFMA32(*(const bf16x8*)(srow + 16 * s + 8 * hh), Qf[s], Y[vt]);
            }
        }
        __syncthreads();
    }
    float ss = 0.f;
#pragma unroll
    for (int r = 0; r < 16; ++r) ss += Y[0][r] * Y[0][r] + Y[1][r] * Y[1][r];
    ss = xsum32(ss);
    const float rs = rsqrtf(ss * (1.f / 64.f) + LN_EPS);
    const int row = row0 + i;
#pragma unroll
    for (int vt = 0; vt < 2; ++vt)
#pragma unroll
        for (int g4 = 0; g4 < 4; ++g4) {
            const int v0 = vt * 32 + 8 * g4 + 4 * hh;
            const f32x4 nw = *(const f32x4*)(p.hgrn_norm_w + l * 64 + v0);
            const u32x2 gw = *(const u32x2*)(p.Hg + (size_t)row * 256 + h * 64 + v0);
            f32x4 o;
            o[0] = Y[vt][g4 * 4 + 0] * rs * nw[0] * lo2f(gw.x); o[1] = Y[vt][g4 * 4 + 1] * rs * nw[1] * hi2f(gw.x);
            o[2] = Y[vt][g4 * 4 + 2] * rs * nw[2] * lo2f(gw.y); o[3] = Y[vt][g4 * 4 + 3] * rs * nw[3] * hi2f(gw.y);
            store4_bf16(p.O + (size_t)row * DM + 512 + h * 64 + v0, o);
        }
}

template <bool DIFF>
DI void attn_unit(CParams& p, int l, int b, int h, int qrow0  , int nkt  , char* lds) {
    const int tid = otid(), wid = tid >> 6, lane = tid & 63, hh = lane >> 5, q31 = lane & 31;
    constexpr int NS = DIFF ? 2 : 1;
    constexpr int NQF = DIFF ? 4 : 6;
    constexpr int BUF = 8192 + 8192 + (DIFF ? 0 : 4096);
    const int qrow = qrow0 + wid * 32 + q31;
    bf16x8 Qf[NQF];
    {
        const bf16_t* qp = DIFF ? p.Qd + (size_t)qrow * 256 + h * 64 : p.Qm + (size_t)qrow * 384 + h * 96;
#pragma unroll
        for (int s = 0; s < NQF; ++s) Qf[s] = *(const bf16x8*)(qp + 16 * s + 8 * hh);
    }
    const size_t krow0 = (size_t)b * TP;
    const bf16_t* kptr = (DIFF ? p.Kd : p.Kn) + (krow0 + (tid >> 3)) * 256 + h * 64 + (tid & 7) * 8;
    const bf16_t* vptr = (DIFF ? p.Vdt : p.Vmt) + ((size_t)(b * 4 + h) * 64 + (tid >> 3)) * TP + (tid & 7) * 8;
    const bf16_t* rptr = p.Kr + (krow0 + ((tid & 255) >> 2)) * 32 + (tid & 3) * 8;
    const int key_w = tid >> 3, c_w = tid & 7;
    const int kwoff = key_w * 128 + ((c_w ^ ((key_w >> 1) & 7)) << 4);
    const int d_w = tid >> 3;
    const int vwoff0 = 8192 + d_w * 128 + (((2 * c_w) ^ ((d_w >> 1) & 15)) << 3), vwoff1 = 8192 + d_w * 128 + (((2 * c_w + 1) ^ ((d_w >> 1) & 15)) << 3);
    const int rkey = (tid & 255) >> 2, rc = tid & 3;
    const int rwoff = 16384 + rkey * 64 + ((rc ^ ((rkey >> 2) & 3)) << 4);
    const int krd = q31 * 128, ksw = (q31 >> 1) & 7;
    const int rrd = 16384 + q31 * 64, rsw = (q31 >> 2) & 3;
    const int vrd = 8192 + q31 * 128, vsw = (q31 >> 1) & 15;
    f32x16 ot[NS][2];
    float m[NS], lsum[NS];
#pragma unroll
    for (int a = 0; a < NS; ++a) { m[a] = 0.f; lsum[a] = 0.f;
#pragma unroll
        for (int r = 0; r < 16; ++r) { ot[a][0][r] = zf(); ot[a][1][r] = zf(); } }
    u32x4 rk, rv, rr;
    rk = *(const u32x4*)kptr; rv = *(const u32x4*)vptr;
    if (!DIFF) { if (tid < 256) rr = *(const u32x4*)rptr; }
    __syncthreads();
    *(u32x4*)(lds + kwoff) = rk;
    *(u32x2*)(lds + vwoff0) = (u32x2){rv.x, rv.y}; *(u32x2*)(lds + vwoff1) = (u32x2){rv.z, rv.w};
    if (!DIFF) { if (tid < 256) *(u32x4*)(lds + rwoff) = rr; }
    __syncthreads();
    for (int kt = 0; kt < nkt; ++kt) {
        const char* cur = lds + (kt & 1) * BUF;
        const bool more = kt + 1 < nkt;
        if (more) {
            rk = *(const u32x4*)(kptr + (size_t)(kt + 1) * 64 * 256);
            rv = *(const u32x4*)(vptr + (kt + 1) * 64);
            if (!DIFF) { if (tid < 256) rr = *(const u32x4*)(rptr + (size_t)(kt + 1) * 64 * 32); }
        }
        bf16x8 Pf[NS][2][2];
#pragma unroll
        for (int a = 0; a < NS; ++a) {
            f32x16 st[2];
            const float negm = -m[a];
            constexpr int NKF = DIFF ? 2 : 6;
            bf16x8 kf[2][NKF];
#pragma unroll
            for (int t = 0; t < 2; ++t) {
                if (DIFF) {
#pragma unroll
                    for (int s = 0; s < 2; ++s) kf[t][s] = *(const bf16x8*)(cur + t * 4096 + krd + (((4 * a + 2 * s + hh) ^ ksw) << 4));
                } else {
#pragma unroll
                    for (int s = 0; s < 4; ++s) kf[t][s] = *(const bf16x8*)(cur + t * 4096 + krd + (((2 * s + hh) ^ ksw) << 4));
#pragma unroll
                    for (int s = 0; s < 2; ++s) kf[t][4 + s] = *(const bf16x8*)(cur + t * 2048 + rrd + (((2 * s + hh) ^ rsw) << 4));
                }
            }
            __builtin_amdgcn_sched_barrier(0);
#pragma unroll
            for (int t = 0; t < 2; ++t) {
                f32x16 acc;
#pragma unroll
                for (int r = 0; r < 16; ++r) acc[r] = negm;
#pragma unroll
                for (int s = 0; s < NKF; ++s) acc = MFMA32(kf[t][s], Qf[DIFF ? 2 * a + s : s], acc);
                st[t] = acc;
            }
            float tm = fmaxf(fmaxf(st[0][0], st[0][1]), st[0][2]);
#pragma unroll
            for (int r = 3; r < 15; r += 2) tm = fmaxf(fmaxf(tm, st[0][r]), st[0][r + 1]);
            tm = fmaxf(tm, st[0][15]);
#pragma unroll
            for (int r = 0; r < 16; r += 2) tm = fmaxf(fmaxf(tm, st[1][r]), st[1][r + 1]);
            { const auto sw = __builtin_amdgcn_permlane32_swap(__float_as_uint(tm), __float_as_uint(tm), false, false); tm = fmaxf(__uint_as_float(sw[0]), __uint_as_float(sw[1])); }
            if (kt == 0 || __any(tm > 8.0f)) {
                const float delta = kt == 0 ? tm : fmaxf(tm, 0.f);
                const float alpha = __builtin_amdgcn_exp2f(-delta);
                m[a] += delta; lsum[a] *= alpha;
#pragma unroll
                for (int r = 0; r < 16; ++r) { st[0][r] -= delta; st[1][r] -= delta; ot[a][0][r] *= alpha; ot[a][1][r] *= alpha; }
            }
            float ps = 0.f;
#pragma unroll
            for (int t = 0; t < 2; ++t) {
#pragma unroll
                for (int r = 0; r < 16; ++r) { const float e = __builtin_amdgcn_exp2f(st[t][r]); st[t][r] = e; ps += e; }
#pragma unroll
                for (int s = 0; s < 2; ++s) {
                    const float v8[8] = {st[t][8 * s], st[t][8 * s + 1], st[t][8 * s + 2], st[t][8 * s + 3], st[t][8 * s + 4], st[t][8 * s + 5], st[t][8 * s + 6], st[t][8 * s + 7]};
                    Pf[a][t][s] = pack8(v8);
                }
            }
            lsum[a] += ps;
            if (DIFF) __builtin_amdgcn_sched_barrier(0);
        }
#pragma unroll
        for (int dt = 0; dt < 2; ++dt) {
            bf16x8 vf[2][2];
#pragma unroll
            for (int t = 0; t < 2; ++t)
#pragma unroll
                for (int s = 0; s < 2; ++s) {
                    const int c8 = 8 * t + 4 * s + hh;
                    const u32x2 lo = *(const u32x2*)(cur + dt * 4096 + vrd + ((c8 ^ vsw) << 3));
                    const u32x2 hi = *(const u32x2*)(cur + dt * 4096 + vrd + (((c8 + 2) ^ vsw) << 3));
                    u32x4 w; w.x = lo.x; w.y = lo.y; w.z = hi.x; w.w = hi.y;
                    vf[t][s] = __builtin_bit_cast(bf16x8, w);
                }
            __builtin_amdgcn_sched_barrier(0);
#pragma unroll
            for (int t = 0; t < 2; ++t)
#pragma unroll
                for (int s = 0; s < 2; ++s)
#pragma unroll
                    for (int a = 0; a < NS; ++a) ot[a][dt] = MFMA32(vf[t][s], Pf[a][t][s], ot[a][dt]);
        }
        if (more) {
            char* nxt = lds + ((kt + 1) & 1) * BUF;
            *(u32x4*)(nxt + kwoff) = rk;
            *(u32x2*)(nxt + vwoff0) = (u32x2){rv.x, rv.y}; *(u32x2*)(nxt + vwoff1) = (u32x2){rv.z, rv.w};
            if (!DIFF) { if (tid < 256) *(u32x4*)(nxt + rwoff) = rr; }
        }
        __syncthreads();
    }
    float linv[NS];
#pragma unroll
    for (int a = 0; a < NS; ++a) { const float lt = xsum32(lsum[a]); linv[a] = 1.0f / lt; }
    f32x16 o[2];
    if (DIFF) {
        const float lam = p.lam[l];
#pragma unroll
        for (int dt = 0; dt < 2; ++dt)
#pragma unroll
            for (int r = 0; r < 16; ++r) o[dt][r] = ot[0][dt][r] * linv[0] - lam * (ot[NS - 1][dt][r] * linv[NS - 1]);
        float ss = 0.f;
#pragma unroll
        for (int r = 0; r < 16; ++r) ss += o[0][r] * o[0][r] + o[1][r] * o[1][r];
        ss = xsum32(ss);
        int lz = l; asm volatile("" : "+s"(lz));
        const float lam_init = lz == 0 ? 0.2f : 0.3555090676f;
        const float rs = rsqrtf(ss * (1.f / 64.f) + LN_EPS) * (1.0f - lam_init);
#pragma unroll
        for (int dt = 0; dt < 2; ++dt)
#pragma unroll
            for (int r = 0; r < 16; ++r) o[dt][r] *= rs;
    } else {
#pragma unroll
        for (int dt = 0; dt < 2; ++dt)
#pragma unroll
            for (int r = 0; r < 16; ++r) o[dt][r] = ot[0][dt][r] * linv[0];
    }
    bf16_t* orow = p.O + (size_t)qrow * DM + (DIFF ? 256 : 768) + h * 64;
#pragma unroll
    for (int dt = 0; dt < 2; ++dt)
#pragma unroll
        for (int g4 = 0; g4 < 4; ++g4) {
            const int d0 = dt * 32 + 8 * g4 + 4 * hh;
            f32x4 v = {o[dt][g4 * 4], o[dt][g4 * 4 + 1], o[dt][g4 * 4 + 2], o[dt][g4 * 4 + 3]};
            if (DIFF) { const f32x4 sw = *(const f32x4*)(p.diff_subln_w + l * 64 + d0); v = v * sw; }
            store4_bf16(orow + d0, v);
        }
}

DI void phase_attn_diff_h2(CParams& p, int l, char* lds, bool h2skip) {
    const int G = gridDim.x;
    const int U_H2 = 256, U_LAT = NB * 4 * 16, U_CTX = (l == 0) ? NB * 4 : 0;
    const int total = U_H2 + 2 * U_LAT + 2 * U_CTX;
    for (int u = blockIdx.x; u < total; u += G) {
        if (u < U_H2) { if (!h2skip) hgrn_h2_unit(p, u); continue; }
        int v = u - U_H2; bool diff; int b, h, q0, nkt;
        if (v < 2 * U_LAT) { diff = v < U_LAT; if (!diff) v -= U_LAT; b = v >> 6; h = (v >> 4) & 3; q0 = b * TP + CTX + (v & 15) * 256; nkt = TP / 64; }
        else { v -= 2 * U_LAT; diff = v < U_CTX; if (!diff) v -= U_CTX; b = v >> 2; h = v & 3; q0 = b * TP; nkt = CTX / 64; }
        if (diff) attn_unit<true>(p, l, b, h, q0, nkt, lds); else attn_unit<false>(p, l, b, h, q0, nkt, lds);
    }
}
DI void phase_attn_mla_h3(CParams& p, int l, char* lds) {
    const int tid_ = otid(); const int wid = tid_ >> 6, lane = tid_ & 63;
    const int U_H3 = NB * 4 * NCH / 8;
    for (int u = blockIdx.x; u < U_H3; u += gridDim.x) { __syncthreads(); hgrn_h3_unit(p, l, u * 8 + wid, lane, lds + 65536 + wid * 8704); }
}

struct SchedOut {
    const char* O; const char* W; int l;
    DI bool next(int i, g8::GU& u) const {
        int pm, pn;
        if (l == 0) { if (!g8::order_next(i, MR / 256, 4, pm, pn)) return false; }
        else { if (!g8::order_next(i, NB * 16, 4, pm, pn)) return false; pm = (pm >> 4) * 17 + 1 + (pm & 15); }
        u.pm = pm; u.pn = pn; u.e = 0; u.j0 = 0; u.a = O + (size_t)pm * 256 * 2048; u.b = W + (size_t)pn * 256 * 2048; return true;
    }
    DI unsigned arow(const g8::GU&, int) const { return 0u; }
};
struct EpiOut {
    float* Y;
    DI void operator()(const f32x4 (&acc)[2][2][4][2], const g8::GU& u, int wr, int wc, int fr, int fq) const {
#pragma unroll
        for (int ai = 0; ai < 2; ++ai)
#pragma unroll
            for (int bj = 0; bj < 2; ++bj)
#pragma unroll
                for (int m = 0; m < 4; ++m)
#pragma unroll
                    for (int n = 0; n < 2; ++n) {
                        const int row = u.pm * 256 + 128 * ai + 64 * wr + 16 * m + fr, col = u.pn * 256 + 128 * bj + 32 * wc + 16 * n + 4 * fq;
                        *(f32x4*)(Y + (size_t)row * DM + col) = acc[ai][bj][m][n];
                    }
    }
};
DI void phase_outproj(CParams& p, int l, char* lds) {
    SchedOut S; S.O = (const char*)p.O; S.W = (const char*)(p.WoutT + (size_t)l * DM * DM); S.l = l;
    EpiOut E; E.Y = p.Y;
    g8::gemm8<EpiOut, SchedOut, false>(lds, DM * 2, nullptr, S, E);
}

DI void phase_postmix(CParams& p, int l, char* lds) {
    const int tid = otid(), wid = tid >> 6, lane = tid & 63;
    float* WrT = (float*)lds;
    int* lcnt = (int*)(lds + 131072);
    int* lbase = lcnt + 32;
    unsigned* ent = (unsigned*)(lds + 131072 + 256);
    const int G = gridDim.x, nrb = (MR + G - 1) / G;
    const float* rw = p.router_w + (size_t)l * DM * NE;
    __syncthreads();
    for (int i = tid; i < DM * NE / 4; i += NTHREADS) {
        const f32x4 v = *(const f32x4*)(rw + i * 4);
        const int d = i >> 3, e0 = (i & 7) * 4;
#pragma unroll
        for (int j = 0; j < 4; ++j) WrT[(e0 + j) * DM + d] = v[j];
    }
    if (tid < 32) lcnt[tid] = 0;
    __syncthreads();
    const int rbeg = blockIdx.x * nrb;
    const float* lw = p.ln_mix_w + l * DM; const float* lb = p.ln_mix_b + l * DM;
    for (int i0 = wid * 2; i0 < nrb; i0 += 16) {
        f32x4 v[2][4]; bool act[2];
#pragma unroll
        for (int rr = 0; rr < 2; ++rr) {
            const int i = i0 + rr; int row = rbeg + i;
            act[rr] = (i < nrb) && (row < MR);
            if (!act[rr]) row = rbeg;
            const int t = row % TP;
            if (l == 1 && t < CTX) { if (act[rr] && lane < 4) ent[(i * 4 + lane) * 2] = 0xffffffffu; act[rr] = false; }
            const float* xr = l == 0 ? in_row(p, row) : p.X + (size_t)row * DM;
            const float* yr = p.Y + (size_t)row * DM;
            const float* g1 = mod_vec(p, l, row, 2); const float* sh2 = mod_vec(p, l, row, 3); const float* sc2 = mod_vec(p, l, row, 4);
            float s = 0.f;
#pragma unroll
            for (int j = 0; j < 4; ++j) { const int c = j * 256 + lane * 4; v[rr][j] = *(const f32x4*)(xr + c) * DN_ALPHA + *(const f32x4*)(g1 + c) * *(const f32x4*)(yr + c); s += (v[rr][j][0] + v[rr][j][1]) + (v[rr][j][2] + v[rr][j][3]); }
            float mean = wave_sum(s) * (1.f / DM); float q = 0.f;
#pragma unroll
            for (int j = 0; j < 4; ++j) { v[rr][j] = v[rr][j] - mean; q += (v[rr][j][0] * v[rr][j][0] + v[rr][j][1] * v[rr][j][1]) + (v[rr][j][2] * v[rr][j][2] + v[rr][j][3] * v[rr][j][3]); }
            float rstd = rsqrtf(wave_sum(q) * (1.f / DM) + LN_EPS);
            s = 0.f;
#pragma unroll
            for (int j = 0; j < 4; ++j) { const int c = j * 256 + lane * 4; v[rr][j] = v[rr][j] * rstd * *(const f32x4*)(lw + c) + *(const f32x4*)(lb + c);
                if (act[rr]) *(f32x4*)(p.X + (size_t)row * DM + c) = v[rr][j];
                s += (v[rr][j][0] + v[rr][j][1]) + (v[rr][j][2] + v[rr][j][3]); }
            mean = wave_sum(s) * (1.f / DM); q = 0.f;
#pragma unroll
            for (int j = 0; j < 4; ++j) { v[rr][j] = v[rr][j] - mean; q += (v[rr][j][0] * v[rr][j][0] + v[rr][j][1] * v[rr][j][1]) + (v[rr][j][2] * v[rr][j][2] + v[rr][j][3] * v[rr][j][3]); }
            rstd = rsqrtf(wave_sum(q) * (1.f / DM) + LN_EPS);
#pragma unroll
            for (int j = 0; j < 4; ++j) { const int c = j * 256 + lane * 4; v[rr][j] = v[rr][j] * rstd * (*(const f32x4*)(sc2 + c) + 1.0f) + *(const f32x4*)(sh2 + c);
                if (act[rr]) *(unsigned*)(p.H8 + (size_t)row * DM + c) = pk4_fp8(v[rr][j][0], v[rr][j][1], v[rr][j][2], v[rr][j][3]); }
            __builtin_amdgcn_sched_barrier(0);
        }
        float lq[2][4];
#pragma unroll
        for (int qt = 0; qt < 4; ++qt) {
            float pl[2][8];
#pragma unroll
            for (int e = 0; e < 8; ++e) {
                float a0 = 0.f, a1 = 0.f;
#pragma unroll
                for (int j = 0; j < 4; ++j) {
                    const f32x4 w = *(const f32x4*)(WrT + (qt * 8 + e) * DM + j * 256 + lane * 4);
                    a0 += (v[0][j][0] * w[0] + v[0][j][1] * w[1]) + (v[0][j][2] * w[2] + v[0][j][3] * w[3]);
                    a1 += (v[1][j][0] * w[0] + v[1][j][1] * w[1]) + (v[1][j][2] * w[2] + v[1][j][3] * w[3]);
                }
                pl[0][e] = a0; pl[1][e] = a1;
                if ((e & 3) == 3) __builtin_amdgcn_sched_barrier(0);
            }
#pragma unroll
            for (int rr = 0; rr < 2; ++rr) {
                float r4[4], r2[2];
#pragma unroll
                for (int e = 0; e < 4; ++e) { const bool up = (lane & 4) != 0; const float keep = up ? pl[rr][e + 4] : pl[rr][e]; const float send = up ? pl[rr][e] : pl[rr][e + 4]; r4[e] = keep + dpp<DPP_HM>(send); }
#pragma unroll
                for (int e = 0; e < 2; ++e) { const bool up = (lane & 2) != 0; const float keep = up ? r4[e + 2] : r4[e]; const float send = up ? r4[e] : r4[e + 2]; r2[e] = keep + dpp<DPP_X2>(send); }
                float x1; { const bool up = (lane & 1) != 0; const float keep = up ? r2[1] : r2[0]; const float send = up ? r2[0] : r2[1]; x1 = keep + dpp<DPP_X1>(send); }
                x1 += shx<8>(x1); x1 += shx<16>(x1); x1 = xsum32(x1);
                lq[rr][qt] = x1;
            }
            __builtin_amdgcn_sched_barrier(0);
        }
#pragma unroll
        for (int rr = 0; rr < 2; ++rr) {
            const int i = i0 + rr;
            const int e_me = lane & 31;
            const int qsel = (lane >> 3) & 3;
            float logit = (qsel == 0 ? lq[rr][0] : qsel == 1 ? lq[rr][1] : qsel == 2 ? lq[rr][2] : lq[rr][3]) + p.router_b[l * NE + e_me];
            logit = (logit == logit) ? fminf(fmaxf(logit, -1e30f), 1e30f) : -1e30f;
            int rank = 0;
#pragma unroll
            for (int e = 0; e < 32; ++e) { const float o = rdlane(logit, e); rank += (o > logit || (o == logit && e < e_me)) ? 1 : 0; }
            const float vmax = rdlane(logit, __builtin_amdgcn_readfirstlane(__ffsll((long long)__ballot(rank == 0 && lane < 32)) - 1));
            const float ex = (rank < 4) ? __expf(logit - vmax) : 0.f;
            const float den = wave_sum((lane < 32) ? ex : 0.f);
            if (act[rr] && lane < 32 && rank < 4) {
                const int lp = atomicAdd(&lcnt[e_me], 1);
                ent[(i * 4 + rank) * 2] = (unsigned)e_me | ((unsigned)lp << 8);
                ent[(i * 4 + rank) * 2 + 1] = __float_as_uint(ex / den);
            }
        }
    }
    __syncthreads();
    if (tid < 32) lbase[tid] = (int)atomicAdd(&p.gcnt[l * NE + tid], (unsigned)lcnt[tid]);
    __syncthreads();
    for (int j = tid; j < nrb * 4; j += NTHREADS) {
        const int row = rbeg + (j >> 2);
        if (row >= MR) break;
        const unsigned w = ent[j * 2];
        if (w == 0xffffffffu) continue;
        const int e = w & 255, pos = lbase[e] + (int)(w >> 8);
        p.ltok[(size_t)e * MR + pos] = row;
        p.lgate[(size_t)e * MR + pos] = __uint_as_float(ent[j * 2 + 1]);
        p.rslot[(size_t)row * 4 + (j & 3)] = (e << 24) | pos;
    }
}

DI int moe_prefix(CParams& p, int l, int* tpre  ) {
    __syncthreads();
    if (otid() == 0) {
        int acc = 0;
        for (int e = 0; e < NE; ++e) { tpre[e] = acc; acc += ((int)p.gcnt[l * NE + e] + 255) >> 8; }
        tpre[NE] = acc;
    }
    __syncthreads();
    return tpre[NE];
}
DI int moe_find(const int* tpre, int mt) { int e = 0;
#pragma unroll 1
    for (int j = 0; j < NE; ++j) if (tpre[j + 1] <= mt) e = j + 1;
    return e; }

constexpr int TPRE_OFF = 135168;
struct SchedMoe {
    const int* tpre; const unsigned* cnt; const int* ltok; const char* A; const char* W; int nN; size_t wstride;
    DI bool next(int i, g8::GU& u) const {
        int pm, pn; if (!g8::order_next(i, __builtin_amdgcn_readfirstlane(tpre[NE]), nN, pm, pn)) return false;
        const int e = __builtin_amdgcn_readfirstlane(moe_find(tpre, pm));
        u.pm = pm; u.pn = pn; u.e = e; u.j0 = __builtin_amdgcn_readfirstlane((pm - tpre[e]) * 256);
        u.a = A + (size_t)pm * 256 * 1024; u.b = W + (size_t)e * wstride + (size_t)pn * 256 * 1024; return true;
    }
    DI unsigned arow(const g8::GU& u, int r) const { const int pos = u.j0 + r; return pos < (int)cnt[u.e] ? (unsigned)ltok[(size_t)u.e * MR + pos] : 0u; }
};
struct EpiMoe1 {
    const float* b1; unsigned char* ACT;
    DI void operator()(const f32x4 (&acc)[2][2][4][2], const g8::GU& u, int wr, int wc, int fr, int fq) const {
        const float* bb1 = b1 + (size_t)u.e * 2048 + u.pn * 256 + 32 * wc + 4 * fq;
        f32x4 bias[2][2];
#pragma unroll
        for (int bj = 0; bj < 2; ++bj)
#pragma unroll
            for (int n = 0; n < 2; ++n) bias[bj][n] = *(const f32x4*)(bb1 + 128 * bj + 16 * n);
#pragma unroll
        for (int ai = 0; ai < 2; ++ai)
#pragma unroll
            for (int m = 0; m < 4; ++m) {
                const int rl = 128 * ai + 64 * wr + 16 * m + fr;
                unsigned char* arow_ = ACT + ((size_t)u.pm * 256 + rl) * 1024 + ((u.pn * 256 + 32 * wc + 4 * fq) >> 1);
#pragma unroll
                for (int bj = 0; bj < 2; ++bj)
#pragma unroll
                    for (int n = 0; n < 2; ++n) {
                        const f32x4 hv = acc[ai][bj][m][n] + bias[bj][n];
                        float o[2];
#pragma unroll
                        for (int q = 0; q < 2; ++q) {
                            const float glu = fminf(hv[2 * q], 7.0f), lin = fminf(fmaxf(hv[2 * q + 1], -7.0f), 7.0f);
                            const float sg = __builtin_amdgcn_rcpf(1.0f + __builtin_amdgcn_exp2f(glu * (-1.702f * LOG2E)));
                            o[q] = (glu * sg) * (lin + 1.0f);
                        }
                        *(unsigned short*)(arow_ + 64 * bj + 8 * n) = (unsigned short)(__builtin_amdgcn_cvt_pk_fp8_f32(o[0], o[1], 0, false) & 0xffff);
                    }
            }
    }
};
struct EpiMoe2 {
    const float* b2; const float* lgate; const unsigned* cnt; bf16_t* YS;
    DI void operator()(const f32x4 (&acc)[2][2][4][2], const g8::GU& u, int wr, int wc, int fr, int fq) const {
        const float* bb2 = b2 + (size_t)u.e * DM + u.pn * 256 + 32 * wc + 4 * fq;
        const int cn = (int)cnt[u.e];
        int frz = fr; asm volatile("" : "+v"(frz));
        f32x4 bias[2][2];
#pragma unroll
        for (int bj = 0; bj < 2; ++bj)
#pragma unroll
            for (int n = 0; n < 2; ++n) bias[bj][n] = *(const f32x4*)(bb2 + 128 * bj + 16 * n);
        float gate[2][4];
#pragma unroll
        for (int ai = 0; ai < 2; ++ai)
#pragma unroll
            for (int m = 0; m < 4; ++m) { const int pos = u.j0 + 128 * ai + 64 * wr + 16 * m + frz; gate[ai][m] = pos < cn ? lgate[(size_t)u.e * MR + pos] : 0.f; }
#pragma unroll
        for (int ai = 0; ai < 2; ++ai)
#pragma unroll
            for (int m = 0; m < 4; ++m) {
                const int rl = 128 * ai + 64 * wr + 16 * m + frz;
                bf16_t* yrow = YS + ((size_t)u.pm * 256 + rl) * 1024 + u.pn * 256 + 32 * wc + 4 * fq;
#pragma unroll
                for (int bj = 0; bj < 2; ++bj)
#pragma unroll
                    for (int n = 0; n < 2; ++n) store4_bf16(yrow + 128 * bj + 16 * n, (acc[ai][bj][m][n] + bias[bj][n]) * gate[ai][m]);
            }
    }
};
DI void phase_moe1(CParams& p, int l, char* lds) {
    int* tpre = (int*)(lds + TPRE_OFF);
    moe_prefix(p, l, tpre);
    SchedMoe S; S.tpre = tpre; S.cnt = p.gcnt + l * NE; S.ltok = p.ltok; S.A = nullptr; S.W = (const char*)p.W1T + (size_t)l * NE * 2048 * DM; S.nN = 8; S.wstride = (size_t)2048 * DM;
    EpiMoe1 E; E.b1 = p.b1 + (size_t)l * NE * 2048; E.ACT = (unsigned char*)p.ACT;
    g8::gemm8<EpiMoe1, SchedMoe, true, true>(lds, DM, (const char*)p.H8, S, E, 0x7a7a7a7au);
}
DI void phase_moe2(CParams& p, int l, char* lds) {
    int* tpre = (int*)(lds + TPRE_OFF);
    moe_prefix(p, l, tpre);
    SchedMoe S; S.tpre = tpre; S.cnt = p.gcnt + l * NE; S.ltok = p.ltok; S.A = (const char*)p.ACT; S.W = (const char*)p.W2T + (size_t)l * NE * DM * DM; S.nN = 4; S.wstride = (size_t)DM * DM;
    EpiMoe2 E; E.b2 = p.b2 + (size_t)l * NE * DM; E.lgate = p.lgate; E.cnt = p.gcnt + l * NE; E.YS = p.YS;
    g8::gemm8<EpiMoe2, SchedMoe, false, true>(lds, DM, nullptr, S, E, 0x79797979u);
}

DI void phase_final(CParams& p, int l, char* lds) {
    const int tid = otid(), wid = tid >> 6, lane = tid & 63;
    int* tpre = (int*)(lds + TPRE_OFF);
    moe_prefix(p, l, tpre);
    const float* lw = p.ln_ffn_w + l * DM; const float* lb = p.ln_ffn_b + l * DM;
    const int nrows = l == 1 ? NB * SEQ : MR;
    const int stride = gridDim.x * 8;
    for (int idx0 = blockIdx.x * 8 + wid; idx0 < nrows; idx0 += 2 * stride) {
        int row[2]; bool act[2];
#pragma unroll
        for (int rr = 0; rr < 2; ++rr) {
            int idx = idx0 + rr * stride; act[rr] = idx < nrows; if (!act[rr]) idx = idx0;
            row[rr] = l == 1 ? (idx >> 12) * TP + CTX + (idx & 4095) : idx;
        }
        const bf16_t* ys[2][4];
#pragma unroll
        for (int rr = 0; rr < 2; ++rr)
#pragma unroll
            for (int k = 0; k < 4; ++k) { const int rs = p.rslot[(size_t)row[rr] * 4 + k]; const int e = rs >> 24, pos = rs & 0xffffff; ys[rr][k] = p.YS + ((size_t)tpre[e] * 256 + pos) * 1024; }
        f32x4 v[2][4]; float s[2] = {0.f, 0.f};
#pragma unroll
        for (int rr = 0; rr < 2; ++rr) {
            const float* g2 = mod_vec(p, l, row[rr], 5);
#pragma unroll
            for (int j = 0; j < 4; ++j) {
                const int c = j * 256 + lane * 4;
                f32x4 y = zero4();
#pragma unroll
                for (int k = 0; k < 4; ++k) { const u32x2 w = *(const u32x2*)(ys[rr][k] + c); y[0] += lo2f(w.x); y[1] += hi2f(w.x); y[2] += lo2f(w.y); y[3] += hi2f(w.y); }
                const f32x4 xv = *(const f32x4*)(p.X + (size_t)row[rr] * DM + c), gg = *(const f32x4*)(g2 + c);
                v[rr][j] = xv * DN_ALPHA + gg * y;
                s[rr] += (v[rr][j][0] + v[rr][j][1]) + (v[rr][j][2] + v[rr][j][3]);
            }
        }
#pragma unroll
        for (int rr = 0; rr < 2; ++rr) {
            float mean = wave_sum(s[rr]) * (1.f / DM); float q = 0.f;
#pragma unroll
            for (int j = 0; j < 4; ++j) { v[rr][j] = v[rr][j] - mean; q += (v[rr][j][0] * v[rr][j][0] + v[rr][j][1] * v[rr][j][1]) + (v[rr][j][2] * v[rr][j][2] + v[rr][j][3] * v[rr][j][3]); }
            float rstd = rsqrtf(wave_sum(q) * (1.f / DM) + LN_EPS);
            float s2 = 0.f;
#pragma unroll
            for (int j = 0; j < 4; ++j) {
                const int c = j * 256 + lane * 4;
                v[rr][j] = v[rr][j] * rstd * *(const f32x4*)(lw + c) + *(const f32x4*)(lb + c);
                s2 += (v[rr][j][0] + v[rr][j][1]) + (v[rr][j][2] + v[rr][j][3]);
            }
            if (!act[rr]) continue;
            if (l == 1) {
                const int b = row[rr] / TP, t = row[rr] - b * TP;
                float* o = p.out + ((size_t)b * SEQ + (t - CTX)) * DM;
#pragma unroll
                for (int j = 0; j < 4; ++j) *(f32x4*)(o + j * 256 + lane * 4) = v[rr][j];
            } else {
#pragma unroll
                for (int j = 0; j < 4; ++j) *(f32x4*)(p.X + (size_t)row[rr] * DM + j * 256 + lane * 4) = v[rr][j];
                mean = wave_sum(s2) * (1.f / DM); q = 0.f;
#pragma unroll
                for (int j = 0; j < 4; ++j) { v[rr][j] = v[rr][j] - mean; q += (v[rr][j][0] * v[rr][j][0] + v[rr][j][1] * v[rr][j][1]) + (v[rr][j][2] * v[rr][j][2] + v[rr][j][3] * v[rr][j][3]); }
                rstd = rsqrtf(wave_sum(q) * (1.f / DM) + LN_EPS);
                const float* sh = mod_vec(p, 1, row[rr], 0); const float* sc = mod_vec(p, 1, row[rr], 1);
#pragma unroll
                for (int j = 0; j < 4; ++j) {
                    const int c = j * 256 + lane * 4;
                    const f32x4 h = v[rr][j] * rstd * (*(const f32x4*)(sc + c) + 1.0f) + *(const f32x4*)(sh + c);
                    *(unsigned*)(p.H8 + (size_t)row[rr] * DM + c) = pk4_fp8(h[0], h[1], h[2], h[3]);
                }
            }
        }
    }
}

constexpr int PH_PER_LAYER = 11, N_PHASES = 1 + 2 * PH_PER_LAYER;

__global__ void __launch_bounds__(NTHREADS, 2) mega(Params p_unused, int ph_lo, int ph_hi) {
    extern __shared__ __attribute__((aligned(16))) char smem[];
    CParams* kp0 = (CParams*)__builtin_amdgcn_kernarg_segment_ptr();
    CParams& p = *kp0;
    ((volatile int*)(smem + WVTAB_OFF))[hw_slot()] = (int)(threadIdx.x >> 6);
    __syncthreads();
    const bool fused = (ph_hi - ph_lo) > 1;
    XcdBarrier bar; bar.bar = p.bar; bar.x = 0; bar.st = (volatile LAS unsigned*)(smem + LDS_BYTES - 16);
    if (fused) {
        if (otid() == 0) *(uint4*)(smem + LDS_BYTES - 16) = make_uint4(0u, 0u, 0u, 0u);
        __syncthreads();
        bar = xcd_barrier_post(p.bar, (volatile LAS unsigned*)(smem + LDS_BYTES - 16));
    }
#if MK_DEBUG == 2
#define PH_STAMP(i) if (blockIdx.x == 0 && threadIdx.x == 0) ((unsigned long long*)(p.gcnt + 1024))[(i) + 1] = wall_clock64();
#else
#define PH_STAMP(i)
#endif
#ifndef MK_REP
#define MK_REP 0u
#endif
#define PH(idx, call) do { const int _i = (idx); if (ph_lo <= _i && _i < ph_hi) { CParams* _kp = kp0; asm volatile("" : "+s"(_kp)); CParams& p = *_kp; call; if ((MK_REP >> (_i == 0 ? 0 : 1 + (_i - 1) % 11)) & 1u) { xcd_barrier(bar); h2skip = true; call; h2skip = false; } if (_i + 1 < ph_hi) xcd_barrier(bar); PH_STAMP(_i) } } while (0)
    bool h2skip = false;
    PH_STAMP(-1)
    PH(0, phase_prologue(p, smem));
#pragma unroll 1
    for (int l = 0; l < 2; ++l) {
        const int base = 1 + l * PH_PER_LAYER;
        PH(base + 0, if (l == 0) phase_ln1(p, smem));
        PH(base + 1, phase_inproj(p, l, smem));
        PH(base + 2, phase_sgu_prep(p, l, smem));
        PH(base + 3, phase_upproj_h1(p, l, smem));
        PH(base + 4, phase_attn_diff_h2(p, l, smem, h2skip));
        PH(base + 5, phase_attn_mla_h3(p, l, smem));
        PH(base + 6, phase_outproj(p, l, smem));
        PH(base + 7, phase_postmix(p, l, smem));
        PH(base + 8, phase_moe1(p, l, smem));
        PH(base + 9, phase_moe2(p, l, smem));
        PH(base + 10, phase_final(p, l, smem));
    }
#undef PH
}


#ifndef MK_DEBUG
#define MK_DEBUG 0
#define MK_REP 0u
#endif
#if MK_DEBUG
struct DbgItem { const void* ptr; unsigned long long n; int f32; int ld; int c0; int c1; int mode; int pad; };
struct DbgList { DbgItem it[40]; int count; int pad; };
__global__ void dbg_scan(DbgList L, unsigned* flag) {
    for (int i = 0; i < L.count; ++i) {
        const DbgItem d = L.it[i];
        bool bad = false;
        for (unsigned long long e = (unsigned long long)blockIdx.x * blockDim.x + threadIdx.x; e < d.n; e += (unsigned long long)gridDim.x * blockDim.x) {
            if (d.ld > 0) { const int c = (int)(e % d.ld); if (c < d.c0 || c >= d.c1) continue; }
            if (d.f32) { const unsigned u = ((const unsigned*)d.ptr)[e]; if (((d.mode & 1) && (u & 0x7f800000u) == 0x7f800000u) || ((d.mode & 2) && u == 0xAAAAAAAAu) || ((d.mode & 4) && (u & 0x7f800000u) >= 0x46800000u)) bad = true; }
            else { const unsigned short u = ((const unsigned short*)d.ptr)[e]; if (((d.mode & 1) && (u & 0x7f80u) == 0x7f80u) || ((d.mode & 2) && u == 0xAAAAu) || ((d.mode & 4) && (u & 0x7f80u) >= 0x4680u)) bad = true; }
        }
        if (bad) atomicMin(flag, (unsigned)i);
    }
}
__global__ void dbg_time(float* out, unsigned long long n, const unsigned long long* ts, unsigned maskA, unsigned maskB) {
    float ta = 0.f, tb = 0.f;
    for (int i = 0; i < 23; ++i) { const float d = (float)(ts[i + 1] - ts[i]) * 0.01f; const int cls = i == 0 ? 0 : 1 + (i - 1) % 11; if (maskA >> cls & 1) ta += d; if (maskB >> cls & 1) tb += d; }
    for (unsigned long long e = (unsigned long long)blockIdx.x * blockDim.x + threadIdx.x; e < n; e += (unsigned long long)gridDim.x * blockDim.x) out[e] = e == 0 ? ta : tb;
}
__global__ void dbg_fill(float* out, unsigned long long n, const unsigned* flag, float hostcode) {
    const unsigned f = *flag;
    float v = f < 1000u ? 100.0f * (float)(f + 1u) : 0.0f;
    if (hostcode != 0.f) v = hostcode;
    for (unsigned long long e = (unsigned long long)blockIdx.x * blockDim.x + threadIdx.x; e < n; e += (unsigned long long)gridDim.x * blockDim.x) out[e] = v;
}
#endif

#ifndef MK_MULTI
#define MK_MULTI 0
#endif

extern "C" void kernel_launch(void* const* d_in, const int* in_sizes, int n_in, void* d_out, int out_size, void* d_ws, size_t ws_size, hipStream_t stream) {
    (void)in_sizes; (void)n_in; (void)out_size; (void)ws_size;
    Params p;
    memset(&p, 0, sizeof(p));
    const float* const* in = (const float* const*)d_in;
    p.x = in[0]; p.c = in[1]; p.ctx = in[2]; p.c_ctx = in[3]; p.ada_w = in[4]; p.ada_b = in[5]; p.w_in = in[6]; p.w_out = in[7];
    p.sgu_ln_w = in[8]; p.sgu_ln_b = in[9]; p.sgu_w = in[10]; p.sgu_b = in[11]; p.diff_lambda = in[12]; p.diff_subln_w = in[13];
    p.hgrn_lb = in[14]; p.hgrn_norm_w = in[15]; p.mla_q_norm_w = in[16]; p.mla_w_uq = in[17]; p.mla_kv_norm_w = in[18]; p.mla_w_ukv = in[19];
    p.ln_mix_w = in[20]; p.ln_mix_b = in[21]; p.ln_ffn_w = in[22]; p.ln_ffn_b = in[23]; p.router_w = in[24]; p.router_b = in[25];
    p.w1 = in[26]; p.b1 = in[27]; p.w2 = in[28]; p.b2 = in[29];
    p.out = (float*)d_out;
    char* ws = (char*)d_ws; size_t off = 0;
    auto take = [&](size_t bytes) { char* r = ws + off; off += (bytes + 255) & ~(size_t)255; return r; };
    constexpr size_t CTRL_BYTES = 65536;
    char* ctrl = take(CTRL_BYTES);
    p.bar = (unsigned*)ctrl; p.gcnt = (unsigned*)(ctrl + 16384);
    p.mod = (float*)take((size_t)2 * 9 * 6144 * 4); p.lball = (float*)take(2 * 512 * 4); p.lam = (float*)take(256); p.ropec = (float*)take(512 * 4); p.ropes = (float*)take(512 * 4);
    p.WinT = (bf16_t*)take((size_t)2 * NINP * DM * 2); p.WoutT = (bf16_t*)take((size_t)2 * DM * DM * 2);
    p.WuqT = (bf16_t*)take((size_t)2 * 384 * 256 * 2); p.WukvT = (bf16_t*)take((size_t)2 * 512 * 128 * 2);
    p.W1T = (bf16_t*)take((size_t)2 * NE * 2048 * DM * 2); p.W2T = (bf16_t*)take((size_t)2 * NE * DM * DM * 2);
    p.X = (float*)take((size_t)MR * DM * 4); p.H = (bf16_t*)take((size_t)MR * DM * 2); p.H8 = (unsigned char*)take((size_t)MR * DM);
    p.Puv = (bf16_t*)take((size_t)MR * 512 * 2); p.Qd = (bf16_t*)take((size_t)MR * 256 * 2); p.Kd = (bf16_t*)take((size_t)MR * 256 * 2); p.Vdt = (bf16_t*)take((size_t)MR * 256 * 2);
    p.Hq = (bf16_t*)take((size_t)MR * 256 * 2); p.Vht = (bf16_t*)take((size_t)MR * 256 * 2); p.Lf = (bf16_t*)take((size_t)2 * MR * 256 * 2); p.Hg = (bf16_t*)take((size_t)MR * 256 * 2);
    p.Cq = (bf16_t*)take((size_t)MR * 256 * 2); p.Ckv = (bf16_t*)take((size_t)MR * 128 * 2); p.Kr = (bf16_t*)take((size_t)MR * 32 * 2);
    p.Qm = (bf16_t*)take((size_t)MR * 384 * 2); p.Kn = (bf16_t*)take((size_t)MR * 256 * 2); p.Vmt = (bf16_t*)take((size_t)MR * 256 * 2);
    p.O = (bf16_t*)take((size_t)MR * DM * 2);
    p.RS = (float*)take((size_t)MR * 2 * 4); p.DST = (bf16_t*)take((size_t)NB * 4 * 2 * NCH * 4096 * 2); p.DEC = (float*)take((size_t)NB * 4 * 2 * NCH * 64 * 4);
    p.Y = (float*)take((size_t)MR * DM * 4);
    p.ltok = (int*)take((size_t)NE * MR * 4); p.lgate = (float*)take((size_t)NE * MR * 4); p.rslot = (int*)take((size_t)MR * 4 * 4);
    p.ACT = (bf16_t*)take((size_t)NSLOT * 1024 * 2); p.YS = (bf16_t*)take((size_t)NSLOT * 1024 * 2);

    static int grid = 0;
    if (!grid) {
        int dev = 0, cus = 0, per_cu = 0;
        hipGetDevice(&dev);
        hipDeviceGetAttribute(&cus, hipDeviceAttributeMultiprocessorCount, dev);
        hipFuncSetAttribute((const void*)mega, hipFuncAttributeMaxDynamicSharedMemorySize, LDS_BYTES);
        hipOccupancyMaxActiveBlocksPerMultiprocessor(&per_cu, mega, NTHREADS, LDS_BYTES);
        if (cus <= 0) cus = 256;
        grid = cus * (per_cu < 1 ? 1 : 1);
    }
    hipMemsetAsync(ctrl, 0, CTRL_BYTES, stream);
#if MK_MULTI
#ifndef MK_NPH
#define MK_NPH N_PHASES
#endif
    for (int ph = 0; ph < MK_NPH; ++ph) {
        if (ph == 1 + PH_PER_LAYER) continue;
        hipLaunchKernelGGL(mega, dim3(grid), dim3(NTHREADS), LDS_BYTES, stream, p, ph, ph + 1);
    }
#else
    hipLaunchKernelGGL(mega, dim3(grid), dim3(NTHREADS), LDS_BYTES, stream, p, 0, N_PHASES);
#endif

#if MK_DEBUG == 2
    hipLaunchKernelGGL(dbg_time, dim3(2048), dim3(256), 0, stream, (float*)d_out, (unsigned long long)NB * SEQ * DM, (const unsigned long long*)(p.gcnt + 1024), (unsigned)MK_TMASK_A, (unsigned)MK_TMASK_B);
#elif MK_DEBUG
    {
        DbgList L; memset(&L, 0, sizeof(L));
        int n = 0;
        auto add = [&](const void* ptr, unsigned long long cnt, int f32, int ld = 0, int c0 = 0, int c1 = 0, int mode = 3) { L.it[n].ptr = ptr; L.it[n].n = cnt; L.it[n].f32 = f32; L.it[n].ld = ld; L.it[n].c0 = c0; L.it[n].c1 = c1; L.it[n].mode = mode; ++n; };
        MK_DEBUG_LIST
        L.count = n;
        unsigned* flag = (unsigned*)(ctrl + 32768);
        hipMemsetAsync(flag, 0x7f, 4, stream);
        hipLaunchKernelGGL(dbg_scan, dim3(2048), dim3(256), 0, stream, L, flag);
        hipLaunchKernelGGL(dbg_fill, dim3(2048), dim3(256), 0, stream, (float*)d_out, (unsigned long long)NB * SEQ * DM, (const unsigned*)flag, 0.0f);
    }
#endif
}
```

```cpp
#include <hip/hip_runtime.h>
#include <stdint.h>
#include <string.h>

#define MK_MULTI 0
#define MK_NPH N_PHASES
#define MK_DEBUG 0
#define MK_REP 0u
#define MK_DEBUG_LIST \
  add(p.mod, 2*9*6144, 1,0,0,0,7); add(p.WinT, 2ull*NINP*DM, 0,0,0,0,7); add(p.H, (unsigned long long)MR*DM, 0,0,0,0,7); add(p.Puv, (unsigned long long)MR*512, 0,0,0,0,7); \
  add(p.Cq, (unsigned long long)MR*256, 0,0,0,0,7); add(p.Ckv, (unsigned long long)MR*128, 0,0,0,0,7); add(p.RS, (unsigned long long)MR*2, 1,0,0,0,7); \
  add(p.Kn, (unsigned long long)MR*256, 0,0,0,0,7); add(p.Vmt, (unsigned long long)MR*256, 0,0,0,0,7); \
  add(p.O, (unsigned long long)MR*DM, 0, DM, 0, 256, 1); \
  add(p.Y, (unsigned long long)MR*DM, 1);

#define DI __device__ __forceinline__
typedef unsigned short bf16_t;
typedef short bf16x8 __attribute__((ext_vector_type(8)));
typedef float f32x4 __attribute__((ext_vector_type(4)));
typedef float f32x2 __attribute__((ext_vector_type(2)));
typedef float f32x16 __attribute__((ext_vector_type(16)));
typedef unsigned u32x4 __attribute__((ext_vector_type(4)));
typedef unsigned u32x2 __attribute__((ext_vector_type(2)));

constexpr int DM = 1024, NB = 8, SEQ = 4096, CTX = 256, TP = 4352, MR = NB * TP;
constexpr int NIN = 2976, NINP = 3072;
constexpr int NE = 32;
constexpr int NCH = TP / 32;
constexpr int NSLOT = 147456;
constexpr float LN_EPS = 1e-6f;
constexpr float DN_ALPHA = 1.4142135623730951f;
constexpr float LOG2E = 1.4426950408889634f;
constexpr int NTHREADS = 512;
constexpr int LDS_BYTES = 147456;

#define XB_TMO      128
#define XB_XCNT(j)  (256  + 64 * (j))
#define XB_XSUB(j)  (1280 + 64 * (j))
#define XB_XGEN(j)  (2304 + 64 * (j))
#define XB_TOP      3328
#define XB_TOPGEN   3392
#define XCD_BAR_WORDS 3456
#define XB_SPIN_CAP (1u << 22)
#define LAS __attribute__((address_space(3)))
__device__ __forceinline__ int otid();

DI unsigned xb_ld(unsigned* p)              { return __hip_atomic_load(p, __ATOMIC_RELAXED, __HIP_MEMORY_SCOPE_AGENT); }
DI unsigned xb_add(unsigned* p, unsigned v) { return __hip_atomic_fetch_add(p, v, __ATOMIC_RELAXED, __HIP_MEMORY_SCOPE_AGENT); }
DI unsigned xb_xcc_id() { return (unsigned)__builtin_amdgcn_s_getreg((3 << 11) | 20) & 0xFu; }
#define XB_SPIN(cond, bar) do { unsigned _sp = 0; while (cond) { __builtin_amdgcn_s_sleep(1); \
    if ((++_sp & 255u) == 0u) { if (xb_ld(&(bar)[XB_TMO])) break; if (_sp > XB_SPIN_CAP) { atomicAdd(&(bar)[XB_TMO], 1u); break; } } } } while (0)

struct XcdBarrier { unsigned* bar; unsigned x; volatile LAS unsigned* st; };

DI XcdBarrier xcd_barrier_post(unsigned* bar, volatile LAS unsigned* st) {
    XcdBarrier b; b.bar = bar; b.x = xb_xcc_id(); b.st = st;
    if (otid() == 0) (void)xb_add(&bar[XB_XCNT(b.x)], 1u);
    return b;
}
DI void xcd_barrier_complete(unsigned* bar, unsigned x, unsigned& nloc, unsigned& nx) {
    const unsigned G = gridDim.x * gridDim.y * gridDim.z;
    unsigned sum, cnt, mine, sp = 0u;
    for (;;) {
        sum = 0u; cnt = 0u; mine = 0u;
#pragma unroll
        for (unsigned j = 0; j < 16; ++j) { const unsigned c = xb_ld(&bar[XB_XCNT(j)]); sum += c; cnt += (c > 0u) ? 1u : 0u; mine = (j == x) ? c : mine; }
        if (sum == G) break;
        __builtin_amdgcn_s_sleep(1);
        if ((++sp & 255u) == 0u) { if (xb_ld(&bar[XB_TMO])) break; if (sp > XB_SPIN_CAP) { atomicAdd(&bar[XB_TMO], 1u); break; } }
    }
    nloc = mine > 0u ? mine : 1u; nx = cnt > 0u ? cnt : 1u;
}
DI void xcd_barrier(const XcdBarrier& b) {
    asm volatile("s_waitcnt vmcnt(0)" ::: "memory");
    __syncthreads();
    if (otid() == 0) {
        unsigned* bar = b.bar;
        __builtin_amdgcn_s_waitcnt(0);
        unsigned nloc = b.st[0], nx = b.st[1];
        if (nloc == 0u) { xcd_barrier_complete(bar, b.x, nloc, nx); b.st[0] = nloc; b.st[1] = nx; }
        const unsigned old = xb_add(&bar[XB_XSUB(b.x)], 1u);
        const unsigned gen = old / nloc;
        if (old + 1u == (gen + 1u) * nloc) {
            __builtin_amdgcn_fence(__ATOMIC_RELEASE, "agent");
            asm volatile("s_waitcnt vmcnt(0)" ::: "memory");
            const unsigned og = xb_add(&bar[XB_TOP], 1u);
            const unsigned tg = og / nx;
            if (og + 1u == (tg + 1u) * nx) xb_add(&bar[XB_TOPGEN], 1u);
            else XB_SPIN(xb_ld(&bar[XB_TOPGEN]) == tg, bar);
            __builtin_amdgcn_fence(__ATOMIC_ACQUIRE, "agent");
            xb_add(&bar[XB_XGEN(b.x)], 1u);
            asm volatile("s_waitcnt vmcnt(0)" ::: "memory");
        } else {
            XB_SPIN(xb_ld(&bar[XB_XGEN(b.x)]) == gen, bar);
            __builtin_amdgcn_fence(__ATOMIC_ACQUIRE, "agent");
            asm volatile("s_waitcnt vmcnt(0)" ::: "memory");
        }
    }
    __syncthreads();
}

struct Params {
    const float *x, *c, *ctx, *c_ctx, *ada_w, *ada_b, *w_in, *w_out, *sgu_ln_w, *sgu_ln_b, *sgu_w, *sgu_b,
                *diff_lambda, *diff_subln_w, *hgrn_lb, *hgrn_norm_w, *mla_q_norm_w, *mla_w_uq, *mla_kv_norm_w, *mla_w_ukv,
                *ln_mix_w, *ln_mix_b, *ln_ffn_w, *ln_ffn_b, *router_w, *router_b, *w1, *b1, *w2, *b2;
    float* out;
    unsigned* bar; unsigned* gcnt;
    float *mod, *lball, *lam, *ropec, *ropes;
    bf16_t *WinT, *WoutT, *WuqT, *WukvT, *W1T, *W2T;
    float* X; bf16_t* H; unsigned char* H8;
    bf16_t *Puv, *Qd, *Kd, *Vdt, *Hq, *Vht, *Lf, *Hg, *Cq, *Ckv, *Kr, *Qm, *Kn, *Vmt, *O;
    float *RS, *DEC, *Y; bf16_t* DST;
    int* ltok; float* lgate; int* rslot; bf16_t *ACT, *YS;
};

typedef const __attribute__((address_space(4))) Params CParams;
extern __shared__ __attribute__((aligned(16))) char smem_all[];
constexpr int WVTAB_OFF = 147456 - 16 - 256;
DI int hw_slot() { return (int)(__builtin_amdgcn_s_getreg((6 << 11) | 4) & 63u); }
DI int otid() {
    int l = (int)__builtin_amdgcn_mbcnt_hi(~0u, __builtin_amdgcn_mbcnt_lo(~0u, 0u));
    const int w = __builtin_amdgcn_readfirstlane(((volatile int*)(smem_all + WVTAB_OFF))[hw_slot()]);
    int t = w * 64 + l; asm volatile("" : "+v"(t)); return t;
}
DI float bf2f(bf16_t v) { return __uint_as_float(((unsigned)v) << 16); }
typedef __bf16 bf16x2_t __attribute__((ext_vector_type(2)));
DI unsigned pk2(float lo, float hi) { const bf16x2_t v = {(__bf16)lo, (__bf16)hi}; return __builtin_bit_cast(unsigned, v); }
DI unsigned pk4_fp8(float a, float b, float c, float d) { int w = 0; w = __builtin_amdgcn_cvt_pk_fp8_f32(a, b, w, false); w = __builtin_amdgcn_cvt_pk_fp8_f32(c, d, w, true); return (unsigned)w; }
DI float lo2f(unsigned w) { return __uint_as_float(w << 16); }
DI float hi2f(unsigned w) { return __uint_as_float(w & 0xffff0000u); }
DI bf16x8 pack8(const float (&v)[8]) { u32x4 w; w.x = pk2(v[0], v[1]); w.y = pk2(v[2], v[3]); w.z = pk2(v[4], v[5]); w.w = pk2(v[6], v[7]); return __builtin_bit_cast(bf16x8, w); }
template <int MASK> DI float shx(float v) {
    if (MASK < 32) return __int_as_float(__builtin_amdgcn_ds_swizzle(__float_as_int(v), (MASK << 10) | 0x1f));
    int l = (int)__builtin_amdgcn_mbcnt_hi(~0u, __builtin_amdgcn_mbcnt_lo(~0u, 0u)); asm volatile("" : "+v"(l));
    return __int_as_float(__builtin_amdgcn_ds_bpermute((l ^ 32) << 2, __float_as_int(v)));
}
DI float zf() { float z = 0.f; asm volatile("" : "+v"(z)); return z; }
DI f32x4 zero4() { const float z = zf(); return (f32x4){z, z, z, z}; }
DI float rdlane(float v, int l) { return __int_as_float(__builtin_amdgcn_readlane(__float_as_int(v), l)); }
template <int CTRL> DI float dpp(float v) { return __int_as_float(__builtin_amdgcn_update_dpp(0, __float_as_int(v), CTRL, 0xf, 0xf, false)); }
constexpr int DPP_X1 = 0xB1, DPP_X2 = 0x4E, DPP_HM = 0x141, DPP_RM = 0x140;
DI float xsum32(float v) { const auto sw = __builtin_amdgcn_permlane32_swap(__float_as_uint(v), __float_as_uint(v), false, false); return __uint_as_float(sw[0]) + __uint_as_float(sw[1]); }
DI float xget32(float v, bool lower_half) { const auto sw = __builtin_amdgcn_permlane32_swap(__float_as_uint(v), __float_as_uint(v), false, false); return lower_half ? __uint_as_float(sw[1]) : __uint_as_float(sw[0]); }
DI float wave_sum(float v) { v += dpp<DPP_X1>(v); v += dpp<DPP_X2>(v); v += dpp<DPP_HM>(v); v += dpp<DPP_RM>(v); v += shx<16>(v); return xsum32(v); }
DI float sigmoidf_(float x) { return __builtin_amdgcn_rcpf(1.0f + __builtin_amdgcn_exp2f(-LOG2E * x)); }
DI float geluf_(float v) {
    const float av = fabsf(v), t = __builtin_amdgcn_rcpf(av * 0.2316418882f + 1.0f);
    float q = t * 0.5307027145f + (-0.7265760135f); q = q * t + 0.7107068705f; q = q * t + (-0.142248368f); q = q * t + 0.127414796f; q = q * t;
    const float e = __builtin_amdgcn_exp2f((v * v) * (-0.72134752044f));
    const float m = v * (q * e);
    return v < 0.f ? m : v - m;
}
DI float siluf_(float x) { return x * sigmoidf_(x); }
DI int crow(int r, int hh) { return (r & 3) + 8 * (r >> 2) + 4 * hh; }
#define MFMA16(a, b, c) __builtin_amdgcn_mfma_f32_16x16x32_bf16((a), (b), (c), 0, 0, 0)
#define MFMA32(a, b, c) __builtin_amdgcn_mfma_f32_32x32x16_bf16((a), (b), (c), 0, 0, 0)

DI const float* in_row(CParams& p, int row) {
    const int b = row / TP, t = row - b * TP;
    return t < CTX ? p.ctx + ((size_t)b * CTX + t) * DM : p.x + ((size_t)b * SEQ + (t - CTX)) * DM;
}
DI const float* mod_vec(CParams& p, int l, int row, int j) {
    const int b = row / TP, t = row - b * TP;
    const int r = t < CTX ? 8 : b;
    return p.mod + ((size_t)(l * 9 + r) * 6 + j) * DM;
}

DI void transpose_tile(const float* __restrict__ src, int K, int N, bf16_t* __restrict__ dst, int k0, int n0, const float* __restrict__ kscale, int perm_ukv, char* wl, int lane, float f8scale = 0.f) {
    bf16_t* S = (bf16_t*)wl;
#pragma unroll 4
    for (int it = 0; it < 16; ++it) {
        const int kk = it * 4 + (lane >> 4), nn = (lane & 15) * 4;
        f32x4 v = {0.f, 0.f, 0.f, 0.f};
        if (n0 + nn < N) v = *(const f32x4*)(src + (size_t)(k0 + kk) * N + n0 + nn);
        if (kscale) { const float s = kscale[k0 + kk]; v = v * s; }
        if (f8scale != 0.f) v = v * f8scale;
        unsigned* d = (unsigned*)(S + kk * 66 + nn);
        d[0] = pk2(v[0], v[1]); d[1] = pk2(v[2], v[3]);
    }
    __builtin_amdgcn_fence(__ATOMIC_RELEASE, "workgroup");
    __builtin_amdgcn_wave_barrier();
    __builtin_amdgcn_fence(__ATOMIC_ACQUIRE, "workgroup");
#pragma unroll 2
    for (int it = 0; it < 8; ++it) {
        const int nn = it * 8 + (lane >> 3), kc = lane & 7;
        unsigned short e[8];
#pragma unroll
        for (int j = 0; j < 8; ++j) e[j] = S[(kc * 8 + j) * 66 + nn];
        u32x4 w; w.x = e[0] | ((unsigned)e[1] << 16); w.y = e[2] | ((unsigned)e[3] << 16); w.z = e[4] | ((unsigned)e[5] << 16); w.w = e[6] | ((unsigned)e[7] << 16);
        int n = n0 + nn;
        if (perm_ukv) { const int hh = n >> 7, t = n & 127; n = t < 64 ? hh * 64 + t : 256 + hh * 64 + (t - 64); }
        if (f8scale != 0.f) {
            u32x2 w8; w8.x = pk4_fp8(bf2f(e[0]), bf2f(e[1]), bf2f(e[2]), bf2f(e[3])); w8.y = pk4_fp8(bf2f(e[4]), bf2f(e[5]), bf2f(e[6]), bf2f(e[7]));
            *(u32x2*)((unsigned char*)dst + (size_t)n * K + k0 + kc * 8) = w8;
        } else *(u32x4*)(dst + (size_t)n * K + k0 + kc * 8) = w;
    }
    __builtin_amdgcn_fence(__ATOMIC_RELEASE, "workgroup");
    __builtin_amdgcn_wave_barrier();
}

DI void phase_prologue(CParams& p, char* lds) {
    const int tid = otid(), wid = tid >> 6, lane = tid & 63;
    char* wl = lds + wid * 8704;
    constexpr int T_IN = 16 * 48, T_OUT = 16 * 16, T_UQ = 4 * 6, T_UKV = 2 * 8, T_W1 = 32 * 16 * 32, T_W2 = 32 * 16 * 16;
    constexpr int T_LAYER = T_IN + T_OUT + T_UQ + T_UKV + T_W1 + T_W2;
    constexpr int T_ALL = 2 * T_LAYER;
    constexpr int U_TR = (T_ALL + 7) / 8;
    constexpr int U_GEMV = 2 * 6144 / 64;
    const int nunits = U_GEMV + U_TR + 1;
    for (int u = blockIdx.x; u < nunits; u += gridDim.x) {
        if (u < U_GEMV) {
            const int l = u / 96, n = (u % 96) * 64 + lane;
            const float* W = p.ada_w + (size_t)l * DM * 6144 + (size_t)(wid * 128) * 6144 + n;
            float* sc = (float*)(lds + 73728);
            float* part = (float*)lds;
            __syncthreads();
            for (int i = tid; i < 9 * DM; i += NTHREADS) { const float cv = i < 8 * DM ? p.c[i] : p.c_ctx[i - 8 * DM]; sc[i] = siluf_(cv); }
            __syncthreads();
            float acc[9];
#pragma unroll
            for (int r = 0; r < 9; ++r) acc[r] = 0.f;
#pragma unroll 2
            for (int k = 0; k < 128; k += 4) {
                float w[4];
#pragma unroll
                for (int j = 0; j < 4; ++j) w[j] = W[(size_t)(k + j) * 6144];
#pragma unroll
                for (int r = 0; r < 9; ++r) {
                    const f32x4 cc = *(const f32x4*)(sc + r * DM + wid * 128 + k);
#pragma unroll
                    for (int j = 0; j < 4; ++j) acc[r] += cc[j] * w[j];
                }
            }
#pragma unroll
            for (int r = 0; r < 9; ++r) part[(wid * 9 + r) * 64 + lane] = acc[r];
            __syncthreads();
            for (int i = tid; i < 9 * 64; i += NTHREADS) {
                const int r = i >> 6, c = i & 63;
                float sum = p.ada_b[l * 6144 + (u % 96) * 64 + c];
#pragma unroll
                for (int w8 = 0; w8 < 8; ++w8) sum += part[(w8 * 9 + r) * 64 + c];
                p.mod[(size_t)(l * 9 + r) * 6144 + (u % 96) * 64 + c] = sum;
            }
            __syncthreads();
        } else if (u < U_GEMV + U_TR) {
            int t = (u - U_GEMV) * 8 + wid;
            if (t < T_ALL) {
                const int l = t / T_LAYER; t -= l * T_LAYER;
                if (t < T_IN) { const int kt = t / 48, nt = t % 48;
                    transpose_tile(p.w_in + (size_t)l * DM * NIN, DM, NIN, (bf16_t*)((unsigned char*)p.WinT + (size_t)l * NINP * DM), kt * 64, nt * 64, nullptr, 0, wl, lane, 32.0f);
                } else if ((t -= T_IN) < T_OUT) { const int kt = t / 16, nt = t % 16;
                    transpose_tile(p.w_out + (size_t)l * DM * DM, DM, DM, p.WoutT + (size_t)l * DM * DM, kt * 64, nt * 64, nullptr, 0, wl, lane);
                } else if ((t -= T_OUT) < T_UQ) { const int kt = t / 6, nt = t % 6;
                    transpose_tile(p.mla_w_uq + (size_t)l * 256 * 384, 256, 384, p.WuqT + (size_t)l * 384 * 256, kt * 64, nt * 64, p.mla_q_norm_w + l * 256, 0, wl, lane);
                } else if ((t -= T_UQ) < T_UKV) { const int kt = t / 8, nt = t % 8;
                    transpose_tile(p.mla_w_ukv + (size_t)l * 128 * 512, 128, 512, p.WukvT + (size_t)l * 512 * 128, kt * 64, nt * 64, p.mla_kv_norm_w + l * 128, 1, wl, lane);
                } else if ((t -= T_UKV) < T_W1) { const int e = t / 512, r = t % 512, kt = r / 32, nt = r % 32;
                    transpose_tile(p.w1 + ((size_t)l * NE + e) * DM * 2048, DM, 2048, (bf16_t*)((unsigned char*)p.W1T + ((size_t)l * NE + e) * 2048 * DM), kt * 64, nt * 64, nullptr, 0, wl, lane, 32.0f);
                } else { t -= T_W1; const int e = t / 256, r = t % 256, kt = r / 16, nt = r % 16;
                    transpose_tile(p.w2 + ((size_t)l * NE + e) * DM * DM, DM, DM, (bf16_t*)((unsigned char*)p.W2T + ((size_t)l * NE + e) * DM * DM), kt * 64, nt * 64, nullptr, 0, wl, lane, 64.0f);
                }
            }
        } else {
            if (tid < 512) {
                const int j = tid;
                const float a0 = p.hgrn_lb[j], a1 = p.hgrn_lb[512 + j];
                const float m = fmaxf(a0, a1), e0 = expf(a0 - m), e1 = expf(a1 - m);
                p.lball[j] = 0.f;
                p.lball[512 + j] = e1 / (e0 + e1);
            }
            if (tid < 2) {
                const float* lp = p.diff_lambda + tid * 4 * 32;
                float s01 = 0.f, s23 = 0.f;
                for (int i = 0; i < 32; ++i) { s01 += lp[i] * lp[32 + i]; s23 += lp[64 + i] * lp[96 + i]; }
                const float lam_init = tid == 0 ? 0.2f : 0.3555090676f;
                p.lam[tid] = expf(s01) - expf(s23) + lam_init;
            }
            {
                const int pos = tid >> 3, i = tid & 7;
                const float inv = powf(10000.0f, -(float)(2 * i) / 16.0f);
                float sn, cs; sincosf((float)pos * inv, &sn, &cs);
                p.ropec[tid] = cs; p.ropes[tid] = sn;
            }
        }
    }
}

DI void phase_ln1(CParams& p, char* lds) {
    const int tid = otid(), wid = tid >> 6, lane = tid & 63;
    for (int row = blockIdx.x * 8 + wid; row < MR; row += gridDim.x * 8) {
        const float* xr = in_row(p, row);
        f32x4 v[4]; float s = 0.f;
#pragma unroll
        for (int j = 0; j < 4; ++j) { v[j] = *(const f32x4*)(xr + j * 256 + lane * 4); s += (v[j][0] + v[j][1]) + (v[j][2] + v[j][3]); }
        const float mean = wave_sum(s) * (1.f / DM);
        float q = 0.f;
#pragma unroll
        for (int j = 0; j < 4; ++j) { v[j] = v[j] - mean; q += (v[j][0] * v[j][0] + v[j][1] * v[j][1]) + (v[j][2] * v[j][2] + v[j][3] * v[j][3]); }
        const float rstd = rsqrtf(wave_sum(q) * (1.f / DM) + LN_EPS);
        const float* sh = mod_vec(p, 0, row, 0); const float* sc = mod_vec(p, 0, row, 1);
#pragma unroll
        for (int j = 0; j < 4; ++j) {
            const int c = j * 256 + lane * 4;
            const f32x4 a = *(const f32x4*)(sh + c), b = *(const f32x4*)(sc + c);
            const f32x4 h = v[j] * rstd * (b + 1.0f) + a;
            *(unsigned*)(p.H8 + (size_t)row * DM + c) = pk4_fp8(h[0], h[1], h[2], h[3]);
        }
    }
}

template <int ORI>
DI void gemm_core(const bf16_t* const (&pa)[4], const bf16_t* const (&pb)[2], int K, char* lds, f32x4 (&acc)[4][4]) {
    const int tid = otid(), wid = tid >> 6, lane = tid & 63, wr = wid >> 1, wc = wid & 1, fr = lane & 15, fq = lane >> 4;
    const int sw = ((tid & 7) ^ ((tid >> 4) & 7)) << 4;
    const int offA = (tid >> 3) * 128 + sw, offB = 32768 + (tid >> 3) * 128 + sw;
    const int rdA = (wr * 64 + fr) * 128 + ((fq ^ (fr >> 1)) << 4), rdB = 32768 + (wc * 64 + fr) * 128 + ((fq ^ (fr >> 1)) << 4);
#pragma unroll
    for (int mi = 0; mi < 4; ++mi)
#pragma unroll
        for (int ni = 0; ni < 4; ++ni) acc[mi][ni] = zero4();
    u32x4 ra[4], rb[2];
#pragma unroll
    for (int i = 0; i < 4; ++i) ra[i] = *(const u32x4*)(pa[i]);
#pragma unroll
    for (int j = 0; j < 2; ++j) rb[j] = *(const u32x4*)(pb[j]);
#pragma unroll
    for (int i = 0; i < 4; ++i) *(u32x4*)(lds + offA + i * 8192) = ra[i];
#pragma unroll
    for (int j = 0; j < 2; ++j) *(u32x4*)(lds + offB + j * 8192) = rb[j];
    __syncthreads();
    const int nk = K >> 6;
    for (int kt = 0; kt < nk; ++kt) {
        const char* cur = lds + (kt & 1) * 49152;
        const bool more = kt + 1 < nk;
        if (more) {
#pragma unroll
            for (int i = 0; i < 4; ++i) ra[i] = *(const u32x4*)(pa[i] + (kt + 1) * 64);
#pragma unroll
            for (int j = 0; j < 2; ++j) rb[j] = *(const u32x4*)(pb[j] + (kt + 1) * 64);
        }
#pragma unroll
        for (int kk = 0; kk < 2; ++kk) {
            bf16x8 af[4], bfr[4];
#pragma unroll
            for (int mi = 0; mi < 4; ++mi) af[mi] = *(const bf16x8*)(cur + ((rdA + mi * 2048) ^ (kk * 64)));
#pragma unroll
            for (int ni = 0; ni < 4; ++ni) bfr[ni] = *(const bf16x8*)(cur + ((rdB + ni * 2048) ^ (kk * 64)));
#pragma unroll
            for (int mi = 0; mi < 4; ++mi)
#pragma unroll
                for (int ni = 0; ni < 4; ++ni) {
                    if (ORI == 0) acc[mi][ni] = MFMA16(bfr[ni], af[mi], acc[mi][ni]);
                    else          acc[mi][ni] = MFMA16(af[mi], bfr[ni], acc[mi][ni]);
                }
        }
        if (more) {
            char* nxt = lds + ((kt + 1) & 1) * 49152;
#pragma unroll
            for (int i = 0; i < 4; ++i) *(u32x4*)(nxt + offA + i * 8192) = ra[i];
#pragma unroll
            for (int j = 0; j < 2; ++j) *(u32x4*)(nxt + offB + j * 8192) = rb[j];
        }
        __syncthreads();
    }
}

DI void gemm_ptrs(const bf16_t* A, int lda, int row0, const bf16_t* Bt, int ldb, int n0, const bf16_t* (&pa)[4], const bf16_t* (&pb)[2]) {
    const int tid = otid(), r = tid >> 3, c = (tid & 7) * 8;
#pragma unroll
    for (int i = 0; i < 4; ++i) pa[i] = A + (size_t)(row0 + r + 64 * i) * lda + c;
#pragma unroll
    for (int j = 0; j < 2; ++j) pb[j] = Bt + (size_t)(n0 + r + 64 * j) * ldb + c;
}

DI void store4_bf16(bf16_t* dst, const f32x4& v) { u32x2 w; w.x = pk2(v[0], v[1]); w.y = pk2(v[2], v[3]); *(u32x2*)dst = w; }

DI f32x4 rope_tile(CParams& p, f32x4 v, int row, int axis_is_col, int fq) {
    f32x4 o;
    const int b = row / TP, t = row - b * TP;
    const int pos = t - CTX;
    const int ax = axis_is_col ? (pos & 63) : (pos >> 6);
    f32x4 cs = {1.f, 1.f, 1.f, 1.f}, sn = {0.f, 0.f, 0.f, 0.f};
    if (t >= CTX) { cs = *(const f32x4*)(p.ropec + ax * 8 + (fq & 1) * 4); sn = *(const f32x4*)(p.ropes + ax * 8 + (fq & 1) * 4); }
#pragma unroll
    for (int r = 0; r < 4; ++r) {
        const float pr = xget32(v[r], fq < 2);
        o[r] = fq < 2 ? v[r] * cs[r] - pr * sn[r] : v[r] * cs[r] + pr * sn[r];
    }
    return o;
}

namespace g8 {
constexpr int BK = 64, HALF = 128, HTB = HALF * BK * 2, STAGE_BYTES = 8 * HTB;
DI int lds_byte(int r, int c) { const int st = (r >> 4) * 2 + (c >> 5), rr = r & 15, cc = c & 31, ob = rr * 64 + cc * 2; return st * 1024 + (ob ^ (((ob >> 9) & 1) << 5)); }
DI void stage_rc(int b, int& R, int& C) { const int st = b / 1024, sb = b % 1024, swz = sb ^ (((sb >> 9) & 1) << 5); R = (st >> 1) * 16 + swz / 64; C = (st & 1) * 32 + (swz % 64) / 2; }
struct GU { const char* a; const char* b; int pm, pn, e, j0; };
DI bool order_next(int i, int nM, int nN, int& pm, int& pn) {
    const int nwg = nM * nN; const long L = (long)i * gridDim.x + blockIdx.x; if (L >= nwg) return false;
    int wgid = (int)L; { const int q = nwg / 8, r = nwg % 8, xcd = wgid % 8, off = wgid / 8; wgid = (xcd < r ? xcd * (q + 1) : r * (q + 1) + (xcd - r) * q) + off; }
    const int nig = 8 * nN, gid = wgid / nig, fm = gid * 8, gsz = (nM - fm) < 8 ? (nM - fm) : 8;
    pm = fm + ((wgid % nig) % gsz); pn = (wgid % nig) / gsz; return true;
}

typedef int v4i_t __attribute__((ext_vector_type(4)));
typedef int v8i_t __attribute__((ext_vector_type(8)));
DI int perm32(int rho) { const int n = rho >> 4, i = rho & 15; return 8 * (i >> 2) + 4 * n + (i & 3); }
template <class Epi, class Sched, bool GATHER, bool FP8 = false, bool SWAPSC = false, bool PERM = false>
DI void gemm8(char* lds_generic, const int KB, const char* Abase, const Sched& S, const Epi& E, const unsigned sclB = 0x7f7f7f7fu) {
    LAS unsigned char* lds = (LAS unsigned char*)lds_generic;
    const int tid = otid(), wid = __builtin_amdgcn_readfirstlane(tid >> 6), lane = tid & 63, wr = wid >> 2, wc = wid & 3, fr = lane & 15, fq = lane >> 4;
    const int nt = KB / 128;
    int R[2], C[2];
#pragma unroll
    for (int i = 0; i < 2; ++i) stage_rc(tid * 16 + i * 8192, R[i], C[i]);
    unsigned voff[2];
#pragma unroll
    for (int i = 0; i < 2; ++i) voff[i] = (unsigned)(R[i] * KB + C[i] * 2);
    unsigned voffB[2];
#pragma unroll
    for (int i = 0; i < 2; ++i) { const int Rb = (R[i] & ~31) + perm32(R[i] & 31); voffB[i] = PERM ? (unsigned)(Rb * KB + C[i] * 2) : 0u; }
    const size_t kstep = (size_t)(BK * 2), hstep = (size_t)HALF * KB;
    const unsigned ldsw = (unsigned)wid * 1024u;
    const int aoff = lds_byte(wr * 64 + fr, fq * 8), boff = lds_byte(wc * 32 + fr, fq * 8);
    LAS unsigned* gtab = (LAS unsigned*)(lds + STAGE_BYTES);
#define G8_SA(b, h) (((b) * 2 + (h)) * HTB)
#define G8_SB(b, h) ((4 + (b) * 2 + (h)) * HTB)
#define G8_LDS(gp, bufoff, i) __builtin_amdgcn_global_load_lds((const unsigned*)(gp), (LAS unsigned*)(lds + (bufoff) + ldsw + (i) * 8192), 16, 0, 0)
#define G8_STAGE_B(bufoff, gbase) do { _Pragma("unroll") for (int _i = 0; _i < 2; ++_i) G8_LDS((const char*)(gbase) + (PERM ? voffB[_i] : voff[_i]), bufoff, _i); } while (0)
#define G8_STAGE_A(bufoff, h, nx, ko) do { _Pragma("unroll") for (int _i = 0; _i < 2; ++_i) { \
        const char* _gp = GATHER ? Abase + (size_t)(gtab[((((nx) ? ui + 1 : ui) & 1) << 8) + (h) * HALF + R[_i]] + (unsigned)(C[_i] * 2)) + (ko) : ((nx) ? nA : cA) + (size_t)(h) * hstep + (ko) + voff[_i]; G8_LDS(_gp, bufoff, _i); } } while (0)
#define G8_LDA(dst, b, h) do { _Pragma("unroll") for (int m = 0; m < 4; ++m) _Pragma("unroll") for (int k = 0; k < 2; ++k) dst[m][k] = *(const LAS bf16x8*)(lds + G8_SA(b, h) + aoff + m * 2048 + k * 1024); } while (0)
#define G8_LDB(dst, b, h) do { _Pragma("unroll") for (int n = 0; n < 2; ++n) _Pragma("unroll") for (int k = 0; k < 2; ++k) dst[n][k] = *(const LAS bf16x8*)(lds + G8_SB(b, h) + boff + n * 2048 + k * 1024); } while (0)
#define G8_MMA(ai, bj, At, Bt) do { __builtin_amdgcn_s_setprio(1); _Pragma("unroll") for (int m = 0; m < 4; ++m) _Pragma("unroll") for (int n = 0; n < 2; ++n) { \
        if constexpr (FP8) { const v8i_t _a = __builtin_shufflevector(__builtin_bit_cast(v4i_t, At[m][0]), __builtin_bit_cast(v4i_t, At[m][1]), 0, 1, 2, 3, 4, 5, 6, 7); \
                   const v8i_t _b = __builtin_shufflevector(__builtin_bit_cast(v4i_t, Bt[n][0]), __builtin_bit_cast(v4i_t, Bt[n][1]), 0, 1, 2, 3, 4, 5, 6, 7); \
                   acc[ai][bj][m][n] = __builtin_amdgcn_mfma_scale_f32_16x16x128_f8f6f4(_b, _a, acc[ai][bj][m][n], 0, 0, 0, (int)(SWAPSC && cur.e ? 0x7f7f7f7fu : sclB), 0, (int)(SWAPSC && cur.e ? sclB : 0x7f7f7f7fu)); } \
        else { _Pragma("unroll") for (int k = 0; k < 2; ++k) acc[ai][bj][m][n] = __builtin_amdgcn_mfma_f32_16x16x32_bf16(Bt[n][k], At[m][k], acc[ai][bj][m][n], 0, 0, 0); } } \
        if constexpr (FP8) asm volatile("" : "+v"(acc[ai][bj][0][0]), "+v"(acc[ai][bj][0][1]), "+v"(acc[ai][bj][1][0]), "+v"(acc[ai][bj][1][1]), "+v"(acc[ai][bj][2][0]), "+v"(acc[ai][bj][2][1]), "+v"(acc[ai][bj][3][0]), "+v"(acc[ai][bj][3][1]));   \
        __builtin_amdgcn_s_setprio(0); } while (0)
#define G8_WAIT_V(n) asm volatile("s_waitcnt vmcnt(" #n ")" ::: "memory")
#define G8_WAIT_L(n) asm volatile("s_waitcnt lgkmcnt(" #n ")" ::: "memory")
#define G8_BAR __builtin_amdgcn_s_barrier()
#define G8_SCHED __builtin_amdgcn_sched_barrier(0)
#define G8_GOFF(slot, u) do { if (GATHER) { int _tz = tid; asm volatile("" : "+v"(_tz)); if (_tz < 256) gtab[((slot) << 8) + _tz] = S.arow(u, _tz) * (unsigned)KB; } } while (0)
    GU cur, nxt; int ui = 0;
    __syncthreads();
    if (!S.next(0, cur)) return;
    f32x4 acc[2][2][4][2];
    { const f32x4 z4 = zero4();
#pragma unroll
    for (int a = 0; a < 2; ++a)
#pragma unroll
        for (int b = 0; b < 2; ++b)
#pragma unroll
            for (int m = 0; m < 4; ++m)
#pragma unroll
                for (int n = 0; n < 2; ++n) acc[a][b][m][n] = z4; }
    bf16x8 At[4][2], B0[2][2], B1[2][2];
    const char* cA = cur.a; const char* cB = cur.b; const char* nA = cA; const char* nB = cB;
    G8_GOFF(0, cur);
    if (GATHER) __syncthreads();
    G8_STAGE_B(G8_SB(0, 0), cB); G8_STAGE_B(G8_SB(0, 1), cB + hstep); G8_STAGE_A(G8_SA(0, 0), 0, false, (size_t)0); G8_STAGE_A(G8_SA(0, 1), 1, false, (size_t)0);
    if (wr == 1) G8_BAR;
    G8_WAIT_V(2); G8_BAR;
    G8_STAGE_B(G8_SB(1, 0), cB + kstep); G8_STAGE_A(G8_SA(1, 0), 0, false, kstep); G8_STAGE_B(G8_SB(1, 1), cB + hstep + kstep);
    G8_WAIT_V(6); G8_BAR;
    for (;;) {
        const bool has_next = S.next(ui + 1, nxt);
        nA = has_next ? nxt.a : cA; nB = has_next ? nxt.b : cB;
        G8_GOFF((ui + 1) & 1, has_next ? nxt : cur);
        for (int t = 0; t < nt; t += 2) {
            const bool last = (t == nt - 2);
            const size_t k1 = (size_t)(t + 1) * kstep, k2 = last ? (size_t)0 : (size_t)(t + 2) * kstep, k3 = k2 + kstep;
            const char* b2 = last ? nB : cB + (size_t)(t + 2) * kstep; const char* b3 = b2 + kstep;
            G8_LDB(B0, 0, 0); G8_LDB(B1, 0, 1); G8_SCHED; G8_LDA(At, 0, 0); G8_STAGE_A(G8_SA(1, 1), 1, false, k1);
            G8_WAIT_V(8); G8_WAIT_L(0); G8_BAR; G8_MMA(0, 0, At, B0); G8_MMA(0, 1, At, B1); G8_BAR; G8_SCHED;
            G8_LDA(At, 0, 1); G8_STAGE_B(G8_SB(0, 0), b2); G8_STAGE_B(G8_SB(0, 1), b2 + hstep); G8_STAGE_A(G8_SA(0, 0), 0, last, k2);
            G8_WAIT_V(8); G8_WAIT_L(0); G8_BAR; G8_MMA(1, 0, At, B0); G8_MMA(1, 1, At, B1); G8_BAR; G8_SCHED;
            G8_LDB(B0, 1, 0); G8_LDB(B1, 1, 1); G8_SCHED; G8_LDA(At, 1, 0); G8_STAGE_A(G8_SA(0, 1), 1, last, k2);
            G8_WAIT_V(8); G8_WAIT_L(0); G8_BAR; G8_MMA(0, 0, At, B0); G8_MMA(0, 1, At, B1); G8_BAR; G8_SCHED;
            G8_LDA(At, 1, 1); G8_STAGE_B(G8_SB(1, 0), b3); G8_STAGE_B(G8_SB(1, 1), b3 + hstep); G8_STAGE_A(G8_SA(1, 0), 0, last, k3);
            G8_WAIT_V(8); G8_WAIT_L(0); G8_BAR; G8_MMA(1, 0, At, B0); G8_MMA(1, 1, At, B1); G8_BAR; G8_SCHED;
        }
        if (wr == 0) G8_BAR;
        E(acc, cur, wr, wc, fr, fq);
        if (!has_next) break;
        const f32x4 z4 = zero4();
#pragma unroll
        for (int a = 0; a < 2; ++a)
#pragma unroll
            for (int b = 0; b < 2; ++b)
#pragma unroll
                for (int m = 0; m < 4; ++m)
#pragma unroll
                    for (int n = 0; n < 2; ++n) acc[a][b][m][n] = z4;
        cur = nxt; cA = nA; cB = nB; ++ui;
        if (wr == 1) G8_BAR;
    }
    G8_WAIT_V(0);
    G8_BAR;
#undef G8_SA
#undef G8_SB
#undef G8_LDS
#undef G8_STAGE_A
#undef G8_STAGE_B
#undef G8_LDA
#undef G8_LDB
#undef G8_MMA
#undef G8_WAIT_V
#undef G8_WAIT_L
#undef G8_BAR
#undef G8_SCHED
#undef G8_GOFF
}
}

#define INPROJ_LOOP(BODY) _Pragma("unroll") for (int ai = 0; ai < 2; ++ai) _Pragma("unroll") for (int m = 0; m < 4; ++m) _Pragma("unroll") for (int n = 0; n < 2; ++n) { \
        const int row = row0 + 128 * ai + 16 * m, col = col0 + 16 * n; f32x4 v = acc[ai][bj][m][n]; BODY }
template <int bj>
DI void inproj_half(CParams& p, int l, int nt, const f32x4 (&acc)[2][2][4][2], int row0  , int col0  , int fq) {
    if (nt < 4) {
        INPROJ_LOOP({
            _Pragma("unroll") for (int r = 0; r < 4; ++r) v[r] = geluf_(v[r]);
            store4_bf16(p.Puv + (size_t)row * 512 + col, v); })
    } else if (nt < 6) {
        INPROJ_LOOP({ v = rope_tile(p, v, row, n, fq) * (0.17677669529663687f * LOG2E); store4_bf16(p.Qd + (size_t)row * 256 + (col - 512), v); })
    } else if (nt < 8) {
        INPROJ_LOOP({ v = rope_tile(p, v, row, n, fq); store4_bf16(p.Kd + (size_t)row * 256 + (col - 768), v); })
    } else if (nt < 12) {
        INPROJ_LOOP({
            _Pragma("unroll") for (int r = 0; r < 4; ++r) v[r] = siluf_(v[r]);
            store4_bf16(p.Hq + (size_t)row * 256 + (col - 1280), v); })
    } else if (nt < 18) {
        const int dir = nt >= 16, cb = dir ? 2048 : 1792;
        const f32x4 lb2[2] = {*(const f32x4*)(p.lball + (l * 2 + dir) * 256 + col0 - cb), *(const f32x4*)(p.lball + (l * 2 + dir) * 256 + col0 + 16 - cb)};
        INPROJ_LOOP({
            const int cc = col - cb;
            const f32x4 lb = lb2[n];
            _Pragma("unroll") for (int r = 0; r < 4; ++r) v[r] = 0.69314718056f * __builtin_amdgcn_logf(lb[r] + (1.0f - lb[r]) * sigmoidf_(v[r]));
            store4_bf16(p.Lf + ((size_t)dir * MR + row) * 256 + cc, v); })
    } else if (nt < 20) {
        INPROJ_LOOP({
            _Pragma("unroll") for (int r = 0; r < 4; ++r) v[r] = siluf_(v[r]);
            store4_bf16(p.Hg + (size_t)row * 256 + (col - 2304), v); })
    } else if (nt < 22) {
        INPROJ_LOOP({ store4_bf16(p.Cq + (size_t)row * 256 + (col - 2560), v); })
    } else if (nt == 22) {
        INPROJ_LOOP({ store4_bf16(p.Ckv + (size_t)row * 128 + (col - 2816), v); })
    } else {
        INPROJ_LOOP({ v = rope_tile(p, v, row, n, fq); if (col < 2976) store4_bf16(p.Kr + (size_t)row * 32 + (col - 2944), v); })
    }
}
struct SchedIn {
    const char* H; const char* W;
    DI bool next(int i, g8::GU& u) const {
        int pm, pn; if (!g8::order_next(i, MR / 256, 12, pm, pn)) return false;
        const bool sw = (pn == 4 || pn == 6);
        u.pm = pm; u.pn = pn; u.e = sw ? 1 : 0; u.j0 = 0;
        const char* ht = H + (size_t)pm * 256 * 1024; const char* wt = W + (size_t)pn * 256 * 1024;
        u.a = sw ? wt : ht; u.b = sw ? ht : wt; return true;
    }
    DI unsigned arow(const g8::GU&, int) const { return 0u; }
};
struct EpiIn {
    CParams* pp; int l;
    DI void operator()(const f32x4 (&acc)[2][2][4][2], const g8::GU& u, int wr, int wc, int fr, int fq) const {
        CParams& p = *pp;
        if (u.e) {
            bf16_t* dst = (u.pn == 4) ? p.Vdt : p.Vht;
            const int m0 = u.pm * 256, b = m0 / TP, t0 = m0 - b * TP;
#pragma unroll
            for (int ai = 0; ai < 2; ++ai)
#pragma unroll
                for (int bj = 0; bj < 2; ++bj)
#pragma unroll
                    for (int m = 0; m < 4; ++m)
#pragma unroll
                        for (int n = 0; n < 2; ++n) {
                            const int f = 128 * ai + 64 * wr + 16 * m + fr, t = t0 + 128 * bj + 32 * wc + 16 * n + 4 * fq;
                            store4_bf16(dst + ((size_t)(b * 256 + f)) * TP + t, acc[ai][bj][m][n]);
                        }
        } else {
            inproj_half<0>(p, l, 2 * u.pn, acc, u.pm * 256 + 64 * wr + fr, u.pn * 256 + 32 * wc + 4 * fq, fq);
            inproj_half<1>(p, l, 2 * u.pn + 1, acc, u.pm * 256 + 64 * wr + fr, u.pn * 256 + 128 + 32 * wc + 4 * fq, fq);
        }
    }
};
DI void phase_inproj(CParams& p, int l, char* lds) {
    SchedIn S; S.H = (const char*)p.H8; S.W = (const char*)p.WinT + (size_t)l * NINP * DM;
    EpiIn E; E.pp = &p; E.l = l;
    g8::gemm8<EpiIn, SchedIn, false, true, true>(lds, DM, nullptr, S, E, 0x7a7a7a7au);
}

DI void phase_sgu_prep(CParams& p, int l, char* lds) {
    const int tid = otid(), wid = tid >> 6, lane = tid & 63, fr = lane & 15, fq = lane >> 4;
    constexpr int U_SGU = (MR / 128) * 4, U_PREP = MR / 64;
    float* stats = (float*)(lds + 16384);
    for (int u = blockIdx.x; u < U_SGU + U_PREP; u += gridDim.x) {
        if (u < U_SGU) {
            const int ch = u >> 2, g = u & 3, row0 = ch * 128;
            __syncthreads();
#pragma unroll 1
            for (int i = 0; i < 16; ++i) {
                const int r = wid * 16 + i;
                const u32x2 w = *(const u32x2*)(p.Puv + (size_t)(row0 + r) * 512 + 256 + lane * 4);
                const float a0 = lo2f(w.x), a1 = hi2f(w.x), a2 = lo2f(w.y), a3 = hi2f(w.y);
                const float mean = wave_sum((a0 + a1) + (a2 + a3)) * (1.f / 256.f);
                const float d0 = a0 - mean, d1 = a1 - mean, d2 = a2 - mean, d3 = a3 - mean;
                const float var = wave_sum((d0 * d0 + d1 * d1) + (d2 * d2 + d3 * d3)) * (1.f / 256.f);
                if (lane == 0) { stats[r * 2] = mean; stats[r * 2 + 1] = rsqrtf(var + LN_EPS); }
            }
            __syncthreads();
            {
                const int s = tid >> 2, c0 = (tid & 3) * 16;
                const float mean = stats[s * 2], rstd = stats[s * 2 + 1];
                const bf16_t* src = p.Puv + (size_t)(row0 + s) * 512 + 256 + g * 64 + c0;
                const u32x4 w0 = *(const u32x4*)src, w1 = *(const u32x4*)(src + 8);
                const unsigned ww[8] = {w0.x, w0.y, w0.z, w0.w, w1.x, w1.y, w1.z, w1.w};
                const float* lw = p.sgu_ln_w + l * 256 + g * 64 + c0; const float* lb = p.sgu_ln_b + l * 256 + g * 64 + c0;
#pragma unroll
                for (int j = 0; j < 16; ++j) {
                    const float xv = (j & 1) ? hi2f(ww[j >> 1]) : lo2f(ww[j >> 1]);
                    const float y = (xv - mean) * rstd * lw[j] + lb[j];
                    const int c = c0 + j;
                    const unsigned pk = pk2(y, 0.f);
                    *(bf16_t*)(lds + c * 256 + ((((s >> 3) ^ (c & 15)) << 4) | ((s & 7) * 2))) = (bf16_t)(pk & 0xffffu);
                }
            }
            __syncthreads();
            f32x4 acc[4];
#pragma unroll
            for (int ni = 0; ni < 4; ++ni) acc[ni] = zero4();
            const float* Wg = p.sgu_w + ((size_t)(l * 4 + g) * 128 + wid * 16 + fr) * 128;
#pragma unroll
            for (int ks = 0; ks < 4; ++ks) {
                const f32x4 a0 = *(const f32x4*)(Wg + ks * 32 + fq * 8), a1 = *(const f32x4*)(Wg + ks * 32 + fq * 8 + 4);
                const float av[8] = {a0[0], a0[1], a0[2], a0[3], a1[0], a1[1], a1[2], a1[3]};
                const bf16x8 af = pack8(av);
#pragma unroll
                for (int ni = 0; ni < 4; ++ni) {
                    const int c = ni * 16 + fr;
                    const bf16x8 bfr = *(const bf16x8*)(lds + c * 256 + (((ks * 4 + fq) ^ (c & 15)) << 4));
                    acc[ni] = MFMA16(bfr, af, acc[ni]);
                }
            }
            const int t = wid * 16 + fr, row = row0 + t;
            const float bs = p.sgu_b[(l * 4 + g) * 128 + t];
#pragma unroll
            for (int ni = 0; ni < 4; ++ni) {
                const int c = g * 64 + ni * 16 + fq * 4;
                const u32x2 w = *(const u32x2*)(p.Puv + (size_t)row * 512 + c);
                f32x4 o;
                o[0] = (acc[ni][0] + bs) * lo2f(w.x); o[1] = (acc[ni][1] + bs) * hi2f(w.x);
                o[2] = (acc[ni][2] + bs) * lo2f(w.y); o[3] = (acc[ni][3] + bs) * hi2f(w.y);
                store4_bf16(p.O + (size_t)row * DM + c, o);
            }
        } else {
            const int rbase = (u - U_SGU) * 64 + wid * 8;
#pragma unroll 1
            for (int i = 0; i < 8; ++i) {
                const int row = rbase + i;
                const u32x2 wq = *(const u32x2*)(p.Cq + (size_t)row * 256 + lane * 4);
                const unsigned wk = *(const unsigned*)(p.Ckv + (size_t)row * 128 + lane * 2);
                const float q0 = lo2f(wq.x), q1 = hi2f(wq.x), q2 = lo2f(wq.y), q3 = hi2f(wq.y), k0 = lo2f(wk), k1 = hi2f(wk);
                const float sq = wave_sum((q0 * q0 + q1 * q1) + (q2 * q2 + q3 * q3));
                const float sk = wave_sum(k0 * k0 + k1 * k1);
                if (lane == 0) { p.RS[row * 2] = rsqrtf(sq * (1.f / 256.f) + LN_EPS); p.RS[row * 2 + 1] = rsqrtf(sk * (1.f / 128.f) + LN_EPS); }
            }
        }
    }
}

DI void hgrn_h1_unit(CParams& p, int wu, int lane) {
    const int c = wu % NCH; int t = wu / NCH; const int dir = t & 1, h = (t >> 1) & 3, b = t >> 3;
    const int row0 = b * TP + c * 32, hh = lane >> 5, l31 = lane & 31;
    const bf16_t* Lf = p.Lf + ((size_t)dir * MR + row0) * 256 + h * 64;
    bf16x8 Bf[2][2];
    float* decp = p.DEC + (size_t)wu * 64;
#pragma unroll
    for (int kt = 0; kt < 2; ++kt) {
        const int k = kt * 32 + l31;
        float lf[32], kd[32];
#pragma unroll
        for (int j = 0; j < 32; ++j) lf[j] = bf2f(Lf[(size_t)j * 256 + k]);
        float tot = 0.f;
#pragma unroll
        for (int j = 0; j < 32; ++j) tot += lf[j];
        float run = 0.f;
        if (dir == 0) {
#pragma unroll
            for (int j = 0; j < 32; ++j) { run += lf[j]; kd[j] = (1.0f - __expf(lf[j])) * __expf(tot - run); }
        } else {
#pragma unroll
            for (int j = 31; j >= 0; --j) { run += lf[j]; kd[j] = (1.0f - __expf(lf[j])) * __expf(tot - run); }
        }
        if (hh == 0) decp[k] = __expf(tot);
#pragma unroll
        for (int s = 0; s < 2; ++s) {
            float v8[8];
#pragma unroll
            for (int jj = 0; jj < 8; ++jj) v8[jj] = hh ? kd[16 * s + 8 + jj] : kd[16 * s + jj];
            Bf[kt][s] = pack8(v8);
        }
    }
    const bf16_t* Vt = p.Vht + ((size_t)(b * 4 + h) * 64) * TP + c * 32;
    bf16_t* dst = p.DST + (size_t)wu * 4096;
#pragma unroll
    for (int vt = 0; vt < 2; ++vt) {
        bf16x8 Af[2];
#pragma unroll
        for (int s = 0; s < 2; ++s) Af[s] = *(const bf16x8*)(Vt + (size_t)(vt * 32 + l31) * TP + 16 * s + 8 * hh);
#pragma unroll
        for (int kt = 0; kt < 2; ++kt) {
            f32x16 d;
#pragma unroll
            for (int i = 0; i < 16; ++i) d[i] = zf();
            d = MFMA32(Af[0], Bf[kt][0], d);
            d = MFMA32(Af[1], Bf[kt][1], d);
#pragma unroll
            for (int r = 0; r < 16; ++r) dst[(vt * 32 + crow(r, hh)) * 64 + kt * 32 + l31] = (bf16_t)(pk2(d[r], 0.f) & 0xffffu);
        }
    }
}

DI void phase_upproj_h1(CParams& p, int l, char* lds) {
    const int tid = otid(), wid = tid >> 6, lane = tid & 63, wr = wid >> 1, wc = wid & 1, fr = lane & 15, fq = lane >> 4;
    constexpr int U_Q = (MR / 256) * 3, U_KV = (MR / 256) * 4, U_H1 = NB * 4 * 2 * NCH / 8;
    for (int u = blockIdx.x; u < U_Q + U_KV + U_H1; u += gridDim.x) {
        if (u < U_Q) {
            const int mt = u / 3, nt = u % 3, m0 = mt * 256, n0 = nt * 128;
            const bf16_t* pa[4]; const bf16_t* pb[2];
            gemm_ptrs(p.Cq, 256, m0, p.WuqT + (size_t)l * 384 * 256, 256, n0, pa, pb);
            f32x4 acc[4][4];
            gemm_core<0>(pa, pb, 256, lds, acc);
            float rsq[4];
#pragma unroll
            for (int mi = 0; mi < 4; ++mi) rsq[mi] = p.RS[(m0 + wr * 64 + mi * 16 + fr) * 2] * (0.10206207261596577f * LOG2E);
#pragma unroll
            for (int mi = 0; mi < 4; ++mi)
#pragma unroll
                for (int ni = 0; ni < 4; ++ni) {
                    const int row = m0 + wr * 64 + mi * 16 + fr, col = n0 + wc * 64 + ni * 16 + fq * 4;
                    f32x4 v = acc[mi][ni] * rsq[mi];
                    const int cm = col % 96;
                    const f32x4 vr = rope_tile(p, v, row, (cm >> 4) & 1, fq);
                    if (cm >= 64) v = vr;
                    store4_bf16(p.Qm + (size_t)row * 384 + col, v);
                }
        } else if (u < U_Q + U_KV) {
            const int uu = u - U_Q, mt = uu >> 2, nt = uu & 3, m0 = mt * 256, n0 = nt * 128;
            const bf16_t* pa[4]; const bf16_t* pb[2];
            gemm_ptrs(p.Ckv, 128, m0, p.WukvT + (size_t)l * 512 * 128, 128, n0, pa, pb);
            f32x4 acc[4][4];
            if (nt < 2) {
                gemm_core<0>(pa, pb, 128, lds, acc);
                float rsk[4];
#pragma unroll
                for (int mi = 0; mi < 4; ++mi) rsk[mi] = p.RS[(m0 + wr * 64 + mi * 16 + fr) * 2 + 1];
#pragma unroll
                for (int mi = 0; mi < 4; ++mi)
#pragma unroll
                    for (int ni = 0; ni < 4; ++ni) {
                        const int row = m0 + wr * 64 + mi * 16 + fr, col = n0 + wc * 64 + ni * 16 + fq * 4;
                        store4_bf16(p.Kn + (size_t)row * 256 + col, acc[mi][ni] * rsk[mi]);
                    }
            } else {
                gemm_core<1>(pa, pb, 128, lds, acc);
                const int b = m0 / TP, t0 = m0 - b * TP;
                f32x4 rsv[4];
#pragma unroll
                for (int mi = 0; mi < 4; ++mi) { const int rl = m0 + wr * 64 + mi * 16 + fq * 4; rsv[mi] = (f32x4){p.RS[rl * 2 + 1], p.RS[(rl + 1) * 2 + 1], p.RS[(rl + 2) * 2 + 1], p.RS[(rl + 3) * 2 + 1]}; }
#pragma unroll
                for (int mi = 0; mi < 4; ++mi)
#pragma unroll
                    for (int ni = 0; ni < 4; ++ni) {
                        const int f = n0 - 256 + wc * 64 + ni * 16 + fr;
                        const int rl = wr * 64 + mi * 16 + fq * 4;
                        store4_bf16(p.Vmt + ((size_t)(b * 256 + f)) * TP + t0 + rl, acc[mi][ni] * rsv[mi]);
                    }
            }
        } else {
            hgrn_h1_unit(p, (u - U_Q - U_KV) * 8 + wid, lane);
        }
    }
}

DI void hgrn_h2_unit(CParams& p, int cu  ) {
    const int tid = otid();
    if (tid >= 256) return;
    const int gid = cu * 256 + tid;
    const int seq = gid >> 10, e4 = gid & 1023;
    const int dir = seq & 1, k4 = (e4 & 15) * 4;
    f32x4 st = zero4();
    for (int t0 = 0; t0 < NCH; t0 += 8) {
        f32x4 ds[8], dc[8]; bf16_t* ptr[8];
#pragma unroll
        for (int j = 0; j < 8; ++j) {
            const int t = t0 + j, pc = dir == 0 ? t : (t < 8 ? 7 - t : 143 - t);
            ptr[j] = p.DST + ((size_t)(seq * NCH + pc)) * 4096 + e4 * 4;
            const u32x2 w = *(const u32x2*)ptr[j];
            ds[j] = (f32x4){lo2f(w.x), hi2f(w.x), lo2f(w.y), hi2f(w.y)};
            dc[j] = *(const f32x4*)(p.DEC + (size_t)(seq * NCH + pc) * 64 + k4);
        }
#pragma unroll
        for (int j = 0; j < 8; ++j) { store4_bf16(ptr[j], st); st = dc[j] * st + ds[j]; }
    }
}

DI void hgrn_h3_unit(CParams& p, int l, int wu, int lane, char* wl) {
    const int pc = wu % NCH; const int t_ = wu / NCH; const int h = t_ & 3, b = t_ >> 2;
    const int row0 = b * TP + pc * 32, hh = lane >> 5, i = lane & 31;
    float* Bl = (float*)wl;
    f32x16 Y[2];
    { const float z = zf();
#pragma unroll
    for (int r = 0; r < 16; ++r) { Y[0][r] = z; Y[1][r] = z; } }
#pragma unroll 1
    for (int dir = 0; dir < 2; ++dir) {
        const bf16_t* Lf = p.Lf + ((size_t)dir * MR + row0) * 256 + h * 64;
        {
            float lf[32];
#pragma unroll
            for (int j = 0; j < 32; ++j) lf[j] = bf2f(Lf[(size_t)j * 256 + lane]);
            float run = 0.f;
            if (dir == 0) {
#pragma unroll
                for (int j = 0; j < 32; ++j) { run += lf[j]; Bl[j * 68 + lane] = run; }
            } else {
#pragma unroll
                for (int j = 31; j >= 0; --j) { run += lf[j]; Bl[j * 68 + lane] = run; }
            }
        }
        __syncthreads();
        bf16x8 Qf[4], Kf[4];
#pragma unroll
        for (int s = 0; s < 4; ++s) {
            const int kb = 16 * s + 8 * hh;
            const u32x4 qw = *(const u32x4*)(p.Hq + (size_t)(row0 + i) * 256 + h * 64 + kb);
            const u32x4 fw = *(const u32x4*)(Lf + (size_t)i * 256 + kb);
            const f32x4 b0 = *(const f32x4*)(Bl + i * 68 + kb), b1 = *(const f32x4*)(Bl + i * 68 + kb + 4);
            const float bb[8] = {b0[0], b0[1], b0[2], b0[3], b1[0], b1[1], b1[2], b1[3]};
            const unsigned qq[4] = {qw.x, qw.y, qw.z, qw.w}, ff[4] = {fw.x, fw.y, fw.z, fw.w};
            float qd[8], kd[8];
#pragma unroll
            for (int j = 0; j < 8; ++j) {
                const float qv = (j & 1) ? hi2f(qq[j >> 1]) : lo2f(qq[j >> 1]);
                const float fv = (j & 1) ? hi2f(ff[j >> 1]) : lo2f(ff[j >> 1]);
                qd[j] = qv * __expf(bb[j]);
                kd[j] = (1.0f - __expf(fv)) * __expf(-bb[j]);
            }
            Qf[s] = pack8(qd); Kf[s] = pack8(kd);
        }
        f32x16 X;
#pragma unroll
        for (int r = 0; r < 16; ++r) X[r] = zf();
#pragma unroll
        for (int s = 0; s < 4; ++s) X = MFMA32(Kf[s], Qf[s], X);
#pragma unroll
        for (int r = 0; r < 16; ++r) { const int j = crow(r, hh); const bool keep = dir == 0 ? (j <= i) : (j >= i); X[r] = keep ? X[r] : 0.f; }
        bf16x8 Xs[2];
#pragma unroll
        for (int s = 0; s < 2; ++s) { const float v8[8] = {X[8 * s], X[8 * s + 1], X[8 * s + 2], X[8 * s + 3], X[8 * s + 4], X[8 * s + 5], X[8 * s + 6], X[8 * s + 7]}; Xs[s] = pack8(v8); }
        const bf16_t* Vt = p.Vht + ((size_t)(b * 4 + h) * 64) * TP + pc * 32;
        const bf16_t* ST = p.DST + ((size_t)(((b * 4 + h) * 2 + dir) * NCH + pc)) * 4096;
#pragma unroll
        for (int vt = 0; vt < 2; ++vt) {
            const bf16_t* vrow = Vt + (size_t)(vt * 32 + i) * TP;
#pragma unroll
            for (int s = 0; s < 2; ++s) {
                const u32x2 lo = *(const u32x2*)(vrow + 16 * s + 4 * hh), hi = *(const u32x2*)(vrow + 16 * s + 8 + 4 * hh);
                u32x4 w; w.x = lo.x; w.y = lo.y; w.z = hi.x; w.w = hi.y;
                Y[vt] = MFMA32(__builtin_bit_cast(bf16x8, w), Xs[s], Y[vt]);
            }
            const bf16_t* srow = ST + (vt * 32 + i) * 64;
#pragma unroll
            for (int s = 0; s < 4; ++s) {
                Y[vt] = MFMA32(*(const bf16x8*)(srow + 16 * s + 8 * hh), Qf[s], Y[vt]);
            }
        }
        __syncthreads();
    }
    float ss = 0.f;
#pragma unroll
    for (int r = 0; r < 16; ++r) ss += Y[0][r] * Y[0][r] + Y[1][r] * Y[1][r];
    ss = xsum32(ss);
    const float rs = rsqrtf(ss * (1.f / 64.f) + LN_EPS);
    const int row = row0 + i;
#pragma unroll
    for (int vt = 0; vt < 2; ++vt)
#pragma unroll
        for (int g4 = 0; g4 < 4; ++g4) {
            const int v0 = vt * 32 + 8 * g4 + 4 * hh;
            const f32x4 nw = *(const f32x4*)(p.hgrn_norm_w + l * 64 + v0);
            const u32x2 gw = *(const u32x2*)(p.Hg + (size_t)row * 256 + h * 64 + v0);
            f32x4 o;
            o[0] = Y[vt][g4 * 4 + 0] * rs * nw[0] * lo2f(gw.x); o[1] = Y[vt][g4 * 4 + 1] * rs * nw[1] * hi2f(gw.x);
            o[2] = Y[vt][g4 * 4 + 2] * rs * nw[2] * lo2f(gw.y); o[3] = Y[vt][g4 * 4 + 3] * rs * nw[3] * hi2f(gw.y);
            store4_bf16(p.O + (size_t)row * DM + 512 + h * 64 + v0, o);
        }
}

template <bool DIFF>
DI void attn_unit(CParams& p, int l, int b, int h, int qrow0  , int nkt  , char* lds) {
    const int tid = otid(), wid = tid >> 6, lane = tid & 63, hh = lane >> 5, q31 = lane & 31;
    constexpr int NS = DIFF ? 2 : 1;
    constexpr int NQF = DIFF ? 4 : 6;
    constexpr int BUF = 8192 + 8192 + (DIFF ? 0 : 4096);
    const int qrow = qrow0 + wid * 32 + q31;
    bf16x8 Qf[NQF];
    {
        const bf16_t* qp = DIFF ? p.Qd + (size_t)qrow * 256 + h * 64 : p.Qm + (size_t)qrow * 384 + h * 96;
#pragma unroll
        for (int s = 0; s < NQF; ++s) Qf[s] = *(const bf16x8*)(qp + 16 * s + 8 * hh);
    }
    const size_t krow0 = (size_t)b * TP;
    const bf16_t* kptr = (DIFF ? p.Kd : p.Kn) + (krow0 + (tid >> 3)) * 256 + h * 64 + (tid & 7) * 8;
    const bf16_t* vptr = (DIFF ? p.Vdt : p.Vmt) + ((size_t)(b * 4 + h) * 64 + (tid >> 3)) * TP + (tid & 7) * 8;
    const bf16_t* rptr = p.Kr + (krow0 + ((tid & 255) >> 2)) * 32 + (tid & 3) * 8;
    const int key_w = tid >> 3, c_w = tid & 7;
    const int kwoff = key_w * 128 + ((c_w ^ ((key_w >> 1) & 7)) << 4);
    const int d_w = tid >> 3;
    const int vwoff0 = 8192 + d_w * 128 + (((2 * c_w) ^ ((d_w >> 1) & 15)) << 3), vwoff1 = 8192 + d_w * 128 + (((2 * c_w + 1) ^ ((d_w >> 1) & 15)) << 3);
    const int rkey = (tid & 255) >> 2, rc = tid & 3;
    const int rwoff = 16384 + rkey * 64 + ((rc ^ ((rkey >> 2) & 3)) << 4);
    const int krd = q31 * 128, ksw = (q31 >> 1) & 7;
    const int rrd = 16384 + q31 * 64, rsw = (q31 >> 2) & 3;
    const int vrd = 8192 + q31 * 128, vsw = (q31 >> 1) & 15;
    f32x16 ot[NS][2];
    float m[NS], lsum[NS];
#pragma unroll
    for (int a = 0; a < NS; ++a) { m[a] = 0.f; lsum[a] = 0.f;
#pragma unroll
        for (int r = 0; r < 16; ++r) { ot[a][0][r] = zf(); ot[a][1][r] = zf(); } }
    u32x4 rk, rv, rr;
    rk = *(const u32x4*)kptr; rv = *(const u32x4*)vptr;
    if (!DIFF) { if (tid < 256) rr = *(const u32x4*)rptr; }
    __syncthreads();
    *(u32x4*)(lds + kwoff) = rk;
    *(u32x2*)(lds + vwoff0) = (u32x2){rv.x, rv.y}; *(u32x2*)(lds + vwoff1) = (u32x2){rv.z, rv.w};
    if (!DIFF) { if (tid < 256) *(u32x4*)(lds + rwoff) = rr; }
    __syncthreads();
    for (int kt = 0; kt < nkt; ++kt) {
        const char* cur = lds + (kt & 1) * BUF;
        const bool more = kt + 1 < nkt;
        if (more) {
            rk = *(const u32x4*)(kptr + (size_t)(kt + 1) * 64 * 256);
            rv = *(const u32x4*)(vptr + (kt + 1) * 64);
            if (!DIFF) { if (tid < 256) rr = *(const u32x4*)(rptr + (size_t)(kt + 1) * 64 * 32); }
        }
        bf16x8 Pf[NS][2][2];
#pragma unroll
        for (int a = 0; a < NS; ++a) {
            f32x16 st[2];
            const float negm = -m[a];
            constexpr int NKF = DIFF ? 2 : 6;
            bf16x8 kf[2][NKF];
#pragma unroll
            for (int t = 0; t < 2; ++t) {
                if (DIFF) {
#pragma unroll
                    for (int s = 0; s < 2; ++s) kf[t][s] = *(const bf16x8*)(cur + t * 4096 + krd + (((4 * a + 2 * s + hh) ^ ksw) << 4));
                } else {
#pragma unroll
                    for (int s = 0; s < 4; ++s) kf[t][s] = *(const bf16x8*)(cur + t * 4096 + krd + (((2 * s + hh) ^ ksw) << 4));
#pragma unroll
                    for (int s = 0; s < 2; ++s) kf[t][4 + s] = *(const bf16x8*)(cur + t * 2048 + rrd + (((2 * s + hh) ^ rsw) << 4));
                }
            }
            __builtin_amdgcn_sched_barrier(0);
#pragma unroll
            for (int t = 0; t < 2; ++t) {
                f32x16 acc;
#pragma unroll
                for (int r = 0; r < 16; ++r) acc[r] = negm;
#pragma unroll
                for (int s = 0; s < NKF; ++s) acc = MFMA32(kf[t][s], Qf[DIFF ? 2 * a + s : s], acc);
                st[t] = acc;
            }
            float tm = fmaxf(fmaxf(st[0][0], st[0][1]), st[0][2]);
#pragma unroll
            for (int r = 3; r < 15; r += 2) tm = fmaxf(fmaxf(tm, st[0][r]), st[0][r + 1]);
            tm = fmaxf(tm, st[0][15]);
#pragma unroll
            for (int r = 0; r < 16; r += 2) tm = fmaxf(fmaxf(tm, st[1][r]), st[1][r + 1]);
            { const auto sw = __builtin_amdgcn_permlane32_swap(__float_as_uint(tm), __float_as_uint(tm), false, false); tm = fmaxf(__uint_as_float(sw[0]), __uint_as_float(sw[1])); }
            if (kt == 0 || __any(tm > 8.0f)) {
                const float delta = kt == 0 ? tm : fmaxf(tm, 0.f);
                const float alpha = __builtin_amdgcn_exp2f(-delta);
                m[a] += delta; lsum[a] *= alpha;
#pragma unroll
                for (int r = 0; r < 16; ++r) { st[0][r] -= delta; st[1][r] -= delta; ot[a][0][r] *= alpha; ot[a][1][r] *= alpha; }
            }
            float ps = 0.f;
#pragma unroll
            for (int t = 0; t < 2; ++t) {
#pragma unroll
                for (int r = 0; r < 16; ++r) { const float e = __builtin_amdgcn_exp2f(st[t][r]); st[t][r] = e; ps += e; }
#pragma unroll
                for (int s = 0; s < 2; ++s) {
                    const float v8[8] = {st[t][8 * s], st[t][8 * s + 1], st[t][8 * s + 2], st[t][8 * s + 3], st[t][8 * s + 4], st[t][8 * s + 5], st[t][8 * s + 6], st[t][8 * s + 7]};
                    Pf[a][t][s] = pack8(v8);
                }
            }
            lsum[a] += ps;
            if (DIFF) __builtin_amdgcn_sched_barrier(0);
        }
#pragma unroll
        for (int dt = 0; dt < 2; ++dt) {
            bf16x8 vf[2][2];
#pragma unroll
            for (int t = 0; t < 2; ++t)
#pragma unroll
                for (int s = 0; s < 2; ++s) {
                    const int c8 = 8 * t + 4 * s + hh;
                    const u32x2 lo = *(const u32x2*)(cur + dt * 4096 + vrd + ((c8 ^ vsw) << 3));
                    const u32x2 hi = *(const u32x2*)(cur + dt * 4096 + vrd + (((c8 + 2) ^ vsw) << 3));
                    u32x4 w; w.x = lo.x; w.y = lo.y; w.z = hi.x; w.w = hi.y;
                    vf[t][s] = __builtin_bit_cast(bf16x8, w);
                }
            __builtin_amdgcn_sched_barrier(0);
#pragma unroll
            for (int t = 0; t < 2; ++t)
#pragma unroll
                for (int s = 0; s < 2; ++s)
#pragma unroll
                    for (int a = 0; a < NS; ++a) ot[a][dt] = MFMA32(vf[t][s], Pf[a][t][s], ot[a][dt]);
        }
        if (more) {
            char* nxt = lds + ((kt + 1) & 1) * BUF;
            *(u32x4*)(nxt + kwoff) = rk;
            *(u32x2*)(nxt + vwoff0) = (u32x2){rv.x, rv.y}; *(u32x2*)(nxt + vwoff1) = (u32x2){rv.z, rv.w};
            if (!DIFF) { if (tid < 256) *(u32x4*)(nxt + rwoff) = rr; }
        }
        __syncthreads();
    }
    float linv[NS];
#pragma unroll
    for (int a = 0; a < NS; ++a) { const float lt = xsum32(lsum[a]); linv[a] = 1.0f / lt; }
    f32x16 o[2];
    if (DIFF) {
        const float lam = p.lam[l];
#pragma unroll
        for (int dt = 0; dt < 2; ++dt)
#pragma unroll
            for (int r = 0; r < 16; ++r) o[dt][r] = ot[0][dt][r] * linv[0] - lam * (ot[NS - 1][dt][r] * linv[NS - 1]);
        float ss = 0.f;
#pragma unroll
        for (int r = 0; r < 16; ++r) ss += o[0][r] * o[0][r] + o[1][r] * o[1][r];
        ss = xsum32(ss);
        int lz = l; asm volatile("" : "+s"(lz));
        const float lam_init = lz == 0 ? 0.2f : 0.3555090676f;
        const float rs = rsqrtf(ss * (1.f / 64.f) + LN_EPS) * (1.0f - lam_init);
#pragma unroll
        for (int dt = 0; dt < 2; ++dt)
#pragma unroll
            for (int r = 0; r < 16; ++r) o[dt][r] *= rs;
    } else {
#pragma unroll
        for (int dt = 0; dt < 2; ++dt)
#pragma unroll
            for (int r = 0; r < 16; ++r) o[dt][r] = ot[0][dt][r] * linv[0];
    }
    bf16_t* orow = p.O + (size_t)qrow * DM + (DIFF ? 256 : 768) + h * 64;
#pragma unroll
    for (int dt = 0; dt < 2; ++dt)
#pragma unroll
        for (int g4 = 0; g4 < 4; ++g4) {
            const int d0 = dt * 32 + 8 * g4 + 4 * hh;
            f32x4 v = {o[dt][g4 * 4], o[dt][g4 * 4 + 1], o[dt][g4 * 4 + 2], o[dt][g4 * 4 + 3]};
            if (DIFF) { const f32x4 sw = *(const f32x4*)(p.diff_subln_w + l * 64 + d0); v = v * sw; }
            store4_bf16(orow + d0, v);
        }
}

DI void phase_attn_diff_h2(CParams& p, int l, char* lds, bool h2skip) {
    const int G = gridDim.x;
    const int U_H2 = 256, U_LAT = NB * 4 * 16, U_CTX = (l == 0) ? NB * 4 : 0;
    const int total = U_H2 + 2 * U_LAT + 2 * U_CTX;
    for (int u = blockIdx.x; u < total; u += G) {
        if (u < U_H2) { if (!h2skip) hgrn_h2_unit(p, u); continue; }
        int v = u - U_H2; bool diff; int b, h, q0, nkt;
        if (v < 2 * U_LAT) { diff = v < U_LAT; if (!diff) v -= U_LAT; b = v >> 6; h = (v >> 4) & 3; q0 = b * TP + CTX + (v & 15) * 256; nkt = TP / 64; }
        else { v -= 2 * U_LAT; diff = v < U_CTX; if (!diff) v -= U_CTX; b = v >> 2; h = v & 3; q0 = b * TP; nkt = CTX / 64; }
        if (diff) attn_unit<true>(p, l, b, h, q0, nkt, lds); else attn_unit<false>(p, l, b, h, q0, nkt, lds);
    }
}
DI void phase_attn_mla_h3(CParams& p, int l, char* lds) {
    const int tid_ = otid(); const int wid = tid_ >> 6, lane = tid_ & 63;
    const int U_H3 = NB * 4 * NCH / 8;
    for (int u = blockIdx.x; u < U_H3; u += gridDim.x) { __syncthreads(); hgrn_h3_unit(p, l, u * 8 + wid, lane, lds + 65536 + wid * 8704); }
}

struct SchedOut {
    const char* O; const char* W; int l;
    DI bool next(int i, g8::GU& u) const {
        int pm, pn;
        if (l == 0) { if (!g8::order_next(i, MR / 256, 4, pm, pn)) return false; }
        else { if (!g8::order_next(i, NB * 16, 4, pm, pn)) return false; pm = (pm >> 4) * 17 + 1 + (pm & 15); }
        u.pm = pm; u.pn = pn; u.e = 0; u.j0 = 0; u.a = O + (size_t)pm * 256 * 2048; u.b = W + (size_t)pn * 256 * 2048; return true;
    }
    DI unsigned arow(const g8::GU&, int) const { return 0u; }
};
struct EpiOut {
    float* Y;
    DI void operator()(const f32x4 (&acc)[2][2][4][2], const g8::GU& u, int wr, int wc, int fr, int fq) const {
#pragma unroll
        for (int ai = 0; ai < 2; ++ai)
#pragma unroll
            for (int bj = 0; bj < 2; ++bj)
#pragma unroll
                for (int m = 0; m < 4; ++m)
#pragma unroll
                    for (int n = 0; n < 2; ++n) {
                        const int row = u.pm * 256 + 128 * ai + 64 * wr + 16 * m + fr, col = u.pn * 256 + 128 * bj + 32 * wc + 16 * n + 4 * fq;
                        *(f32x4*)(Y + (size_t)row * DM + col) = acc[ai][bj][m][n];
                    }
    }
};
DI void phase_outproj(CParams& p, int l, char* lds) {
    SchedOut S; S.O = (const char*)p.O; S.W = (const char*)(p.WoutT + (size_t)l * DM * DM); S.l = l;
    EpiOut E; E.Y = p.Y;
    g8::gemm8<EpiOut, SchedOut, false>(lds, DM * 2, nullptr, S, E);
}

DI void phase_postmix(CParams& p, int l, char* lds) {
    const int tid = otid(), wid = tid >> 6, lane = tid & 63;
    float* WrT = (float*)lds;
    int* lcnt = (int*)(lds + 131072);
    int* lbase = lcnt + 32;
    unsigned* ent = (unsigned*)(lds + 131072 + 256);
    const int G = gridDim.x, nrb = (MR + G - 1) / G;
    const float* rw = p.router_w + (size_t)l * DM * NE;
    __syncthreads();
    for (int i = tid; i < DM * NE / 4; i += NTHREADS) {
        const f32x4 v = *(const f32x4*)(rw + i * 4);
        const int d = i >> 3, e0 = (i & 7) * 4;
#pragma unroll
        for (int j = 0; j < 4; ++j) WrT[(e0 + j) * DM + d] = v[j];
    }
    if (tid < 32) lcnt[tid] = 0;
    __syncthreads();
    const int rbeg = blockIdx.x * nrb;
    const float* lw = p.ln_mix_w + l * DM; const float* lb = p.ln_mix_b + l * DM;
    for (int i0 = wid * 2; i0 < nrb; i0 += 16) {
        f32x4 v[2][4]; bool act[2];
#pragma unroll
        for (int rr = 0; rr < 2; ++rr) {
            const int i = i0 + rr; int row = rbeg + i;
            act[rr] = (i < nrb) && (row < MR);
            if (!act[rr]) row = rbeg;
            const int t = row % TP;
            if (l == 1 && t < CTX) { if (act[rr] && lane < 4) ent[(i * 4 + lane) * 2] = 0xffffffffu; act[rr] = false; }
            const float* xr = l == 0 ? in_row(p, row) : p.X + (size_t)row * DM;
            const float* yr = p.Y + (size_t)row * DM;
            const float* g1 = mod_vec(p, l, row, 2); const float* sh2 = mod_vec(p, l, row, 3); const float* sc2 = mod_vec(p, l, row, 4);
            float s = 0.f;
#pragma unroll
            for (int j = 0; j < 4; ++j) { const int c = j * 256 + lane * 4; v[rr][j] = *(const f32x4*)(xr + c) * DN_ALPHA + *(const f32x4*)(g1 + c) * *(const f32x4*)(yr + c); s += (v[rr][j][0] + v[rr][j][1]) + (v[rr][j][2] + v[rr][j][3]); }
            float mean = wave_sum(s) * (1.f / DM); float q = 0.f;
#pragma unroll
            for (int j = 0; j < 4; ++j) { v[rr][j] = v[rr][j] - mean; q += (v[rr][j][0] * v[rr][j][0] + v[rr][j][1] * v[rr][j][1]) + (v[rr][j][2] * v[rr][j][2] + v[rr][j][3] * v[rr][j][3]); }
            float rstd = rsqrtf(wave_sum(q) * (1.f / DM) + LN_EPS);
            s = 0.f;
#pragma unroll
            for (int j = 0; j < 4; ++j) { const int c = j * 256 + lane * 4; v[rr][j] = v[rr][j] * rstd * *(const f32x4*)(lw + c) + *(const f32x4*)(lb + c);
                if (act[rr]) *(f32x4*)(p.X + (size_t)row * DM + c) = v[rr][j];
                s += (v[rr][j][0] + v[rr][j][1]) + (v[rr][j][2] + v[rr][j][3]); }
            mean = wave_sum(s) * (1.f / DM); q = 0.f;
#pragma unroll
            for (int j = 0; j < 4; ++j) { v[rr][j] = v[rr][j] - mean; q += (v[rr][j][0] * v[rr][j][0] + v[rr][j][1] * v[rr][j][1]) + (v[rr][j][2] * v[rr][j][2] + v[rr][j][3] * v[rr][j][3]); }
            rstd = rsqrtf(wave_sum(q) * (1.f / DM) + LN_EPS);
#pragma unroll
            for (int j = 0; j < 4; ++j) { const int c = j * 256 + lane * 4; v[rr][j] = v[rr][j] * rstd * (*(const f32x4*)(sc2 + c) + 1.0f) + *(const f32x4*)(sh2 + c);
                if (act[rr]) *(unsigned*)(p.H8 + (size_t)row * DM + c) = pk4_fp8(v[rr][j][0], v[rr][j][1], v[rr][j][2], v[rr][j][3]); }
            __builtin_amdgcn_sched_barrier(0);
        }
        float lq[2][4];
#pragma unroll
        for (int qt = 0; qt < 4; ++qt) {
            float pl[2][8];
#pragma unroll
            for (int e = 0; e < 8; ++e) {
                float a0 = 0.f, a1 = 0.f;
#pragma unroll
                for (int j = 0; j < 4; ++j) {
                    const f32x4 w = *(const f32x4*)(WrT + (qt * 8 + e) * DM + j * 256 + lane * 4);
                    a0 += (v[0][j][0] * w[0] + v[0][j][1] * w[1]) + (v[0][j][2] * w[2] + v[0][j][3] * w[3]);
                    a1 += (v[1][j][0] * w[0] + v[1][j][1] * w[1]) + (v[1][j][2] * w[2] + v[1][j][3] * w[3]);
                }
                pl[0][e] = a0; pl[1][e] = a1;
                if ((e & 3) == 3) __builtin_amdgcn_sched_barrier(0);
            }
#pragma unroll
            for (int rr = 0; rr < 2; ++rr) {
                float r4[4], r2[2];
#pragma unroll
                for (int e = 0; e < 4; ++e) { const bool up = (lane & 4) != 0; const float keep = up ? pl[rr][e + 4] : pl[rr][e]; const float send = up ? pl[rr][e] : pl[rr][e + 4]; r4[e] = keep + dpp<DPP_HM>(send); }
#pragma unroll
                for (int e = 0; e < 2; ++e) { const bool up = (lane & 2) != 0; const float keep = up ? r4[e + 2] : r4[e]; const float send = up ? r4[e] : r4[e + 2]; r2[e] = keep + dpp<DPP_X2>(send); }
                float x1; { const bool up = (lane & 1) != 0; const float keep = up ? r2[1] : r2[0]; const float send = up ? r2[0] : r2[1]; x1 = keep + dpp<DPP_X1>(send); }
                x1 += shx<8>(x1); x1 += shx<16>(x1); x1 = xsum32(x1);
                lq[rr][qt] = x1;
            }
            __builtin_amdgcn_sched_barrier(0);
        }
#pragma unroll
        for (int rr = 0; rr < 2; ++rr) {
            const int i = i0 + rr;
            const int e_me = lane & 31;
            const int qsel = (lane >> 3) & 3;
            float logit = (qsel == 0 ? lq[rr][0] : qsel == 1 ? lq[rr][1] : qsel == 2 ? lq[rr][2] : lq[rr][3]) + p.router_b[l * NE + e_me];
            logit = (logit == logit) ? fminf(fmaxf(logit, -1e30f), 1e30f) : -1e30f;
            int rank = 0;
#pragma unroll
            for (int e = 0; e < 32; ++e) { const float o = rdlane(logit, e); rank += (o > logit || (o == logit && e < e_me)) ? 1 : 0; }
            const float vmax = rdlane(logit, __builtin_amdgcn_readfirstlane(__ffsll((long long)__ballot(rank == 0 && lane < 32)) - 1));
            const float ex = (rank < 4) ? __expf(logit - vmax) : 0.f;
            const float den = wave_sum((lane < 32) ? ex : 0.f);
            if (act[rr] && lane < 32 && rank < 4) {
                const int lp = atomicAdd(&lcnt[e_me], 1);
                ent[(i * 4 + rank) * 2] = (unsigned)e_me | ((unsigned)lp << 8);
                ent[(i * 4 + rank) * 2 + 1] = __float_as_uint(ex / den);
            }
        }
    }
    __syncthreads();
    if (tid < 32) lbase[tid] = (int)atomicAdd(&p.gcnt[l * NE + tid], (unsigned)lcnt[tid]);
    __syncthreads();
    for (int j = tid; j < nrb * 4; j += NTHREADS) {
        const int row = rbeg + (j >> 2);
        if (row >= MR) break;
        const unsigned w = ent[j * 2];
        if (w == 0xffffffffu) continue;
        const int e = w & 255, pos = lbase[e] + (int)(w >> 8);
        p.ltok[(size_t)e * MR + pos] = row;
        p.lgate[(size_t)e * MR + pos] = __uint_as_float(ent[j * 2 + 1]);
        p.rslot[(size_t)row * 4 + (j & 3)] = (e << 24) | pos;
    }
}

DI int moe_prefix(CParams& p, int l, int* tpre  ) {
    __syncthreads();
    if (otid() == 0) {
        int acc = 0;
        for (int e = 0; e < NE; ++e) { tpre[e] = acc; acc += ((int)p.gcnt[l * NE + e] + 255) >> 8; }
        tpre[NE] = acc;
    }
    __syncthreads();
    return tpre[NE];
}
DI int moe_find(const int* tpre, int mt) { int e = 0;
#pragma unroll 1
    for (int j = 0; j < NE; ++j) if (tpre[j + 1] <= mt) e = j + 1;
    return e; }

constexpr int TPRE_OFF = 135168;
struct SchedMoe {
    const int* tpre; const unsigned* cnt; const int* ltok; const char* A; const char* W; int nN; size_t wstride;
    DI bool next(int i, g8::GU& u) const {
        int pm, pn; if (!g8::order_next(i, __builtin_amdgcn_readfirstlane(tpre[NE]), nN, pm, pn)) return false;
        const int e = __builtin_amdgcn_readfirstlane(moe_find(tpre, pm));
        u.pm = pm; u.pn = pn; u.e = e; u.j0 = __builtin_amdgcn_readfirstlane((pm - tpre[e]) * 256);
        u.a = A + (size_t)pm * 256 * 1024; u.b = W + (size_t)e * wstride + (size_t)pn * 256 * 1024; return true;
    }
    DI unsigned arow(const g8::GU& u, int r) const { const int pos = u.j0 + r; return pos < (int)cnt[u.e] ? (unsigned)ltok[(size_t)u.e * MR + pos] : 0u; }
};
struct EpiMoe1 {
    const float* b1; unsigned char* ACT;
    DI void operator()(const f32x4 (&acc)[2][2][4][2], const g8::GU& u, int wr, int wc, int fr, int fq) const {
        const float* bb1 = b1 + (size_t)u.e * 2048 + u.pn * 256 + 32 * wc + 8 * fq;
        f32x4 bias[2][2];
#pragma unroll
        for (int bj = 0; bj < 2; ++bj)
#pragma unroll
            for (int n = 0; n < 2; ++n) bias[bj][n] = *(const f32x4*)(bb1 + 128 * bj + 4 * n);
#pragma unroll
        for (int ai = 0; ai < 2; ++ai)
#pragma unroll
            for (int m = 0; m < 4; ++m) {
                const int rl = 128 * ai + 64 * wr + 16 * m + fr;
                unsigned char* arow_ = ACT + ((size_t)u.pm * 256 + rl) * 1024 + ((u.pn * 256 + 32 * wc + 8 * fq) >> 1);
#pragma unroll
                for (int bj = 0; bj < 2; ++bj) {
                    float o[4];
#pragma unroll
                    for (int n = 0; n < 2; ++n) {
                        const f32x4 hv = acc[ai][bj][m][n] + bias[bj][n];
#pragma unroll
                        for (int q = 0; q < 2; ++q) {
                            const float glu = fminf(hv[2 * q], 7.0f), lin = fminf(fmaxf(hv[2 * q + 1], -7.0f), 7.0f);
                            const float sg = __builtin_amdgcn_rcpf(1.0f + __builtin_amdgcn_exp2f(glu * (-1.702f * LOG2E)));
                            o[2 * n + q] = (glu * sg) * (lin + 1.0f);
                        }
                    }
                    *(unsigned*)(arow_ + 64 * bj) = pk4_fp8(o[0], o[1], o[2], o[3]);
                }
            }
    }
};
struct EpiMoe2 {
    const float* b2; const float* lgate; const unsigned* cnt; bf16_t* YS;
    DI void operator()(const f32x4 (&acc)[2][2][4][2], const g8::GU& u, int wr, int wc, int fr, int fq) const {
        const float* bb2 = b2 + (size_t)u.e * DM + u.pn * 256 + 32 * wc + 8 * fq;
        const int cn = (int)cnt[u.e];
        int frz = fr; asm volatile("" : "+v"(frz));
        f32x4 bias[2][2];
#pragma unroll
        for (int bj = 0; bj < 2; ++bj)
#pragma unroll
            for (int n = 0; n < 2; ++n) bias[bj][n] = *(const f32x4*)(bb2 + 128 * bj + 4 * n);
        float gate[2][4];
#pragma unroll
        for (int ai = 0; ai < 2; ++ai)
#pragma unroll
            for (int m = 0; m < 4; ++m) { const int pos = u.j0 + 128 * ai + 64 * wr + 16 * m + frz; gate[ai][m] = pos < cn ? lgate[(size_t)u.e * MR + pos] : 0.f; }
#pragma unroll
        for (int ai = 0; ai < 2; ++ai)
#pragma unroll
            for (int m = 0; m < 4; ++m) {
                const int rl = 128 * ai + 64 * wr + 16 * m + frz;
                bf16_t* yrow = YS + ((size_t)u.pm * 256 + rl) * 1024 + u.pn * 256 + 32 * wc + 8 * fq;
#pragma unroll
                for (int bj = 0; bj < 2; ++bj) {
                    const f32x4 v0 = (acc[ai][bj][m][0] + bias[bj][0]) * gate[ai][m], v1 = (acc[ai][bj][m][1] + bias[bj][1]) * gate[ai][m];
                    u32x4 w; w.x = pk2(v0[0], v0[1]); w.y = pk2(v0[2], v0[3]); w.z = pk2(v1[0], v1[1]); w.w = pk2(v1[2], v1[3]);
                    *(u32x4*)(yrow + 128 * bj) = w;
                }
            }
    }
};
DI void phase_moe1(CParams& p, int l, char* lds) {
    int* tpre = (int*)(lds + TPRE_OFF);
    moe_prefix(p, l, tpre);
    SchedMoe S; S.tpre = tpre; S.cnt = p.gcnt + l * NE; S.ltok = p.ltok; S.A = nullptr; S.W = (const char*)p.W1T + (size_t)l * NE * 2048 * DM; S.nN = 8; S.wstride = (size_t)2048 * DM;
    EpiMoe1 E; E.b1 = p.b1 + (size_t)l * NE * 2048; E.ACT = (unsigned char*)p.ACT;
    g8::gemm8<EpiMoe1, SchedMoe, true, true, false, true>(lds, DM, (const char*)p.H8, S, E, 0x7a7a7a7au);
}
DI void phase_moe2(CParams& p, int l, char* lds) {
    int* tpre = (int*)(lds + TPRE_OFF);
    moe_prefix(p, l, tpre);
    SchedMoe S; S.tpre = tpre; S.cnt = p.gcnt + l * NE; S.ltok = p.ltok; S.A = (const char*)p.ACT; S.W = (const char*)p.W2T + (size_t)l * NE * DM * DM; S.nN = 4; S.wstride = (size_t)DM * DM;
    EpiMoe2 E; E.b2 = p.b2 + (size_t)l * NE * DM; E.lgate = p.lgate; E.cnt = p.gcnt + l * NE; E.YS = p.YS;
    g8::gemm8<EpiMoe2, SchedMoe, false, true, false, true>(lds, DM, nullptr, S, E, 0x79797979u);
}

DI void phase_final(CParams& p, int l, char* lds) {
    const int tid = otid(), wid = tid >> 6, lane = tid & 63;
    int* tpre = (int*)(lds + TPRE_OFF);
    moe_prefix(p, l, tpre);
    const float* lw = p.ln_ffn_w + l * DM; const float* lb = p.ln_ffn_b + l * DM;
    const int nrows = l == 1 ? NB * SEQ : MR;
    const int stride = gridDim.x * 8;
    for (int idx0 = blockIdx.x * 8 + wid; idx0 < nrows; idx0 += 2 * stride) {
        int row[2]; bool act[2];
#pragma unroll
        for (int rr = 0; rr < 2; ++rr) {
            int idx = idx0 + rr * stride; act[rr] = idx < nrows; if (!act[rr]) idx = idx0;
            row[rr] = l == 1 ? (idx >> 12) * TP + CTX + (idx & 4095) : idx;
        }
        const bf16_t* ys[2][4];
#pragma unroll
        for (int rr = 0; rr < 2; ++rr)
#pragma unroll
            for (int k = 0; k < 4; ++k) { const int rs = p.rslot[(size_t)row[rr] * 4 + k]; const int e = rs >> 24, pos = rs & 0xffffff; ys[rr][k] = p.YS + ((size_t)tpre[e] * 256 + pos) * 1024; }
        f32x4 v[2][4]; float s[2] = {0.f, 0.f};
#pragma unroll
        for (int rr = 0; rr < 2; ++rr) {
            const float* g2 = mod_vec(p, l, row[rr], 5);
#pragma unroll
            for (int j = 0; j < 4; ++j) {
                const int c = j * 256 + lane * 4;
                f32x4 y = zero4();
#pragma unroll
                for (int k = 0; k < 4; ++k) { const u32x2 w = *(const u32x2*)(ys[rr][k] + c); y[0] += lo2f(w.x); y[1] += hi2f(w.x); y[2] += lo2f(w.y); y[3] += hi2f(w.y); }
                const f32x4 xv = *(const f32x4*)(p.X + (size_t)row[rr] * DM + c), gg = *(const f32x4*)(g2 + c);
                v[rr][j] = xv * DN_ALPHA + gg * y;
                s[rr] += (v[rr][j][0] + v[rr][j][1]) + (v[rr][j][2] + v[rr][j][3]);
            }
        }
#pragma unroll
        for (int rr = 0; rr < 2; ++rr) {
            float mean = wave_sum(s[rr]) * (1.f / DM); float q = 0.f;
#pragma unroll
            for (int j = 0; j < 4; ++j) { v[rr][j] = v[rr][j] - mean; q += (v[rr][j][0] * v[rr][j][0] + v[rr][j][1] * v[rr][j][1]) + (v[rr][j][2] * v[rr][j][2] + v[rr][j][3] * v[rr][j][3]); }
            float rstd = rsqrtf(wave_sum(q) * (1.f / DM) + LN_EPS);
            float s2 = 0.f;
#pragma unroll
            for (int j = 0; j < 4; ++j) {
                const int c = j * 256 + lane * 4;
                v[rr][j] = v[rr][j] * rstd * *(const f32x4*)(lw + c) + *(const f32x4*)(lb + c);
                s2 += (v[rr][j][0] + v[rr][j][1]) + (v[rr][j][2] + v[rr][j][3]);
            }
            if (!act[rr]) continue;
            if (l == 1) {
                const int b = row[rr] / TP, t = row[rr] - b * TP;
                float* o = p.out + ((size_t)b * SEQ + (t - CTX)) * DM;
#pragma unroll
                for (int j = 0; j < 4; ++j) *(f32x4*)(o + j * 256 + lane * 4) = v[rr][j];
            } else {
#pragma unroll
                for (int j = 0; j < 4; ++j) *(f32x4*)(p.X + (size_t)row[rr] * DM + j * 256 + lane * 4) = v[rr][j];
                mean = wave_sum(s2) * (1.f / DM); q = 0.f;
#pragma unroll
                for (int j = 0; j < 4; ++j) { v[rr][j] = v[rr][j] - mean; q += (v[rr][j][0] * v[rr][j][0] + v[rr][j][1] * v[rr][j][1]) + (v[rr][j][2] * v[rr][j][2] + v[rr][j][3] * v[rr][j][3]); }
                rstd = rsqrtf(wave_sum(q) * (1.f / DM) + LN_EPS);
                const float* sh = mod_vec(p, 1, row[rr], 0); const float* sc = mod_vec(p, 1, row[rr], 1);
#pragma unroll
                for (int j = 0; j < 4; ++j) {
                    const int c = j * 256 + lane * 4;
                    const f32x4 h = v[rr][j] * rstd * (*(const f32x4*)(sc + c) + 1.0f) + *(const f32x4*)(sh + c);
                    *(unsigned*)(p.H8 + (size_t)row[rr] * DM + c) = pk4_fp8(h[0], h[1], h[2], h[3]);
                }
            }
        }
    }
}

constexpr int PH_PER_LAYER = 11, N_PHASES = 1 + 2 * PH_PER_LAYER;

__global__ void __launch_bounds__(NTHREADS, 2) mega(Params p_unused, int ph_lo, int ph_hi) {
    extern __shared__ __attribute__((aligned(16))) char smem[];
    CParams* kp0 = (CParams*)__builtin_amdgcn_kernarg_segment_ptr();
    CParams& p = *kp0;
    ((volatile int*)(smem + WVTAB_OFF))[hw_slot()] = (int)(threadIdx.x >> 6);
    __syncthreads();
    const bool fused = (ph_hi - ph_lo) > 1;
    XcdBarrier bar; bar.bar = p.bar; bar.x = 0; bar.st = (volatile LAS unsigned*)(smem + LDS_BYTES - 16);
    if (fused) {
        if (otid() == 0) *(uint4*)(smem + LDS_BYTES - 16) = make_uint4(0u, 0u, 0u, 0u);
        __syncthreads();
        bar = xcd_barrier_post(p.bar, (volatile LAS unsigned*)(smem + LDS_BYTES - 16));
    }
#if MK_DEBUG == 2
#define PH_STAMP(i) if (blockIdx.x == 0 && threadIdx.x == 0) ((unsigned long long*)(p.gcnt + 1024))[(i) + 1] = wall_clock64();
#else
#define PH_STAMP(i)
#endif
#ifndef MK_REP
#define MK_REP 0u
#endif
#define PH(idx, call) do { const int _i = (idx); if (ph_lo <= _i && _i < ph_hi) { CParams* _kp = kp0; asm volatile("" : "+s"(_kp)); CParams& p = *_kp; call; if ((MK_REP >> (_i == 0 ? 0 : 1 + (_i - 1) % 11)) & 1u) { xcd_barrier(bar); h2skip = true; call; h2skip = false; } if (_i + 1 < ph_hi) xcd_barrier(bar); PH_STAMP(_i) } } while (0)
    bool h2skip = false;
    PH_STAMP(-1)
    PH(0, phase_prologue(p, smem));
#pragma unroll 1
    for (int l = 0; l < 2; ++l) {
        const int base = 1 + l * PH_PER_LAYER;
        PH(base + 0, if (l == 0) phase_ln1(p, smem));
        PH(base + 1, phase_inproj(p, l, smem));
        PH(base + 2, phase_sgu_prep(p, l, smem));
        PH(base + 3, phase_upproj_h1(p, l, smem));
        PH(base + 4, phase_attn_diff_h2(p, l, smem, h2skip));
        PH(base + 5, phase_attn_mla_h3(p, l, smem));
        PH(base + 6, phase_outproj(p, l, smem));
        PH(base + 7, phase_postmix(p, l, smem));
        PH(base + 8, phase_moe1(p, l, smem));
        PH(base + 9, phase_moe2(p, l, smem));
        PH(base + 10, phase_final(p, l, smem));
    }
#undef PH
}


#ifndef MK_DEBUG
#define MK_DEBUG 0
#define MK_REP 0u
#endif
#if MK_DEBUG
struct DbgItem { const void* ptr; unsigned long long n; int f32; int ld; int c0; int c1; int mode; int pad; };
struct DbgList { DbgItem it[40]; int count; int pad; };
__global__ void dbg_scan(DbgList L, unsigned* flag) {
    for (int i = 0; i < L.count; ++i) {
        const DbgItem d = L.it[i];
        bool bad = false;
        for (unsigned long long e = (unsigned long long)blockIdx.x * blockDim.x + threadIdx.x; e < d.n; e += (unsigned long long)gridDim.x * blockDim.x) {
            if (d.ld > 0) { const int c = (int)(e % d.ld); if (c < d.c0 || c >= d.c1) continue; }
            if (d.f32) { const unsigned u = ((const unsigned*)d.ptr)[e]; if (((d.mode & 1) && (u & 0x7f800000u) == 0x7f800000u) || ((d.mode & 2) && u == 0xAAAAAAAAu) || ((d.mode & 4) && (u & 0x7f800000u) >= 0x46800000u)) bad = true; }
            else { const unsigned short u = ((const unsigned short*)d.ptr)[e]; if (((d.mode & 1) && (u & 0x7f80u) == 0x7f80u) || ((d.mode & 2) && u == 0xAAAAu) || ((d.mode & 4) && (u & 0x7f80u) >= 0x4680u)) bad = true; }
        }
        if (bad) atomicMin(flag, (unsigned)i);
    }
}
__global__ void dbg_time(float* out, unsigned long long n, const unsigned long long* ts, unsigned maskA, unsigned maskB) {
    float ta = 0.f, tb = 0.f;
    for (int i = 0; i < 23; ++i) { const float d = (float)(ts[i + 1] - ts[i]) * 0.01f; const int cls = i == 0 ? 0 : 1 + (i - 1) % 11; if (maskA >> cls & 1) ta += d; if (maskB >> cls & 1) tb += d; }
    for (unsigned long long e = (unsigned long long)blockIdx.x * blockDim.x + threadIdx.x; e < n; e += (unsigned long long)gridDim.x * blockDim.x) out[e] = e == 0 ? ta : tb;
}
__global__ void dbg_fill(float* out, unsigned long long n, const unsigned* flag, float hostcode) {
    const unsigned f = *flag;
    float v = f < 1000u ? 100.0f * (float)(f + 1u) : 0.0f;
    if (hostcode != 0.f) v = hostcode;
    for (unsigned long long e = (unsigned long long)blockIdx.x * blockDim.x + threadIdx.x; e < n; e += (unsigned long long)gridDim.x * blockDim.x) out[e] = v;
}
#endif

#ifndef MK_MULTI
#define MK_MULTI 0
#endif

extern "C" void kernel_launch(void* const* d_in, const int* in_sizes, int n_in, void* d_out, int out_size, void* d_ws, size_t ws_size, hipStream_t stream) {
    (void)in_sizes; (void)n_in; (void)out_size; (void)ws_size;
    Params p;
    memset(&p, 0, sizeof(p));
    const float* const* in = (const float* const*)d_in;
    p.x = in[0]; p.c = in[1]; p.ctx = in[2]; p.c_ctx = in[3]; p.ada_w = in[4]; p.ada_b = in[5]; p.w_in = in[6]; p.w_out = in[7];
    p.sgu_ln_w = in[8]; p.sgu_ln_b = in[9]; p.sgu_w = in[10]; p.sgu_b = in[11]; p.diff_lambda = in[12]; p.diff_subln_w = in[13];
    p.hgrn_lb = in[14]; p.hgrn_norm_w = in[15]; p.mla_q_norm_w = in[16]; p.mla_w_uq = in[17]; p.mla_kv_norm_w = in[18]; p.mla_w_ukv = in[19];
    p.ln_mix_w = in[20]; p.ln_mix_b = in[21]; p.ln_ffn_w = in[22]; p.ln_ffn_b = in[23]; p.router_w = in[24]; p.router_b = in[25];
    p.w1 = in[26]; p.b1 = in[27]; p.w2 = in[28]; p.b2 = in[29];
    p.out = (float*)d_out;
    char* ws = (char*)d_ws; size_t off = 0;
    auto take = [&](size_t bytes) { char* r = ws + off; off += (bytes + 255) & ~(size_t)255; return r; };
    constexpr size_t CTRL_BYTES = 65536;
    char* ctrl = take(CTRL_BYTES);
    p.bar = (unsigned*)ctrl; p.gcnt = (unsigned*)(ctrl + 16384);
    p.mod = (float*)take((size_t)2 * 9 * 6144 * 4); p.lball = (float*)take(2 * 512 * 4); p.lam = (float*)take(256); p.ropec = (float*)take(512 * 4); p.ropes = (float*)take(512 * 4);
    p.WinT = (bf16_t*)take((size_t)2 * NINP * DM * 2); p.WoutT = (bf16_t*)take((size_t)2 * DM * DM * 2);
    p.WuqT = (bf16_t*)take((size_t)2 * 384 * 256 * 2); p.WukvT = (bf16_t*)take((size_t)2 * 512 * 128 * 2);
    p.W1T = (bf16_t*)take((size_t)2 * NE * 2048 * DM * 2); p.W2T = (bf16_t*)take((size_t)2 * NE * DM * DM * 2);
    p.X = (float*)take((size_t)MR * DM * 4); p.H = (bf16_t*)take((size_t)MR * DM * 2); p.H8 = (unsigned char*)take((size_t)MR * DM);
    p.Puv = (bf16_t*)take((size_t)MR * 512 * 2); p.Qd = (bf16_t*)take((size_t)MR * 256 * 2); p.Kd = (bf16_t*)take((size_t)MR * 256 * 2); p.Vdt = (bf16_t*)take((size_t)MR * 256 * 2);
    p.Hq = (bf16_t*)take((size_t)MR * 256 * 2); p.Vht = (bf16_t*)take((size_t)MR * 256 * 2); p.Lf = (bf16_t*)take((size_t)2 * MR * 256 * 2); p.Hg = (bf16_t*)take((size_t)MR * 256 * 2);
    p.Cq = (bf16_t*)take((size_t)MR * 256 * 2); p.Ckv = (bf16_t*)take((size_t)MR * 128 * 2); p.Kr = (bf16_t*)take((size_t)MR * 32 * 2);
    p.Qm = (bf16_t*)take((size_t)MR * 384 * 2); p.Kn = (bf16_t*)take((size_t)MR * 256 * 2); p.Vmt = (bf16_t*)take((size_t)MR * 256 * 2);
    p.O = (bf16_t*)take((size_t)MR * DM * 2);
    p.RS = (float*)take((size_t)MR * 2 * 4); p.DST = (bf16_t*)take((size_t)NB * 4 * 2 * NCH * 4096 * 2); p.DEC = (float*)take((size_t)NB * 4 * 2 * NCH * 64 * 4);
    p.Y = (float*)take((size_t)MR * DM * 4);
    p.ltok = (int*)take((size_t)NE * MR * 4); p.lgate = (float*)take((size_t)NE * MR * 4); p.rslot = (int*)take((size_t)MR * 4 * 4);
    p.ACT = (bf16_t*)take((size_t)NSLOT * 1024 * 2); p.YS = (bf16_t*)take((size_t)NSLOT * 1024 * 2);

    static int grid = 0;
    if (!grid) {
        int dev = 0, cus = 0, per_cu = 0;
        hipGetDevice(&dev);
        hipDeviceGetAttribute(&cus, hipDeviceAttributeMultiprocessorCount, dev);
        hipFuncSetAttribute((const void*)mega, hipFuncAttributeMaxDynamicSharedMemorySize, LDS_BYTES);
        hipOccupancyMaxActiveBlocksPerMultiprocessor(&per_cu, mega, NTHREADS, LDS_BYTES);
        if (cus <= 0) cus = 256;
        grid = cus * (per_cu < 1 ? 1 : 1);
    }
    hipMemsetAsync(ctrl, 0, CTRL_BYTES, stream);
#if MK_MULTI
#ifndef MK_NPH
#define MK_NPH N_PHASES
#endif
    for (int ph = 0; ph < MK_NPH; ++ph) {
        if (ph == 1 + PH_PER_LAYER) continue;
        hipLaunchKernelGGL(mega, dim3(grid), dim3(NTHREADS), LDS_BYTES, stream, p, ph, ph + 1);
    }
#else
    hipLaunchKernelGGL(mega, dim3(grid), dim3(NTHREADS), LDS_BYTES, stream, p, 0, N_PHASES);
#endif

#if MK_DEBUG == 2
    hipLaunchKernelGGL(dbg_time, dim3(2048), dim3(256), 0, stream, (float*)d_out, (unsigned long long)NB * SEQ * DM, (const unsigned long long*)(p.gcnt + 1024), (unsigned)MK_TMASK_A, (unsigned)MK_TMASK_B);
#elif MK_DEBUG
    {
        DbgList L; memset(&L, 0, sizeof(L));
        int n = 0;
        auto add = [&](const void* ptr, unsigned long long cnt, int f32, int ld = 0, int c0 = 0, int c1 = 0, int mode = 3) { L.it[n].ptr = ptr; L.it[n].n = cnt; L.it[n].f32 = f32; L.it[n].ld = ld; L.it[n].c0 = c0; L.it[n].c1 = c1; L.it[n].mode = mode; ++n; };
        MK_DEBUG_LIST
        L.count = n;
        unsigned* flag = (unsigned*)(ctrl + 32768);
        hipMemsetAsync(flag, 0x7f, 4, stream);
        hipLaunchKernelGGL(dbg_scan, dim3(2048), dim3(256), 0, stream, L, flag);
        hipLaunchKernelGGL(dbg_fill, dim3(2048), dim3(256), 0, stream, (float*)d_out, (unsigned long long)NB * SEQ * DM, (const unsigned*)flag, 0.0f);
    }
#endif
}
```
